# Optimizing an MI355X kernel written in HIP

```python
import math
import jax, jax.numpy as jnp
from jax import lax
import numpy as np

D_MODEL = 1024
BATCH = 4
SEQ = 8192
DEPTH = 1

GRID_W = 64
CTX_LEN = 256
HEAD_DIM = 64
N_HEADS_DIFF = D_MODEL // (4 * HEAD_DIM)
N_HEADS_NA = D_MODEL // (2 * HEAD_DIM)
DIFF_WIDTH = N_HEADS_DIFF * 2 * HEAD_DIM
NA_WIDTH = N_HEADS_NA * HEAD_DIM
MIX_WIDTH = DIFF_WIDTH + NA_WIDTH
NA_ROWS_MAX = 8
NA_COLS = 16
ROPE_BASE = 10000.0
ROPE_FREQS = HEAD_DIM // 4
Q_BLOCK = 128
N_EXPERTS = 32
TOP_K = 4
D_FF = D_MODEL
SWIGLU_ALPHA = 1.702
SWIGLU_LIMIT = 7.0
EXPERT_BLOCK = 256
NORM_EPS = 1e-6

kernel_name = 'hybrid_diffattn_natten_moe_dit_layer'


def rms_norm(x, g):
    xf = x.astype(jnp.float32)
    y = xf * lax.rsqrt(jnp.mean(xf * xf, axis=-1, keepdims=True) + NORM_EPS)
    return (y * g.astype(jnp.float32)).astype(x.dtype)


def modulate(h, shift, scale):
    return h * (1.0 + scale) + shift


def adaln(cv, w_ada, b_ada):
    return (jax.nn.silu(cv) @ w_ada + b_ada).reshape(cv.shape[0], 6, -1)


def axial_rope_tables(row, col):
    inv = 1.0 / (ROPE_BASE ** (jnp.arange(ROPE_FREQS, dtype=jnp.float32) / ROPE_FREQS))
    ang_r = row.astype(jnp.float32)[:, None] * inv
    ang_c = col.astype(jnp.float32)[:, None] * inv
    return (jnp.cos(ang_r), jnp.sin(ang_r), jnp.cos(ang_c), jnp.sin(ang_c))


def _rotate(x, cos, sin):
    x1, x2 = x[..., :ROPE_FREQS], x[..., ROPE_FREQS:]
    return jnp.concatenate([x1 * cos - x2 * sin, x2 * cos + x1 * sin], axis=-1)


def apply_axial_rope(x, tables):
    cr, sr, cc, sc = [t.reshape((t.shape[0],) + (1,) * (x.ndim - 3) + (ROPE_FREQS,)) for t in tables]
    half = HEAD_DIM // 2
    out = jnp.concatenate([_rotate(x[..., :half], cr, sr), _rotate(x[..., half:], cc, sc)], axis=-1)
    return out.astype(x.dtype)


def project_heads(h, w_in, qn_d, kn_d, qn_n, kn_n):
    p = h @ w_in
    bn, n = p.shape[:2]
    cuts = [DIFF_WIDTH, 2 * DIFF_WIDTH, 3 * DIFF_WIDTH, 3 * DIFF_WIDTH + NA_WIDTH, 3 * DIFF_WIDTH + 2 * NA_WIDTH]
    qd, kd, vd, qn, kn, vn = jnp.split(p, cuts, axis=-1)
    qd = rms_norm(qd.reshape(bn, n, N_HEADS_DIFF, 2, HEAD_DIM), qn_d)
    kd = rms_norm(kd.reshape(bn, n, N_HEADS_DIFF, 2, HEAD_DIM), kn_d)
    vd = vd.reshape(bn, n, N_HEADS_DIFF, 2 * HEAD_DIM)
    qn = rms_norm(qn.reshape(bn, n, N_HEADS_NA, HEAD_DIM), qn_n)
    kn = rms_norm(kn.reshape(bn, n, N_HEADS_NA, HEAD_DIM), kn_n)
    vn = vn.reshape(bn, n, N_HEADS_NA, HEAD_DIM)
    return qd, kd, vd, qn, kn, vn


def diff_attend(q, k, v, lam):
    s = jnp.einsum('bqhmd,bkhmd->bhmqk', q, k).astype(jnp.float32) * (HEAD_DIM ** -0.5)
    p = jax.nn.softmax(s, axis=-1).astype(v.dtype)
    o = jnp.einsum('bhmqk,bkhe->bqhme', p, v)
    return o[:, :, :, 0] - lam.astype(o.dtype) * o[:, :, :, 1]


def diff_attention_blocks(q, k, v, lam):
    b, s = q.shape[:2]
    nb = s // Q_BLOCK
    qb = q.reshape(b, nb, Q_BLOCK, N_HEADS_DIFF, 2, HEAD_DIM).swapaxes(0, 1)
    out = lax.map(lambda qq: diff_attend(qq, k, v, lam), qb)
    return out.swapaxes(0, 1).reshape(b, s, N_HEADS_DIFF, 2 * HEAD_DIM)


def softmax_attention(q, k, v):
    s = jnp.einsum('bqhd,bkhd->bhqk', q, k).astype(jnp.float32) * (HEAD_DIM ** -0.5)
    p = jax.nn.softmax(s, axis=-1).astype(v.dtype)
    return jnp.einsum('bhqk,bkhd->bqhd', p, v)


def neighbourhood_attention(q, k, v, k_ctx, v_ctx, rpb, rows_n):
    b, s, h, dh = q.shape
    kr = min(NA_ROWS_MAX, rows_n)
    kc = NA_COLS
    qg = q.reshape(b, rows_n, GRID_W, h, dh).swapaxes(0, 1)
    kg = k.reshape(b, rows_n, GRID_W, h, dh)
    vg = v.reshape(b, rows_n, GRID_W, h, dh)
    cols = jnp.arange(GRID_W)
    col_start = jnp.clip(cols - kc // 2, 0, GRID_W - kc)
    col_idx = col_start[:, None] + jnp.arange(kc)[None, :]
    col_bias_idx = col_idx - cols[:, None] + (NA_COLS - 1)
    scale = HEAD_DIM ** -0.5

    def row_block(args):
        r, q_r = args
        r0 = jnp.clip(r - kr // 2, 0, rows_n - kr)
        k_rows = lax.dynamic_slice_in_dim(kg, r0, kr, axis=1)
        v_rows = lax.dynamic_slice_in_dim(vg, r0, kr, axis=1)
        k_win = k_rows[:, :, col_idx]
        v_win = v_rows[:, :, col_idx]
        row_bias_idx = r0 + jnp.arange(kr) - r + (NA_ROWS_MAX - 1)
        bias = rpb[:, row_bias_idx][:, :, col_bias_idx]
        s_lat = jnp.einsum('bwhd,brwkhd->bhwrk', q_r, k_win).astype(jnp.float32) * scale
        s_lat = s_lat + bias.transpose(0, 2, 1, 3)[None].astype(jnp.float32)
        s_ctx = jnp.einsum('bwhd,bchd->bhwc', q_r, k_ctx).astype(jnp.float32) * scale
        sc = jnp.concatenate([s_lat.reshape(b, h, GRID_W, kr * kc), s_ctx], axis=-1)
        p = jax.nn.softmax(sc, axis=-1).astype(v.dtype)
        p_lat = p[..., :kr * kc].reshape(b, h, GRID_W, kr, kc)
        p_ctx = p[..., kr * kc:]
        return (jnp.einsum('bhwrk,brwkhd->bwhd', p_lat, v_win)
                + jnp.einsum('bhwc,bchd->bwhd', p_ctx, v_ctx))

    out = lax.map(row_block, (jnp.arange(rows_n), qg))
    return out.swapaxes(0, 1).reshape(b, s, h, dh)


def routed_swiglu_moe(h, w_router, b_router, w_gate_up, b_gate_up, w_down, b_down):
    t, d = h.shape
    logits = (h @ w_router + b_router).astype(jnp.float32)
    top_vals, top_idx = lax.top_k(logits, TOP_K)
    gates = jax.nn.softmax(top_vals, axis=-1)
    n_assign = t * TOP_K
    e_flat = top_idx.reshape(-1)
    order = jnp.argsort(e_flat)
    e_sorted = e_flat[order]
    tok_sorted = order // TOP_K
    gate_sorted = gates.reshape(-1)[order]
    counts = jnp.bincount(e_flat, length=N_EXPERTS)
    starts = jnp.cumsum(counts) - counts
    padded = (counts + EXPERT_BLOCK - 1) // EXPERT_BLOCK * EXPERT_BLOCK
    pad_ends = jnp.cumsum(padded)
    pad_starts = pad_ends - padded
    dest = pad_starts[e_sorted] + jnp.arange(n_assign) - starts[e_sorted]
    n_blocks = -(-n_assign // EXPERT_BLOCK) + N_EXPERTS
    buf = jnp.zeros((n_blocks * EXPERT_BLOCK, d), h.dtype).at[dest].set(h[tok_sorted])
    block_expert = jnp.minimum(
        jnp.searchsorted(pad_ends, jnp.arange(n_blocks) * EXPERT_BLOCK, side='right'), N_EXPERTS - 1)

    def expert_block(args):
        xb, e = args
        gu = xb @ w_gate_up[e] + b_gate_up[e]
        glu = jnp.minimum(gu[:, :D_FF], SWIGLU_LIMIT)
        lin = jnp.clip(gu[:, D_FF:], -SWIGLU_LIMIT, SWIGLU_LIMIT)
        act = glu * jax.nn.sigmoid(SWIGLU_ALPHA * glu) * (lin + 1.0)
        return act @ w_down[e] + b_down[e]

    ys = lax.map(expert_block, (buf.reshape(n_blocks, EXPERT_BLOCK, d), block_expert)).reshape(-1, d)
    contrib = ys[dest] * gate_sorted[:, None].astype(ys.dtype)
    return jax.ops.segment_sum(contrib, tok_sorted, num_segments=t)


def hybrid_layer(x, ctx, c, c_ctx, lp, layer_idx, rope, rows_n, update_ctx):
    b, s, d = x.shape
    mod = adaln(c, lp['w_ada'], lp['b_ada'])
    mod_c = adaln(c_ctx[None, :], lp['w_ada'], lp['b_ada'])
    sh1, sc1, g1, sh2, sc2, g2 = [mod[:, i][:, None, :] for i in range(6)]
    sh1c, sc1c, g1c, sh2c, sc2c, g2c = [mod_c[:, i][:, None, :] for i in range(6)]

    h_lat = modulate(rms_norm(x, lp['g_attn']), sh1, sc1)
    h_ctx = modulate(rms_norm(ctx, lp['g_attn']), sh1c, sc1c)
    norms = (lp['q_norm_diff'], lp['k_norm_diff'], lp['q_norm_na'], lp['k_norm_na'])
    qd, kd, vd, qn, kn, vn = project_heads(h_lat, lp['w_in'], *norms)
    qd_c, kd_c, vd_c, qn_c, kn_c, vn_c = project_heads(h_ctx, lp['w_in'], *norms)
    qd = apply_axial_rope(qd, rope)
    kd = apply_axial_rope(kd, rope)

    lam_init = 0.8 - 0.6 * math.exp(-0.3 * layer_idx)
    lam = (jnp.exp(jnp.sum(lp['lam_q1'].astype(jnp.float32) * lp['lam_k1'].astype(jnp.float32)))
           - jnp.exp(jnp.sum(lp['lam_q2'].astype(jnp.float32) * lp['lam_k2'].astype(jnp.float32)))
           + lam_init)

    kd_all = jnp.concatenate([kd, kd_c], axis=1)
    vd_all = jnp.concatenate([vd, vd_c], axis=1)
    o_diff = rms_norm(diff_attention_blocks(qd, kd_all, vd_all, lam), lp['subln_diff']) * (1.0 - lam_init)
    o_na = neighbourhood_attention(qn, kn, vn, kn_c, vn_c, lp['rpb_na'], rows_n)
    o_na = rms_norm(o_na, lp['out_norm_na'].reshape(N_HEADS_NA, HEAD_DIM))
    mix = jnp.concatenate([o_diff.reshape(b, s, DIFF_WIDTH), o_na.reshape(b, s, NA_WIDTH)], axis=-1)
    x = x + g1 * (mix @ lp['w_out'])

    moe_w = (lp['w_router'], lp['b_router'], lp['w_gate_up'], lp['b_gate_up'], lp['w_down'], lp['b_down'])
    h2 = modulate(rms_norm(x, lp['g_ffn']), sh2, sc2)
    x = x + g2 * routed_swiglu_moe(h2.reshape(-1, d), *moe_w).reshape(b, s, d)

    if update_ctx:
        oc_diff = rms_norm(diff_attend(qd_c, kd_c, vd_c, lam), lp['subln_diff']) * (1.0 - lam_init)
        oc_na = rms_norm(softmax_attention(qn_c, kn_c, vn_c), lp['out_norm_na'].reshape(N_HEADS_NA, HEAD_DIM))
        bc, nc = ctx.shape[:2]
        mix_c = jnp.concatenate([oc_diff.reshape(bc, nc, DIFF_WIDTH), oc_na.reshape(bc, nc, NA_WIDTH)], axis=-1)
        ctx = ctx + g1c * (mix_c @ lp['w_out'])
        h2c = modulate(rms_norm(ctx, lp['g_ffn']), sh2c, sc2c)
        ctx = ctx + g2c * routed_swiglu_moe(h2c.reshape(-1, d), *moe_w).reshape(ctx.shape)
    return x, ctx


def setup_inputs(seed: int = 0) -> dict:
    key = jax.random.key(seed)
    ks = jax.random.split(key, 32)
    f32 = jnp.float32
    nrm = lambda k, shape, sc: jax.random.normal(k, shape, f32) * sc
    L, D, E, F = DEPTH, D_MODEL, N_EXPERTS, D_FF
    return {
        'x': nrm(ks[0], (BATCH, SEQ, D), 1.0),
        'c': nrm(ks[1], (BATCH, D), 1.0),
        'ctx': nrm(ks[2], (BATCH, CTX_LEN, D), 1.0),
        'c_ctx': nrm(ks[3], (D,), 1.0),
        'w_ada': nrm(ks[4], (L, D, 6 * D), 0.5 * D ** -0.5),
        'b_ada': nrm(ks[5], (L, 6 * D), 0.01),
        'g_attn': 1.0 + nrm(ks[6], (L, D), 0.05),
        'w_in': nrm(ks[7], (L, D, 3 * MIX_WIDTH), D ** -0.5),
        'q_norm_diff': 1.0 + nrm(ks[8], (L, HEAD_DIM), 0.05),
        'k_norm_diff': 1.0 + nrm(ks[9], (L, HEAD_DIM), 0.05),
        'lam_q1': nrm(ks[10], (L, HEAD_DIM), 0.1),
        'lam_k1': nrm(ks[11], (L, HEAD_DIM), 0.1),
        'lam_q2': nrm(ks[12], (L, HEAD_DIM), 0.1),
        'lam_k2': nrm(ks[13], (L, HEAD_DIM), 0.1),
        'subln_diff': 1.0 + nrm(ks[14], (L, 2 * HEAD_DIM), 0.05),
        'q_norm_na': 1.0 + nrm(ks[15], (L, HEAD_DIM), 0.05),
        'k_norm_na': 1.0 + nrm(ks[16], (L, HEAD_DIM), 0.05),
        'rpb_na': nrm(ks[17], (L, N_HEADS_NA, 2 * NA_ROWS_MAX - 1, 2 * NA_COLS - 1), 0.1),
        'out_norm_na': 1.0 + nrm(ks[18], (L, NA_WIDTH), 0.05),
        'w_out': nrm(ks[19], (L, MIX_WIDTH, D), MIX_WIDTH ** -0.5),
        'g_ffn': 1.0 + nrm(ks[20], (L, D), 0.05),
        'w_router': nrm(ks[21], (L, D, E), D ** -0.5),
        'b_router': nrm(ks[22], (L, E), 0.01),
        'w_gate_up': nrm(ks[23], (L, E, D, 2 * F), D ** -0.5),
        'b_gate_up': nrm(ks[24], (L, E, 2 * F), 0.01),
        'w_down': nrm(ks[25], (L, E, F, D), F ** -0.5),
        'b_down': nrm(ks[26], (L, E, D), 0.01),
    }


def reference(x, c, ctx, c_ctx, w_ada, b_ada, g_attn, w_in, q_norm_diff, k_norm_diff,
              lam_q1, lam_k1, lam_q2, lam_k2, subln_diff, q_norm_na, k_norm_na, rpb_na,
              out_norm_na, w_out, g_ffn, w_router, b_router, w_gate_up, b_gate_up, w_down, b_down):
    s = x.shape[1]
    rows_n = s // GRID_W
    pos = jnp.arange(s, dtype=jnp.int32)
    rope = axial_rope_tables(pos // GRID_W, pos % GRID_W)
    for l in range(DEPTH):
        lp = {
            'w_ada': w_ada[l], 'b_ada': b_ada[l], 'g_attn': g_attn[l], 'w_in': w_in[l],
            'q_norm_diff': q_norm_diff[l], 'k_norm_diff': k_norm_diff[l],
            'lam_q1': lam_q1[l], 'lam_k1': lam_k1[l], 'lam_q2': lam_q2[l], 'lam_k2': lam_k2[l],
            'subln_diff': subln_diff[l], 'q_norm_na': q_norm_na[l], 'k_norm_na': k_norm_na[l],
            'rpb_na': rpb_na[l], 'out_norm_na': out_norm_na[l], 'w_out': w_out[l], 'g_ffn': g_ffn[l],
            'w_router': w_router[l], 'b_router': b_router[l], 'w_gate_up': w_gate_up[l],
            'b_gate_up': b_gate_up[l], 'w_down': w_down[l], 'b_down': b_down[l],
        }
        x, ctx = hybrid_layer(x, ctx, c, c_ctx, lp, l, rope, rows_n, l < DEPTH - 1)
    return x
```

```cpp
#include <hip/hip_runtime.h>
#include <hip/hip_cooperative_groups.h>
#include <cstdio>
#include <cstdint>
namespace cg = cooperative_groups;
namespace pg8 {
#define PG8_LAS __attribute__((address_space(3)))
typedef unsigned short bf16_t;
typedef short bf16x8 __attribute__((ext_vector_type(8)));
typedef float f32x4 __attribute__((ext_vector_type(4)));
typedef unsigned u32x4 __attribute__((ext_vector_type(4)));
constexpr int BM = 256, BK = 64, HALF = 128, HTB = HALF * BK * 2  , STAGE_BYTES = 8 * HTB, NXCD = 8, WGM = 8;

__host__ __device__ __forceinline__ int lds_byte(int r, int c) { const int st = (r >> 4) * 2 + (c >> 5), rr = r & 15, cc = c & 31, ob = rr * 64 + cc * 2; return st * 1024 + (ob ^ (((ob >> 9) & 1) << 5)); }
__host__ __device__ __forceinline__ void stage_rc(int b, int& R, int& C) { const int st = b / 1024, sb = b % 1024, swz = sb ^ (((sb >> 9) & 1) << 5); R = (st >> 1) * 16 + swz / 64; C = (st & 1) * 32 + (swz % 64) / 2; }
__host__ __device__ __forceinline__ int perm32(int rho) { const int n = rho >> 4, i = rho & 15; return 8 * (i >> 2) + 4 * n + (i & 3); }

struct Unit { int pm, pn, e; };
struct Gemm { const bf16_t* A; const bf16_t* Bt; int M, N, K; size_t estride; };

struct StaticOrder {
    int nM, nN, nwg, G, c;
    __host__ __device__ void init(int M, int N, int G_, int c_) { nM = M / BM; nN = N / BM; nwg = nM * nN; G = G_; c = c_; }
    __host__ __device__ bool next(int i, Unit& u) const {
        const long L = (long)i * G + c; if (L >= nwg) return false;
        int wgid = (int)L; { const int q = nwg / NXCD, r = nwg % NXCD, xcd = wgid % NXCD, off = wgid / NXCD; wgid = (xcd < r ? xcd * (q + 1) : r * (q + 1) + (xcd - r) * q) + off; }
        const int nig = WGM * nN, gid = wgid / nig, fm = gid * WGM, gsz = (nM - fm) < WGM ? (nM - fm) : WGM;
        u.pm = fm + ((wgid % nig) % gsz); u.pn = (wgid % nig) / gsz; u.e = 0; return true;
    }
    __device__ __forceinline__ void a_ready(const Unit&) const {}
    __device__ __forceinline__ void done(const Unit&) const {}
};

__device__ __forceinline__ unsigned cvt_pk_bf16(float lo, float hi) { unsigned r; asm volatile("v_cvt_pk_bf16_f32 %0, %1, %2" : "=v"(r) : "v"(lo), "v"(hi)); return r; }
typedef float f32x2 __attribute__((ext_vector_type(2)));
__device__ __forceinline__ f32x2 gelu_pk(f32x2 v) {
    const f32x2 av = __builtin_elementwise_abs(v), d = av * 0.2316418882f + 1.0f;
    f32x2 t; t.x = __builtin_amdgcn_rcpf(d.x); t.y = __builtin_amdgcn_rcpf(d.y);
    f32x2 q = t * 0.5307027145f + (-0.7265760135f); q = q * t + 0.7107068705f; q = q * t + (-0.142248368f); q = q * t + 0.127414796f; q = q * t;
    const f32x2 s = (v * v) * (-0.72134752044f);
    f32x2 e; e.x = __builtin_amdgcn_exp2f(s.x); e.y = __builtin_amdgcn_exp2f(s.y);
    const f32x2 m = v * (q * e), r = v - m;
    f32x2 o; o.x = v.x < 0.f ? m.x : r.x; o.y = v.y < 0.f ? m.y : r.y; return o;
}

template <int ACT  > struct EpiBf16 {
    static constexpr bool PERM = true, AFTER_DRAIN = false; static_assert(ACT == 0 || ACT == 1, "EpiBf16: ACT is 0 (none) or 1 (gelu_pk)");
    bf16_t* O; int ldc; const float* bias; int split_cols; size_t split_stride; float scale0;
    __device__ __forceinline__ void operator()(const f32x4 (&acc)[2][2][4][2], const Unit& u, int wr, int wc, int fr, int fq) const {
        const int row0 = u.pm * BM + wr * 64 + fr; int colt = u.pn * BM; bf16_t* base = O;
        float sc = 1.f; if (split_cols) { const int t = colt / split_cols; base += (size_t)t * split_stride; colt -= t * split_cols; if (t == 0) sc = scale0; }
        const int col0 = colt + wc * 32 + 8 * fq, bcol0 = u.pn * BM + wc * 32 + 8 * fq;
        f32x4 bv[2][2];
#pragma unroll
        for (int bj = 0; bj < 2; ++bj)
#pragma unroll
            for (int n = 0; n < 2; ++n) bv[bj][n] = bias ? *(const f32x4*)(bias + bcol0 + bj * HALF + 4 * n) : (f32x4){0.f, 0.f, 0.f, 0.f};
#pragma unroll
        for (int ai = 0; ai < 2; ++ai)
#pragma unroll
            for (int m = 0; m < 4; ++m) { bf16_t* rowp = base + (size_t)(row0 + ai * HALF + m * 16) * ldc + col0;
#pragma unroll
                for (int bj = 0; bj < 2; ++bj) { f32x4 v0 = acc[ai][bj][m][0] + bv[bj][0], v1 = acc[ai][bj][m][1] + bv[bj][1];
                    if (ACT == 1) { f32x2 a = gelu_pk((f32x2){v0[0], v0[1]}), b = gelu_pk((f32x2){v0[2], v0[3]}), c = gelu_pk((f32x2){v1[0], v1[1]}), d = gelu_pk((f32x2){v1[2], v1[3]});
                        v0 = (f32x4){a.x, a.y, b.x, b.y}; v1 = (f32x4){c.x, c.y, d.x, d.y}; }
                    v0 = v0 * sc; v1 = v1 * sc; u32x4 w; w.x = cvt_pk_bf16(v0[0], v0[1]); w.y = cvt_pk_bf16(v0[2], v0[3]); w.z = cvt_pk_bf16(v1[0], v1[1]); w.w = cvt_pk_bf16(v1[2], v1[3]);
                    *(u32x4*)(rowp + bj * HALF) = w; } }
    }
};

template <class Epi, class Sched, bool ALIGN_EPI = false, bool SP2 = false>
__device__ __forceinline__ void gemm_phase(PG8_LAS unsigned char* lds, const Gemm g, const Sched& S, const Epi& E) {
    const int tid = threadIdx.x, wid = __builtin_amdgcn_readfirstlane(tid >> 6), lane = tid & 63, wr = wid >> 2, wc = wid & 3, fr = lane & 15, fq = lane >> 4;
    const int K = g.K, nt = K / BK;
    unsigned voffA[2], voffB[2];
#pragma unroll
    for (int i = 0; i < 2; ++i) { int R, C; stage_rc(tid * 16 + i * 8192, R, C); const int Rb = Epi::PERM ? ((R & ~31) + perm32(R & 31)) : R;
        voffA[i] = (unsigned)(R * K + C) * 2u; voffB[i] = (unsigned)(Rb * K + C) * 2u; }
    const size_t kstep = (size_t)(BK * 2);
    const size_t hstep = (size_t)HALF * K * 2;
    const size_t tstep = 2 * hstep;
    const unsigned ldsw = (unsigned)wid * 1024u;
    const int aoff = lds_byte(wr * 64 + fr, fq * 8), boff = lds_byte(wc * 32 + fr, fq * 8);
#define PG8_SA(b, h) (((b) * 2 + (h)) * HTB)
#define PG8_SB(b, h) ((4 + (b) * 2 + (h)) * HTB)
#define PG8_STAGE(bufoff, gbase, voff) do { _Pragma("unroll") for (int _i = 0; _i < 2; ++_i) \
        __builtin_amdgcn_global_load_lds((const unsigned*)((const char*)(gbase) + (voff)[_i]), (PG8_LAS unsigned*)(lds + (bufoff) + ldsw + _i * 8192), 16, 0, 0); } while (0)
#define PG8_LDA(dst, b, h) do { _Pragma("unroll") for (int m = 0; m < 4; ++m) _Pragma("unroll") for (int k = 0; k < 2; ++k) dst[m][k] = *(const PG8_LAS bf16x8*)(lds + PG8_SA(b, h) + aoff + m * 2048 + k * 1024); } while (0)
#define PG8_LDB(dst, b, h) do { _Pragma("unroll") for (int n = 0; n < 2; ++n) _Pragma("unroll") for (int k = 0; k < 2; ++k) dst[n][k] = *(const PG8_LAS bf16x8*)(lds + PG8_SB(b, h) + boff + n * 2048 + k * 1024); } while (0)
#define PG8_MMA(ai, bj, At, Bt) do { __builtin_amdgcn_s_setprio(1); _Pragma("unroll") for (int m = 0; m < 4; ++m) _Pragma("unroll") for (int n = 0; n < 2; ++n) _Pragma("unroll") for (int k = 0; k < 2; ++k) \
        acc[ai][bj][m][n] = __builtin_amdgcn_mfma_f32_16x16x32_bf16(Bt[n][k], At[m][k], acc[ai][bj][m][n], 0, 0, 0); __builtin_amdgcn_s_setprio(0); } while (0)
#define PG8_WAIT_V(n) asm volatile("s_waitcnt vmcnt(" #n ")" ::: "memory")
#define PG8_WAIT_L(n) asm volatile("s_waitcnt lgkmcnt(" #n ")" ::: "memory")
#define PG8_BAR __builtin_amdgcn_s_barrier()
#define PG8_SCHED __builtin_amdgcn_sched_barrier(0)
    Unit cur, nxt; int ui = 0;
    if (!S.next(0, cur)) return;
    f32x4 acc[2][2][4][2];
#pragma unroll
    for (int a = 0; a < 2; ++a)
#pragma unroll
        for (int b = 0; b < 2; ++b)
#pragma unroll
            for (int m = 0; m < 4; ++m)
#pragma unroll
                for (int n = 0; n < 2; ++n) acc[a][b][m][n] = (f32x4){0.f, 0.f, 0.f, 0.f};
    bf16x8 At[4][2], B0[2][2], B1[2][2];
    const char* cA = (const char*)g.A + (size_t)cur.pm * tstep; const char* cB = (const char*)g.Bt + (size_t)cur.e * g.estride + (size_t)cur.pn * tstep;
    S.a_ready(cur);
    if constexpr (SP2) {
        PG8_STAGE(PG8_SB(0, 0), cB, voffB); PG8_STAGE(PG8_SB(0, 1), cB + hstep, voffB); PG8_STAGE(PG8_SA(0, 0), cA, voffA); PG8_STAGE(PG8_SA(0, 1), cA + hstep, voffA);
        if (wr == 1) PG8_BAR;
        PG8_WAIT_V(2); PG8_BAR;
        PG8_STAGE(PG8_SB(1, 0), cB + kstep, voffB); PG8_STAGE(PG8_SA(1, 0), cA + kstep, voffA); PG8_STAGE(PG8_SB(1, 1), cB + hstep + kstep, voffB);
        PG8_WAIT_V(6); PG8_BAR;
    } else {
        PG8_STAGE(PG8_SB(0, 0), cB, voffB); PG8_STAGE(PG8_SA(0, 0), cA, voffA); PG8_STAGE(PG8_SB(0, 1), cB + hstep, voffB); PG8_STAGE(PG8_SA(0, 1), cA + hstep, voffA);
        if (wr == 1) PG8_BAR;
        PG8_WAIT_V(4); PG8_BAR;
        PG8_STAGE(PG8_SB(1, 0), cB + kstep, voffB); PG8_STAGE(PG8_SA(1, 0), cA + kstep, voffA); PG8_STAGE(PG8_SB(1, 1), cB + hstep + kstep, voffB);
        PG8_WAIT_V(6); PG8_BAR;
    }
    for (;;) {
        const bool has_next = S.next(ui + 1, nxt);
        const char* nA = has_next ? (const char*)g.A + (size_t)nxt.pm * tstep : cA; const char* nB = has_next ? (const char*)g.Bt + (size_t)nxt.e * g.estride + (size_t)nxt.pn * tstep : cB;
        for (int t = 0; t < nt; t += 2) {
            const bool last = (t == nt - 2);
            const char* a1 = cA + (size_t)(t + 1) * kstep;
            const char* a2 = last ? nA : cA + (size_t)(t + 2) * kstep; const char* b2 = last ? nB : cB + (size_t)(t + 2) * kstep;
            const char* a3 = a2 + kstep; const char* b3 = b2 + kstep;
            if (last && has_next) S.a_ready(nxt);
            if constexpr (SP2) {
            PG8_LDB(B0, 0, 0); PG8_LDB(B1, 0, 1); PG8_SCHED; PG8_LDA(At, 0, 0); PG8_STAGE(PG8_SA(1, 1), a1 + hstep, voffA);
            PG8_WAIT_V(8); PG8_WAIT_L(0); PG8_BAR; PG8_MMA(0, 0, At, B0); PG8_MMA(0, 1, At, B1); PG8_BAR; PG8_SCHED;
            PG8_LDA(At, 0, 1); PG8_STAGE(PG8_SB(0, 0), b2, voffB); PG8_STAGE(PG8_SB(0, 1), b2 + hstep, voffB); PG8_STAGE(PG8_SA(0, 0), a2, voffA);
            PG8_WAIT_V(8); PG8_WAIT_L(0); PG8_BAR; PG8_MMA(1, 0, At, B0); PG8_MMA(1, 1, At, B1); PG8_BAR; PG8_SCHED;
            PG8_LDB(B0, 1, 0); PG8_LDB(B1, 1, 1); PG8_SCHED; PG8_LDA(At, 1, 0); PG8_STAGE(PG8_SA(0, 1), a2 + hstep, voffA);
            PG8_WAIT_V(8); PG8_WAIT_L(0); PG8_BAR; PG8_MMA(0, 0, At, B0); PG8_MMA(0, 1, At, B1); PG8_BAR; PG8_SCHED;
            PG8_LDA(At, 1, 1); PG8_STAGE(PG8_SB(1, 0), b3, voffB); PG8_STAGE(PG8_SB(1, 1), b3 + hstep, voffB); PG8_STAGE(PG8_SA(1, 0), a3, voffA);
            PG8_WAIT_V(8); PG8_WAIT_L(0); PG8_BAR; PG8_MMA(1, 0, At, B0); PG8_MMA(1, 1, At, B1); PG8_BAR; PG8_SCHED;
            } else {
            PG8_LDB(B0, 0, 0); PG8_SCHED; PG8_LDA(At, 0, 0); PG8_STAGE(PG8_SA(1, 1), a1 + hstep, voffA);
            PG8_WAIT_L(8); PG8_BAR; PG8_WAIT_L(0); PG8_MMA(0, 0, At, B0); PG8_BAR; PG8_SCHED;
            PG8_LDB(B1, 0, 1); PG8_STAGE(PG8_SB(0, 0), b2, voffB);
            PG8_BAR; PG8_WAIT_L(0); PG8_MMA(0, 1, At, B1); PG8_BAR;
            PG8_LDA(At, 0, 1); PG8_STAGE(PG8_SA(0, 0), a2, voffA);
            PG8_BAR; PG8_WAIT_L(0); PG8_MMA(1, 0, At, B0); PG8_BAR; PG8_SCHED;
            PG8_STAGE(PG8_SB(0, 1), b2 + hstep, voffB);
            PG8_WAIT_V(6); PG8_BAR; PG8_MMA(1, 1, At, B1); PG8_BAR;
            PG8_LDB(B0, 1, 0); PG8_SCHED; PG8_LDA(At, 1, 0); PG8_STAGE(PG8_SA(0, 1), a2 + hstep, voffA);
            PG8_WAIT_L(8); PG8_BAR; PG8_WAIT_L(0); PG8_MMA(0, 0, At, B0); PG8_BAR; PG8_SCHED;
            PG8_LDB(B1, 1, 1); PG8_STAGE(PG8_SB(1, 0), b3, voffB);
            PG8_BAR; PG8_WAIT_L(0); PG8_MMA(0, 1, At, B1); PG8_BAR;
            PG8_LDA(At, 1, 1); PG8_STAGE(PG8_SA(1, 0), a3, voffA);
            PG8_BAR; PG8_WAIT_L(0); PG8_MMA(1, 0, At, B0); PG8_BAR; PG8_SCHED;
            PG8_STAGE(PG8_SB(1, 1), b3 + hstep, voffB);
            PG8_WAIT_V(6); PG8_BAR; PG8_MMA(1, 1, At, B1); PG8_BAR;
            }
        }
        if constexpr (ALIGN_EPI) { if (wr == 0) PG8_BAR; }
        if constexpr (!Epi::AFTER_DRAIN) { E(acc, cur, wr, wc, fr, fq); S.done(cur); }
        if (!has_next) break;
#pragma unroll
        for (int a = 0; a < 2; ++a)
#pragma unroll
            for (int b = 0; b < 2; ++b)
#pragma unroll
                for (int m = 0; m < 4; ++m)
#pragma unroll
                    for (int n = 0; n < 2; ++n) acc[a][b][m][n] = (f32x4){0.f, 0.f, 0.f, 0.f};
        cur = nxt; cA = nA; cB = nB; ++ui;
        if constexpr (ALIGN_EPI) { if (wr == 1) PG8_BAR; }
    }
    PG8_WAIT_V(0);
    if constexpr (!ALIGN_EPI) { if (wr == 0) PG8_BAR; }
    PG8_BAR;
    if constexpr (Epi::AFTER_DRAIN) { E.fused(acc, cur, wr, wc, fr, fq, lds, wid, lane); S.done(cur); }
#undef PG8_SA
#undef PG8_SB
#undef PG8_STAGE
#undef PG8_LDA
#undef PG8_LDB
#undef PG8_MMA
#undef PG8_WAIT_V
#undef PG8_WAIT_L
#undef PG8_BAR
#undef PG8_SCHED
}
}

namespace pg8 {
struct MoeOrder {
    int nM, nN, nwg, G, c; const PG8_LAS int* bexp;
    __device__ __forceinline__ void init(int nM_, int nN_, int G_, int c_, const PG8_LAS int* bexp_) { nM = nM_; nN = nN_; nwg = nM_ * nN_; G = G_; c = c_; bexp = bexp_; }
    __device__ __forceinline__ bool next(int i, Unit& u) const {
        const long L = (long)i * G + c; if (L >= nwg) return false;
        int wgid = (int)L; { const int q = nwg / NXCD, r = nwg % NXCD, xcd = wgid % NXCD, off = wgid / NXCD; wgid = (xcd < r ? xcd * (q + 1) : r * (q + 1) + (xcd - r) * q) + off; }
        const int nig = WGM * nN, gid = wgid / nig, fm = gid * WGM, gsz = (nM - fm) < WGM ? (nM - fm) : WGM;
        u.pm = fm + ((wgid % nig) % gsz); u.pn = (wgid % nig) / gsz; u.e = __builtin_amdgcn_readfirstlane(bexp[u.pm]); return true;
    }
    __device__ __forceinline__ void a_ready(const Unit&) const {}
    __device__ __forceinline__ void done(const Unit&) const {}
};
struct EpiOut {
    static constexpr bool PERM = false, AFTER_DRAIN = false;
    const float* x; float* out; const float* mod;
    __device__ __forceinline__ void operator()(const f32x4 (&acc)[2][2][4][2], const Unit& u, int wr, int wc, int fr, int fq) const {
        const int row0 = u.pm * BM + wr * 64 + fr, col0 = u.pn * BM + wc * 32 + 4 * fq;
        const float* g = mod + (size_t)(u.pm >> 5) * 6144 + 2 * 1024;
        f32x4 gv[2][2];
#pragma unroll
        for (int bj = 0; bj < 2; ++bj)
#pragma unroll
            for (int n = 0; n < 2; ++n) gv[bj][n] = *(const f32x4*)(g + col0 + bj * HALF + n * 16);
#pragma unroll
        for (int ai = 0; ai < 2; ++ai)
#pragma unroll
            for (int m = 0; m < 4; ++m) { const size_t off = (size_t)(row0 + ai * HALF + m * 16) * 1024 + col0;
#pragma unroll
                for (int bj = 0; bj < 2; ++bj)
#pragma unroll
                    for (int n = 0; n < 2; ++n) { const f32x4 xv = *(const f32x4*)(x + off + bj * HALF + n * 16); *(f32x4*)(out + off + bj * HALF + n * 16) = xv + gv[bj][n] * acc[ai][bj][m][n]; } }
    }
};
__device__ __forceinline__ float swiglu1(float g, float l) {
    const float glu = fminf(g, 7.0f), lin = fminf(fmaxf(l, -7.0f), 7.0f);
    const float sg = __builtin_amdgcn_rcpf(1.0f + __builtin_amdgcn_exp2f(glu * (-1.702f * 1.4426950408889634f)));
    return glu * sg * (lin + 1.0f);
}
struct EpiSwiGLU {
    static constexpr bool PERM = true, AFTER_DRAIN = false;
    bf16_t* act; const float* bgu;
    __device__ __forceinline__ void operator()(const f32x4 (&acc)[2][2][4][2], const Unit& u, int wr, int wc, int fr, int fq) const {
        const int row0 = u.pm * BM + wr * 64 + fr, cg = u.pn * 128 + wc * 32 + 8 * fq;
        const float* bb = bgu + (size_t)u.e * 2048;
        f32x4 bg[2], bl[2];
#pragma unroll
        for (int n = 0; n < 2; ++n) { bg[n] = *(const f32x4*)(bb + cg + 4 * n); bl[n] = *(const f32x4*)(bb + 1024 + cg + 4 * n); }
#pragma unroll
        for (int ai = 0; ai < 2; ++ai)
#pragma unroll
            for (int m = 0; m < 4; ++m) { bf16_t* rowp = act + (size_t)(row0 + ai * HALF + m * 16) * 1024 + cg;
                const f32x4 g0 = acc[ai][0][m][0] + bg[0], g1 = acc[ai][0][m][1] + bg[1], l0 = acc[ai][1][m][0] + bl[0], l1 = acc[ai][1][m][1] + bl[1];
                u32x4 w; w.x = cvt_pk_bf16(swiglu1(g0[0], l0[0]), swiglu1(g0[1], l0[1])); w.y = cvt_pk_bf16(swiglu1(g0[2], l0[2]), swiglu1(g0[3], l0[3]));
                w.z = cvt_pk_bf16(swiglu1(g1[0], l1[0]), swiglu1(g1[1], l1[1])); w.w = cvt_pk_bf16(swiglu1(g1[2], l1[2]), swiglu1(g1[3], l1[3]));
                *(u32x4*)rowp = w; }
    }
};
struct EpiDown {
    static constexpr bool PERM = true, AFTER_DRAIN = false;
    bf16_t* y; const float* bd;
    __device__ __forceinline__ void operator()(const f32x4 (&acc)[2][2][4][2], const Unit& u, int wr, int wc, int fr, int fq) const {
        const int row0 = u.pm * BM + wr * 64 + fr, col0 = u.pn * BM + wc * 32 + 8 * fq;
        const float* bb = bd + (size_t)u.e * 1024 + col0;
        f32x4 bv[2][2];
#pragma unroll
        for (int bj = 0; bj < 2; ++bj)
#pragma unroll
            for (int n = 0; n < 2; ++n) bv[bj][n] = *(const f32x4*)(bb + bj * HALF + 4 * n);
#pragma unroll
        for (int ai = 0; ai < 2; ++ai)
#pragma unroll
            for (int m = 0; m < 4; ++m) { bf16_t* rowp = y + (size_t)(row0 + ai * HALF + m * 16) * 1024 + col0;
#pragma unroll
                for (int bj = 0; bj < 2; ++bj) { const f32x4 v0 = acc[ai][bj][m][0] + bv[bj][0], v1 = acc[ai][bj][m][1] + bv[bj][1];
                    u32x4 w; w.x = cvt_pk_bf16(v0[0], v0[1]); w.y = cvt_pk_bf16(v0[2], v0[3]); w.z = cvt_pk_bf16(v1[0], v1[1]); w.w = cvt_pk_bf16(v1[2], v1[3]);
                    *(u32x4*)(rowp + bj * HALF) = w; } }
    }
};
}

namespace att {
typedef unsigned short bf16_t;
using bf16x8 = __attribute__((ext_vector_type(8))) short;
using s16x4  = __attribute__((ext_vector_type(4))) short;
using f32x16 = __attribute__((ext_vector_type(16))) float;
using u32x4  = __attribute__((ext_vector_type(4))) unsigned;
constexpr int NW = 8, QBLK = 32, KVBLK = 64, LD = 3072;
constexpr float SCALE = 0.125f, THR = 8.f;
#define KSWZ64(row, colB) ((row) * 128 + ((colB) ^ ((((row) >> 1) & 7) << 4)))
#define ASBAR() __builtin_amdgcn_sched_barrier(0)
__device__ __forceinline__ int crow(int r, int hi) { return (r & 3) + 8 * (r >> 2) + 4 * hi; }
__device__ __forceinline__ unsigned cvtpk(float lo, float hi) { unsigned r; asm volatile("v_cvt_pk_bf16_f32 %0, %1, %2" : "=v"(r) : "v"(lo), "v"(hi)); return r; }
__device__ __forceinline__ bf16x8 ld8(const bf16_t* p) { return *reinterpret_cast<const bf16x8*>(p); }

__device__ __forceinline__ void partialSM(f32x16& p0, f32x16& p1, float& m_reg, float& mn, float& alpha) {
  constexpr float C = SCALE * 1.4426950408889634f;
  float pmax = p0[0];
#pragma unroll
  for (int r = 1; r < 16; ++r) pmax = fmaxf(pmax, p0[r]);
#pragma unroll
  for (int r = 0; r < 16; ++r) pmax = fmaxf(pmax, p1[r]);
  { auto rr = __builtin_amdgcn_permlane32_swap(__float_as_uint(pmax), __float_as_uint(pmax), false, false);
    pmax = fmaxf(__uint_as_float(rr[0]), __uint_as_float(rr[1])); }
  if (__builtin_expect(__all(pmax - m_reg <= THR / SCALE), 1)) { mn = m_reg; alpha = 1.f; }
  else { mn = fmaxf(m_reg, pmax); alpha = __builtin_amdgcn_exp2f((m_reg - mn) * C); m_reg = mn; }
  const float mnC = -mn * C;
#pragma unroll
  for (int r = 0; r < 16; ++r) p0[r] = fmaf(p0[r], C, mnC);
#pragma unroll
  for (int r = 0; r < 16; ++r) p1[r] = fmaf(p1[r], C, mnC);
#pragma unroll
  for (int r = 0; r < 16; ++r) p0[r] = __builtin_amdgcn_exp2f(p0[r]);
}
__device__ __forceinline__ void finishSM(f32x16& p0, f32x16& p1, float alpha, float& l_reg, bf16x8& pa0, bf16x8& pa1, bf16x8& pa2, bf16x8& pa3) {
#pragma unroll
  for (int r = 0; r < 16; ++r) p1[r] = __builtin_amdgcn_exp2f(p1[r]);
  float ps = 0;
#pragma unroll
  for (int r = 0; r < 16; ++r) ps += p0[r];
#pragma unroll
  for (int r = 0; r < 16; ++r) ps += p1[r];
  { auto rr = __builtin_amdgcn_permlane32_swap(__float_as_uint(ps), __float_as_uint(ps), false, false);
    ps = __uint_as_float(rr[0]) + __uint_as_float(rr[1]); }
  l_reg = l_reg * alpha + ps;
#define PK4(P, BASE, OUT) do { unsigned a0 = cvtpk(P[BASE + 0], P[BASE + 1]), a1 = cvtpk(P[BASE + 2], P[BASE + 3]);   \
    unsigned b0 = cvtpk(P[BASE + 4], P[BASE + 5]), b1 = cvtpk(P[BASE + 6], P[BASE + 7]);                              \
    auto r0 = __builtin_amdgcn_permlane32_swap(a0, b0, false, false); auto r1 = __builtin_amdgcn_permlane32_swap(a1, b1, false, false); \
    u32x4 w = {r0[0], r1[0], r0[1], r1[1]}; OUT = *reinterpret_cast<bf16x8*>(&w); } while (0)
  PK4(p0, 0, pa0); PK4(p0, 8, pa1); PK4(p1, 0, pa2); PK4(p1, 8, pa3);
#undef PK4
}
__device__ __forceinline__ void qkt(f32x16& p0, f32x16& p1, const char* Ks, const bf16x8* qr, int r32, int hi) {
  p0 = f32x16{}; p1 = f32x16{};
#pragma unroll
  for (int d0 = 0; d0 < 4; ++d0) { const int cb = (d0 * 16 + hi * 8) * 2;
    const bf16x8 b0 = *reinterpret_cast<const bf16x8*>(Ks + KSWZ64(r32, cb));
    const bf16x8 b1 = *reinterpret_cast<const bf16x8*>(Ks + KSWZ64(32 + r32, cb));
    p0 = __builtin_amdgcn_mfma_f32_32x32x16_bf16(b0, qr[d0], p0, 0, 0, 0);
    p1 = __builtin_amdgcn_mfma_f32_32x32x16_bf16(b1, qr[d0], p1, 0, 0, 0); }
}
template <int NVB> __device__ __forceinline__ int v_st(int k, int c) { const int kk = (k & ~0xC) | ((k & 4) << 1) | ((k & 8) >> 1); return ((kk >> 3) * NVB + (c >> 5)) * 512 + ((kk & 7) * 32 + (c & 31)) * 2; }
__device__ __forceinline__ int v_rd_base(int lane) { return ((lane & 3) << 3) | (((lane >> 2) & 3) << 6) | (((lane >> 4) & 1) << 5) | (((lane >> 5) & 1) << 8); }
template <int NVB> constexpr int v_rd_off(int d0, int ks, int half) { return d0 * 512 + ks * (NVB * 1024) + half * (NVB * 512); }
template <int OFF> __device__ __forceinline__ s16x4 tr_read(int vb) {
  s16x4 r; asm volatile("ds_read_b64_tr_b16 %0, %1 offset:%2" : "=&v"(r) : "v"(vb), "i"(OFF) : "memory"); return r;
}
template <int NVB, int D0> __device__ __forceinline__ void pv_one(f32x16& od, int vb, bf16x8 pa0, bf16x8 pa1, bf16x8 pa2, bf16x8 pa3) {
  const s16x4 l0 = tr_read<v_rd_off<NVB>(D0, 0, 0)>(vb), h0 = tr_read<v_rd_off<NVB>(D0, 0, 1)>(vb), l1 = tr_read<v_rd_off<NVB>(D0, 1, 0)>(vb), h1 = tr_read<v_rd_off<NVB>(D0, 1, 1)>(vb);
  const s16x4 l2 = tr_read<v_rd_off<NVB>(D0, 2, 0)>(vb), h2 = tr_read<v_rd_off<NVB>(D0, 2, 1)>(vb), l3 = tr_read<v_rd_off<NVB>(D0, 3, 0)>(vb), h3 = tr_read<v_rd_off<NVB>(D0, 3, 1)>(vb);
  asm volatile("s_waitcnt lgkmcnt(0)" ::: "memory"); ASBAR();
#define PK(L, H) (bf16x8){L[0], L[1], L[2], L[3], H[0], H[1], H[2], H[3]}
  od = __builtin_amdgcn_mfma_f32_32x32x16_bf16(pa0, PK(l0, h0), od, 0, 0, 0);
  od = __builtin_amdgcn_mfma_f32_32x32x16_bf16(pa1, PK(l1, h1), od, 0, 0, 0);
  od = __builtin_amdgcn_mfma_f32_32x32x16_bf16(pa2, PK(l2, h2), od, 0, 0, 0);
  od = __builtin_amdgcn_mfma_f32_32x32x16_bf16(pa3, PK(l3, h3), od, 0, 0, 0);
#undef PK
}
template <int NVB> __device__ __forceinline__ void pv_all(f32x16* o, int vb, bf16x8 pa0, bf16x8 pa1, bf16x8 pa2, bf16x8 pa3) {
  pv_one<NVB, 0>(o[0], vb, pa0, pa1, pa2, pa3); pv_one<NVB, 1>(o[1], vb, pa0, pa1, pa2, pa3);
  if constexpr (NVB == 4) { pv_one<NVB, 2>(o[2], vb, pa0, pa1, pa2, pa3); pv_one<NVB, 3>(o[3], vb, pa0, pa1, pa2, pa3); }
}
struct DiffPol {
  const bf16_t* Kg; const bf16_t* Vg; long lat0, ctx0;
  __device__ __forceinline__ long krow(int t) const { return t < 128 ? lat0 + 64L * t : ctx0 + 64L * (t - 128); }
  __device__ __forceinline__ void mod(f32x16&, f32x16&, int, int, int, int) const {}
};
struct NaPol {
  const bf16_t* Kg; const bf16_t* Vg; long lat0, ctx0; int rbase, r; const float* tab;
  __device__ __forceinline__ long krow(int t) const { if (t < 12) { int kr = rbase + t; kr = kr > 127 ? 127 : kr; return lat0 + 64L * kr; } return ctx0 + 64L * (t - 12); }
  __device__ __forceinline__ void mod(f32x16& p0, f32x16& p1, int t, int wid, int r32, int hi) const {
    if (t >= 12) return;
    const float NEG = -INFINITY;
    const int kr = rbase + t, rq = r + (wid >> 1), c = 32 * (wid & 1) + r32;
    int r0q = rq - 4; r0q = r0q < 0 ? 0 : (r0q > 120 ? 120 : r0q);
    if (!((kr >= r0q) && (kr < r0q + 8))) {
#pragma unroll
      for (int i = 0; i < 16; ++i) { p0[i] = NEG; p1[i] = NEG; }
      return; }
    int c0 = c - 8; c0 = c0 < 0 ? 0 : (c0 > 48 ? 48 : c0);
    const float* trow = tab + (kr - rq + 7) * 31 + (15 - c);
#pragma unroll
    for (int i = 0; i < 16; ++i) {
      const int k0 = crow(i, hi), k1 = k0 + 32;
      const bool v0 = (k0 >= c0) && (k0 < c0 + 16), v1 = (k1 >= c0) && (k1 < c0 + 16);
      const float b0 = trow[v0 ? k0 : c], b1 = trow[v1 ? k1 : c];
      p0[i] = v0 ? p0[i] + b0 : NEG; p1[i] = v1 ? p1[i] + b1 : NEG; }
  }
};
template <int NVB> constexpr int lds_bytes() { return 2 * (64 * NVB * 64) + 2 * (64 * 128) + NW * 64 * 4; }
template <int NVB, class Pol>
__device__ __forceinline__ void attn_unit(const bf16_t* __restrict__ Qb, const Pol& pol, bf16_t* __restrict__ Ob, int ldo, int NT, char* lds) {
  constexpr int SHM_V = 64 * NVB * 64, SHM_K = 64 * 128;
  const int tid = threadIdx.x, wid = tid >> 6, lane = tid & 63, r32 = lane & 31, hi = lane >> 5;
  char* V_lds = lds; char* K_lds = lds + 2 * SHM_V;
  float* ws = (float*)(lds + 2 * SHM_V + 2 * SHM_K) + wid * 64; float* li_l = ws; float* al_l = ws + 32;
  float m_reg = -1e30f, l_reg = 0; f32x16 o[NVB]; bf16x8 qr[4];
#pragma unroll
  for (int d = 0; d < NVB; ++d) o[d] = f32x16{};
  const bf16_t* Qw = Qb + (long)(wid * QBLK + r32) * LD + hi * 8;
#pragma unroll
  for (int d0 = 0; d0 < 4; ++d0) qr[d0] = ld8(Qw + d0 * 16);
  const int ksr = tid >> 3, ksc = (tid & 7) * 8, kst = KSWZ64(ksr, ksc * 2);
  const int vsr = (NVB == 4) ? (tid >> 4) : (tid >> 3), vsc = (NVB == 4) ? (tid & 15) * 8 : (tid & 7) * 8;
  const int vst0 = v_st<NVB>(vsr, vsc), vst1 = v_st<NVB>(32 + vsr, vsc);
  const int vb0 = (int)(uintptr_t)V_lds + v_rd_base(lane);
  struct { bf16x8 v0, v1, k0; } sr_[2];
#define SLOAD(i, t) do { const long row0_ = pol.krow(t); sr_[i].v0 = ld8(pol.Vg + (row0_ + vsr) * LD + vsc); \
    if constexpr (NVB == 4) sr_[i].v1 = ld8(pol.Vg + (row0_ + 32 + vsr) * LD + vsc); sr_[i].k0 = ld8(pol.Kg + (row0_ + ksr) * LD + ksc); } while (0)
#define SWRITE(b, i) do { *(bf16x8*)(V_lds + (b) * SHM_V + vst0) = sr_[i].v0; if constexpr (NVB == 4) *(bf16x8*)(V_lds + (b) * SHM_V + vst1) = sr_[i].v1; \
    *(bf16x8*)(K_lds + (b) * SHM_K + kst) = sr_[i].k0; } while (0)
#define SWAIT() do { if constexpr (NVB == 4) asm volatile("s_waitcnt vmcnt(3)" ::: "memory"); else asm volatile("s_waitcnt vmcnt(2)" ::: "memory"); } while (0)
#define RESC(a) do { if (__any((a) < 1.f)) { if (hi == 0) al_l[r32] = (a); asm volatile("s_waitcnt lgkmcnt(0)" ::: "memory"); \
    _Pragma("unroll") for (int d = 0; d < NVB; ++d) _Pragma("unroll") for (int r = 0; r < 16; ++r) o[d][r] *= al_l[crow(r, hi)]; } } while (0)
  f32x16 pA0, pA1, pB0, pB1; float mnA, mnB, alA, alB; bf16x8 pa0, pa1, pa2, pa3;
  constexpr int SE = 0, SO = 1;
  SLOAD(SE, 0); asm volatile("s_waitcnt vmcnt(0)" ::: "memory"); SWRITE(0, SE); __syncthreads();
  qkt(pA0, pA1, K_lds, qr, r32, hi); pol.mod(pA0, pA1, 0, wid, r32, hi); partialSM(pA0, pA1, m_reg, mnA, alA);
  SLOAD(SO, 1); if (2 < NT) SLOAD(SE, 2);
  SWAIT(); SWRITE(1, SO); __syncthreads();
  for (int j = 1; j + 1 < NT; j += 2) {
    ASBAR(); qkt(pB0, pB1, K_lds + SHM_K, qr, r32, hi);
    finishSM(pA0, pA1, alA, l_reg, pa0, pa1, pa2, pa3); ASBAR();
    SLOAD(SO, j + 2); ASBAR();
    pv_all<NVB>(o, vb0, pa0, pa1, pa2, pa3); pol.mod(pB0, pB1, j, wid, r32, hi); partialSM(pB0, pB1, m_reg, mnB, alB);
    __syncthreads(); SWAIT(); SWRITE(0, SE);
    RESC(alB); __syncthreads();
    ASBAR(); qkt(pA0, pA1, K_lds, qr, r32, hi);
    finishSM(pB0, pB1, alB, l_reg, pa0, pa1, pa2, pa3); ASBAR();
    if (j + 3 < NT) SLOAD(SE, j + 3); ASBAR();
    pv_all<NVB>(o, vb0 + SHM_V, pa0, pa1, pa2, pa3); pol.mod(pA0, pA1, j + 1, wid, r32, hi); partialSM(pA0, pA1, m_reg, mnA, alA);
    __syncthreads(); SWAIT(); SWRITE(1, SO);
    RESC(alA); __syncthreads();
  }
  ASBAR(); qkt(pB0, pB1, K_lds + SHM_K, qr, r32, hi);
  finishSM(pA0, pA1, alA, l_reg, pa0, pa1, pa2, pa3); ASBAR();
  pv_all<NVB>(o, vb0, pa0, pa1, pa2, pa3); pol.mod(pB0, pB1, NT - 1, wid, r32, hi); partialSM(pB0, pB1, m_reg, mnB, alB);
  __syncthreads(); RESC(alB);
  finishSM(pB0, pB1, alB, l_reg, pa0, pa1, pa2, pa3); ASBAR();
  pv_all<NVB>(o, vb0 + SHM_V, pa0, pa1, pa2, pa3);
  if (hi == 0) li_l[r32] = l_reg; asm volatile("s_waitcnt lgkmcnt(0)" ::: "memory");
  float rli[16];
#pragma unroll
  for (int r = 0; r < 16; ++r) rli[r] = __builtin_amdgcn_rcpf(li_l[crow(r, hi)]);
  bf16_t* Ow = Ob + (long)(wid * QBLK) * ldo;
#pragma unroll
  for (int r = 0; r < 16; ++r) { const int orow = crow(r, hi);
#pragma unroll
    for (int d0 = 0; d0 < NVB; ++d0) { const float v = o[d0][r] * rli[r]; const unsigned pk = cvtpk(v, v); Ow[(long)orow * ldo + d0 * 32 + r32] = (bf16_t)(pk & 0xffffu); } }
  __syncthreads();
#undef SLOAD
#undef SWRITE
#undef SWAIT
#undef RESC
}
}

#ifndef MK_N_LAUNCHES
#define MK_N_LAUNCHES 12
#endif
constexpr int N_PHASES = 12;
constexpr int NWAVES = 8;
constexpr int DM = 1024, NB = 4, SEQ = 8192, TT = NB * SEQ, CTX = 256, TC = NB * CTX, MQ = TT + TC, NQKV = 3072;
constexpr int NE = 32, TOPK = 4, MPAD = TT * TOPK + NE * 256, MAXBLK = MPAD / 256;
constexpr float NORM_EPS = 1e-6f;
enum { I_X = 0, I_C, I_CTX, I_CCTX, I_WADA, I_BADA, I_GATTN, I_WIN, I_QND, I_KND, I_LQ1, I_LK1, I_LQ2, I_LK2, I_SUBLN, I_QNN, I_KNN, I_RPB, I_ONN, I_WOUT, I_GFFN, I_WR, I_BR, I_WGU, I_BGU, I_WD, I_BD, N_IN };

constexpr size_t MiB = 1u << 20;
constexpr size_t WS_CTL = 0, CTL_ZERO_BYTES = 64 * 1024;
constexpr size_t WS_TAB = 1 * MiB;
constexpr size_t WS_WQKV = 2 * MiB, WS_WO = 8 * MiB, WS_WGU = 10 * MiB, WS_WDN = 138 * MiB;
constexpr size_t WS_XN = 202 * MiB;
constexpr size_t WS_P = 268 * MiB;
constexpr size_t WS_OD = 499 * MiB, WS_ON = 563 * MiB, WS_MIX = 595 * MiB;
constexpr size_t WS_XG = 202 * MiB;
constexpr size_t WS_ACT = 659 * MiB;
constexpr size_t WS_Y = 202 * MiB;
constexpr size_t WS_RT = 931 * MiB;
constexpr size_t WS_END = 936 * MiB;
static_assert(WS_XN + (size_t)MQ * 2048 <= WS_P && WS_P + (size_t)MQ * 6144 <= WS_OD && WS_XG + (size_t)MPAD * 2048 <= WS_OD && WS_ACT + (size_t)MPAD * 2048 <= WS_RT, "d_ws map");
constexpr int TB_MOD = 0;
constexpr int TB_RCOS = 30720, TB_RSIN = TB_RCOS + 128 * 16, TB_CCOS = TB_RSIN + 128 * 16, TB_CSIN = TB_CCOS + 64 * 16;
constexpr int TB_LAM = TB_CSIN + 64 * 16;
constexpr int TB_WR = TB_LAM + 64;
constexpr int TB_RC = TB_WR + 4 * 1024 * 32;
static_assert((size_t)(TB_RC + 128) * 4 <= MiB, "TAB region");
constexpr int CW_CNT = 0;
constexpr size_t RT_E = 0, RT_G = 512 * 1024, RT_POS = 1024 * 1024, RT_SLOT = 1536 * 1024;

constexpr int RING_BYTES = 131072;
constexpr int MISC_OFF = RING_BYTES;
constexpr int LDS_BYTES = 147456;

#define GAS __attribute__((address_space(1)))
#define LAS __attribute__((address_space(3)))
typedef unsigned short bf16;
typedef unsigned v4u __attribute__((ext_vector_type(4)));
typedef unsigned v2u __attribute__((ext_vector_type(2)));
typedef float f32x4 __attribute__((ext_vector_type(4)));
typedef float f32x16 __attribute__((ext_vector_type(16)));
#define LDS_WAIT() asm volatile("s_waitcnt lgkmcnt(0)" ::: "memory")
__device__ __forceinline__ unsigned f2bf(float f) { unsigned u = __builtin_bit_cast(unsigned, f); return (u + 0x7fffu + ((u >> 16) & 1u)) >> 16; }
__device__ __forceinline__ unsigned pk2(float lo, float hi) { return f2bf(lo) | (f2bf(hi) << 16); }
__device__ __forceinline__ float bflo(unsigned w) { return __uint_as_float(w << 16); }
__device__ __forceinline__ float bfhi(unsigned w) { return __uint_as_float(w & 0xffff0000u); }
__device__ __forceinline__ float wave_sum(float v) {
#pragma unroll
    for (int o = 1; o < 64; o <<= 1) v += __shfl_xor(v, o);
    return v;
}

struct Frame {
    LAS unsigned char* lds;
    int tid, lane, wave, vcu, G;
    const float* in[N_IN]; float* out; unsigned char* ws;
};

__device__ __forceinline__ void p0_transpose_item(const float* W, int K, int N, bf16* WT, int k0, int n0, int drow0, LAS float* scr, int lane) {
#pragma unroll 8
    for (int i = 0; i < 32; ++i) { const int kk = 2 * i + (lane >> 5); scr[kk * 33 + (lane & 31)] = W[(size_t)(k0 + kk) * N + n0 + (lane & 31)]; }
    LDS_WAIT(); asm volatile("" ::: "memory");
    const int c = lane & 7;
#pragma unroll
    for (int j = 0; j < 4; ++j) { const int n = (lane >> 3) + 8 * j; const LAS float* s = scr + (8 * c) * 33 + n;
        v4u o; o.x = pk2(s[0 * 33], s[1 * 33]); o.y = pk2(s[2 * 33], s[3 * 33]); o.z = pk2(s[4 * 33], s[5 * 33]); o.w = pk2(s[6 * 33], s[7 * 33]);
        *(v4u*)(WT + (size_t)(drow0 + n) * K + k0 + 8 * c) = o; }
    LDS_WAIT(); asm volatile("" ::: "memory");
}

__device__ __forceinline__ void p0_prologue(Frame& F) {
    float* tab = (float*)(F.ws + WS_TAB);
    for (int task = blockIdx.x; task < 96; task += F.G) {
        LAS float* ssilu = (LAS float*)F.lds;
        LAS float* part = ssilu + 5 * 1024;
        for (int i = F.tid; i < 5 * 1024; i += 512) { const int r = i >> 10, k = i & 1023; const float v = (r < 4) ? F.in[I_C][r * 1024 + k] : F.in[I_CCTX][k]; ssilu[i] = v / (1.0f + __expf(-v)); }
        __syncthreads();
        const int col = task * 64 + F.lane; const float* w = F.in[I_WADA] + col; float a0 = 0, a1 = 0, a2 = 0, a3 = 0, a4 = 0;
        const int kb = F.wave * 128;
#pragma unroll 8
        for (int k = kb; k < kb + 128; ++k) { const float wv = w[(size_t)k * 6144]; a0 += ssilu[k] * wv; a1 += ssilu[1024 + k] * wv; a2 += ssilu[2048 + k] * wv; a3 += ssilu[3072 + k] * wv; a4 += ssilu[4096 + k] * wv; }
        part[(F.wave * 5 + 0) * 64 + F.lane] = a0; part[(F.wave * 5 + 1) * 64 + F.lane] = a1; part[(F.wave * 5 + 2) * 64 + F.lane] = a2; part[(F.wave * 5 + 3) * 64 + F.lane] = a3; part[(F.wave * 5 + 4) * 64 + F.lane] = a4;
        __syncthreads();
        if (F.tid < 320) { const int r = F.tid >> 6, cl = F.tid & 63; float s = 0; for (int wv = 0; wv < 8; ++wv) s += part[(wv * 5 + r) * 64 + cl]; const int j = task * 64 + cl; tab[TB_MOD + r * 6144 + j] = s + F.in[I_BADA][j]; }
        __syncthreads();
    }
    if ((int)blockIdx.x == F.G - 1) {
        for (int i = F.tid; i < 192 * 16; i += 512) { const int p = i >> 4, f = i & 15; const float inv = 1.0f / powf(10000.0f, (float)f / 16.0f); const int pos = p < 128 ? p : p - 128; const float ang = (float)pos * inv;
            const float cv = cosf(ang), sv = sinf(ang);
            if (p < 128) { tab[TB_RCOS + pos * 16 + f] = cv; tab[TB_RSIN + pos * 16 + f] = sv; } else { tab[TB_CCOS + pos * 16 + f] = cv; tab[TB_CSIN + pos * 16 + f] = sv; } }
        if (F.wave == 0) { const float s1 = wave_sum(F.in[I_LQ1][F.lane] * F.in[I_LK1][F.lane]), s2 = wave_sum(F.in[I_LQ2][F.lane] * F.in[I_LK2][F.lane]);
            if (F.lane == 0) tab[TB_LAM] = expf(s1) - expf(s2) + 0.2f; }
    }
    LAS float* scr = (LAS float*)(F.lds + 32768 + F.wave * 8704);
    const int gw = F.vcu * NWAVES + F.wave, NGW = F.G * NWAVES;
    constexpr int I_IN = 16 * 96, I_OUT = 16 * 32, I_GU = 16 * 64, I_DN = 16 * 32;
    constexpr int NITEMS = I_IN + I_OUT + NE * (I_GU + I_DN);
    bf16* wqkv = (bf16*)(F.ws + WS_WQKV); bf16* wo = (bf16*)(F.ws + WS_WO); bf16* wgu = (bf16*)(F.ws + WS_WGU); bf16* wdn = (bf16*)(F.ws + WS_WDN);
    for (int it = gw; it < NITEMS; it += NGW) {
        int r = it;
        if (r < I_IN) { const int kb = r / 96, nb = r % 96; p0_transpose_item(F.in[I_WIN], 1024, 3072, wqkv, 64 * kb, 32 * nb, 32 * nb, scr, F.lane); continue; } r -= I_IN;
        if (r < I_OUT) { const int kb = r / 32, nb = r % 32; p0_transpose_item(F.in[I_WOUT], 1024, 1024, wo, 64 * kb, 32 * nb, 32 * nb, scr, F.lane); continue; } r -= I_OUT;
        if (r < NE * I_GU) { const int e = r / I_GU, q = r % I_GU, kb = q / 64, nb = q % 64, n0 = 32 * nb;
            const int drow = (n0 < 1024) ? ((n0 >> 7) * 256 + (n0 & 127)) : (((n0 - 1024) >> 7) * 256 + 128 + ((n0 - 1024) & 127));
            p0_transpose_item(F.in[I_WGU] + (size_t)e * 1024 * 2048, 1024, 2048, wgu + (size_t)e * 2048 * 1024, 64 * kb, n0, drow, scr, F.lane); continue; } r -= NE * I_GU;
        { const int e = r / I_DN, q = r % I_DN, kb = q / 32, nb = q % 32;
            p0_transpose_item(F.in[I_WD] + (size_t)e * 1024 * 1024, 1024, 1024, wdn + (size_t)e * 1024 * 1024, 64 * kb, 32 * nb, 32 * nb, scr, F.lane); }
    }
}

__device__ __forceinline__ void p1_norm(Frame& F) {
    const float* tab = (const float*)(F.ws + WS_TAB); bf16* XN = (bf16*)(F.ws + WS_XN);
    const int gw = F.vcu * NWAVES + F.wave, NGW = F.G * NWAVES;
    const f32x4* gat = (const f32x4*)F.in[I_GATTN] + F.lane;
    for (int m = gw; m < MQ; m += NGW) {
        const int b = m < TT ? (m >> 13) : 4;
        const float* xrow = m < TT ? F.in[I_X] + (size_t)m * DM : F.in[I_CTX] + (size_t)(m - TT) * DM;
        const f32x4* xr = (const f32x4*)xrow + F.lane;
        const f32x4* sh = (const f32x4*)(tab + TB_MOD + b * 6144) + F.lane; const f32x4* sc = (const f32x4*)(tab + TB_MOD + b * 6144 + 1024) + F.lane;
        f32x4 v[4]; float s = 0.f;
#pragma unroll
        for (int j = 0; j < 4; ++j) { v[j] = xr[64 * j]; s += (v[j].x * v[j].x + v[j].y * v[j].y) + (v[j].z * v[j].z + v[j].w * v[j].w); }
        const float rstd = 1.0f / sqrtf(wave_sum(s) * (1.f / DM) + NORM_EPS);
        unsigned long long* o8 = (unsigned long long*)(XN + (size_t)m * DM) + F.lane;
#pragma unroll
        for (int j = 0; j < 4; ++j) { const f32x4 g = gat[64 * j], a = sc[64 * j], c = sh[64 * j];
            const f32x4 h = (v[j] * rstd) * g * (a + 1.0f) + c;
            o8[64 * j] = (unsigned long long)pk2(h.x, h.y) | ((unsigned long long)pk2(h.z, h.w) << 32); }
    }
    float* tw = (float*)(F.ws + WS_TAB);
    for (int i = (int)blockIdx.x * 512 + F.tid; i < 4 * 1024 * 32; i += F.G * 512) { const int b = i >> 15, k = (i >> 5) & 1023;
        tw[TB_WR + i] = F.in[I_GFFN][k] * (1.0f + tab[TB_MOD + b * 6144 + 4 * 1024 + k]) * F.in[I_WR][i & 32767]; }
    for (int t = gw; t < 128; t += NGW) { const int b = t >> 5, e = t & 31; float s = 0.f;
        for (int k = F.lane; k < 1024; k += 64) s += tab[TB_MOD + b * 6144 + 3 * 1024 + k] * F.in[I_WR][k * 32 + e];
        s = wave_sum(s); if (F.lane == 0) tw[TB_RC + t] = s + F.in[I_BR][e]; }
}

__device__ __forceinline__ void p3_qknorm(Frame& F) {
    const float* tab = (const float*)(F.ws + WS_TAB); bf16* P = (bf16*)(F.ws + WS_P);
    const int gw = F.vcu * NWAVES + F.wave, NGW = F.G * NWAVES;
    const int j = F.lane & 7;
    for (int task = gw; task < MQ * 4; task += NGW) {
        const int row = task >> 2, g = task & 3;
        const int colb = (g == 0) ? 0 : (g == 1) ? 512 : (g == 2) ? 1536 : 2048;
        const float* nw = ((g == 0) ? F.in[I_QND] : (g == 1) ? F.in[I_KND] : (g == 2) ? F.in[I_QNN] : F.in[I_KNN]) + 8 * j;
        bf16* p = P + (size_t)row * NQKV + colb + F.lane * 8;
        const v4u w = *(const v4u*)p;
        float v[8] = {bflo(w.x), bfhi(w.x), bflo(w.y), bfhi(w.y), bflo(w.z), bfhi(w.z), bflo(w.w), bfhi(w.w)};
        float ss = 0.f;
#pragma unroll
        for (int i = 0; i < 8; ++i) ss += v[i] * v[i];
        ss += __shfl_xor(ss, 1); ss += __shfl_xor(ss, 2); ss += __shfl_xor(ss, 4);
        const float rstd = 1.0f / sqrtf(ss * (1.f / 64.f) + NORM_EPS);
        const f32x4 n0 = *(const f32x4*)nw, n1 = *(const f32x4*)(nw + 4);
        v[0] *= rstd * n0.x; v[1] *= rstd * n0.y; v[2] *= rstd * n0.z; v[3] *= rstd * n0.w; v[4] *= rstd * n1.x; v[5] *= rstd * n1.y; v[6] *= rstd * n1.z; v[7] *= rstd * n1.w;
        if (g < 2 && row < TT) {
            const int s = row & (SEQ - 1), prow = s >> 6, pcol = s & 63, half = j >> 2, isx2 = (j >> 1) & 1;
            const float* ct = tab + (half ? TB_CCOS + pcol * 16 : TB_RCOS + prow * 16) + 8 * (j & 1);
            const float* st = tab + (half ? TB_CSIN + pcol * 16 : TB_RSIN + prow * 16) + 8 * (j & 1);
            const f32x4 c0 = *(const f32x4*)ct, c1 = *(const f32x4*)(ct + 4), s0 = *(const f32x4*)st, s1 = *(const f32x4*)(st + 4);
            const float cc[8] = {c0.x, c0.y, c0.z, c0.w, c1.x, c1.y, c1.z, c1.w}, sn[8] = {s0.x, s0.y, s0.z, s0.w, s1.x, s1.y, s1.z, s1.w};
#pragma unroll
            for (int i = 0; i < 8; ++i) { const float pr = __shfl_xor(v[i], 2); v[i] = isx2 ? (v[i] * cc[i] + pr * sn[i]) : (v[i] * cc[i] - pr * sn[i]); }
        }
        v4u o; o.x = pk2(v[0], v[1]); o.y = pk2(v[2], v[3]); o.z = pk2(v[4], v[5]); o.w = pk2(v[6], v[7]);
        *(v4u*)p = o;
    }
}

__device__ __forceinline__ void p4_attention(Frame& F, char* lds) {
    const bf16* P = (const bf16*)(F.ws + WS_P); bf16* OD = (bf16*)(F.ws + WS_OD); bf16* ON = (bf16*)(F.ws + WS_ON);
    for (int unit = F.vcu; unit < 1024; unit += F.G) {
        const int bhm = unit >> 5, qb = unit & 31, b = bhm >> 3, h = (bhm >> 1) & 3, m = bhm & 1;
        att::DiffPol pol; pol.Kg = P + 512 + h * 128 + m * 64; pol.Vg = P + 1024 + h * 128; pol.lat0 = (long)b * SEQ; pol.ctx0 = (long)TT + b * CTX;
        att::attn_unit<4, att::DiffPol>(P + ((size_t)b * SEQ + qb * 256) * NQKV + h * 128 + m * 64, pol, OD + ((size_t)b * SEQ + qb * 256) * 1024 + h * 256 + m * 128, 1024, 132, lds);
    }
    float* tabl = (float*)(lds + att::lds_bytes<4>());
    for (int unit = F.vcu; unit < 1024; unit += F.G) {
        const int bh = unit >> 5, rb = unit & 31, b = bh >> 3, hn = bh & 7, r = rb * 4;
        for (int i = F.tid; i < 15 * 31; i += 512) tabl[i] = F.in[I_RPB][hn * 465 + i] * 8.0f;
        att::NaPol pol; pol.Kg = P + 2048 + hn * 64; pol.Vg = P + 2560 + hn * 64; pol.lat0 = (long)b * SEQ; pol.ctx0 = (long)TT + b * CTX;
        pol.r = r; pol.rbase = (r - 4) < 0 ? 0 : ((r - 4) > 120 ? 120 : (r - 4)); pol.tab = tabl;
        att::attn_unit<2, att::NaPol>(P + ((size_t)b * SEQ + r * 64) * NQKV + 1536 + hn * 64, pol, ON + ((size_t)b * SEQ + r * 64) * 512 + hn * 64, 512, 16, lds);
    }
}

__device__ __forceinline__ void p5_mix(Frame& F) {
    const float* tab = (const float*)(F.ws + WS_TAB); const bf16* OD = (const bf16*)(F.ws + WS_OD); const bf16* ON = (const bf16*)(F.ws + WS_ON); bf16* MX = (bf16*)(F.ws + WS_MIX);
    const int gw = F.vcu * NWAVES + F.wave, NGW = F.G * NWAVES;
    const float lam = tab[TB_LAM];
    const int h = F.lane >> 4, e0 = (F.lane & 15) * 8;
    const f32x4 sl0 = *(const f32x4*)(F.in[I_SUBLN] + e0), sl1 = *(const f32x4*)(F.in[I_SUBLN] + e0 + 4);
    const f32x4 on0 = *(const f32x4*)(F.in[I_ONN] + F.lane * 8), on1 = *(const f32x4*)(F.in[I_ONN] + F.lane * 8 + 4);
    for (int t = gw; t < TT; t += NGW) {
        const v4u a = *(const v4u*)(OD + (size_t)t * 1024 + h * 256 + e0), c = *(const v4u*)(OD + (size_t)t * 1024 + h * 256 + 128 + e0);
        const v4u n = *(const v4u*)(ON + (size_t)t * 512 + F.lane * 8);
        float d[8] = {bflo(a.x) - lam * bflo(c.x), bfhi(a.x) - lam * bfhi(c.x), bflo(a.y) - lam * bflo(c.y), bfhi(a.y) - lam * bfhi(c.y),
                      bflo(a.z) - lam * bflo(c.z), bfhi(a.z) - lam * bfhi(c.z), bflo(a.w) - lam * bflo(c.w), bfhi(a.w) - lam * bfhi(c.w)};
        float ss = 0.f;
#pragma unroll
        for (int i = 0; i < 8; ++i) ss += d[i] * d[i];
        ss += __shfl_xor(ss, 1); ss += __shfl_xor(ss, 2); ss += __shfl_xor(ss, 4); ss += __shfl_xor(ss, 8);
        const float rs = 0.8f / sqrtf(ss * (1.f / 128.f) + NORM_EPS);
        v4u o; o.x = pk2(d[0] * rs * sl0.x, d[1] * rs * sl0.y); o.y = pk2(d[2] * rs * sl0.z, d[3] * rs * sl0.w); o.z = pk2(d[4] * rs * sl1.x, d[5] * rs * sl1.y); o.w = pk2(d[6] * rs * sl1.z, d[7] * rs * sl1.w);
        *(v4u*)(MX + (size_t)t * 1024 + h * 128 + e0) = o;
        float q[8] = {bflo(n.x), bfhi(n.x), bflo(n.y), bfhi(n.y), bflo(n.z), bfhi(n.z), bflo(n.w), bfhi(n.w)};
        float s2 = 0.f;
#pragma unroll
        for (int i = 0; i < 8; ++i) s2 += q[i] * q[i];
        s2 += __shfl_xor(s2, 1); s2 += __shfl_xor(s2, 2); s2 += __shfl_xor(s2, 4);
        const float r2 = 1.0f / sqrtf(s2 * (1.f / 64.f) + NORM_EPS);
        v4u o2; o2.x = pk2(q[0] * r2 * on0.x, q[1] * r2 * on0.y); o2.y = pk2(q[2] * r2 * on0.z, q[3] * r2 * on0.w); o2.z = pk2(q[4] * r2 * on1.x, q[5] * r2 * on1.y); o2.w = pk2(q[6] * r2 * on1.z, q[7] * r2 * on1.w);
        *(v4u*)(MX + (size_t)t * 1024 + 512 + F.lane * 8) = o2;
    }
}

__device__ __forceinline__ void p7_router(Frame& F) {
    const float* tab = (const float*)(F.ws + WS_TAB); unsigned* cnt = (unsigned*)(F.ws + WS_CTL) + CW_CNT;
    int* rt_e = (int*)(F.ws + WS_RT + RT_E); float* rt_g = (float*)(F.ws + WS_RT + RT_G); int* rt_pos = (int*)(F.ws + WS_RT + RT_POS);
    LAS unsigned* cntl = (LAS unsigned*)(F.lds + MISC_OFF); LAS unsigned* basel = cntl + 32;
    const int j = F.lane & 31, kh = F.lane >> 5;
    for (int tile = F.vcu; tile < TT / 128; tile += F.G) {
        if (F.tid < 32) cntl[F.tid] = 0u;
        __syncthreads();
        int te[4] = {0, 0, 0, 0}; float tg[4] = {0, 0, 0, 0}; unsigned lp[4] = {0, 0, 0, 0}; const int t = tile * 128 + 32 * F.wave + j;
        if (F.wave < 4) {
            const int b = t >> 13;
            const float* xr = F.out + (size_t)t * DM + 4 * kh;
            const float* wp = tab + TB_WR + (size_t)b * 32768 + (4 * kh) * 32 + j;
            f32x16 acc = f32x16{}; float ss = 0.f;
#pragma unroll 4
            for (int u = 0; u < 128; ++u) {
                const f32x4 xv = *(const f32x4*)(xr + 8 * u);
                const float w0 = wp[(8 * u + 0) * 32], w1 = wp[(8 * u + 1) * 32], w2 = wp[(8 * u + 2) * 32], w3 = wp[(8 * u + 3) * 32];
                ss += (xv.x * xv.x + xv.y * xv.y) + (xv.z * xv.z + xv.w * xv.w);
                acc = __builtin_amdgcn_mfma_f32_32x32x2f32(w0, xv.x, acc, 0, 0, 0);
                acc = __builtin_amdgcn_mfma_f32_32x32x2f32(w1, xv.y, acc, 0, 0, 0);
                acc = __builtin_amdgcn_mfma_f32_32x32x2f32(w2, xv.z, acc, 0, 0, 0);
                acc = __builtin_amdgcn_mfma_f32_32x32x2f32(w3, xv.w, acc, 0, 0, 0);
            }
            ss += __shfl_xor(ss, 32);
            const float rstd = 1.0f / sqrtf(ss * (1.f / DM) + NORM_EPS);
            float v[16];
#pragma unroll
            for (int r = 0; r < 16; ++r) v[r] = acc[r] * rstd + tab[TB_RC + b * 32 + att::crow(r, kh)];
            float cv[8]; int ce[8];
#pragma unroll
            for (int k = 0; k < 4; ++k) { float best = -INFINITY; int bi = 0;
#pragma unroll
                for (int r = 0; r < 16; ++r) if (v[r] > best) { best = v[r]; bi = r; }
#pragma unroll
                for (int r = 0; r < 16; ++r) if (r == bi) v[r] = -INFINITY;
                cv[k] = best; ce[k] = att::crow(bi, kh); }
#pragma unroll
            for (int k = 0; k < 4; ++k) { cv[4 + k] = __shfl_xor(cv[k], 32); ce[4 + k] = __shfl_xor(ce[k], 32); }
            float tv[4];
#pragma unroll
            for (int k = 0; k < 4; ++k) { float best = -INFINITY; int be = 1 << 30, bi = 0;
#pragma unroll
                for (int q = 0; q < 8; ++q) if (cv[q] > best || (cv[q] == best && ce[q] < be)) { best = cv[q]; be = ce[q]; bi = q; }
#pragma unroll
                for (int q = 0; q < 8; ++q) if (q == bi) cv[q] = -INFINITY;
                tv[k] = best; te[k] = be; }
            const float e1 = __expf(tv[1] - tv[0]), e2 = __expf(tv[2] - tv[0]), e3 = __expf(tv[3] - tv[0]); const float inv = 1.0f / (1.0f + e1 + e2 + e3);
            tg[0] = inv; tg[1] = e1 * inv; tg[2] = e2 * inv; tg[3] = e3 * inv;
            if (kh == 0) {
#pragma unroll
                for (int k = 0; k < 4; ++k) lp[k] = __hip_atomic_fetch_add(cntl + te[k], 1u, __ATOMIC_RELAXED, __HIP_MEMORY_SCOPE_WORKGROUP);
            }
        }
        __syncthreads();
        if (F.tid < 32) { const unsigned c = cntl[F.tid]; basel[F.tid] = c ? atomicAdd(cnt + F.tid, c) : 0u; }
        __syncthreads();
        if (F.wave < 4 && kh == 0) {
#pragma unroll
            for (int k = 0; k < 4; ++k) { rt_e[t * 4 + k] = te[k]; rt_g[t * 4 + k] = tg[k]; rt_pos[t * 4 + k] = (int)(basel[te[k]] + lp[k]); }
        }
        __syncthreads();
    }
}

__device__ __forceinline__ int pad_starts(const unsigned* cnt, int lane) {
    const int c = lane < 32 ? (int)__hip_atomic_load(cnt + lane, __ATOMIC_RELAXED, __HIP_MEMORY_SCOPE_AGENT) : 0;
    int p = (c + 255) & ~255, incl = p;
#pragma unroll
    for (int o = 1; o < 64; o <<= 1) { const int n = __shfl_up(incl, o); if (lane >= o) incl += n; }
    return incl - p;
}

__device__ __forceinline__ void p8_scatter(Frame& F) {
    const float* tab = (const float*)(F.ws + WS_TAB); const unsigned* cnt = (const unsigned*)(F.ws + WS_CTL) + CW_CNT;
    const int* rt_e = (const int*)(F.ws + WS_RT + RT_E); const int* rt_pos = (const int*)(F.ws + WS_RT + RT_POS); int* rt_slot = (int*)(F.ws + WS_RT + RT_SLOT);
    bf16* XG = (bf16*)(F.ws + WS_XG);
    const int gw = F.vcu * NWAVES + F.wave, NGW = F.G * NWAVES;
    const int pst = pad_starts(cnt, F.lane);
    const f32x4* gf = (const f32x4*)F.in[I_GFFN] + F.lane;
    for (int t = gw; t < TT; t += NGW) {
        const int b = t >> 13;
        const f32x4* xr = (const f32x4*)(F.out + (size_t)t * DM) + F.lane;
        const f32x4* sh = (const f32x4*)(tab + TB_MOD + b * 6144 + 3 * 1024) + F.lane; const f32x4* sc = (const f32x4*)(tab + TB_MOD + b * 6144 + 4 * 1024) + F.lane;
        f32x4 v[4]; float s = 0.f;
#pragma unroll
        for (int jj = 0; jj < 4; ++jj) { v[jj] = xr[64 * jj]; s += (v[jj].x * v[jj].x + v[jj].y * v[jj].y) + (v[jj].z * v[jj].z + v[jj].w * v[jj].w); }
        const float rstd = 1.0f / sqrtf(wave_sum(s) * (1.f / DM) + NORM_EPS);
        unsigned long long pk[4];
#pragma unroll
        for (int jj = 0; jj < 4; ++jj) { const f32x4 g = gf[64 * jj], a = sc[64 * jj], c = sh[64 * jj]; const f32x4 h = (v[jj] * rstd) * g * (a + 1.0f) + c;
            pk[jj] = (unsigned long long)pk2(h.x, h.y) | ((unsigned long long)pk2(h.z, h.w) << 32); }
        const int my_e = rt_e[t * 4 + (F.lane & 3)], my_pos = rt_pos[t * 4 + (F.lane & 3)];
#pragma unroll
        for (int k = 0; k < 4; ++k) { const int e = __shfl(my_e, k), pos = __shfl(my_pos, k); const int slot = __shfl(pst, e) + pos;
            unsigned long long* o8 = (unsigned long long*)(XG + (size_t)slot * DM) + F.lane;
#pragma unroll
            for (int jj = 0; jj < 4; ++jj) o8[64 * jj] = pk[jj];
            if (F.lane == 0) rt_slot[t * 4 + k] = slot; }
    }
}

__device__ __forceinline__ int moe_block_table(Frame& F, LAS int* bexp) {
    const unsigned* cnt = (const unsigned*)(F.ws + WS_CTL) + CW_CNT;
    const int pst = pad_starts(cnt, F.lane);
    const int total = __shfl(pst, 32) >> 8;
    if (F.wave == 0) {
        const int nxt = __shfl_down(pst, 1);
        if (F.lane < 32) for (int bl = pst >> 8; bl < (nxt >> 8); ++bl) bexp[bl] = F.lane;
    }
    __syncthreads();
    return __builtin_amdgcn_readfirstlane(total);
}

__device__ __forceinline__ void p11_combine(Frame& F) {
    const float* tab = (const float*)(F.ws + WS_TAB); const bf16* Y = (const bf16*)(F.ws + WS_Y);
    const float* rt_g = (const float*)(F.ws + WS_RT + RT_G); const int* rt_slot = (const int*)(F.ws + WS_RT + RT_SLOT);
    const int gw = F.vcu * NWAVES + F.wave, NGW = F.G * NWAVES;
    for (int t = gw; t < TT; t += NGW) {
        const int b = t >> 13;
        f32x4* xr = (f32x4*)(F.out + (size_t)t * DM) + F.lane;
        const f32x4* g2 = (const f32x4*)(tab + TB_MOD + b * 6144 + 5 * 1024) + F.lane;
        f32x4 acc[4];
#pragma unroll
        for (int jj = 0; jj < 4; ++jj) acc[jj] = (f32x4){0.f, 0.f, 0.f, 0.f};
        const int my_slot = rt_slot[t * 4 + (F.lane & 3)]; const float my_g = rt_g[t * 4 + (F.lane & 3)];
#pragma unroll
        for (int k = 0; k < 4; ++k) { const int slot = __shfl(my_slot, k); const float g = __shfl(my_g, k);
            const v2u* yr = (const v2u*)(Y + (size_t)slot * DM) + F.lane;
#pragma unroll
            for (int jj = 0; jj < 4; ++jj) { const v2u w = yr[64 * jj]; acc[jj] += (f32x4){bflo(w.x), bfhi(w.x), bflo(w.y), bfhi(w.y)} * g; } }
#pragma unroll
        for (int jj = 0; jj < 4; ++jj) xr[64 * jj] = xr[64 * jj] + g2[64 * jj] * acc[jj];
    }
}

struct Args { const float* in[N_IN]; float* out; unsigned char* ws; int ph_lo, ph_hi; };
__global__ void __launch_bounds__(NWAVES * 64, 2) mk_fwd(Args args) {
    extern __shared__ __attribute__((aligned(16))) unsigned char lds[];
    Frame F;
    F.lds = (LAS unsigned char*)lds;
    F.tid = threadIdx.x; F.lane = F.tid & 63; F.wave = __builtin_amdgcn_readfirstlane(F.tid >> 6);
    F.G = gridDim.x; { const int bx = blockIdx.x; F.vcu = (F.G % 8 == 0) ? (bx % 8) * (F.G / 8) + bx / 8 : bx; }
#pragma unroll
    for (int i = 0; i < N_IN; ++i) F.in[i] = args.in[i];
    F.out = args.out; F.ws = args.ws;
    const int lo = args.ph_lo, hi = args.ph_hi;
#define IN(k) (lo <= (k) && (k) < hi)
#define SEAM(k) do { if (IN(k) && IN((k) + 1)) { cg::this_grid().sync(); } } while (0)
    if (IN(0)) { p0_prologue(F); } SEAM(0);
    if (IN(1)) { p1_norm(F); } SEAM(1);
    if (IN(2)) {
        pg8::Gemm g{(const bf16*)(F.ws + WS_XN), (const bf16*)(F.ws + WS_WQKV), MQ, NQKV, DM, 0};
        pg8::StaticOrder S; S.init(MQ, NQKV, F.G, (int)blockIdx.x);
        pg8::EpiBf16<0> E{(bf16*)(F.ws + WS_P), NQKV, nullptr, 0, 0, 1.f};
        pg8::gemm_phase<pg8::EpiBf16<0>, pg8::StaticOrder, true, true>(F.lds, g, S, E);
    } SEAM(2);
    if (IN(3)) { p3_qknorm(F); } SEAM(3);
    if (IN(4)) { p4_attention(F, (char*)lds); } SEAM(4);
    if (IN(5)) { p5_mix(F); } SEAM(5);
    if (IN(6)) {
        pg8::Gemm g{(const bf16*)(F.ws + WS_MIX), (const bf16*)(F.ws + WS_WO), TT, DM, DM, 0};
        pg8::StaticOrder S; S.init(TT, DM, F.G, (int)blockIdx.x);
        pg8::EpiOut E{F.in[I_X], F.out, (const float*)(F.ws + WS_TAB) + TB_MOD};
        pg8::gemm_phase<pg8::EpiOut, pg8::StaticOrder, true, true>(F.lds, g, S, E);
    } SEAM(6);
    if (IN(7)) { p7_router(F); } SEAM(7);
    if (IN(8)) { p8_scatter(F); } SEAM(8);
    if (IN(9)) {
        LAS int* bexp = (LAS int*)(F.lds + MISC_OFF + 1024);
        const int nblk = moe_block_table(F, bexp);
        pg8::Gemm g{(const bf16*)(F.ws + WS_XG), (const bf16*)(F.ws + WS_WGU), MPAD, 2048, DM, (size_t)2048 * 1024 * 2};
        pg8::MoeOrder S; S.init(nblk, 8, F.G, (int)blockIdx.x, bexp);
        pg8::EpiSwiGLU E{(bf16*)(F.ws + WS_ACT), F.in[I_BGU]};
        pg8::gemm_phase<pg8::EpiSwiGLU, pg8::MoeOrder, true, true>(F.lds, g, S, E);
    } SEAM(9);
    if (IN(10)) {
        LAS int* bexp = (LAS int*)(F.lds + MISC_OFF + 1024);
        const int nblk = moe_block_table(F, bexp);
        pg8::Gemm g{(const bf16*)(F.ws + WS_ACT), (const bf16*)(F.ws + WS_WDN), MPAD, 1024, DM, (size_t)1024 * 1024 * 2};
        pg8::MoeOrder S; S.init(nblk, 4, F.G, (int)blockIdx.x, bexp);
        pg8::EpiDown E{(bf16*)(F.ws + WS_Y), F.in[I_BD]};
        pg8::gemm_phase<pg8::EpiDown, pg8::MoeOrder, true, true>(F.lds, g, S, E);
    } SEAM(10);
    if (IN(11)) { p11_combine(F); }
#undef IN
#undef SEAM
}

extern "C" void kernel_launch(void* const* d_in, const int* in_sizes, int n_in, void* d_out, int out_size, void* d_ws, size_t ws_size, hipStream_t stream) {
    static int grid = 0;
    if (grid == 0) {
        if (n_in != N_IN || in_sizes[0] != TT * DM || out_size != TT * DM || ws_size < WS_END) { fprintf(stderr, "kernel_launch: unexpected shapes (n_in %d, in0 %d, out %d, ws %zu)\n", n_in, n_in > 0 ? in_sizes[0] : -1, out_size, ws_size); grid = -1; return; }
        int dev = 0, cus = 0, per_cu = 0;
        if (hipGetDevice(&dev) != hipSuccess || hipDeviceGetAttribute(&cus, hipDeviceAttributeMultiprocessorCount, dev) != hipSuccess) { grid = -1; return; }
        if (hipFuncSetAttribute((const void*)mk_fwd, hipFuncAttributeMaxDynamicSharedMemorySize, LDS_BYTES) != hipSuccess) { fprintf(stderr, "kernel_launch: hipFuncSetAttribute failed\n"); grid = -1; return; }
        if (hipOccupancyMaxActiveBlocksPerMultiprocessor(&per_cu, (const void*)mk_fwd, NWAVES * 64, LDS_BYTES) != hipSuccess || per_cu < 1) { fprintf(stderr, "kernel_launch: occupancy query reports %d\n", per_cu); (void)hipGetLastError(); per_cu = 1; }
        grid = cus;
    }
    if (grid < 0) return;
    (void)hipMemsetAsync((char*)d_ws + WS_CTL, 0, CTL_ZERO_BYTES, stream);
    Args a{};
    for (int i = 0; i < N_IN; ++i) a.in[i] = (const float*)d_in[i];
    a.out = (float*)d_out; a.ws = (unsigned char*)d_ws;
    if (MK_N_LAUNCHES == 1) {
        a.ph_lo = 0; a.ph_hi = N_PHASES;
        void* params[] = {&a};
        const hipError_t e = hipLaunchCooperativeKernel((const void*)mk_fwd, dim3(grid), dim3(NWAVES * 64), params, LDS_BYTES, stream);
        if (e != hipSuccess) fprintf(stderr, "kernel_launch: cooperative launch failed: %s (grid %d)\n", hipGetErrorString(e), grid);
    } else {
        for (int p = 0; p < N_PHASES; ++p) { a.ph_lo = p; a.ph_hi = p + 1; hipLaunchKernelGGL(mk_fwd, dim3(grid), dim3(NWAVES * 64), LDS_BYTES, stream, a); }
        const hipError_t le = hipPeekAtLastError();
        if (le != hipSuccess) fprintf(stderr, "kernel_launch: launch failed: %s\n", hipGetErrorName(le));
    }
}
```

```cpp
#include <hip/hip_runtime.h>
#include <hip/hip_cooperative_groups.h>
#include <cstdio>
#include <cstdint>
namespace cg = cooperative_groups;
namespace pg8 {
#define PG8_LAS __attribute__((address_space(3)))
typedef unsigned short bf16_t;
typedef short bf16x8 __attribute__((ext_vector_type(8)));
typedef float f32x4 __attribute__((ext_vector_type(4)));
typedef unsigned u32x4 __attribute__((ext_vector_type(4)));
constexpr int BM = 256, BK = 64, HALF = 128, HTB = HALF * BK * 2  , STAGE_BYTES = 8 * HTB, NXCD = 8, WGM = 8;

__host__ __device__ __forceinline__ int lds_byte(int r, int c) { const int st = (r >> 4) * 2 + (c >> 5), rr = r & 15, cc = c & 31, ob = rr * 64 + cc * 2; return st * 1024 + (ob ^ (((ob >> 9) & 1) << 5)); }
__host__ __device__ __forceinline__ void stage_rc(int b, int& R, int& C) { const int st = b / 1024, sb = b % 1024, swz = sb ^ (((sb >> 9) & 1) << 5); R = (st >> 1) * 16 + swz / 64; C = (st & 1) * 32 + (swz % 64) / 2; }
__host__ __device__ __forceinline__ int perm32(int rho) { const int n = rho >> 4, i = rho & 15; return 8 * (i >> 2) + 4 * n + (i & 3); }

struct Unit { int pm, pn, e; };
struct Gemm { const bf16_t* A; const bf16_t* Bt; int M, N, K; size_t estride; };

struct StaticOrder {
    int nM, nN, nwg, G, c;
    __host__ __device__ void init(int M, int N, int G_, int c_) { nM = M / BM; nN = N / BM; nwg = nM * nN; G = G_; c = c_; }
    __host__ __device__ bool next(int i, Unit& u) const {
        const long L = (long)i * G + c; if (L >= nwg) return false;
        int wgid = (int)L; { const int q = nwg / NXCD, r = nwg % NXCD, xcd = wgid % NXCD, off = wgid / NXCD; wgid = (xcd < r ? xcd * (q + 1) : r * (q + 1) + (xcd - r) * q) + off; }
        const int nig = WGM * nN, gid = wgid / nig, fm = gid * WGM, gsz = (nM - fm) < WGM ? (nM - fm) : WGM;
        u.pm = fm + ((wgid % nig) % gsz); u.pn = (wgid % nig) / gsz; u.e = 0; return true;
    }
    __device__ __forceinline__ void a_ready(const Unit&) const {}
    __device__ __forceinline__ void done(const Unit&) const {}
};

__device__ __forceinline__ unsigned cvt_pk_bf16(float lo, float hi) { unsigned r; asm volatile("v_cvt_pk_bf16_f32 %0, %1, %2" : "=v"(r) : "v"(lo), "v"(hi)); return r; }
typedef float f32x2 __attribute__((ext_vector_type(2)));
__device__ __forceinline__ f32x2 gelu_pk(f32x2 v) {
    const f32x2 av = __builtin_elementwise_abs(v), d = av * 0.2316418882f + 1.0f;
    f32x2 t; t.x = __builtin_amdgcn_rcpf(d.x); t.y = __builtin_amdgcn_rcpf(d.y);
    f32x2 q = t * 0.5307027145f + (-0.7265760135f); q = q * t + 0.7107068705f; q = q * t + (-0.142248368f); q = q * t + 0.127414796f; q = q * t;
    const f32x2 s = (v * v) * (-0.72134752044f);
    f32x2 e; e.x = __builtin_amdgcn_exp2f(s.x); e.y = __builtin_amdgcn_exp2f(s.y);
    const f32x2 m = v * (q * e), r = v - m;
    f32x2 o; o.x = v.x < 0.f ? m.x : r.x; o.y = v.y < 0.f ? m.y : r.y; return o;
}

template <int ACT  > struct EpiBf16 {
    static constexpr bool PERM = true, AFTER_DRAIN = false; static_assert(ACT == 0 || ACT == 1, "EpiBf16: ACT is 0 (none) or 1 (gelu_pk)");
    bf16_t* O; int ldc; const float* bias; int split_cols; size_t split_stride; float scale0;
    __device__ __forceinline__ void operator()(const f32x4 (&acc)[2][2][4][2], const Unit& u, int wr, int wc, int fr, int fq) const {
        const int row0 = u.pm * BM + wr * 64 + fr; int colt = u.pn * BM; bf16_t* base = O;
        float sc = 1.f; if (split_cols) { const int t = colt / split_cols; base += (size_t)t * split_stride; colt -= t * split_cols; if (t == 0) sc = scale0; }
        const int col0 = colt + wc * 32 + 8 * fq, bcol0 = u.pn * BM + wc * 32 + 8 * fq;
        f32x4 bv[2][2];
#pragma unroll
        for (int bj = 0; bj < 2; ++bj)
#pragma unroll
            for (int n = 0; n < 2; ++n) bv[bj][n] = bias ? *(const f32x4*)(bias + bcol0 + bj * HALF + 4 * n) : (f32x4){0.f, 0.f, 0.f, 0.f};
#pragma unroll
        for (int ai = 0; ai < 2; ++ai)
#pragma unroll
            for (int m = 0; m < 4; ++m) { bf16_t* rowp = base + (size_t)(row0 + ai * HALF + m * 16) * ldc + col0;
#pragma unroll
                for (int bj = 0; bj < 2; ++bj) { f32x4 v0 = acc[ai][bj][m][0] + bv[bj][0], v1 = acc[ai][bj][m][1] + bv[bj][1];
                    if (ACT == 1) { f32x2 a = gelu_pk((f32x2){v0[0], v0[1]}), b = gelu_pk((f32x2){v0[2], v0[3]}), c = gelu_pk((f32x2){v1[0], v1[1]}), d = gelu_pk((f32x2){v1[2], v1[3]});
                        v0 = (f32x4){a.x, a.y, b.x, b.y}; v1 = (f32x4){c.x, c.y, d.x, d.y}; }
                    v0 = v0 * sc; v1 = v1 * sc; u32x4 w; w.x = cvt_pk_bf16(v0[0], v0[1]); w.y = cvt_pk_bf16(v0[2], v0[3]); w.z = cvt_pk_bf16(v1[0], v1[1]); w.w = cvt_pk_bf16(v1[2], v1[3]);
                    *(u32x4*)(rowp + bj * HALF) = w; } }
    }
};

template <class Epi, class Sched, bool ALIGN_EPI = false, bool SP2 = false>
__device__ __forceinline__ void gemm_phase(PG8_LAS unsigned char* lds, const Gemm g, const Sched& S, const Epi& E) {
    const int tid = threadIdx.x, wid = __builtin_amdgcn_readfirstlane(tid >> 6), lane = tid & 63, wr = wid >> 2, wc = wid & 3, fr = lane & 15, fq = lane >> 4;
    const int K = g.K, nt = K / BK;
    unsigned voffA[2], voffB[2];
#pragma unroll
    for (int i = 0; i < 2; ++i) { int R, C; stage_rc(tid * 16 + i * 8192, R, C); const int Rb = Epi::PERM ? ((R & ~31) + perm32(R & 31)) : R;
        voffA[i] = (unsigned)(R * K + C) * 2u; voffB[i] = (unsigned)(Rb * K + C) * 2u; }
    const size_t kstep = (size_t)(BK * 2);
    const size_t hstep = (size_t)HALF * K * 2;
    const size_t tstep = 2 * hstep;
    const unsigned ldsw = (unsigned)wid * 1024u;
    const int aoff = lds_byte(wr * 64 + fr, fq * 8), boff = lds_byte(wc * 32 + fr, fq * 8);
#define PG8_SA(b, h) (((b) * 2 + (h)) * HTB)
#define PG8_SB(b, h) ((4 + (b) * 2 + (h)) * HTB)
#define PG8_STAGE(bufoff, gbase, voff) do { _Pragma("unroll") for (int _i = 0; _i < 2; ++_i) \
        __builtin_amdgcn_global_load_lds((const unsigned*)((const char*)(gbase) + (voff)[_i]), (PG8_LAS unsigned*)(lds + (bufoff) + ldsw + _i * 8192), 16, 0, 0); } while (0)
#define PG8_LDA(dst, b, h) do { _Pragma("unroll") for (int m = 0; m < 4; ++m) _Pragma("unroll") for (int k = 0; k < 2; ++k) dst[m][k] = *(const PG8_LAS bf16x8*)(lds + PG8_SA(b, h) + aoff + m * 2048 + k * 1024); } while (0)
#define PG8_LDB(dst, b, h) do { _Pragma("unroll") for (int n = 0; n < 2; ++n) _Pragma("unroll") for (int k = 0; k < 2; ++k) dst[n][k] = *(const PG8_LAS bf16x8*)(lds + PG8_SB(b, h) + boff + n * 2048 + k * 1024); } while (0)
#define PG8_MMA(ai, bj, At, Bt) do { __builtin_amdgcn_s_setprio(1); _Pragma("unroll") for (int m = 0; m < 4; ++m) _Pragma("unroll") for (int n = 0; n < 2; ++n) _Pragma("unroll") for (int k = 0; k < 2; ++k) \
        acc[ai][bj][m][n] = __builtin_amdgcn_mfma_f32_16x16x32_bf16(Bt[n][k], At[m][k], acc[ai][bj][m][n], 0, 0, 0); __builtin_amdgcn_s_setprio(0); } while (0)
#define PG8_WAIT_V(n) asm volatile("s_waitcnt vmcnt(" #n ")" ::: "memory")
#define PG8_WAIT_L(n) asm volatile("s_waitcnt lgkmcnt(" #n ")" ::: "memory")
#define PG8_BAR __builtin_amdgcn_s_barrier()
#define PG8_SCHED __builtin_amdgcn_sched_barrier(0)
    Unit cur, nxt; int ui = 0;
    if (!S.next(0, cur)) return;
    f32x4 acc[2][2][4][2];
#pragma unroll
    for (int a = 0; a < 2; ++a)
#pragma unroll
        for (int b = 0; b < 2; ++b)
#pragma unroll
            for (int m = 0; m < 4; ++m)
#pragma unroll
                for (int n = 0; n < 2; ++n) acc[a][b][m][n] = (f32x4){0.f, 0.f, 0.f, 0.f};
    bf16x8 At[4][2], B0[2][2], B1[2][2];
    const char* cA = (const char*)g.A + (size_t)cur.pm * tstep; const char* cB = (const char*)g.Bt + (size_t)cur.e * g.estride + (size_t)cur.pn * tstep;
    S.a_ready(cur);
    if constexpr (SP2) {
        PG8_STAGE(PG8_SB(0, 0), cB, voffB); PG8_STAGE(PG8_SB(0, 1), cB + hstep, voffB); PG8_STAGE(PG8_SA(0, 0), cA, voffA); PG8_STAGE(PG8_SA(0, 1), cA + hstep, voffA);
        if (wr == 1) PG8_BAR;
        PG8_WAIT_V(2); PG8_BAR;
        PG8_STAGE(PG8_SB(1, 0), cB + kstep, voffB); PG8_STAGE(PG8_SA(1, 0), cA + kstep, voffA); PG8_STAGE(PG8_SB(1, 1), cB + hstep + kstep, voffB);
        PG8_WAIT_V(6); PG8_BAR;
    } else {
        PG8_STAGE(PG8_SB(0, 0), cB, voffB); PG8_STAGE(PG8_SA(0, 0), cA, voffA); PG8_STAGE(PG8_SB(0, 1), cB + hstep, voffB); PG8_STAGE(PG8_SA(0, 1), cA + hstep, voffA);
        if (wr == 1) PG8_BAR;
        PG8_WAIT_V(4); PG8_BAR;
        PG8_STAGE(PG8_SB(1, 0), cB + kstep, voffB); PG8_STAGE(PG8_SA(1, 0), cA + kstep, voffA); PG8_STAGE(PG8_SB(1, 1), cB + hstep + kstep, voffB);
        PG8_WAIT_V(6); PG8_BAR;
    }
    for (;;) {
        const bool has_next = S.next(ui + 1, nxt);
        const char* nA = has_next ? (const char*)g.A + (size_t)nxt.pm * tstep : cA; const char* nB = has_next ? (const char*)g.Bt + (size_t)nxt.e * g.estride + (size_t)nxt.pn * tstep : cB;
        for (int t = 0; t < nt; t += 2) {
            const bool last = (t == nt - 2);
            const char* a1 = cA + (size_t)(t + 1) * kstep;
            const char* a2 = last ? nA : cA + (size_t)(t + 2) * kstep; const char* b2 = last ? nB : cB + (size_t)(t + 2) * kstep;
            const char* a3 = a2 + kstep; const char* b3 = b2 + kstep;
            if (last && has_next) S.a_ready(nxt);
            if constexpr (SP2) {
            PG8_LDB(B0, 0, 0); PG8_LDB(B1, 0, 1); PG8_SCHED; PG8_LDA(At, 0, 0); PG8_STAGE(PG8_SA(1, 1), a1 + hstep, voffA);
            PG8_WAIT_V(8); PG8_WAIT_L(0); PG8_BAR; PG8_MMA(0, 0, At, B0); PG8_MMA(0, 1, At, B1); PG8_BAR; PG8_SCHED;
            PG8_LDA(At, 0, 1); PG8_STAGE(PG8_SB(0, 0), b2, voffB); PG8_STAGE(PG8_SB(0, 1), b2 + hstep, voffB); PG8_STAGE(PG8_SA(0, 0), a2, voffA);
            PG8_WAIT_V(8); PG8_WAIT_L(0); PG8_BAR; PG8_MMA(1, 0, At, B0); PG8_MMA(1, 1, At, B1); PG8_BAR; PG8_SCHED;
            PG8_LDB(B0, 1, 0); PG8_LDB(B1, 1, 1); PG8_SCHED; PG8_LDA(At, 1, 0); PG8_STAGE(PG8_SA(0, 1), a2 + hstep, voffA);
            PG8_WAIT_V(8); PG8_WAIT_L(0); PG8_BAR; PG8_MMA(0, 0, At, B0); PG8_MMA(0, 1, At, B1); PG8_BAR; PG8_SCHED;
            PG8_LDA(At, 1, 1); PG8_STAGE(PG8_SB(1, 0), b3, voffB); PG8_STAGE(PG8_SB(1, 1), b3 + hstep, voffB); PG8_STAGE(PG8_SA(1, 0), a3, voffA);
            PG8_WAIT_V(8); PG8_WAIT_L(0); PG8_BAR; PG8_MMA(1, 0, At, B0); PG8_MMA(1, 1, At, B1); PG8_BAR; PG8_SCHED;
            } else {
            PG8_LDB(B0, 0, 0); PG8_SCHED; PG8_LDA(At, 0, 0); PG8_STAGE(PG8_SA(1, 1), a1 + hstep, voffA);
            PG8_WAIT_L(8); PG8_BAR; PG8_WAIT_L(0); PG8_MMA(0, 0, At, B0); PG8_BAR; PG8_SCHED;
            PG8_LDB(B1, 0, 1); PG8_STAGE(PG8_SB(0, 0), b2, voffB);
            PG8_BAR; PG8_WAIT_L(0); PG8_MMA(0, 1, At, B1); PG8_BAR;
            PG8_LDA(At, 0, 1); PG8_STAGE(PG8_SA(0, 0), a2, voffA);
            PG8_BAR; PG8_WAIT_L(0); PG8_MMA(1, 0, At, B0); PG8_BAR; PG8_SCHED;
            PG8_STAGE(PG8_SB(0, 1), b2 + hstep, voffB);
            PG8_WAIT_V(6); PG8_BAR; PG8_MMA(1, 1, At, B1); PG8_BAR;
            PG8_LDB(B0, 1, 0); PG8_SCHED; PG8_LDA(At, 1, 0); PG8_STAGE(PG8_SA(0, 1), a2 + hstep, voffA);
            PG8_WAIT_L(8); PG8_BAR; PG8_WAIT_L(0); PG8_MMA(0, 0, At, B0); PG8_BAR; PG8_SCHED;
            PG8_LDB(B1, 1, 1); PG8_STAGE(PG8_SB(1, 0), b3, voffB);
            PG8_BAR; PG8_WAIT_L(0); PG8_MMA(0, 1, At, B1); PG8_BAR;
            PG8_LDA(At, 1, 1); PG8_STAGE(PG8_SA(1, 0), a3, voffA);
            PG8_BAR; PG8_WAIT_L(0); PG8_MMA(1, 0, At, B0); PG8_BAR; PG8_SCHED;
            PG8_STAGE(PG8_SB(1, 1), b3 + hstep, voffB);
            PG8_WAIT_V(6); PG8_BAR; PG8_MMA(1, 1, At, B1); PG8_BAR;
            }
        }
        if constexpr (ALIGN_EPI) { if (wr == 0) PG8_BAR; }
        if constexpr (!Epi::AFTER_DRAIN) { E(acc, cur, wr, wc, fr, fq); S.done(cur); }
        if (!has_next) break;
#pragma unroll
        for (int a = 0; a < 2; ++a)
#pragma unroll
            for (int b = 0; b < 2; ++b)
#pragma unroll
                for (int m = 0; m < 4; ++m)
#pragma unroll
                    for (int n = 0; n < 2; ++n) acc[a][b][m][n] = (f32x4){0.f, 0.f, 0.f, 0.f};
        cur = nxt; cA = nA; cB = nB; ++ui;
        if constexpr (ALIGN_EPI) { if (wr == 1) PG8_BAR; }
    }
    PG8_WAIT_V(0);
    if constexpr (!ALIGN_EPI) { if (wr == 0) PG8_BAR; }
    PG8_BAR;
    if constexpr (Epi::AFTER_DRAIN) { E.fused(acc, cur, wr, wc, fr, fq, lds, wid, lane); S.done(cur); }
#undef PG8_SA
#undef PG8_SB
#undef PG8_STAGE
#undef PG8_LDA
#undef PG8_LDB
#undef PG8_MMA
#undef PG8_WAIT_V
#undef PG8_WAIT_L
#undef PG8_BAR
#undef PG8_SCHED
}
}

namespace pg8 {
struct MoeOrder {
    int nM, nN, nwg, G, c; const PG8_LAS int* bexp;
    __device__ __forceinline__ void init(int nM_, int nN_, int G_, int c_, const PG8_LAS int* bexp_) { nM = nM_; nN = nN_; nwg = nM_ * nN_; G = G_; c = c_; bexp = bexp_; }
    __device__ __forceinline__ bool next(int i, Unit& u) const {
        const long L = (long)i * G + c; if (L >= nwg) return false;
        int wgid = (int)L; { const int q = nwg / NXCD, r = nwg % NXCD, xcd = wgid % NXCD, off = wgid / NXCD; wgid = (xcd < r ? xcd * (q + 1) : r * (q + 1) + (xcd - r) * q) + off; }
        const int nig = WGM * nN, gid = wgid / nig, fm = gid * WGM, gsz = (nM - fm) < WGM ? (nM - fm) : WGM;
        u.pm = fm + ((wgid % nig) % gsz); u.pn = (wgid % nig) / gsz; u.e = __builtin_amdgcn_readfirstlane(bexp[u.pm]); return true;
    }
    __device__ __forceinline__ void a_ready(const Unit&) const {}
    __device__ __forceinline__ void done(const Unit&) const {}
};
struct EpiOut {
    static constexpr bool PERM = false, AFTER_DRAIN = false;
    const float* x; float* out; const float* mod;
    __device__ __forceinline__ void operator()(const f32x4 (&acc)[2][2][4][2], const Unit& u, int wr, int wc, int fr, int fq) const {
        const int row0 = u.pm * BM + wr * 64 + fr, col0 = u.pn * BM + wc * 32 + 4 * fq;
        const float* g = mod + (size_t)(u.pm >> 5) * 6144 + 2 * 1024;
        f32x4 gv[2][2];
#pragma unroll
        for (int bj = 0; bj < 2; ++bj)
#pragma unroll
            for (int n = 0; n < 2; ++n) gv[bj][n] = *(const f32x4*)(g + col0 + bj * HALF + n * 16);
#pragma unroll
        for (int ai = 0; ai < 2; ++ai)
#pragma unroll
            for (int m = 0; m < 4; ++m) { const size_t off = (size_t)(row0 + ai * HALF + m * 16) * 1024 + col0;
#pragma unroll
                for (int bj = 0; bj < 2; ++bj)
#pragma unroll
                    for (int n = 0; n < 2; ++n) { const f32x4 xv = *(const f32x4*)(x + off + bj * HALF + n * 16); *(f32x4*)(out + off + bj * HALF + n * 16) = xv + gv[bj][n] * acc[ai][bj][m][n]; } }
    }
};
__device__ __forceinline__ float swiglu1(float g, float l) {
    const float glu = fminf(g, 7.0f), lin = fminf(fmaxf(l, -7.0f), 7.0f);
    const float sg = __builtin_amdgcn_rcpf(1.0f + __builtin_amdgcn_exp2f(glu * (-1.702f * 1.4426950408889634f)));
    return glu * sg * (lin + 1.0f);
}
struct EpiSwiGLU {
    static constexpr bool PERM = true, AFTER_DRAIN = false;
    bf16_t* act; const float* bgu;
    __device__ __forceinline__ void operator()(const f32x4 (&acc)[2][2][4][2], const Unit& u, int wr, int wc, int fr, int fq) const {
        const int row0 = u.pm * BM + wr * 64 + fr, cg = u.pn * 128 + wc * 32 + 8 * fq;
        const float* bb = bgu + (size_t)u.e * 2048;
        f32x4 bg[2], bl[2];
#pragma unroll
        for (int n = 0; n < 2; ++n) { bg[n] = *(const f32x4*)(bb + cg + 4 * n); bl[n] = *(const f32x4*)(bb + 1024 + cg + 4 * n); }
#pragma unroll
        for (int ai = 0; ai < 2; ++ai)
#pragma unroll
            for (int m = 0; m < 4; ++m) { bf16_t* rowp = act + (size_t)(row0 + ai * HALF + m * 16) * 1024 + cg;
                const f32x4 g0 = acc[ai][0][m][0] + bg[0], g1 = acc[ai][0][m][1] + bg[1], l0 = acc[ai][1][m][0] + bl[0], l1 = acc[ai][1][m][1] + bl[1];
                u32x4 w; w.x = cvt_pk_bf16(swiglu1(g0[0], l0[0]), swiglu1(g0[1], l0[1])); w.y = cvt_pk_bf16(swiglu1(g0[2], l0[2]), swiglu1(g0[3], l0[3]));
                w.z = cvt_pk_bf16(swiglu1(g1[0], l1[0]), swiglu1(g1[1], l1[1])); w.w = cvt_pk_bf16(swiglu1(g1[2], l1[2]), swiglu1(g1[3], l1[3]));
                *(u32x4*)rowp = w; }
    }
};
struct EpiDown {
    static constexpr bool PERM = true, AFTER_DRAIN = false;
    bf16_t* y; const float* bd;
    __device__ __forceinline__ void operator()(const f32x4 (&acc)[2][2][4][2], const Unit& u, int wr, int wc, int fr, int fq) const {
        const int row0 = u.pm * BM + wr * 64 + fr, col0 = u.pn * BM + wc * 32 + 8 * fq;
        const float* bb = bd + (size_t)u.e * 1024 + col0;
        f32x4 bv[2][2];
#pragma unroll
        for (int bj = 0; bj < 2; ++bj)
#pragma unroll
            for (int n = 0; n < 2; ++n) bv[bj][n] = *(const f32x4*)(bb + bj * HALF + 4 * n);
#pragma unroll
        for (int ai = 0; ai < 2; ++ai)
#pragma unroll
            for (int m = 0; m < 4; ++m) { bf16_t* rowp = y + (size_t)(row0 + ai * HALF + m * 16) * 1024 + col0;
#pragma unroll
                for (int bj = 0; bj < 2; ++bj) { const f32x4 v0 = acc[ai][bj][m][0] + bv[bj][0], v1 = acc[ai][bj][m][1] + bv[bj][1];
                    u32x4 w; w.x = cvt_pk_bf16(v0[0], v0[1]); w.y = cvt_pk_bf16(v0[2], v0[3]); w.z = cvt_pk_bf16(v1[0], v1[1]); w.w = cvt_pk_bf16(v1[2], v1[3]);
                    *(u32x4*)(rowp + bj * HALF) = w; } }
    }
};
}

namespace att {
typedef unsigned short bf16_t;
using bf16x8 = __attribute__((ext_vector_type(8))) short;
using s16x4  = __attribute__((ext_vector_type(4))) short;
using f32x16 = __attribute__((ext_vector_type(16))) float;
using u32x4  = __attribute__((ext_vector_type(4))) unsigned;
constexpr int NW = 8, QBLK = 32, KVBLK = 64, LD = 3072;
constexpr float SCALE = 0.125f, THR = 8.f;
#define KSWZ64(row, colB) ((row) * 128 + ((colB) ^ ((((row) >> 1) & 7) << 4)))
#define ASBAR() __builtin_amdgcn_sched_barrier(0)
__device__ __forceinline__ int crow(int r, int hi) { return (r & 3) + 8 * (r >> 2) + 4 * hi; }
__device__ __forceinline__ unsigned cvtpk(float lo, float hi) { unsigned r; asm volatile("v_cvt_pk_bf16_f32 %0, %1, %2" : "=v"(r) : "v"(lo), "v"(hi)); return r; }
__device__ __forceinline__ bf16x8 ld8(const bf16_t* p) { return *reinterpret_cast<const bf16x8*>(p); }

__device__ __forceinline__ void partialSM(f32x16& p0, f32x16& p1, float& m_reg, float& mn, float& alpha) {
  constexpr float C = SCALE * 1.4426950408889634f;
  float pmax = p0[0];
#pragma unroll
  for (int r = 1; r < 16; ++r) pmax = fmaxf(pmax, p0[r]);
#pragma unroll
  for (int r = 0; r < 16; ++r) pmax = fmaxf(pmax, p1[r]);
  { auto rr = __builtin_amdgcn_permlane32_swap(__float_as_uint(pmax), __float_as_uint(pmax), false, false);
    pmax = fmaxf(__uint_as_float(rr[0]), __uint_as_float(rr[1])); }
  if (__builtin_expect(__all(pmax - m_reg <= THR / SCALE), 1)) { mn = m_reg; alpha = 1.f; }
  else { mn = fmaxf(m_reg, pmax); alpha = __builtin_amdgcn_exp2f((m_reg - mn) * C); m_reg = mn; }
  const float mnC = -mn * C;
#pragma unroll
  for (int r = 0; r < 16; ++r) p0[r] = fmaf(p0[r], C, mnC);
#pragma unroll
  for (int r = 0; r < 16; ++r) p1[r] = fmaf(p1[r], C, mnC);
#pragma unroll
  for (int r = 0; r < 16; ++r) p0[r] = __builtin_amdgcn_exp2f(p0[r]);
}
__device__ __forceinline__ void finishSM(f32x16& p0, f32x16& p1, float alpha, float& l_reg, bf16x8& pa0, bf16x8& pa1, bf16x8& pa2, bf16x8& pa3) {
#pragma unroll
  for (int r = 0; r < 16; ++r) p1[r] = __builtin_amdgcn_exp2f(p1[r]);
  float ps = 0;
#pragma unroll
  for (int r = 0; r < 16; ++r) ps += p0[r];
#pragma unroll
  for (int r = 0; r < 16; ++r) ps += p1[r];
  { auto rr = __builtin_amdgcn_permlane32_swap(__float_as_uint(ps), __float_as_uint(ps), false, false);
    ps = __uint_as_float(rr[0]) + __uint_as_float(rr[1]); }
  l_reg = l_reg * alpha + ps;
#define PK4(P, BASE, OUT) do { unsigned a0 = cvtpk(P[BASE + 0], P[BASE + 1]), a1 = cvtpk(P[BASE + 2], P[BASE + 3]);   \
    unsigned b0 = cvtpk(P[BASE + 4], P[BASE + 5]), b1 = cvtpk(P[BASE + 6], P[BASE + 7]);                              \
    auto r0 = __builtin_amdgcn_permlane32_swap(a0, b0, false, false); auto r1 = __builtin_amdgcn_permlane32_swap(a1, b1, false, false); \
    u32x4 w = {r0[0], r1[0], r0[1], r1[1]}; OUT = *reinterpret_cast<bf16x8*>(&w); } while (0)
  PK4(p0, 0, pa0); PK4(p0, 8, pa1); PK4(p1, 0, pa2); PK4(p1, 8, pa3);
#undef PK4
}
__device__ __forceinline__ void qkt(f32x16& p0, f32x16& p1, const char* Ks, const bf16x8* qr, int r32, int hi) {
  p0 = f32x16{}; p1 = f32x16{};
#pragma unroll
  for (int d0 = 0; d0 < 4; ++d0) { const int cb = (d0 * 16 + hi * 8) * 2;
    const bf16x8 b0 = *reinterpret_cast<const bf16x8*>(Ks + KSWZ64(r32, cb));
    const bf16x8 b1 = *reinterpret_cast<const bf16x8*>(Ks + KSWZ64(32 + r32, cb));
    p0 = __builtin_amdgcn_mfma_f32_32x32x16_bf16(b0, qr[d0], p0, 0, 0, 0);
    p1 = __builtin_amdgcn_mfma_f32_32x32x16_bf16(b1, qr[d0], p1, 0, 0, 0); }
}
template <int NVB> __device__ __forceinline__ int v_st(int k, int c) { const int kk = (k & ~0xC) | ((k & 4) << 1) | ((k & 8) >> 1); return ((kk >> 3) * NVB + (c >> 5)) * 512 + ((kk & 7) * 32 + (c & 31)) * 2; }
__device__ __forceinline__ int v_rd_base(int lane) { return ((lane & 3) << 3) | (((lane >> 2) & 3) << 6) | (((lane >> 4) & 1) << 5) | (((lane >> 5) & 1) << 8); }
template <int NVB> constexpr int v_rd_off(int d0, int ks, int half) { return d0 * 512 + ks * (NVB * 1024) + half * (NVB * 512); }
template <int OFF> __device__ __forceinline__ s16x4 tr_read(int vb) {
  s16x4 r; asm volatile("ds_read_b64_tr_b16 %0, %1 offset:%2" : "=&v"(r) : "v"(vb), "i"(OFF) : "memory"); return r;
}
template <int NVB, int D0> __device__ __forceinline__ void pv_one(f32x16& od, int vb, bf16x8 pa0, bf16x8 pa1, bf16x8 pa2, bf16x8 pa3) {
  const s16x4 l0 = tr_read<v_rd_off<NVB>(D0, 0, 0)>(vb), h0 = tr_read<v_rd_off<NVB>(D0, 0, 1)>(vb), l1 = tr_read<v_rd_off<NVB>(D0, 1, 0)>(vb), h1 = tr_read<v_rd_off<NVB>(D0, 1, 1)>(vb);
  const s16x4 l2 = tr_read<v_rd_off<NVB>(D0, 2, 0)>(vb), h2 = tr_read<v_rd_off<NVB>(D0, 2, 1)>(vb), l3 = tr_read<v_rd_off<NVB>(D0, 3, 0)>(vb), h3 = tr_read<v_rd_off<NVB>(D0, 3, 1)>(vb);
  asm volatile("s_waitcnt lgkmcnt(0)" ::: "memory"); ASBAR();
#define PK(L, H) (bf16x8){L[0], L[1], L[2], L[3], H[0], H[1], H[2], H[3]}
  od = __builtin_amdgcn_mfma_f32_32x32x16_bf16(pa0, PK(l0, h0), od, 0, 0, 0);
  od = __builtin_amdgcn_mfma_f32_32x32x16_bf16(pa1, PK(l1, h1), od, 0, 0, 0);
  od = __builtin_amdgcn_mfma_f32_32x32x16_bf16(pa2, PK(l2, h2), od, 0, 0, 0);
  od = __builtin_amdgcn_mfma_f32_32x32x16_bf16(pa3, PK(l3, h3), od, 0, 0, 0);
#undef PK
}
template <int NVB> __device__ __forceinline__ void pv_all(f32x16* o, int vb, bf16x8 pa0, bf16x8 pa1, bf16x8 pa2, bf16x8 pa3) {
  pv_one<NVB, 0>(o[0], vb, pa0, pa1, pa2, pa3); pv_one<NVB, 1>(o[1], vb, pa0, pa1, pa2, pa3);
  if constexpr (NVB == 4) { pv_one<NVB, 2>(o[2], vb, pa0, pa1, pa2, pa3); pv_one<NVB, 3>(o[3], vb, pa0, pa1, pa2, pa3); }
}
struct DiffPol {
  const bf16_t* Kg; const bf16_t* Vg; long lat0, ctx0;
  __device__ __forceinline__ long krow(int t) const { return t < 128 ? lat0 + 64L * t : ctx0 + 64L * (t - 128); }
  __device__ __forceinline__ void mod(f32x16&, f32x16&, int, int, int, int) const {}
};
struct NaPol {
  const bf16_t* Kg; const bf16_t* Vg; long lat0, ctx0; int rbase, r; const float* tab;
  __device__ __forceinline__ long krow(int t) const { if (t < 12) { int kr = rbase + t; kr = kr > 127 ? 127 : kr; return lat0 + 64L * kr; } return ctx0 + 64L * (t - 12); }
  __device__ __forceinline__ void mod(f32x16& p0, f32x16& p1, int t, int wid, int r32, int hi) const {
    if (t >= 12) return;
    const float NEG = -INFINITY;
    const int kr = rbase + t, rq = r + (wid >> 1), c = 32 * (wid & 1) + r32;
    int r0q = rq - 4; r0q = r0q < 0 ? 0 : (r0q > 120 ? 120 : r0q);
    if (!((kr >= r0q) && (kr < r0q + 8))) {
#pragma unroll
      for (int i = 0; i < 16; ++i) { p0[i] = NEG; p1[i] = NEG; }
      return; }
    int c0 = c - 8; c0 = c0 < 0 ? 0 : (c0 > 48 ? 48 : c0);
    const float* trow = tab + (kr - rq + 7) * 31 + (15 - c);
#pragma unroll
    for (int i = 0; i < 16; ++i) {
      const int k0 = crow(i, hi), k1 = k0 + 32;
      const bool v0 = (k0 >= c0) && (k0 < c0 + 16), v1 = (k1 >= c0) && (k1 < c0 + 16);
      const float b0 = trow[v0 ? k0 : c], b1 = trow[v1 ? k1 : c];
      p0[i] = v0 ? p0[i] + b0 : NEG; p1[i] = v1 ? p1[i] + b1 : NEG; }
  }
};
template <int NVB> constexpr int lds_bytes() { return 2 * (64 * NVB * 64) + 2 * (64 * 128) + NW * 64 * 4; }
template <int NVB, class Pol>
__device__ __forceinline__ void attn_unit(const bf16_t* __restrict__ Qb, const Pol& pol, bf16_t* __restrict__ Ob, int ldo, int NT, char* lds) {
  constexpr int SHM_V = 64 * NVB * 64, SHM_K = 64 * 128;
  const int tid = threadIdx.x, wid = tid >> 6, lane = tid & 63, r32 = lane & 31, hi = lane >> 5;
  char* V_lds = lds; char* K_lds = lds + 2 * SHM_V;
  float* ws = (float*)(lds + 2 * SHM_V + 2 * SHM_K) + wid * 64; float* li_l = ws; float* al_l = ws + 32;
  float m_reg = -1e30f, l_reg = 0; f32x16 o[NVB]; bf16x8 qr[4];
#pragma unroll
  for (int d = 0; d < NVB; ++d) o[d] = f32x16{};
  const bf16_t* Qw = Qb + (long)(wid * QBLK + r32) * LD + hi * 8;
#pragma unroll
  for (int d0 = 0; d0 < 4; ++d0) qr[d0] = ld8(Qw + d0 * 16);
  const int ksr = tid >> 3, ksc = (tid & 7) * 8, kst = KSWZ64(ksr, ksc * 2);
  const int vsr = (NVB == 4) ? (tid >> 4) : (tid >> 3), vsc = (NVB == 4) ? (tid & 15) * 8 : (tid & 7) * 8;
  const int vst0 = v_st<NVB>(vsr, vsc), vst1 = v_st<NVB>(32 + vsr, vsc);
  const int vb0 = (int)(uintptr_t)V_lds + v_rd_base(lane);
  struct { bf16x8 v0, v1, k0; } sr_[2];
#define SLOAD(i, t) do { const long row0_ = pol.krow(t); sr_[i].v0 = ld8(pol.Vg + (row0_ + vsr) * LD + vsc); \
    if constexpr (NVB == 4) sr_[i].v1 = ld8(pol.Vg + (row0_ + 32 + vsr) * LD + vsc); sr_[i].k0 = ld8(pol.Kg + (row0_ + ksr) * LD + ksc); } while (0)
#define SWRITE(b, i) do { *(bf16x8*)(V_lds + (b) * SHM_V + vst0) = sr_[i].v0; if constexpr (NVB == 4) *(bf16x8*)(V_lds + (b) * SHM_V + vst1) = sr_[i].v1; \
    *(bf16x8*)(K_lds + (b) * SHM_K + kst) = sr_[i].k0; } while (0)
#define SWAIT() do { if constexpr (NVB == 4) asm volatile("s_waitcnt vmcnt(3)" ::: "memory"); else asm volatile("s_waitcnt vmcnt(2)" ::: "memory"); } while (0)
#define RESC(a) do { if (__any((a) < 1.f)) { if (hi == 0) al_l[r32] = (a); asm volatile("s_waitcnt lgkmcnt(0)" ::: "memory"); \
    _Pragma("unroll") for (int d = 0; d < NVB; ++d) _Pragma("unroll") for (int r = 0; r < 16; ++r) o[d][r] *= al_l[crow(r, hi)]; } } while (0)
  f32x16 pA0, pA1, pB0, pB1; float mnA, mnB, alA, alB; bf16x8 pa0, pa1, pa2, pa3;
  constexpr int SE = 0, SO = 1;
  SLOAD(SE, 0); asm volatile("s_waitcnt vmcnt(0)" ::: "memory"); SWRITE(0, SE); __syncthreads();
  qkt(pA0, pA1, K_lds, qr, r32, hi); pol.mod(pA0, pA1, 0, wid, r32, hi); partialSM(pA0, pA1, m_reg, mnA, alA);
  SLOAD(SO, 1); if (2 < NT) SLOAD(SE, 2);
  SWAIT(); SWRITE(1, SO); __syncthreads();
  for (int j = 1; j + 1 < NT; j += 2) {
    ASBAR(); qkt(pB0, pB1, K_lds + SHM_K, qr, r32, hi);
    finishSM(pA0, pA1, alA, l_reg, pa0, pa1, pa2, pa3); ASBAR();
    SLOAD(SO, j + 2); ASBAR();
    pv_all<NVB>(o, vb0, pa0, pa1, pa2, pa3); pol.mod(pB0, pB1, j, wid, r32, hi); partialSM(pB0, pB1, m_reg, mnB, alB);
    __syncthreads(); SWAIT(); SWRITE(0, SE);
    RESC(alB); __syncthreads();
    ASBAR(); qkt(pA0, pA1, K_lds, qr, r32, hi);
    finishSM(pB0, pB1, alB, l_reg, pa0, pa1, pa2, pa3); ASBAR();
    if (j + 3 < NT) SLOAD(SE, j + 3); ASBAR();
    pv_all<NVB>(o, vb0 + SHM_V, pa0, pa1, pa2, pa3); pol.mod(pA0, pA1, j + 1, wid, r32, hi); partialSM(pA0, pA1, m_reg, mnA, alA);
    __syncthreads(); SWAIT(); SWRITE(1, SO);
    RESC(alA); __syncthreads();
  }
  ASBAR(); qkt(pB0, pB1, K_lds + SHM_K, qr, r32, hi);
  finishSM(pA0, pA1, alA, l_reg, pa0, pa1, pa2, pa3); ASBAR();
  pv_all<NVB>(o, vb0, pa0, pa1, pa2, pa3); pol.mod(pB0, pB1, NT - 1, wid, r32, hi); partialSM(pB0, pB1, m_reg, mnB, alB);
  __syncthreads(); RESC(alB);
  finishSM(pB0, pB1, alB, l_reg, pa0, pa1, pa2, pa3); ASBAR();
  pv_all<NVB>(o, vb0 + SHM_V, pa0, pa1, pa2, pa3);
  if (hi == 0) li_l[r32] = l_reg; asm volatile("s_waitcnt lgkmcnt(0)" ::: "memory");
  float rli[16];
#pragma unroll
  for (int r = 0; r < 16; ++r) rli[r] = __builtin_amdgcn_rcpf(li_l[crow(r, hi)]);
  bf16_t* Ow = Ob + (long)(wid * QBLK) * ldo;
#pragma unroll
  for (int r = 0; r < 16; ++r) { const int orow = crow(r, hi);
#pragma unroll
    for (int d0 = 0; d0 < NVB; ++d0) { const float v = o[d0][r] * rli[r]; const unsigned pk = cvtpk(v, v); Ow[(long)orow * ldo + d0 * 32 + r32] = (bf16_t)(pk & 0xffffu); } }
  __syncthreads();
#undef SLOAD
#undef SWRITE
#undef SWAIT
#undef RESC
}
}

#ifndef MK_N_LAUNCHES
#define MK_N_LAUNCHES 1
#endif
constexpr int N_PHASES = 12;
constexpr int NWAVES = 8;
constexpr int DM = 1024, NB = 4, SEQ = 8192, TT = NB * SEQ, CTX = 256, TC = NB * CTX, MQ = TT + TC, NQKV = 3072;
constexpr int NE = 32, TOPK = 4, MPAD = TT * TOPK + NE * 256, MAXBLK = MPAD / 256;
constexpr float NORM_EPS = 1e-6f;
enum { I_X = 0, I_C, I_CTX, I_CCTX, I_WADA, I_BADA, I_GATTN, I_WIN, I_QND, I_KND, I_LQ1, I_LK1, I_LQ2, I_LK2, I_SUBLN, I_QNN, I_KNN, I_RPB, I_ONN, I_WOUT, I_GFFN, I_WR, I_BR, I_WGU, I_BGU, I_WD, I_BD, N_IN };

constexpr size_t MiB = 1u << 20;
constexpr size_t WS_CTL = 0, CTL_ZERO_BYTES = 64 * 1024;
constexpr size_t WS_TAB = 1 * MiB;
constexpr size_t WS_WQKV = 2 * MiB, WS_WO = 8 * MiB, WS_WGU = 10 * MiB, WS_WDN = 138 * MiB;
constexpr size_t WS_XN = 202 * MiB;
constexpr size_t WS_P = 268 * MiB;
constexpr size_t WS_OD = 499 * MiB, WS_ON = 563 * MiB, WS_MIX = 595 * MiB;
constexpr size_t WS_XG = 202 * MiB;
constexpr size_t WS_ACT = 659 * MiB;
constexpr size_t WS_Y = 202 * MiB;
constexpr size_t WS_RT = 931 * MiB;
constexpr size_t WS_END = 936 * MiB;
static_assert(WS_XN + (size_t)MQ * 2048 <= WS_P && WS_P + (size_t)MQ * 6144 <= WS_OD && WS_XG + (size_t)MPAD * 2048 <= WS_OD && WS_ACT + (size_t)MPAD * 2048 <= WS_RT, "d_ws map");
constexpr int TB_MOD = 0;
constexpr int TB_RCOS = 30720, TB_RSIN = TB_RCOS + 128 * 16, TB_CCOS = TB_RSIN + 128 * 16, TB_CSIN = TB_CCOS + 64 * 16;
constexpr int TB_LAM = TB_CSIN + 64 * 16;
constexpr int TB_WR = TB_LAM + 64;
constexpr int TB_RC = TB_WR + 4 * 1024 * 32;
static_assert((size_t)(TB_RC + 128) * 4 <= MiB, "TAB region");
constexpr int CW_CNT = 0;
constexpr size_t RT_E = 0, RT_G = 512 * 1024, RT_POS = 1024 * 1024, RT_SLOT = 1536 * 1024;

constexpr int RING_BYTES = 131072;
constexpr int MISC_OFF = RING_BYTES;
constexpr int LDS_BYTES = 147456;

#define GAS __attribute__((address_space(1)))
#define LAS __attribute__((address_space(3)))
typedef unsigned short bf16;
typedef unsigned v4u __attribute__((ext_vector_type(4)));
typedef unsigned v2u __attribute__((ext_vector_type(2)));
typedef float f32x4 __attribute__((ext_vector_type(4)));
typedef float f32x16 __attribute__((ext_vector_type(16)));
#define LDS_WAIT() asm volatile("s_waitcnt lgkmcnt(0)" ::: "memory")
__device__ __forceinline__ unsigned f2bf(float f) { unsigned u = __builtin_bit_cast(unsigned, f); return (u + 0x7fffu + ((u >> 16) & 1u)) >> 16; }
__device__ __forceinline__ unsigned pk2(float lo, float hi) { return f2bf(lo) | (f2bf(hi) << 16); }
__device__ __forceinline__ float bflo(unsigned w) { return __uint_as_float(w << 16); }
__device__ __forceinline__ float bfhi(unsigned w) { return __uint_as_float(w & 0xffff0000u); }
__device__ __forceinline__ float wave_sum(float v) {
#pragma unroll
    for (int o = 1; o < 64; o <<= 1) v += __shfl_xor(v, o);
    return v;
}

struct Frame {
    LAS unsigned char* lds;
    int tid, lane, wave, vcu, G;
    const float* in[N_IN]; float* out; unsigned char* ws;
};

__device__ __forceinline__ void p0_transpose_item(const float* W, int K, int N, bf16* WT, int k0, int n0, int drow0, LAS float* scr, int lane) {
#pragma unroll 8
    for (int i = 0; i < 32; ++i) { const int kk = 2 * i + (lane >> 5); scr[kk * 33 + (lane & 31)] = W[(size_t)(k0 + kk) * N + n0 + (lane & 31)]; }
    LDS_WAIT(); asm volatile("" ::: "memory");
    const int c = lane & 7;
#pragma unroll
    for (int j = 0; j < 4; ++j) { const int n = (lane >> 3) + 8 * j; const LAS float* s = scr + (8 * c) * 33 + n;
        v4u o; o.x = pk2(s[0 * 33], s[1 * 33]); o.y = pk2(s[2 * 33], s[3 * 33]); o.z = pk2(s[4 * 33], s[5 * 33]); o.w = pk2(s[6 * 33], s[7 * 33]);
        *(v4u*)(WT + (size_t)(drow0 + n) * K + k0 + 8 * c) = o; }
    LDS_WAIT(); asm volatile("" ::: "memory");
}

__device__ __forceinline__ void p0_prologue(Frame& F) {
    float* tab = (float*)(F.ws + WS_TAB);
    for (int task = blockIdx.x; task < 96; task += F.G) {
        LAS float* ssilu = (LAS float*)F.lds;
        LAS float* part = ssilu + 5 * 1024;
        for (int i = F.tid; i < 5 * 1024; i += 512) { const int r = i >> 10, k = i & 1023; const float v = (r < 4) ? F.in[I_C][r * 1024 + k] : F.in[I_CCTX][k]; ssilu[i] = v / (1.0f + __expf(-v)); }
        __syncthreads();
        const int col = task * 64 + F.lane; const float* w = F.in[I_WADA] + col; float a0 = 0, a1 = 0, a2 = 0, a3 = 0, a4 = 0;
        const int kb = F.wave * 128;
#pragma unroll 8
        for (int k = kb; k < kb + 128; ++k) { const float wv = w[(size_t)k * 6144]; a0 += ssilu[k] * wv; a1 += ssilu[1024 + k] * wv; a2 += ssilu[2048 + k] * wv; a3 += ssilu[3072 + k] * wv; a4 += ssilu[4096 + k] * wv; }
        part[(F.wave * 5 + 0) * 64 + F.lane] = a0; part[(F.wave * 5 + 1) * 64 + F.lane] = a1; part[(F.wave * 5 + 2) * 64 + F.lane] = a2; part[(F.wave * 5 + 3) * 64 + F.lane] = a3; part[(F.wave * 5 + 4) * 64 + F.lane] = a4;
        __syncthreads();
        if (F.tid < 320) { const int r = F.tid >> 6, cl = F.tid & 63; float s = 0; for (int wv = 0; wv < 8; ++wv) s += part[(wv * 5 + r) * 64 + cl]; const int j = task * 64 + cl; tab[TB_MOD + r * 6144 + j] = s + F.in[I_BADA][j]; }
        __syncthreads();
    }
    if ((int)blockIdx.x == F.G - 1) {
        for (int i = F.tid; i < 192 * 16; i += 512) { const int p = i >> 4, f = i & 15; const float inv = 1.0f / powf(10000.0f, (float)f / 16.0f); const int pos = p < 128 ? p : p - 128; const float ang = (float)pos * inv;
            const float cv = cosf(ang), sv = sinf(ang);
            if (p < 128) { tab[TB_RCOS + pos * 16 + f] = cv; tab[TB_RSIN + pos * 16 + f] = sv; } else { tab[TB_CCOS + pos * 16 + f] = cv; tab[TB_CSIN + pos * 16 + f] = sv; } }
        if (F.wave == 0) { const float s1 = wave_sum(F.in[I_LQ1][F.lane] * F.in[I_LK1][F.lane]), s2 = wave_sum(F.in[I_LQ2][F.lane] * F.in[I_LK2][F.lane]);
            if (F.lane == 0) tab[TB_LAM] = expf(s1) - expf(s2) + 0.2f; }
    }
    LAS float* scr = (LAS float*)(F.lds + 32768 + F.wave * 8704);
    const int gw = F.vcu * NWAVES + F.wave, NGW = F.G * NWAVES;
    constexpr int I_IN = 16 * 96, I_OUT = 16 * 32, I_GU = 16 * 64, I_DN = 16 * 32;
    constexpr int NITEMS = I_IN + I_OUT + NE * (I_GU + I_DN);
    bf16* wqkv = (bf16*)(F.ws + WS_WQKV); bf16* wo = (bf16*)(F.ws + WS_WO); bf16* wgu = (bf16*)(F.ws + WS_WGU); bf16* wdn = (bf16*)(F.ws + WS_WDN);
    for (int it = gw; it < NITEMS; it += NGW) {
        int r = it;
        if (r < I_IN) { const int kb = r / 96, nb = r % 96; p0_transpose_item(F.in[I_WIN], 1024, 3072, wqkv, 64 * kb, 32 * nb, 32 * nb, scr, F.lane); continue; } r -= I_IN;
        if (r < I_OUT) { const int kb = r / 32, nb = r % 32; p0_transpose_item(F.in[I_WOUT], 1024, 1024, wo, 64 * kb, 32 * nb, 32 * nb, scr, F.lane); continue; } r -= I_OUT;
        if (r < NE * I_GU) { const int e = r / I_GU, q = r % I_GU, kb = q / 64, nb = q % 64, n0 = 32 * nb;
            const int drow = (n0 < 1024) ? ((n0 >> 7) * 256 + (n0 & 127)) : (((n0 - 1024) >> 7) * 256 + 128 + ((n0 - 1024) & 127));
            p0_transpose_item(F.in[I_WGU] + (size_t)e * 1024 * 2048, 1024, 2048, wgu + (size_t)e * 2048 * 1024, 64 * kb, n0, drow, scr, F.lane); continue; } r -= NE * I_GU;
        { const int e = r / I_DN, q = r % I_DN, kb = q / 32, nb = q % 32;
            p0_transpose_item(F.in[I_WD] + (size_t)e * 1024 * 1024, 1024, 1024, wdn + (size_t)e * 1024 * 1024, 64 * kb, 32 * nb, 32 * nb, scr, F.lane); }
    }
}

__device__ __forceinline__ void p1_norm(Frame& F) {
    const float* tab = (const float*)(F.ws + WS_TAB); bf16* XN = (bf16*)(F.ws + WS_XN);
    const int gw = F.vcu * NWAVES + F.wave, NGW = F.G * NWAVES;
    const f32x4* gat = (const f32x4*)F.in[I_GATTN] + F.lane;
    for (int m = gw; m < MQ; m += NGW) {
        const int b = m < TT ? (m >> 13) : 4;
        const float* xrow = m < TT ? F.in[I_X] + (size_t)m * DM : F.in[I_CTX] + (size_t)(m - TT) * DM;
        const f32x4* xr = (const f32x4*)xrow + F.lane;
        const f32x4* sh = (const f32x4*)(tab + TB_MOD + b * 6144) + F.lane; const f32x4* sc = (const f32x4*)(tab + TB_MOD + b * 6144 + 1024) + F.lane;
        f32x4 v[4]; float s = 0.f;
#pragma unroll
        for (int j = 0; j < 4; ++j) { v[j] = xr[64 * j]; s += (v[j].x * v[j].x + v[j].y * v[j].y) + (v[j].z * v[j].z + v[j].w * v[j].w); }
        const float rstd = 1.0f / sqrtf(wave_sum(s) * (1.f / DM) + NORM_EPS);
        unsigned long long* o8 = (unsigned long long*)(XN + (size_t)m * DM) + F.lane;
#pragma unroll
        for (int j = 0; j < 4; ++j) { const f32x4 g = gat[64 * j], a = sc[64 * j], c = sh[64 * j];
            const f32x4 h = (v[j] * rstd) * g * (a + 1.0f) + c;
            o8[64 * j] = (unsigned long long)pk2(h.x, h.y) | ((unsigned long long)pk2(h.z, h.w) << 32); }
    }
    float* tw = (float*)(F.ws + WS_TAB);
    for (int i = (int)blockIdx.x * 512 + F.tid; i < 4 * 1024 * 32; i += F.G * 512) { const int b = i >> 15, k = (i >> 5) & 1023;
        tw[TB_WR + i] = F.in[I_GFFN][k] * (1.0f + tab[TB_MOD + b * 6144 + 4 * 1024 + k]) * F.in[I_WR][i & 32767]; }
    for (int t = gw; t < 128; t += NGW) { const int b = t >> 5, e = t & 31; float s = 0.f;
        for (int k = F.lane; k < 1024; k += 64) s += tab[TB_MOD + b * 6144 + 3 * 1024 + k] * F.in[I_WR][k * 32 + e];
        s = wave_sum(s); if (F.lane == 0) tw[TB_RC + t] = s + F.in[I_BR][e]; }
}

__device__ __forceinline__ void p3_qknorm(Frame& F) {
    const float* tab = (const float*)(F.ws + WS_TAB); bf16* P = (bf16*)(F.ws + WS_P);
    const int gw = F.vcu * NWAVES + F.wave, NGW = F.G * NWAVES;
    const int j = F.lane & 7;
    for (int task = gw; task < MQ * 4; task += NGW) {
        const int row = task >> 2, g = task & 3;
        const int colb = (g == 0) ? 0 : (g == 1) ? 512 : (g == 2) ? 1536 : 2048;
        const float* nw = ((g == 0) ? F.in[I_QND] : (g == 1) ? F.in[I_KND] : (g == 2) ? F.in[I_QNN] : F.in[I_KNN]) + 8 * j;
        bf16* p = P + (size_t)row * NQKV + colb + F.lane * 8;
        const v4u w = *(const v4u*)p;
        float v[8] = {bflo(w.x), bfhi(w.x), bflo(w.y), bfhi(w.y), bflo(w.z), bfhi(w.z), bflo(w.w), bfhi(w.w)};
        float ss = 0.f;
#pragma unroll
        for (int i = 0; i < 8; ++i) ss += v[i] * v[i];
        ss += __shfl_xor(ss, 1); ss += __shfl_xor(ss, 2); ss += __shfl_xor(ss, 4);
        const float rstd = 1.0f / sqrtf(ss * (1.f / 64.f) + NORM_EPS);
        const f32x4 n0 = *(const f32x4*)nw, n1 = *(const f32x4*)(nw + 4);
        v[0] *= rstd * n0.x; v[1] *= rstd * n0.y; v[2] *= rstd * n0.z; v[3] *= rstd * n0.w; v[4] *= rstd * n1.x; v[5] *= rstd * n1.y; v[6] *= rstd * n1.z; v[7] *= rstd * n1.w;
        if (g < 2 && row < TT) {
            const int s = row & (SEQ - 1), prow = s >> 6, pcol = s & 63, half = j >> 2, isx2 = (j >> 1) & 1;
            const float* ct = tab + (half ? TB_CCOS + pcol * 16 : TB_RCOS + prow * 16) + 8 * (j & 1);
            const float* st = tab + (half ? TB_CSIN + pcol * 16 : TB_RSIN + prow * 16) + 8 * (j & 1);
            const f32x4 c0 = *(const f32x4*)ct, c1 = *(const f32x4*)(ct + 4), s0 = *(const f32x4*)st, s1 = *(const f32x4*)(st + 4);
            const float cc[8] = {c0.x, c0.y, c0.z, c0.w, c1.x, c1.y, c1.z, c1.w}, sn[8] = {s0.x, s0.y, s0.z, s0.w, s1.x, s1.y, s1.z, s1.w};
#pragma unroll
            for (int i = 0; i < 8; ++i) { const float pr = __shfl_xor(v[i], 2); v[i] = isx2 ? (v[i] * cc[i] + pr * sn[i]) : (v[i] * cc[i] - pr * sn[i]); }
        }
        v4u o; o.x = pk2(v[0], v[1]); o.y = pk2(v[2], v[3]); o.z = pk2(v[4], v[5]); o.w = pk2(v[6], v[7]);
        *(v4u*)p = o;
    }
}

__device__ __forceinline__ void p4_attention(Frame& F, char* lds) {
    const bf16* P = (const bf16*)(F.ws + WS_P); bf16* OD = (bf16*)(F.ws + WS_OD); bf16* ON = (bf16*)(F.ws + WS_ON);
    for (int unit = F.vcu; unit < 1024; unit += F.G) {
        const int bhm = unit >> 5, qb = unit & 31, b = bhm >> 3, h = (bhm >> 1) & 3, m = bhm & 1;
        att::DiffPol pol; pol.Kg = P + 512 + h * 128 + m * 64; pol.Vg = P + 1024 + h * 128; pol.lat0 = (long)b * SEQ; pol.ctx0 = (long)TT + b * CTX;
        att::attn_unit<4, att::DiffPol>(P + ((size_t)b * SEQ + qb * 256) * NQKV + h * 128 + m * 64, pol, OD + ((size_t)b * SEQ + qb * 256) * 1024 + h * 256 + m * 128, 1024, 132, lds);
    }
    float* tabl = (float*)(lds + att::lds_bytes<4>());
    for (int unit = F.vcu; unit < 1024; unit += F.G) {
        const int bh = unit >> 5, rb = unit & 31, b = bh >> 3, hn = bh & 7, r = rb * 4;
        for (int i = F.tid; i < 15 * 31; i += 512) tabl[i] = F.in[I_RPB][hn * 465 + i] * 8.0f;
        att::NaPol pol; pol.Kg = P + 2048 + hn * 64; pol.Vg = P + 2560 + hn * 64; pol.lat0 = (long)b * SEQ; pol.ctx0 = (long)TT + b * CTX;
        pol.r = r; pol.rbase = (r - 4) < 0 ? 0 : ((r - 4) > 120 ? 120 : (r - 4)); pol.tab = tabl;
        att::attn_unit<2, att::NaPol>(P + ((size_t)b * SEQ + r * 64) * NQKV + 1536 + hn * 64, pol, ON + ((size_t)b * SEQ + r * 64) * 512 + hn * 64, 512, 16, lds);
    }
}

__device__ __forceinline__ void p5_mix(Frame& F) {
    const float* tab = (const float*)(F.ws + WS_TAB); const bf16* OD = (const bf16*)(F.ws + WS_OD); const bf16* ON = (const bf16*)(F.ws + WS_ON); bf16* MX = (bf16*)(F.ws + WS_MIX);
    const int gw = F.vcu * NWAVES + F.wave, NGW = F.G * NWAVES;
    const float lam = tab[TB_LAM];
    const int h = F.lane >> 4, e0 = (F.lane & 15) * 8;
    const f32x4 sl0 = *(const f32x4*)(F.in[I_SUBLN] + e0), sl1 = *(const f32x4*)(F.in[I_SUBLN] + e0 + 4);
    const f32x4 on0 = *(const f32x4*)(F.in[I_ONN] + F.lane * 8), on1 = *(const f32x4*)(F.in[I_ONN] + F.lane * 8 + 4);
    for (int t = gw; t < TT; t += NGW) {
        const v4u a = *(const v4u*)(OD + (size_t)t * 1024 + h * 256 + e0), c = *(const v4u*)(OD + (size_t)t * 1024 + h * 256 + 128 + e0);
        const v4u n = *(const v4u*)(ON + (size_t)t * 512 + F.lane * 8);
        float d[8] = {bflo(a.x) - lam * bflo(c.x), bfhi(a.x) - lam * bfhi(c.x), bflo(a.y) - lam * bflo(c.y), bfhi(a.y) - lam * bfhi(c.y),
                      bflo(a.z) - lam * bflo(c.z), bfhi(a.z) - lam * bfhi(c.z), bflo(a.w) - lam * bflo(c.w), bfhi(a.w) - lam * bfhi(c.w)};
        float ss = 0.f;
#pragma unroll
        for (int i = 0; i < 8; ++i) ss += d[i] * d[i];
        ss += __shfl_xor(ss, 1); ss += __shfl_xor(ss, 2); ss += __shfl_xor(ss, 4); ss += __shfl_xor(ss, 8);
        const float rs = 0.8f / sqrtf(ss * (1.f / 128.f) + NORM_EPS);
        v4u o; o.x = pk2(d[0] * rs * sl0.x, d[1] * rs * sl0.y); o.y = pk2(d[2] * rs * sl0.z, d[3] * rs * sl0.w); o.z = pk2(d[4] * rs * sl1.x, d[5] * rs * sl1.y); o.w = pk2(d[6] * rs * sl1.z, d[7] * rs * sl1.w);
        *(v4u*)(MX + (size_t)t * 1024 + h * 128 + e0) = o;
        float q[8] = {bflo(n.x), bfhi(n.x), bflo(n.y), bfhi(n.y), bflo(n.z), bfhi(n.z), bflo(n.w), bfhi(n.w)};
        float s2 = 0.f;
#pragma unroll
        for (int i = 0; i < 8; ++i) s2 += q[i] * q[i];
        s2 += __shfl_xor(s2, 1); s2 += __shfl_xor(s2, 2); s2 += __shfl_xor(s2, 4);
        const float r2 = 1.0f / sqrtf(s2 * (1.f / 64.f) + NORM_EPS);
        v4u o2; o2.x = pk2(q[0] * r2 * on0.x, q[1] * r2 * on0.y); o2.y = pk2(q[2] * r2 * on0.z, q[3] * r2 * on0.w); o2.z = pk2(q[4] * r2 * on1.x, q[5] * r2 * on1.y); o2.w = pk2(q[6] * r2 * on1.z, q[7] * r2 * on1.w);
        *(v4u*)(MX + (size_t)t * 1024 + 512 + F.lane * 8) = o2;
    }
}

__device__ __forceinline__ void p7_router(Frame& F) {
    const float* tab = (const float*)(F.ws + WS_TAB); unsigned* cnt = (unsigned*)(F.ws + WS_CTL) + CW_CNT;
    int* rt_e = (int*)(F.ws + WS_RT + RT_E); float* rt_g = (float*)(F.ws + WS_RT + RT_G); int* rt_pos = (int*)(F.ws + WS_RT + RT_POS);
    LAS unsigned* cntl = (LAS unsigned*)(F.lds + MISC_OFF); LAS unsigned* basel = cntl + 32;
    const int j = F.lane & 31, kh = F.lane >> 5;
    for (int tile = F.vcu; tile < TT / 128; tile += F.G) {
        if (F.tid < 32) cntl[F.tid] = 0u;
        __syncthreads();
        int te[4] = {0, 0, 0, 0}; float tg[4] = {0, 0, 0, 0}; unsigned lp[4] = {0, 0, 0, 0}; const int t = tile * 128 + 32 * F.wave + j;
        if (F.wave < 4) {
            const int b = t >> 13;
            const float* xr = F.out + (size_t)t * DM + 4 * kh;
            const float* wp = tab + TB_WR + (size_t)b * 32768 + (4 * kh) * 32 + j;
            f32x16 acc = f32x16{}; float ss = 0.f;
#pragma unroll 4
            for (int u = 0; u < 128; ++u) {
                const f32x4 xv = *(const f32x4*)(xr + 8 * u);
                const float w0 = wp[(8 * u + 0) * 32], w1 = wp[(8 * u + 1) * 32], w2 = wp[(8 * u + 2) * 32], w3 = wp[(8 * u + 3) * 32];
                ss += (xv.x * xv.x + xv.y * xv.y) + (xv.z * xv.z + xv.w * xv.w);
                acc = __builtin_amdgcn_mfma_f32_32x32x2f32(w0, xv.x, acc, 0, 0, 0);
                acc = __builtin_amdgcn_mfma_f32_32x32x2f32(w1, xv.y, acc, 0, 0, 0);
                acc = __builtin_amdgcn_mfma_f32_32x32x2f32(w2, xv.z, acc, 0, 0, 0);
                acc = __builtin_amdgcn_mfma_f32_32x32x2f32(w3, xv.w, acc, 0, 0, 0);
            }
            ss += __shfl_xor(ss, 32);
            const float rstd = 1.0f / sqrtf(ss * (1.f / DM) + NORM_EPS);
            float v[16];
#pragma unroll
            for (int r = 0; r < 16; ++r) v[r] = acc[r] * rstd + tab[TB_RC + b * 32 + att::crow(r, kh)];
            float cv[8]; int ce[8];
#pragma unroll
            for (int k = 0; k < 4; ++k) { float best = -INFINITY; int bi = 0;
#pragma unroll
                for (int r = 0; r < 16; ++r) if (v[r] > best) { best = v[r]; bi = r; }
#pragma unroll
                for (int r = 0; r < 16; ++r) if (r == bi) v[r] = -INFINITY;
                cv[k] = best; ce[k] = att::crow(bi, kh); }
#pragma unroll
            for (int k = 0; k < 4; ++k) { cv[4 + k] = __shfl_xor(cv[k], 32); ce[4 + k] = __shfl_xor(ce[k], 32); }
            float tv[4];
#pragma unroll
            for (int k = 0; k < 4; ++k) { float best = -INFINITY; int be = 1 << 30, bi = 0;
#pragma unroll
                for (int q = 0; q < 8; ++q) if (cv[q] > best || (cv[q] == best && ce[q] < be)) { best = cv[q]; be = ce[q]; bi = q; }
#pragma unroll
                for (int q = 0; q < 8; ++q) if (q == bi) cv[q] = -INFINITY;
                tv[k] = best; te[k] = be; }
            const float e1 = __expf(tv[1] - tv[0]), e2 = __expf(tv[2] - tv[0]), e3 = __expf(tv[3] - tv[0]); const float inv = 1.0f / (1.0f + e1 + e2 + e3);
            tg[0] = inv; tg[1] = e1 * inv; tg[2] = e2 * inv; tg[3] = e3 * inv;
            if (kh == 0) {
#pragma unroll
                for (int k = 0; k < 4; ++k) lp[k] = __hip_atomic_fetch_add(cntl + te[k], 1u, __ATOMIC_RELAXED, __HIP_MEMORY_SCOPE_WORKGROUP);
            }
        }
        __syncthreads();
        if (F.tid < 32) { const unsigned c = cntl[F.tid]; basel[F.tid] = c ? atomicAdd(cnt + F.tid, c) : 0u; }
        __syncthreads();
        if (F.wave < 4 && kh == 0) {
#pragma unroll
            for (int k = 0; k < 4; ++k) { rt_e[t * 4 + k] = te[k]; rt_g[t * 4 + k] = tg[k]; rt_pos[t * 4 + k] = (int)(basel[te[k]] + lp[k]); }
        }
        __syncthreads();
    }
}

__device__ __forceinline__ int pad_starts(const unsigned* cnt, int lane) {
    const int c = lane < 32 ? (int)__hip_atomic_load(cnt + lane, __ATOMIC_RELAXED, __HIP_MEMORY_SCOPE_AGENT) : 0;
    int p = (c + 255) & ~255, incl = p;
#pragma unroll
    for (int o = 1; o < 64; o <<= 1) { const int n = __shfl_up(incl, o); if (lane >= o) incl += n; }
    return incl - p;
}

__device__ __forceinline__ void p8_scatter(Frame& F) {
    const float* tab = (const float*)(F.ws + WS_TAB); const unsigned* cnt = (const unsigned*)(F.ws + WS_CTL) + CW_CNT;
    const int* rt_e = (const int*)(F.ws + WS_RT + RT_E); const int* rt_pos = (const int*)(F.ws + WS_RT + RT_POS); int* rt_slot = (int*)(F.ws + WS_RT + RT_SLOT);
    bf16* XG = (bf16*)(F.ws + WS_XG);
    const int gw = F.vcu * NWAVES + F.wave, NGW = F.G * NWAVES;
    const int pst = pad_starts(cnt, F.lane);
    const f32x4* gf = (const f32x4*)F.in[I_GFFN] + F.lane;
    for (int t = gw; t < TT; t += NGW) {
        const int b = t >> 13;
        const f32x4* xr = (const f32x4*)(F.out + (size_t)t * DM) + F.lane;
        const f32x4* sh = (const f32x4*)(tab + TB_MOD + b * 6144 + 3 * 1024) + F.lane; const f32x4* sc = (const f32x4*)(tab + TB_MOD + b * 6144 + 4 * 1024) + F.lane;
        f32x4 v[4]; float s = 0.f;
#pragma unroll
        for (int jj = 0; jj < 4; ++jj) { v[jj] = xr[64 * jj]; s += (v[jj].x * v[jj].x + v[jj].y * v[jj].y) + (v[jj].z * v[jj].z + v[jj].w * v[jj].w); }
        const float rstd = 1.0f / sqrtf(wave_sum(s) * (1.f / DM) + NORM_EPS);
        unsigned long long pk[4];
#pragma unroll
        for (int jj = 0; jj < 4; ++jj) { const f32x4 g = gf[64 * jj], a = sc[64 * jj], c = sh[64 * jj]; const f32x4 h = (v[jj] * rstd) * g * (a + 1.0f) + c;
            pk[jj] = (unsigned long long)pk2(h.x, h.y) | ((unsigned long long)pk2(h.z, h.w) << 32); }
        const int my_e = rt_e[t * 4 + (F.lane & 3)], my_pos = rt_pos[t * 4 + (F.lane & 3)];
#pragma unroll
        for (int k = 0; k < 4; ++k) { const int e = __shfl(my_e, k), pos = __shfl(my_pos, k); const int slot = __shfl(pst, e) + pos;
            unsigned long long* o8 = (unsigned long long*)(XG + (size_t)slot * DM) + F.lane;
#pragma unroll
            for (int jj = 0; jj < 4; ++jj) o8[64 * jj] = pk[jj];
            if (F.lane == 0) rt_slot[t * 4 + k] = slot; }
    }
}

__device__ __forceinline__ int moe_block_table(Frame& F, LAS int* bexp) {
    const unsigned* cnt = (const unsigned*)(F.ws + WS_CTL) + CW_CNT;
    const int pst = pad_starts(cnt, F.lane);
    const int total = __shfl(pst, 32) >> 8;
    if (F.wave == 0) {
        const int nxt = __shfl_down(pst, 1);
        if (F.lane < 32) for (int bl = pst >> 8; bl < (nxt >> 8); ++bl) bexp[bl] = F.lane;
    }
    __syncthreads();
    return __builtin_amdgcn_readfirstlane(total);
}

__device__ __forceinline__ void p11_combine(Frame& F) {
    const float* tab = (const float*)(F.ws + WS_TAB); const bf16* Y = (const bf16*)(F.ws + WS_Y);
    const float* rt_g = (const float*)(F.ws + WS_RT + RT_G); const int* rt_slot = (const int*)(F.ws + WS_RT + RT_SLOT);
    const int gw = F.vcu * NWAVES + F.wave, NGW = F.G * NWAVES;
    for (int t = gw; t < TT; t += NGW) {
        const int b = t >> 13;
        f32x4* xr = (f32x4*)(F.out + (size_t)t * DM) + F.lane;
        const f32x4* g2 = (const f32x4*)(tab + TB_MOD + b * 6144 + 5 * 1024) + F.lane;
        f32x4 acc[4];
#pragma unroll
        for (int jj = 0; jj < 4; ++jj) acc[jj] = (f32x4){0.f, 0.f, 0.f, 0.f};
        const int my_slot = rt_slot[t * 4 + (F.lane & 3)]; const float my_g = rt_g[t * 4 + (F.lane & 3)];
#pragma unroll
        for (int k = 0; k < 4; ++k) { const int slot = __shfl(my_slot, k); const float g = __shfl(my_g, k);
            const v2u* yr = (const v2u*)(Y + (size_t)slot * DM) + F.lane;
#pragma unroll
            for (int jj = 0; jj < 4; ++jj) { const v2u w = yr[64 * jj]; acc[jj] += (f32x4){bflo(w.x), bfhi(w.x), bflo(w.y), bfhi(w.y)} * g; } }
#pragma unroll
        for (int jj = 0; jj < 4; ++jj) xr[64 * jj] = xr[64 * jj] + g2[64 * jj] * acc[jj];
    }
}

struct Args { const float* in[N_IN]; float* out; unsigned char* ws; int ph_lo, ph_hi; };
__global__ void __launch_bounds__(NWAVES * 64, 2) mk_fwd(Args args) {
    extern __shared__ __attribute__((aligned(16))) unsigned char lds[];
    Frame F;
    F.lds = (LAS unsigned char*)lds;
    F.tid = threadIdx.x; F.lane = F.tid & 63; F.wave = __builtin_amdgcn_readfirstlane(F.tid >> 6);
    F.G = gridDim.x; { const int bx = blockIdx.x; F.vcu = (F.G % 8 == 0) ? (bx % 8) * (F.G / 8) + bx / 8 : bx; }
#pragma unroll
    for (int i = 0; i < N_IN; ++i) F.in[i] = args.in[i];
    F.out = args.out; F.ws = args.ws;
    const int lo = args.ph_lo, hi = args.ph_hi;
#define IN(k) (lo <= (k) && (k) < hi)
#define SEAM(k) do { if (IN(k) && IN((k) + 1)) { cg::this_grid().sync(); } } while (0)
    if (IN(0)) { p0_prologue(F); } SEAM(0);
    if (IN(1)) { p1_norm(F); } SEAM(1);
    if (IN(2)) {
        pg8::Gemm g{(const bf16*)(F.ws + WS_XN), (const bf16*)(F.ws + WS_WQKV), MQ, NQKV, DM, 0};
        pg8::StaticOrder S; S.init(MQ, NQKV, F.G, (int)blockIdx.x);
        pg8::EpiBf16<0> E{(bf16*)(F.ws + WS_P), NQKV, nullptr, 0, 0, 1.f};
        pg8::gemm_phase<pg8::EpiBf16<0>, pg8::StaticOrder, true, true>(F.lds, g, S, E);
    } SEAM(2);
    if (IN(3)) { p3_qknorm(F); } SEAM(3);
    if (IN(4)) { p4_attention(F, (char*)lds); } SEAM(4);
    if (IN(5)) { p5_mix(F); } SEAM(5);
    if (IN(6)) {
        pg8::Gemm g{(const bf16*)(F.ws + WS_MIX), (const bf16*)(F.ws + WS_WO), TT, DM, DM, 0};
        pg8::StaticOrder S; S.init(TT, DM, F.G, (int)blockIdx.x);
        pg8::EpiOut E{F.in[I_X], F.out, (const float*)(F.ws + WS_TAB) + TB_MOD};
        pg8::gemm_phase<pg8::EpiOut, pg8::StaticOrder, true, true>(F.lds, g, S, E);
    } SEAM(6);
    if (IN(7)) { p7_router(F); } SEAM(7);
    if (IN(8)) { p8_scatter(F); } SEAM(8);
    if (IN(9)) {
        LAS int* bexp = (LAS int*)(F.lds + MISC_OFF + 1024);
        const int nblk = moe_block_table(F, bexp);
        pg8::Gemm g{(const bf16*)(F.ws + WS_XG), (const bf16*)(F.ws + WS_WGU), MPAD, 2048, DM, (size_t)2048 * 1024 * 2};
        pg8::MoeOrder S; S.init(nblk, 8, F.G, (int)blockIdx.x, bexp);
        pg8::EpiSwiGLU E{(bf16*)(F.ws + WS_ACT), F.in[I_BGU]};
        pg8::gemm_phase<pg8::EpiSwiGLU, pg8::MoeOrder, true, true>(F.lds, g, S, E);
    } SEAM(9);
    if (IN(10)) {
        LAS int* bexp = (LAS int*)(F.lds + MISC_OFF + 1024);
        const int nblk = moe_block_table(F, bexp);
        pg8::Gemm g{(const bf16*)(F.ws + WS_ACT), (const bf16*)(F.ws + WS_WDN), MPAD, 1024, DM, (size_t)1024 * 1024 * 2};
        pg8::MoeOrder S; S.init(nblk, 4, F.G, (int)blockIdx.x, bexp);
        pg8::EpiDown E{(bf16*)(F.ws + WS_Y), F.in[I_BD]};
        pg8::gemm_phase<pg8::EpiDown, pg8::MoeOrder, true, true>(F.lds, g, S, E);
    } SEAM(10);
    if (IN(11)) { p11_combine(F); }
#undef IN
#undef SEAM
}

extern "C" void kernel_launch(void* const* d_in, const int* in_sizes, int n_in, void* d_out, int out_size, void* d_ws, size_t ws_size, hipStream_t stream) {
    static int grid = 0;
    if (grid == 0) {
        if (n_in != N_IN || in_sizes[0] != TT * DM || out_size != TT * DM || ws_size < WS_END) { fprintf(stderr, "kernel_launch: unexpected shapes (n_in %d, in0 %d, out %d, ws %zu)\n", n_in, n_in > 0 ? in_sizes[0] : -1, out_size, ws_size); grid = -1; return; }
        int dev = 0, cus = 0, per_cu = 0;
        if (hipGetDevice(&dev) != hipSuccess || hipDeviceGetAttribute(&cus, hipDeviceAttributeMultiprocessorCount, dev) != hipSuccess) { grid = -1; return; }
        if (hipFuncSetAttribute((const void*)mk_fwd, hipFuncAttributeMaxDynamicSharedMemorySize, LDS_BYTES) != hipSuccess) { fprintf(stderr, "kernel_launch: hipFuncSetAttribute failed\n"); grid = -1; return; }
        if (hipOccupancyMaxActiveBlocksPerMultiprocessor(&per_cu, (const void*)mk_fwd, NWAVES * 64, LDS_BYTES) != hipSuccess || per_cu < 1) { fprintf(stderr, "kernel_launch: occupancy query reports %d\n", per_cu); (void)hipGetLastError(); per_cu = 1; }
        grid = cus;
    }
    if (grid < 0) return;
    (void)hipMemsetAsync((char*)d_ws + WS_CTL, 0, CTL_ZERO_BYTES, stream);
    Args a{};
    for (int i = 0; i < N_IN; ++i) a.in[i] = (const float*)d_in[i];
    a.out = (float*)d_out; a.ws = (unsigned char*)d_ws;
    if (MK_N_LAUNCHES == 1) {
        a.ph_lo = 0; a.ph_hi = N_PHASES;
        void* params[] = {&a};
        const hipError_t e = hipLaunchCooperativeKernel((const void*)mk_fwd, dim3(grid), dim3(NWAVES * 64), params, LDS_BYTES, stream);
        if (e != hipSuccess) fprintf(stderr, "kernel_launch: cooperative launch failed: %s (grid %d)\n", hipGetErrorString(e), grid);
    } else {
        for (int p = 0; p < N_PHASES; ++p) { a.ph_lo = p; a.ph_hi = p + 1; hipLaunchKernelGGL(mk_fwd, dim3(grid), dim3(NWAVES * 64), LDS_BYTES, stream, a); }
        const hipError_t le = hipPeekAtLastError();
        if (le != hipSuccess) fprintf(stderr, "kernel_launch: launch failed: %s\n", hipGetErrorName(le));
    }
}
```

```cpp
#include <hip/hip_runtime.h>
#include <hip/hip_cooperative_groups.h>
#include <cstdio>
#include <cstdint>
namespace cg = cooperative_groups;
namespace pg8 {
#define PG8_LAS __attribute__((address_space(3)))
typedef unsigned short bf16_t;
typedef short bf16x8 __attribute__((ext_vector_type(8)));
typedef float f32x4 __attribute__((ext_vector_type(4)));
typedef unsigned u32x4 __attribute__((ext_vector_type(4)));
constexpr int BM = 256, BK = 64, HALF = 128, HTB = HALF * BK * 2  , STAGE_BYTES = 8 * HTB, NXCD = 8, WGM = 8;

__host__ __device__ __forceinline__ int lds_byte(int r, int c) { const int st = (r >> 4) * 2 + (c >> 5), rr = r & 15, cc = c & 31, ob = rr * 64 + cc * 2; return st * 1024 + (ob ^ (((ob >> 9) & 1) << 5)); }
__host__ __device__ __forceinline__ void stage_rc(int b, int& R, int& C) { const int st = b / 1024, sb = b % 1024, swz = sb ^ (((sb >> 9) & 1) << 5); R = (st >> 1) * 16 + swz / 64; C = (st & 1) * 32 + (swz % 64) / 2; }
__host__ __device__ __forceinline__ int perm32(int rho) { const int n = rho >> 4, i = rho & 15; return 8 * (i >> 2) + 4 * n + (i & 3); }

struct Unit { int pm, pn, e; };
struct Gemm { const bf16_t* A; const bf16_t* Bt; int M, N, K; size_t estride; };

struct StaticOrder {
    int nM, nN, nwg, G, c;
    __host__ __device__ void init(int M, int N, int G_, int c_) { nM = M / BM; nN = N / BM; nwg = nM * nN; G = G_; c = c_; }
    __host__ __device__ bool next(int i, Unit& u) const {
        const long L = (long)i * G + c; if (L >= nwg) return false;
        int wgid = (int)L; { const int q = nwg / NXCD, r = nwg % NXCD, xcd = wgid % NXCD, off = wgid / NXCD; wgid = (xcd < r ? xcd * (q + 1) : r * (q + 1) + (xcd - r) * q) + off; }
        const int nig = WGM * nN, gid = wgid / nig, fm = gid * WGM, gsz = (nM - fm) < WGM ? (nM - fm) : WGM;
        u.pm = fm + ((wgid % nig) % gsz); u.pn = (wgid % nig) / gsz; u.e = 0; return true;
    }
    __device__ __forceinline__ void a_ready(const Unit&) const {}
    __device__ __forceinline__ void done(const Unit&) const {}
};

__device__ __forceinline__ unsigned cvt_pk_bf16(float lo, float hi) { unsigned r; asm volatile("v_cvt_pk_bf16_f32 %0, %1, %2" : "=v"(r) : "v"(lo), "v"(hi)); return r; }
typedef float f32x2 __attribute__((ext_vector_type(2)));
__device__ __forceinline__ f32x2 gelu_pk(f32x2 v) {
    const f32x2 av = __builtin_elementwise_abs(v), d = av * 0.2316418882f + 1.0f;
    f32x2 t; t.x = __builtin_amdgcn_rcpf(d.x); t.y = __builtin_amdgcn_rcpf(d.y);
    f32x2 q = t * 0.5307027145f + (-0.7265760135f); q = q * t + 0.7107068705f; q = q * t + (-0.142248368f); q = q * t + 0.127414796f; q = q * t;
    const f32x2 s = (v * v) * (-0.72134752044f);
    f32x2 e; e.x = __builtin_amdgcn_exp2f(s.x); e.y = __builtin_amdgcn_exp2f(s.y);
    const f32x2 m = v * (q * e), r = v - m;
    f32x2 o; o.x = v.x < 0.f ? m.x : r.x; o.y = v.y < 0.f ? m.y : r.y; return o;
}

template <int ACT  > struct EpiBf16 {
    static constexpr bool PERM = true, AFTER_DRAIN = false; static_assert(ACT == 0 || ACT == 1, "EpiBf16: ACT is 0 (none) or 1 (gelu_pk)");
    bf16_t* O; int ldc; const float* bias; int split_cols; size_t split_stride; float scale0;
    __device__ __forceinline__ void operator()(const f32x4 (&acc)[2][2][4][2], const Unit& u, int wr, int wc, int fr, int fq) const {
        const int row0 = u.pm * BM + wr * 64 + fr; int colt = u.pn * BM; bf16_t* base = O;
        float sc = 1.f; if (split_cols) { const int t = colt / split_cols; base += (size_t)t * split_stride; colt -= t * split_cols; if (t == 0) sc = scale0; }
        const int col0 = colt + wc * 32 + 8 * fq, bcol0 = u.pn * BM + wc * 32 + 8 * fq;
        f32x4 bv[2][2];
#pragma unroll
        for (int bj = 0; bj < 2; ++bj)
#pragma unroll
            for (int n = 0; n < 2; ++n) bv[bj][n] = bias ? *(const f32x4*)(bias + bcol0 + bj * HALF + 4 * n) : (f32x4){0.f, 0.f, 0.f, 0.f};
#pragma unroll
        for (int ai = 0; ai < 2; ++ai)
#pragma unroll
            for (int m = 0; m < 4; ++m) { bf16_t* rowp = base + (size_t)(row0 + ai * HALF + m * 16) * ldc + col0;
#pragma unroll
                for (int bj = 0; bj < 2; ++bj) { f32x4 v0 = acc[ai][bj][m][0] + bv[bj][0], v1 = acc[ai][bj][m][1] + bv[bj][1];
                    if (ACT == 1) { f32x2 a = gelu_pk((f32x2){v0[0], v0[1]}), b = gelu_pk((f32x2){v0[2], v0[3]}), c = gelu_pk((f32x2){v1[0], v1[1]}), d = gelu_pk((f32x2){v1[2], v1[3]});
                        v0 = (f32x4){a.x, a.y, b.x, b.y}; v1 = (f32x4){c.x, c.y, d.x, d.y}; }
                    v0 = v0 * sc; v1 = v1 * sc; u32x4 w; w.x = cvt_pk_bf16(v0[0], v0[1]); w.y = cvt_pk_bf16(v0[2], v0[3]); w.z = cvt_pk_bf16(v1[0], v1[1]); w.w = cvt_pk_bf16(v1[2], v1[3]);
                    *(u32x4*)(rowp + bj * HALF) = w; } }
    }
};

template <class Epi, class Sched, bool ALIGN_EPI = false, bool SP2 = false>
__device__ __forceinline__ void gemm_phase(PG8_LAS unsigned char* lds, const Gemm g, const Sched& S, const Epi& E) {
    const int tid = threadIdx.x, wid = __builtin_amdgcn_readfirstlane(tid >> 6), lane = tid & 63, wr = wid >> 2, wc = wid & 3, fr = lane & 15, fq = lane >> 4;
    const int K = g.K, nt = K / BK;
    unsigned voffA[2], voffB[2];
#pragma unroll
    for (int i = 0; i < 2; ++i) { int R, C; stage_rc(tid * 16 + i * 8192, R, C); const int Rb = Epi::PERM ? ((R & ~31) + perm32(R & 31)) : R;
        voffA[i] = (unsigned)(R * K + C) * 2u; voffB[i] = (unsigned)(Rb * K + C) * 2u; }
    const size_t kstep = (size_t)(BK * 2);
    const size_t hstep = (size_t)HALF * K * 2;
    const size_t tstep = 2 * hstep;
    const unsigned ldsw = (unsigned)wid * 1024u;
    const int aoff = lds_byte(wr * 64 + fr, fq * 8), boff = lds_byte(wc * 32 + fr, fq * 8);
#define PG8_SA(b, h) (((b) * 2 + (h)) * HTB)
#define PG8_SB(b, h) ((4 + (b) * 2 + (h)) * HTB)
#define PG8_STAGE(bufoff, gbase, voff) do { _Pragma("unroll") for (int _i = 0; _i < 2; ++_i) \
        __builtin_amdgcn_global_load_lds((const unsigned*)((const char*)(gbase) + (voff)[_i]), (PG8_LAS unsigned*)(lds + (bufoff) + ldsw + _i * 8192), 16, 0, 0); } while (0)
#define PG8_LDA(dst, b, h) do { _Pragma("unroll") for (int m = 0; m < 4; ++m) _Pragma("unroll") for (int k = 0; k < 2; ++k) dst[m][k] = *(const PG8_LAS bf16x8*)(lds + PG8_SA(b, h) + aoff + m * 2048 + k * 1024); } while (0)
#define PG8_LDB(dst, b, h) do { _Pragma("unroll") for (int n = 0; n < 2; ++n) _Pragma("unroll") for (int k = 0; k < 2; ++k) dst[n][k] = *(const PG8_LAS bf16x8*)(lds + PG8_SB(b, h) + boff + n * 2048 + k * 1024); } while (0)
#define PG8_MMA(ai, bj, At, Bt) do { __builtin_amdgcn_s_setprio(1); _Pragma("unroll") for (int m = 0; m < 4; ++m) _Pragma("unroll") for (int n = 0; n < 2; ++n) _Pragma("unroll") for (int k = 0; k < 2; ++k) \
        acc[ai][bj][m][n] = __builtin_amdgcn_mfma_f32_16x16x32_bf16(Bt[n][k], At[m][k], acc[ai][bj][m][n], 0, 0, 0); __builtin_amdgcn_s_setprio(0); } while (0)
#define PG8_WAIT_V(n) asm volatile("s_waitcnt vmcnt(" #n ")" ::: "memory")
#define PG8_WAIT_L(n) asm volatile("s_waitcnt lgkmcnt(" #n ")" ::: "memory")
#define PG8_BAR __builtin_amdgcn_s_barrier()
#define PG8_SCHED __builtin_amdgcn_sched_barrier(0)
    Unit cur, nxt; int ui = 0;
    if (!S.next(0, cur)) return;
    f32x4 acc[2][2][4][2];
#pragma unroll
    for (int a = 0; a < 2; ++a)
#pragma unroll
        for (int b = 0; b < 2; ++b)
#pragma unroll
            for (int m = 0; m < 4; ++m)
#pragma unroll
                for (int n = 0; n < 2; ++n) acc[a][b][m][n] = (f32x4){0.f, 0.f, 0.f, 0.f};
    bf16x8 At[4][2], B0[2][2], B1[2][2];
    const char* cA = (const char*)g.A + (size_t)cur.pm * tstep; const char* cB = (const char*)g.Bt + (size_t)cur.e * g.estride + (size_t)cur.pn * tstep;
    S.a_ready(cur);
    if constexpr (SP2) {
        PG8_STAGE(PG8_SB(0, 0), cB, voffB); PG8_STAGE(PG8_SB(0, 1), cB + hstep, voffB); PG8_STAGE(PG8_SA(0, 0), cA, voffA); PG8_STAGE(PG8_SA(0, 1), cA + hstep, voffA);
        if (wr == 1) PG8_BAR;
        PG8_WAIT_V(2); PG8_BAR;
        PG8_STAGE(PG8_SB(1, 0), cB + kstep, voffB); PG8_STAGE(PG8_SA(1, 0), cA + kstep, voffA); PG8_STAGE(PG8_SB(1, 1), cB + hstep + kstep, voffB);
        PG8_WAIT_V(6); PG8_BAR;
    } else {
        PG8_STAGE(PG8_SB(0, 0), cB, voffB); PG8_STAGE(PG8_SA(0, 0), cA, voffA); PG8_STAGE(PG8_SB(0, 1), cB + hstep, voffB); PG8_STAGE(PG8_SA(0, 1), cA + hstep, voffA);
        if (wr == 1) PG8_BAR;
        PG8_WAIT_V(4); PG8_BAR;
        PG8_STAGE(PG8_SB(1, 0), cB + kstep, voffB); PG8_STAGE(PG8_SA(1, 0), cA + kstep, voffA); PG8_STAGE(PG8_SB(1, 1), cB + hstep + kstep, voffB);
        PG8_WAIT_V(6); PG8_BAR;
    }
    for (;;) {
        const bool has_next = S.next(ui + 1, nxt);
        const char* nA = has_next ? (const char*)g.A + (size_t)nxt.pm * tstep : cA; const char* nB = has_next ? (const char*)g.Bt + (size_t)nxt.e * g.estride + (size_t)nxt.pn * tstep : cB;
        for (int t = 0; t < nt; t += 2) {
            const bool last = (t == nt - 2);
            const char* a1 = cA + (size_t)(t + 1) * kstep;
            const char* a2 = last ? nA : cA + (size_t)(t + 2) * kstep; const char* b2 = last ? nB : cB + (size_t)(t + 2) * kstep;
            const char* a3 = a2 + kstep; const char* b3 = b2 + kstep;
            if (last && has_next) S.a_ready(nxt);
            if constexpr (SP2) {
            PG8_LDB(B0, 0, 0); PG8_LDB(B1, 0, 1); PG8_SCHED; PG8_LDA(At, 0, 0); PG8_STAGE(PG8_SA(1, 1), a1 + hstep, voffA);
            PG8_WAIT_V(8); PG8_WAIT_L(0); PG8_BAR; PG8_MMA(0, 0, At, B0); PG8_MMA(0, 1, At, B1); PG8_BAR; PG8_SCHED;
            PG8_LDA(At, 0, 1); PG8_STAGE(PG8_SB(0, 0), b2, voffB); PG8_STAGE(PG8_SB(0, 1), b2 + hstep, voffB); PG8_STAGE(PG8_SA(0, 0), a2, voffA);
            PG8_WAIT_V(8); PG8_WAIT_L(0); PG8_BAR; PG8_MMA(1, 0, At, B0); PG8_MMA(1, 1, At, B1); PG8_BAR; PG8_SCHED;
            PG8_LDB(B0, 1, 0); PG8_LDB(B1, 1, 1); PG8_SCHED; PG8_LDA(At, 1, 0); PG8_STAGE(PG8_SA(0, 1), a2 + hstep, voffA);
            PG8_WAIT_V(8); PG8_WAIT_L(0); PG8_BAR; PG8_MMA(0, 0, At, B0); PG8_MMA(0, 1, At, B1); PG8_BAR; PG8_SCHED;
            PG8_LDA(At, 1, 1); PG8_STAGE(PG8_SB(1, 0), b3, voffB); PG8_STAGE(PG8_SB(1, 1), b3 + hstep, voffB); PG8_STAGE(PG8_SA(1, 0), a3, voffA);
            PG8_WAIT_V(8); PG8_WAIT_L(0); PG8_BAR; PG8_MMA(1, 0, At, B0); PG8_MMA(1, 1, At, B1); PG8_BAR; PG8_SCHED;
            } else {
            PG8_LDB(B0, 0, 0); PG8_SCHED; PG8_LDA(At, 0, 0); PG8_STAGE(PG8_SA(1, 1), a1 + hstep, voffA);
            PG8_WAIT_L(8); PG8_BAR; PG8_WAIT_L(0); PG8_MMA(0, 0, At, B0); PG8_BAR; PG8_SCHED;
            PG8_LDB(B1, 0, 1); PG8_STAGE(PG8_SB(0, 0), b2, voffB);
            PG8_BAR; PG8_WAIT_L(0); PG8_MMA(0, 1, At, B1); PG8_BAR;
            PG8_LDA(At, 0, 1); PG8_STAGE(PG8_SA(0, 0), a2, voffA);
            PG8_BAR; PG8_WAIT_L(0); PG8_MMA(1, 0, At, B0); PG8_BAR; PG8_SCHED;
            PG8_STAGE(PG8_SB(0, 1), b2 + hstep, voffB);
            PG8_WAIT_V(6); PG8_BAR; PG8_MMA(1, 1, At, B1); PG8_BAR;
            PG8_LDB(B0, 1, 0); PG8_SCHED; PG8_LDA(At, 1, 0); PG8_STAGE(PG8_SA(0, 1), a2 + hstep, voffA);
            PG8_WAIT_L(8); PG8_BAR; PG8_WAIT_L(0); PG8_MMA(0, 0, At, B0); PG8_BAR; PG8_SCHED;
            PG8_LDB(B1, 1, 1); PG8_STAGE(PG8_SB(1, 0), b3, voffB);
            PG8_BAR; PG8_WAIT_L(0); PG8_MMA(0, 1, At, B1); PG8_BAR;
            PG8_LDA(At, 1, 1); PG8_STAGE(PG8_SA(1, 0), a3, voffA);
            PG8_BAR; PG8_WAIT_L(0); PG8_MMA(1, 0, At, B0); PG8_BAR; PG8_SCHED;
            PG8_STAGE(PG8_SB(1, 1), b3 + hstep, voffB);
            PG8_WAIT_V(6); PG8_BAR; PG8_MMA(1, 1, At, B1); PG8_BAR;
            }
        }
        if constexpr (ALIGN_EPI) { if (wr == 0) PG8_BAR; }
        if constexpr (!Epi::AFTER_DRAIN) { E(acc, cur, wr, wc, fr, fq); S.done(cur); }
        if (!has_next) break;
#pragma unroll
        for (int a = 0; a < 2; ++a)
#pragma unroll
            for (int b = 0; b < 2; ++b)
#pragma unroll
                for (int m = 0; m < 4; ++m)
#pragma unroll
                    for (int n = 0; n < 2; ++n) acc[a][b][m][n] = (f32x4){0.f, 0.f, 0.f, 0.f};
        cur = nxt; cA = nA; cB = nB; ++ui;
        if constexpr (ALIGN_EPI) { if (wr == 1) PG8_BAR; }
    }
    PG8_WAIT_V(0);
    if constexpr (!ALIGN_EPI) { if (wr == 0) PG8_BAR; }
    PG8_BAR;
    if constexpr (Epi::AFTER_DRAIN) { E.fused(acc, cur, wr, wc, fr, fq, lds, wid, lane); S.done(cur); }
#undef PG8_SA
#undef PG8_SB
#undef PG8_STAGE
#undef PG8_LDA
#undef PG8_LDB
#undef PG8_MMA
#undef PG8_WAIT_V
#undef PG8_WAIT_L
#undef PG8_BAR
#undef PG8_SCHED
}
}

namespace pg8 {
struct MoeOrder {
    int nM, nN, nwg, G, c; const PG8_LAS int* bexp;
    __device__ __forceinline__ void init(int nM_, int nN_, int G_, int c_, const PG8_LAS int* bexp_) { nM = nM_; nN = nN_; nwg = nM_ * nN_; G = G_; c = c_; bexp = bexp_; }
    __device__ __forceinline__ bool next(int i, Unit& u) const {
        const long L = (long)i * G + c; if (L >= nwg) return false;
        int wgid = (int)L; { const int q = nwg / NXCD, r = nwg % NXCD, xcd = wgid % NXCD, off = wgid / NXCD; wgid = (xcd < r ? xcd * (q + 1) : r * (q + 1) + (xcd - r) * q) + off; }
        const int nig = WGM * nN, gid = wgid / nig, fm = gid * WGM, gsz = (nM - fm) < WGM ? (nM - fm) : WGM;
        u.pm = fm + ((wgid % nig) % gsz); u.pn = (wgid % nig) / gsz; u.e = __builtin_amdgcn_readfirstlane(bexp[u.pm]); return true;
    }
    __device__ __forceinline__ void a_ready(const Unit&) const {}
    __device__ __forceinline__ void done(const Unit&) const {}
};
struct EpiOut {
    static constexpr bool PERM = false, AFTER_DRAIN = false;
    const float* x; float* out; const float* mod;
    __device__ __forceinline__ void operator()(const f32x4 (&acc)[2][2][4][2], const Unit& u, int wr, int wc, int fr, int fq) const {
        const int row0 = u.pm * BM + wr * 64 + fr, col0 = u.pn * BM + wc * 32 + 4 * fq;
        const float* g = mod + (size_t)(u.pm >> 5) * 6144 + 2 * 1024;
        f32x4 gv[2][2];
#pragma unroll
        for (int bj = 0; bj < 2; ++bj)
#pragma unroll
            for (int n = 0; n < 2; ++n) gv[bj][n] = *(const f32x4*)(g + col0 + bj * HALF + n * 16);
#pragma unroll
        for (int ai = 0; ai < 2; ++ai)
#pragma unroll
            for (int m = 0; m < 4; ++m) { const size_t off = (size_t)(row0 + ai * HALF + m * 16) * 1024 + col0;
#pragma unroll
                for (int bj = 0; bj < 2; ++bj)
#pragma unroll
                    for (int n = 0; n < 2; ++n) { const f32x4 xv = *(const f32x4*)(x + off + bj * HALF + n * 16); *(f32x4*)(out + off + bj * HALF + n * 16) = xv + gv[bj][n] * acc[ai][bj][m][n]; } }
    }
};
__device__ __forceinline__ float swiglu1(float g, float l) {
    const float glu = fminf(g, 7.0f), lin = fminf(fmaxf(l, -7.0f), 7.0f);
    const float sg = __builtin_amdgcn_rcpf(1.0f + __builtin_amdgcn_exp2f(glu * (-1.702f * 1.4426950408889634f)));
    return glu * sg * (lin + 1.0f);
}
struct EpiSwiGLU {
    static constexpr bool PERM = true, AFTER_DRAIN = false;
    bf16_t* act; const float* bgu;
    __device__ __forceinline__ void operator()(const f32x4 (&acc)[2][2][4][2], const Unit& u, int wr, int wc, int fr, int fq) const {
        const int row0 = u.pm * BM + wr * 64 + fr, cg = u.pn * 128 + wc * 32 + 8 * fq;
        const float* bb = bgu + (size_t)u.e * 2048;
        f32x4 bg[2], bl[2];
#pragma unroll
        for (int n = 0; n < 2; ++n) { bg[n] = *(const f32x4*)(bb + cg + 4 * n); bl[n] = *(const f32x4*)(bb + 1024 + cg + 4 * n); }
#pragma unroll
        for (int ai = 0; ai < 2; ++ai)
#pragma unroll
            for (int m = 0; m < 4; ++m) { bf16_t* rowp = act + (size_t)(row0 + ai * HALF + m * 16) * 1024 + cg;
                const f32x4 g0 = acc[ai][0][m][0] + bg[0], g1 = acc[ai][0][m][1] + bg[1], l0 = acc[ai][1][m][0] + bl[0], l1 = acc[ai][1][m][1] + bl[1];
                u32x4 w; w.x = cvt_pk_bf16(swiglu1(g0[0], l0[0]), swiglu1(g0[1], l0[1])); w.y = cvt_pk_bf16(swiglu1(g0[2], l0[2]), swiglu1(g0[3], l0[3]));
                w.z = cvt_pk_bf16(swiglu1(g1[0], l1[0]), swiglu1(g1[1], l1[1])); w.w = cvt_pk_bf16(swiglu1(g1[2], l1[2]), swiglu1(g1[3], l1[3]));
                *(u32x4*)rowp = w; }
    }
};
struct EpiDown {
    static constexpr bool PERM = true, AFTER_DRAIN = false;
    bf16_t* y; const float* bd;
    __device__ __forceinline__ void operator()(const f32x4 (&acc)[2][2][4][2], const Unit& u, int wr, int wc, int fr, int fq) const {
        const int row0 = u.pm * BM + wr * 64 + fr, col0 = u.pn * BM + wc * 32 + 8 * fq;
        const float* bb = bd + (size_t)u.e * 1024 + col0;
        f32x4 bv[2][2];
#pragma unroll
        for (int bj = 0; bj < 2; ++bj)
#pragma unroll
            for (int n = 0; n < 2; ++n) bv[bj][n] = *(const f32x4*)(bb + bj * HALF + 4 * n);
#pragma unroll
        for (int ai = 0; ai < 2; ++ai)
#pragma unroll
            for (int m = 0; m < 4; ++m) { bf16_t* rowp = y + (size_t)(row0 + ai * HALF + m * 16) * 1024 + col0;
#pragma unroll
                for (int bj = 0; bj < 2; ++bj) { const f32x4 v0 = acc[ai][bj][m][0] + bv[bj][0], v1 = acc[ai][bj][m][1] + bv[bj][1];
                    u32x4 w; w.x = cvt_pk_bf16(v0[0], v0[1]); w.y = cvt_pk_bf16(v0[2], v0[3]); w.z = cvt_pk_bf16(v1[0], v1[1]); w.w = cvt_pk_bf16(v1[2], v1[3]);
                    *(u32x4*)(rowp + bj * HALF) = w; } }
    }
};
}

namespace att {
typedef unsigned short bf16_t;
using bf16x8 = __attribute__((ext_vector_type(8))) short;
using s16x4  = __attribute__((ext_vector_type(4))) short;
using f32x16 = __attribute__((ext_vector_type(16))) float;
using u32x4  = __attribute__((ext_vector_type(4))) unsigned;
constexpr int NW = 8, QBLK = 32, KVBLK = 64, LD = 3072;
constexpr float SCALE = 0.125f, THR = 8.f;
#define KSWZ64(row, colB) ((row) * 128 + ((colB) ^ ((((row) >> 1) & 7) << 4)))
#define ASBAR() __builtin_amdgcn_sched_barrier(0)
__device__ __forceinline__ int crow(int r, int hi) { return (r & 3) + 8 * (r >> 2) + 4 * hi; }
__device__ __forceinline__ unsigned cvtpk(float lo, float hi) { unsigned r; asm volatile("v_cvt_pk_bf16_f32 %0, %1, %2" : "=v"(r) : "v"(lo), "v"(hi)); return r; }
__device__ __forceinline__ bf16x8 ld8(const bf16_t* p) { return *reinterpret_cast<const bf16x8*>(p); }

__device__ __forceinline__ void partialSM(f32x16& p0, f32x16& p1, float& m_reg, float& mn, float& alpha) {
  constexpr float C = SCALE * 1.4426950408889634f;
  float pmax = p0[0];
#pragma unroll
  for (int r = 1; r < 16; ++r) pmax = fmaxf(pmax, p0[r]);
#pragma unroll
  for (int r = 0; r < 16; ++r) pmax = fmaxf(pmax, p1[r]);
  { auto rr = __builtin_amdgcn_permlane32_swap(__float_as_uint(pmax), __float_as_uint(pmax), false, false);
    pmax = fmaxf(__uint_as_float(rr[0]), __uint_as_float(rr[1])); }
  if (__builtin_expect(__all(pmax - m_reg <= THR / SCALE), 1)) { mn = m_reg; alpha = 1.f; }
  else { mn = fmaxf(m_reg, pmax); alpha = __builtin_amdgcn_exp2f((m_reg - mn) * C); m_reg = mn; }
  const float mnC = -mn * C;
#pragma unroll
  for (int r = 0; r < 16; ++r) p0[r] = fmaf(p0[r], C, mnC);
#pragma unroll
  for (int r = 0; r < 16; ++r) p1[r] = fmaf(p1[r], C, mnC);
#pragma unroll
  for (int r = 0; r < 16; ++r) p0[r] = __builtin_amdgcn_exp2f(p0[r]);
}
__device__ __forceinline__ void finishSM(f32x16& p0, f32x16& p1, float alpha, float& l_reg, bf16x8& pa0, bf16x8& pa1, bf16x8& pa2, bf16x8& pa3) {
#pragma unroll
  for (int r = 0; r < 16; ++r) p1[r] = __builtin_amdgcn_exp2f(p1[r]);
  float ps = 0;
#pragma unroll
  for (int r = 0; r < 16; ++r) ps += p0[r];
#pragma unroll
  for (int r = 0; r < 16; ++r) ps += p1[r];
  { auto rr = __builtin_amdgcn_permlane32_swap(__float_as_uint(ps), __float_as_uint(ps), false, false);
    ps = __uint_as_float(rr[0]) + __uint_as_float(rr[1]); }
  l_reg = l_reg * alpha + ps;
#define PK4(P, BASE, OUT) do { unsigned a0 = cvtpk(P[BASE + 0], P[BASE + 1]), a1 = cvtpk(P[BASE + 2], P[BASE + 3]);   \
    unsigned b0 = cvtpk(P[BASE + 4], P[BASE + 5]), b1 = cvtpk(P[BASE + 6], P[BASE + 7]);                              \
    auto r0 = __builtin_amdgcn_permlane32_swap(a0, b0, false, false); auto r1 = __builtin_amdgcn_permlane32_swap(a1, b1, false, false); \
    u32x4 w = {r0[0], r1[0], r0[1], r1[1]}; OUT = *reinterpret_cast<bf16x8*>(&w); } while (0)
  PK4(p0, 0, pa0); PK4(p0, 8, pa1); PK4(p1, 0, pa2); PK4(p1, 8, pa3);
#undef PK4
}
__device__ __forceinline__ void qkt(f32x16& p0, f32x16& p1, const char* Ks, const bf16x8* qr, int r32, int hi) {
  p0 = f32x16{}; p1 = f32x16{};
#pragma unroll
  for (int d0 = 0; d0 < 4; ++d0) { const int cb = (d0 * 16 + hi * 8) * 2;
    const bf16x8 b0 = *reinterpret_cast<const bf16x8*>(Ks + KSWZ64(r32, cb));
    const bf16x8 b1 = *reinterpret_cast<const bf16x8*>(Ks + KSWZ64(32 + r32, cb));
    p0 = __builtin_amdgcn_mfma_f32_32x32x16_bf16(b0, qr[d0], p0, 0, 0, 0);
    p1 = __builtin_amdgcn_mfma_f32_32x32x16_bf16(b1, qr[d0], p1, 0, 0, 0); }
}
template <int NVB> __device__ __forceinline__ int v_st(int k, int c) { const int kk = (k & ~0xC) | ((k & 4) << 1) | ((k & 8) >> 1); return ((kk >> 3) * NVB + (c >> 5)) * 512 + ((kk & 7) * 32 + (c & 31)) * 2; }
__device__ __forceinline__ int v_rd_base(int lane) { return ((lane & 3) << 3) | (((lane >> 2) & 3) << 6) | (((lane >> 4) & 1) << 5) | (((lane >> 5) & 1) << 8); }
template <int NVB> constexpr int v_rd_off(int d0, int ks, int half) { return d0 * 512 + ks * (NVB * 1024) + half * (NVB * 512); }
template <int OFF> __device__ __forceinline__ s16x4 tr_read(int vb) {
  s16x4 r; asm volatile("ds_read_b64_tr_b16 %0, %1 offset:%2" : "=&v"(r) : "v"(vb), "i"(OFF) : "memory"); return r;
}
template <int NVB, int D0> __device__ __forceinline__ void pv_one(f32x16& od, int vb, bf16x8 pa0, bf16x8 pa1, bf16x8 pa2, bf16x8 pa3) {
  const s16x4 l0 = tr_read<v_rd_off<NVB>(D0, 0, 0)>(vb), h0 = tr_read<v_rd_off<NVB>(D0, 0, 1)>(vb), l1 = tr_read<v_rd_off<NVB>(D0, 1, 0)>(vb), h1 = tr_read<v_rd_off<NVB>(D0, 1, 1)>(vb);
  const s16x4 l2 = tr_read<v_rd_off<NVB>(D0, 2, 0)>(vb), h2 = tr_read<v_rd_off<NVB>(D0, 2, 1)>(vb), l3 = tr_read<v_rd_off<NVB>(D0, 3, 0)>(vb), h3 = tr_read<v_rd_off<NVB>(D0, 3, 1)>(vb);
  asm volatile("s_waitcnt lgkmcnt(0)" ::: "memory"); ASBAR();
#define PK(L, H) (bf16x8){L[0], L[1], L[2], L[3], H[0], H[1], H[2], H[3]}
  od = __builtin_amdgcn_mfma_f32_32x32x16_bf16(pa0, PK(l0, h0), od, 0, 0, 0);
  od = __builtin_amdgcn_mfma_f32_32x32x16_bf16(pa1, PK(l1, h1), od, 0, 0, 0);
  od = __builtin_amdgcn_mfma_f32_32x32x16_bf16(pa2, PK(l2, h2), od, 0, 0, 0);
  od = __builtin_amdgcn_mfma_f32_32x32x16_bf16(pa3, PK(l3, h3), od, 0, 0, 0);
#undef PK
}
template <int NVB> __device__ __forceinline__ void pv_all(f32x16* o, int vb, bf16x8 pa0, bf16x8 pa1, bf16x8 pa2, bf16x8 pa3) {
  pv_one<NVB, 0>(o[0], vb, pa0, pa1, pa2, pa3); pv_one<NVB, 1>(o[1], vb, pa0, pa1, pa2, pa3);
  if constexpr (NVB == 4) { pv_one<NVB, 2>(o[2], vb, pa0, pa1, pa2, pa3); pv_one<NVB, 3>(o[3], vb, pa0, pa1, pa2, pa3); }
}
struct DiffPol {
  const bf16_t* Kg; const bf16_t* Vg; long lat0, ctx0;
  __device__ __forceinline__ long krow(int t) const { return t < 128 ? lat0 + 64L * t : ctx0 + 64L * (t - 128); }
  __device__ __forceinline__ void mod(f32x16&, f32x16&, int, int, int, int) const {}
};
struct NaPol {
  const bf16_t* Kg; const bf16_t* Vg; long lat0, ctx0; int rbase, r; const float* tab;
  __device__ __forceinline__ long krow(int t) const { if (t < 12) { int kr = rbase + t; kr = kr > 127 ? 127 : kr; return lat0 + 64L * kr; } return ctx0 + 64L * (t - 12); }
  __device__ __forceinline__ void mod(f32x16& p0, f32x16& p1, int t, int wid, int r32, int hi) const {
    if (t >= 12) return;
    const float NEG = -INFINITY;
    const int kr = rbase + t, rq = r + (wid >> 1), c = 32 * (wid & 1) + r32;
    int r0q = rq - 4; r0q = r0q < 0 ? 0 : (r0q > 120 ? 120 : r0q);
    if (!((kr >= r0q) && (kr < r0q + 8))) {
#pragma unroll
      for (int i = 0; i < 16; ++i) { p0[i] = NEG; p1[i] = NEG; }
      return; }
    int c0 = c - 8; c0 = c0 < 0 ? 0 : (c0 > 48 ? 48 : c0);
    const float* trow = tab + (kr - rq + 7) * 31 + (15 - c);
#pragma unroll
    for (int i = 0; i < 16; ++i) {
      const int k0 = crow(i, hi), k1 = k0 + 32;
      const bool v0 = (k0 >= c0) && (k0 < c0 + 16), v1 = (k1 >= c0) && (k1 < c0 + 16);
      const float b0 = trow[v0 ? k0 : c], b1 = trow[v1 ? k1 : c];
      p0[i] = v0 ? p0[i] + b0 : NEG; p1[i] = v1 ? p1[i] + b1 : NEG; }
  }
};
template <int NVB> constexpr int lds_bytes() { return 2 * (64 * NVB * 64) + 2 * (64 * 128) + NW * 64 * 4; }
template <int NVB, class Pol>
__device__ __forceinline__ void attn_unit(const bf16_t* __restrict__ Qb, const Pol& pol, bf16_t* __restrict__ Ob, int ldo, int NT, char* lds) {
  constexpr int SHM_V = 64 * NVB * 64, SHM_K = 64 * 128;
  const int tid = threadIdx.x, wid = tid >> 6, lane = tid & 63, r32 = lane & 31, hi = lane >> 5;
  char* V_lds = lds; char* K_lds = lds + 2 * SHM_V;
  float* ws = (float*)(lds + 2 * SHM_V + 2 * SHM_K) + wid * 64; float* li_l = ws; float* al_l = ws + 32;
  float m_reg = -1e30f, l_reg = 0; f32x16 o[NVB]; bf16x8 qr[4];
#pragma unroll
  for (int d = 0; d < NVB; ++d) o[d] = f32x16{};
  const bf16_t* Qw = Qb + (long)(wid * QBLK + r32) * LD + hi * 8;
#pragma unroll
  for (int d0 = 0; d0 < 4; ++d0) qr[d0] = ld8(Qw + d0 * 16);
  const int ksr = tid >> 3, ksc = (tid & 7) * 8, kst = KSWZ64(ksr, ksc * 2);
  const int vsr = (NVB == 4) ? (tid >> 4) : (tid >> 3), vsc = (NVB == 4) ? (tid & 15) * 8 : (tid & 7) * 8;
  const int vst0 = v_st<NVB>(vsr, vsc), vst1 = v_st<NVB>(32 + vsr, vsc);
  const int vb0 = (int)(uintptr_t)V_lds + v_rd_base(lane);
  struct { bf16x8 v0, v1, k0; } sr_[2];
#define SLOAD(i, t) do { const long row0_ = pol.krow(t); sr_[i].v0 = ld8(pol.Vg + (row0_ + vsr) * LD + vsc); \
    if constexpr (NVB == 4) sr_[i].v1 = ld8(pol.Vg + (row0_ + 32 + vsr) * LD + vsc); sr_[i].k0 = ld8(pol.Kg + (row0_ + ksr) * LD + ksc); } while (0)
#define SWRITE(b, i) do { *(bf16x8*)(V_lds + (b) * SHM_V + vst0) = sr_[i].v0; if constexpr (NVB == 4) *(bf16x8*)(V_lds + (b) * SHM_V + vst1) = sr_[i].v1; \
    *(bf16x8*)(K_lds + (b) * SHM_K + kst) = sr_[i].k0; } while (0)
#define SWAIT() do { if constexpr (NVB == 4) asm volatile("s_waitcnt vmcnt(3)" ::: "memory"); else asm volatile("s_waitcnt vmcnt(2)" ::: "memory"); } while (0)
#define RESC(a) do { if (__any((a) < 1.f)) { if (hi == 0) al_l[r32] = (a); asm volatile("s_waitcnt lgkmcnt(0)" ::: "memory"); \
    _Pragma("unroll") for (int d = 0; d < NVB; ++d) _Pragma("unroll") for (int r = 0; r < 16; ++r) o[d][r] *= al_l[crow(r, hi)]; } } while (0)
  f32x16 pA0, pA1, pB0, pB1; float mnA, mnB, alA, alB; bf16x8 pa0, pa1, pa2, pa3;
  constexpr int SE = 0, SO = 1;
  SLOAD(SE, 0); asm volatile("s_waitcnt vmcnt(0)" ::: "memory"); SWRITE(0, SE); __syncthreads();
  qkt(pA0, pA1, K_lds, qr, r32, hi); pol.mod(pA0, pA1, 0, wid, r32, hi); partialSM(pA0, pA1, m_reg, mnA, alA);
  SLOAD(SO, 1); if (2 < NT) SLOAD(SE, 2);
  SWAIT(); SWRITE(1, SO); __syncthreads();
  for (int j = 1; j + 1 < NT; j += 2) {
    ASBAR(); qkt(pB0, pB1, K_lds + SHM_K, qr, r32, hi);
    finishSM(pA0, pA1, alA, l_reg, pa0, pa1, pa2, pa3); ASBAR();
    SLOAD(SO, j + 2); ASBAR();
    pv_all<NVB>(o, vb0, pa0, pa1, pa2, pa3); pol.mod(pB0, pB1, j, wid, r32, hi); partialSM(pB0, pB1, m_reg, mnB, alB);
    __syncthreads(); SWAIT(); SWRITE(0, SE);
    RESC(alB); __syncthreads();
    ASBAR(); qkt(pA0, pA1, K_lds, qr, r32, hi);
    finishSM(pB0, pB1, alB, l_reg, pa0, pa1, pa2, pa3); ASBAR();
    if (j + 3 < NT) SLOAD(SE, j + 3); ASBAR();
    pv_all<NVB>(o, vb0 + SHM_V, pa0, pa1, pa2, pa3); pol.mod(pA0, pA1, j + 1, wid, r32, hi); partialSM(pA0, pA1, m_reg, mnA, alA);
    __syncthreads(); SWAIT(); SWRITE(1, SO);
    RESC(alA); __syncthreads();
  }
  ASBAR(); qkt(pB0, pB1, K_lds + SHM_K, qr, r32, hi);
  finishSM(pA0, pA1, alA, l_reg, pa0, pa1, pa2, pa3); ASBAR();
  pv_all<NVB>(o, vb0, pa0, pa1, pa2, pa3); pol.mod(pB0, pB1, NT - 1, wid, r32, hi); partialSM(pB0, pB1, m_reg, mnB, alB);
  __syncthreads(); RESC(alB);
  finishSM(pB0, pB1, alB, l_reg, pa0, pa1, pa2, pa3); ASBAR();
  pv_all<NVB>(o, vb0 + SHM_V, pa0, pa1, pa2, pa3);
  if (hi == 0) li_l[r32] = l_reg; asm volatile("s_waitcnt lgkmcnt(0)" ::: "memory");
  float rli[16];
#pragma unroll
  for (int r = 0; r < 16; ++r) rli[r] = __builtin_amdgcn_rcpf(li_l[crow(r, hi)]);
  bf16_t* Ow = Ob + (long)(wid * QBLK) * ldo;
#pragma unroll
  for (int r = 0; r < 16; ++r) { const int orow = crow(r, hi);
#pragma unroll
    for (int d0 = 0; d0 < NVB; ++d0) { const float v = o[d0][r] * rli[r]; const unsigned pk = cvtpk(v, v); Ow[(long)orow * ldo + d0 * 32 + r32] = (bf16_t)(pk & 0xffffu); } }
  __syncthreads();
#undef SLOAD
#undef SWRITE
#undef SWAIT
#undef RESC
}
}

#ifndef MK_N_LAUNCHES
#define MK_N_LAUNCHES 1
#endif
constexpr int N_PHASES = 12;
constexpr int NWAVES = 8;
constexpr int DM = 1024, NB = 4, SEQ = 8192, TT = NB * SEQ, CTX = 256, TC = NB * CTX, MQ = TT + TC, NQKV = 3072;
constexpr int NE = 32, TOPK = 4, MPAD = TT * TOPK + NE * 256, MAXBLK = MPAD / 256;
constexpr float NORM_EPS = 1e-6f;
enum { I_X = 0, I_C, I_CTX, I_CCTX, I_WADA, I_BADA, I_GATTN, I_WIN, I_QND, I_KND, I_LQ1, I_LK1, I_LQ2, I_LK2, I_SUBLN, I_QNN, I_KNN, I_RPB, I_ONN, I_WOUT, I_GFFN, I_WR, I_BR, I_WGU, I_BGU, I_WD, I_BD, N_IN };

constexpr size_t MiB = 1u << 20;
constexpr size_t WS_CTL = 0, CTL_ZERO_BYTES = 64 * 1024;
constexpr size_t WS_TAB = 1 * MiB;
constexpr size_t WS_WQKV = 2 * MiB, WS_WO = 8 * MiB, WS_WGU = 10 * MiB, WS_WDN = 138 * MiB;
constexpr size_t WS_XN = 202 * MiB;
constexpr size_t WS_P = 268 * MiB;
constexpr size_t WS_OD = 499 * MiB, WS_ON = 563 * MiB, WS_MIX = 595 * MiB;
constexpr size_t WS_XG = 202 * MiB;
constexpr size_t WS_ACT = 659 * MiB;
constexpr size_t WS_Y = 202 * MiB;
constexpr size_t WS_RT = 931 * MiB;
constexpr size_t WS_END = 936 * MiB;
static_assert(WS_XN + (size_t)MQ * 2048 <= WS_P && WS_P + (size_t)MQ * 6144 <= WS_OD && WS_XG + (size_t)MPAD * 2048 <= WS_OD && WS_ACT + (size_t)MPAD * 2048 <= WS_RT, "d_ws map");
constexpr int TB_MOD = 0;
constexpr int TB_RCOS = 30720, TB_RSIN = TB_RCOS + 128 * 16, TB_CCOS = TB_RSIN + 128 * 16, TB_CSIN = TB_CCOS + 64 * 16;
constexpr int TB_LAM = TB_CSIN + 64 * 16;
constexpr int TB_WR = TB_LAM + 64;
constexpr int TB_RC = TB_WR + 4 * 1024 * 32;
static_assert((size_t)(TB_RC + 128) * 4 <= MiB, "TAB region");
constexpr int CW_CNT = 0;
constexpr int CW_BAR = 4096;
constexpr size_t RT_E = 0, RT_G = 512 * 1024, RT_POS = 1024 * 1024, RT_SLOT = 1536 * 1024;

constexpr int RING_BYTES = 131072;
constexpr int MISC_OFF = RING_BYTES;
constexpr int LDS_BYTES = 147456;

#define GAS __attribute__((address_space(1)))
#define LAS __attribute__((address_space(3)))
typedef unsigned short bf16;
typedef unsigned v4u __attribute__((ext_vector_type(4)));
typedef unsigned v2u __attribute__((ext_vector_type(2)));
typedef float f32x4 __attribute__((ext_vector_type(4)));
typedef float f32x16 __attribute__((ext_vector_type(16)));
#define LDS_WAIT() asm volatile("s_waitcnt lgkmcnt(0)" ::: "memory")
__device__ __forceinline__ unsigned f2bf(float f) { unsigned u = __builtin_bit_cast(unsigned, f); return (u + 0x7fffu + ((u >> 16) & 1u)) >> 16; }
__device__ __forceinline__ unsigned pk2(float lo, float hi) { return f2bf(lo) | (f2bf(hi) << 16); }
__device__ __forceinline__ float bflo(unsigned w) { return __uint_as_float(w << 16); }
__device__ __forceinline__ float bfhi(unsigned w) { return __uint_as_float(w & 0xffff0000u); }
__device__ __forceinline__ float wave_sum(float v) {
#pragma unroll
    for (int o = 1; o < 64; o <<= 1) v += __shfl_xor(v, o);
    return v;
}

struct Frame {
    LAS unsigned char* lds;
    int tid, lane, wave, vcu, G;
    const float* in[N_IN]; float* out; unsigned char* ws;
};

__device__ __forceinline__ void p0_transpose_item(const float* W, int K, int N, bf16* WT, int k0, int n0, int drow0, LAS float* scr, int lane) {
#pragma unroll 8
    for (int i = 0; i < 32; ++i) { const int kk = 2 * i + (lane >> 5); scr[kk * 33 + (lane & 31)] = W[(size_t)(k0 + kk) * N + n0 + (lane & 31)]; }
    LDS_WAIT(); asm volatile("" ::: "memory");
    const int c = lane & 7;
#pragma unroll
    for (int j = 0; j < 4; ++j) { const int n = (lane >> 3) + 8 * j; const LAS float* s = scr + (8 * c) * 33 + n;
        v4u o; o.x = pk2(s[0 * 33], s[1 * 33]); o.y = pk2(s[2 * 33], s[3 * 33]); o.z = pk2(s[4 * 33], s[5 * 33]); o.w = pk2(s[6 * 33], s[7 * 33]);
        *(v4u*)(WT + (size_t)(drow0 + n) * K + k0 + 8 * c) = o; }
    LDS_WAIT(); asm volatile("" ::: "memory");
}

__device__ __forceinline__ void p0_prologue(Frame& F) {
    float* tab = (float*)(F.ws + WS_TAB);
    for (int task = blockIdx.x; task < 96; task += F.G) {
        LAS float* ssilu = (LAS float*)F.lds;
        LAS float* part = ssilu + 5 * 1024;
        for (int i = F.tid; i < 5 * 1024; i += 512) { const int r = i >> 10, k = i & 1023; const float v = (r < 4) ? F.in[I_C][r * 1024 + k] : F.in[I_CCTX][k]; ssilu[i] = v / (1.0f + __expf(-v)); }
        __syncthreads();
        const int col = task * 64 + F.lane; const float* w = F.in[I_WADA] + col; float a0 = 0, a1 = 0, a2 = 0, a3 = 0, a4 = 0;
        const int kb = F.wave * 128;
#pragma unroll 8
        for (int k = kb; k < kb + 128; ++k) { const float wv = w[(size_t)k * 6144]; a0 += ssilu[k] * wv; a1 += ssilu[1024 + k] * wv; a2 += ssilu[2048 + k] * wv; a3 += ssilu[3072 + k] * wv; a4 += ssilu[4096 + k] * wv; }
        part[(F.wave * 5 + 0) * 64 + F.lane] = a0; part[(F.wave * 5 + 1) * 64 + F.lane] = a1; part[(F.wave * 5 + 2) * 64 + F.lane] = a2; part[(F.wave * 5 + 3) * 64 + F.lane] = a3; part[(F.wave * 5 + 4) * 64 + F.lane] = a4;
        __syncthreads();
        if (F.tid < 320) { const int r = F.tid >> 6, cl = F.tid & 63; float s = 0; for (int wv = 0; wv < 8; ++wv) s += part[(wv * 5 + r) * 64 + cl]; const int j = task * 64 + cl; tab[TB_MOD + r * 6144 + j] = s + F.in[I_BADA][j]; }
        __syncthreads();
    }
    if ((int)blockIdx.x == F.G - 1) {
        for (int i = F.tid; i < 192 * 16; i += 512) { const int p = i >> 4, f = i & 15; const float inv = 1.0f / powf(10000.0f, (float)f / 16.0f); const int pos = p < 128 ? p : p - 128; const float ang = (float)pos * inv;
            const float cv = cosf(ang), sv = sinf(ang);
            if (p < 128) { tab[TB_RCOS + pos * 16 + f] = cv; tab[TB_RSIN + pos * 16 + f] = sv; } else { tab[TB_CCOS + pos * 16 + f] = cv; tab[TB_CSIN + pos * 16 + f] = sv; } }
        if (F.wave == 0) { const float s1 = wave_sum(F.in[I_LQ1][F.lane] * F.in[I_LK1][F.lane]), s2 = wave_sum(F.in[I_LQ2][F.lane] * F.in[I_LK2][F.lane]);
            if (F.lane == 0) tab[TB_LAM] = expf(s1) - expf(s2) + 0.2f; }
    }
    LAS float* scr = (LAS float*)(F.lds + 32768 + F.wave * 8704);
    const int gw = F.vcu * NWAVES + F.wave, NGW = F.G * NWAVES;
    constexpr int I_IN = 16 * 96, I_OUT = 16 * 32, I_GU = 16 * 64, I_DN = 16 * 32;
    constexpr int NITEMS = I_IN + I_OUT + NE * (I_GU + I_DN);
    bf16* wqkv = (bf16*)(F.ws + WS_WQKV); bf16* wo = (bf16*)(F.ws + WS_WO); bf16* wgu = (bf16*)(F.ws + WS_WGU); bf16* wdn = (bf16*)(F.ws + WS_WDN);
    for (int it = gw; it < NITEMS; it += NGW) {
        int r = it;
        if (r < I_IN) { const int kb = r / 96, nb = r % 96; p0_transpose_item(F.in[I_WIN], 1024, 3072, wqkv, 64 * kb, 32 * nb, 32 * nb, scr, F.lane); continue; } r -= I_IN;
        if (r < I_OUT) { const int kb = r / 32, nb = r % 32; p0_transpose_item(F.in[I_WOUT], 1024, 1024, wo, 64 * kb, 32 * nb, 32 * nb, scr, F.lane); continue; } r -= I_OUT;
        if (r < NE * I_GU) { const int e = r / I_GU, q = r % I_GU, kb = q / 64, nb = q % 64, n0 = 32 * nb;
            const int drow = (n0 < 1024) ? ((n0 >> 7) * 256 + (n0 & 127)) : (((n0 - 1024) >> 7) * 256 + 128 + ((n0 - 1024) & 127));
            p0_transpose_item(F.in[I_WGU] + (size_t)e * 1024 * 2048, 1024, 2048, wgu + (size_t)e * 2048 * 1024, 64 * kb, n0, drow, scr, F.lane); continue; } r -= NE * I_GU;
        { const int e = r / I_DN, q = r % I_DN, kb = q / 32, nb = q % 32;
            p0_transpose_item(F.in[I_WD] + (size_t)e * 1024 * 1024, 1024, 1024, wdn + (size_t)e * 1024 * 1024, 64 * kb, 32 * nb, 32 * nb, scr, F.lane); }
    }
}

__device__ __forceinline__ void p1_norm(Frame& F) {
    const float* tab = (const float*)(F.ws + WS_TAB); bf16* XN = (bf16*)(F.ws + WS_XN);
    const int gw = F.vcu * NWAVES + F.wave, NGW = F.G * NWAVES;
    const f32x4* gat = (const f32x4*)F.in[I_GATTN] + F.lane;
    for (int m = gw; m < MQ; m += NGW) {
        const int b = m < TT ? (m >> 13) : 4;
        const float* xrow = m < TT ? F.in[I_X] + (size_t)m * DM : F.in[I_CTX] + (size_t)(m - TT) * DM;
        const f32x4* xr = (const f32x4*)xrow + F.lane;
        const f32x4* sh = (const f32x4*)(tab + TB_MOD + b * 6144) + F.lane; const f32x4* sc = (const f32x4*)(tab + TB_MOD + b * 6144 + 1024) + F.lane;
        f32x4 v[4]; float s = 0.f;
#pragma unroll
        for (int j = 0; j < 4; ++j) { v[j] = xr[64 * j]; s += (v[j].x * v[j].x + v[j].y * v[j].y) + (v[j].z * v[j].z + v[j].w * v[j].w); }
        const float rstd = 1.0f / sqrtf(wave_sum(s) * (1.f / DM) + NORM_EPS);
        unsigned long long* o8 = (unsigned long long*)(XN + (size_t)m * DM) + F.lane;
#pragma unroll
        for (int j = 0; j < 4; ++j) { const f32x4 g = gat[64 * j], a = sc[64 * j], c = sh[64 * j];
            const f32x4 h = (v[j] * rstd) * g * (a + 1.0f) + c;
            o8[64 * j] = (unsigned long long)pk2(h.x, h.y) | ((unsigned long long)pk2(h.z, h.w) << 32); }
    }
    float* tw = (float*)(F.ws + WS_TAB);
    for (int i = (int)blockIdx.x * 512 + F.tid; i < 4 * 1024 * 32; i += F.G * 512) { const int b = i >> 15, k = (i >> 5) & 1023;
        tw[TB_WR + i] = F.in[I_GFFN][k] * (1.0f + tab[TB_MOD + b * 6144 + 4 * 1024 + k]) * F.in[I_WR][i & 32767]; }
    for (int t = gw; t < 128; t += NGW) { const int b = t >> 5, e = t & 31; float s = 0.f;
        for (int k = F.lane; k < 1024; k += 64) s += tab[TB_MOD + b * 6144 + 3 * 1024 + k] * F.in[I_WR][k * 32 + e];
        s = wave_sum(s); if (F.lane == 0) tw[TB_RC + t] = s + F.in[I_BR][e]; }
}

__device__ __forceinline__ void p3_qknorm(Frame& F) {
    const float* tab = (const float*)(F.ws + WS_TAB); bf16* P = (bf16*)(F.ws + WS_P);
    const int gw = F.vcu * NWAVES + F.wave, NGW = F.G * NWAVES;
    const int j = F.lane & 7;
    for (int task = gw; task < MQ * 4; task += NGW) {
        const int row = task >> 2, g = task & 3;
        const int colb = (g == 0) ? 0 : (g == 1) ? 512 : (g == 2) ? 1536 : 2048;
        const float* nw = ((g == 0) ? F.in[I_QND] : (g == 1) ? F.in[I_KND] : (g == 2) ? F.in[I_QNN] : F.in[I_KNN]) + 8 * j;
        bf16* p = P + (size_t)row * NQKV + colb + F.lane * 8;
        const v4u w = *(const v4u*)p;
        float v[8] = {bflo(w.x), bfhi(w.x), bflo(w.y), bfhi(w.y), bflo(w.z), bfhi(w.z), bflo(w.w), bfhi(w.w)};
        float ss = 0.f;
#pragma unroll
        for (int i = 0; i < 8; ++i) ss += v[i] * v[i];
        ss += __shfl_xor(ss, 1); ss += __shfl_xor(ss, 2); ss += __shfl_xor(ss, 4);
        const float rstd = 1.0f / sqrtf(ss * (1.f / 64.f) + NORM_EPS);
        const f32x4 n0 = *(const f32x4*)nw, n1 = *(const f32x4*)(nw + 4);
        v[0] *= rstd * n0.x; v[1] *= rstd * n0.y; v[2] *= rstd * n0.z; v[3] *= rstd * n0.w; v[4] *= rstd * n1.x; v[5] *= rstd * n1.y; v[6] *= rstd * n1.z; v[7] *= rstd * n1.w;
        if (g < 2 && row < TT) {
            const int s = row & (SEQ - 1), prow = s >> 6, pcol = s & 63, half = j >> 2, isx2 = (j >> 1) & 1;
            const float* ct = tab + (half ? TB_CCOS + pcol * 16 : TB_RCOS + prow * 16) + 8 * (j & 1);
            const float* st = tab + (half ? TB_CSIN + pcol * 16 : TB_RSIN + prow * 16) + 8 * (j & 1);
            const f32x4 c0 = *(const f32x4*)ct, c1 = *(const f32x4*)(ct + 4), s0 = *(const f32x4*)st, s1 = *(const f32x4*)(st + 4);
            const float cc[8] = {c0.x, c0.y, c0.z, c0.w, c1.x, c1.y, c1.z, c1.w}, sn[8] = {s0.x, s0.y, s0.z, s0.w, s1.x, s1.y, s1.z, s1.w};
#pragma unroll
            for (int i = 0; i < 8; ++i) { const float pr = __shfl_xor(v[i], 2); v[i] = isx2 ? (v[i] * cc[i] + pr * sn[i]) : (v[i] * cc[i] - pr * sn[i]); }
        }
        v4u o; o.x = pk2(v[0], v[1]); o.y = pk2(v[2], v[3]); o.z = pk2(v[4], v[5]); o.w = pk2(v[6], v[7]);
        *(v4u*)p = o;
    }
}

__device__ __forceinline__ void p4_attention(Frame& F, char* lds) {
    const bf16* P = (const bf16*)(F.ws + WS_P); bf16* OD = (bf16*)(F.ws + WS_OD); bf16* ON = (bf16*)(F.ws + WS_ON);
    for (int unit = F.vcu; unit < 1024; unit += F.G) {
        const int bhm = unit >> 5, qb = unit & 31, b = bhm >> 3, h = (bhm >> 1) & 3, m = bhm & 1;
        att::DiffPol pol; pol.Kg = P + 512 + h * 128 + m * 64; pol.Vg = P + 1024 + h * 128; pol.lat0 = (long)b * SEQ; pol.ctx0 = (long)TT + b * CTX;
        att::attn_unit<4, att::DiffPol>(P + ((size_t)b * SEQ + qb * 256) * NQKV + h * 128 + m * 64, pol, OD + ((size_t)b * SEQ + qb * 256) * 1024 + h * 256 + m * 128, 1024, 132, lds);
    }
    float* tabl = (float*)(lds + att::lds_bytes<4>());
    for (int unit = F.vcu; unit < 1024; unit += F.G) {
        const int bh = unit >> 5, rb = unit & 31, b = bh >> 3, hn = bh & 7, r = rb * 4;
        for (int i = F.tid; i < 15 * 31; i += 512) tabl[i] = F.in[I_RPB][hn * 465 + i] * 8.0f;
        att::NaPol pol; pol.Kg = P + 2048 + hn * 64; pol.Vg = P + 2560 + hn * 64; pol.lat0 = (long)b * SEQ; pol.ctx0 = (long)TT + b * CTX;
        pol.r = r; pol.rbase = (r - 4) < 0 ? 0 : ((r - 4) > 120 ? 120 : (r - 4)); pol.tab = tabl;
        att::attn_unit<2, att::NaPol>(P + ((size_t)b * SEQ + r * 64) * NQKV + 1536 + hn * 64, pol, ON + ((size_t)b * SEQ + r * 64) * 512 + hn * 64, 512, 16, lds);
    }
}

__device__ __forceinline__ void p5_mix(Frame& F) {
    const float* tab = (const float*)(F.ws + WS_TAB); const bf16* OD = (const bf16*)(F.ws + WS_OD); const bf16* ON = (const bf16*)(F.ws + WS_ON); bf16* MX = (bf16*)(F.ws + WS_MIX);
    const int gw = F.vcu * NWAVES + F.wave, NGW = F.G * NWAVES;
    const float lam = tab[TB_LAM];
    const int h = F.lane >> 4, e0 = (F.lane & 15) * 8;
    const f32x4 sl0 = *(const f32x4*)(F.in[I_SUBLN] + e0), sl1 = *(const f32x4*)(F.in[I_SUBLN] + e0 + 4);
    const f32x4 on0 = *(const f32x4*)(F.in[I_ONN] + F.lane * 8), on1 = *(const f32x4*)(F.in[I_ONN] + F.lane * 8 + 4);
    for (int t = gw; t < TT; t += NGW) {
        const v4u a = *(const v4u*)(OD + (size_t)t * 1024 + h * 256 + e0), c = *(const v4u*)(OD + (size_t)t * 1024 + h * 256 + 128 + e0);
        const v4u n = *(const v4u*)(ON + (size_t)t * 512 + F.lane * 8);
        float d[8] = {bflo(a.x) - lam * bflo(c.x), bfhi(a.x) - lam * bfhi(c.x), bflo(a.y) - lam * bflo(c.y), bfhi(a.y) - lam * bfhi(c.y),
                      bflo(a.z) - lam * bflo(c.z), bfhi(a.z) - lam * bfhi(c.z), bflo(a.w) - lam * bflo(c.w), bfhi(a.w) - lam * bfhi(c.w)};
        float ss = 0.f;
#pragma unroll
        for (int i = 0; i < 8; ++i) ss += d[i] * d[i];
        ss += __shfl_xor(ss, 1); ss += __shfl_xor(ss, 2); ss += __shfl_xor(ss, 4); ss += __shfl_xor(ss, 8);
        const float rs = 0.8f / sqrtf(ss * (1.f / 128.f) + NORM_EPS);
        v4u o; o.x = pk2(d[0] * rs * sl0.x, d[1] * rs * sl0.y); o.y = pk2(d[2] * rs * sl0.z, d[3] * rs * sl0.w); o.z = pk2(d[4] * rs * sl1.x, d[5] * rs * sl1.y); o.w = pk2(d[6] * rs * sl1.z, d[7] * rs * sl1.w);
        *(v4u*)(MX + (size_t)t * 1024 + h * 128 + e0) = o;
        float q[8] = {bflo(n.x), bfhi(n.x), bflo(n.y), bfhi(n.y), bflo(n.z), bfhi(n.z), bflo(n.w), bfhi(n.w)};
        float s2 = 0.f;
#pragma unroll
        for (int i = 0; i < 8; ++i) s2 += q[i] * q[i];
        s2 += __shfl_xor(s2, 1); s2 += __shfl_xor(s2, 2); s2 += __shfl_xor(s2, 4);
        const float r2 = 1.0f / sqrtf(s2 * (1.f / 64.f) + NORM_EPS);
        v4u o2; o2.x = pk2(q[0] * r2 * on0.x, q[1] * r2 * on0.y); o2.y = pk2(q[2] * r2 * on0.z, q[3] * r2 * on0.w); o2.z = pk2(q[4] * r2 * on1.x, q[5] * r2 * on1.y); o2.w = pk2(q[6] * r2 * on1.z, q[7] * r2 * on1.w);
        *(v4u*)(MX + (size_t)t * 1024 + 512 + F.lane * 8) = o2;
    }
}

__device__ __forceinline__ void p7_router(Frame& F) {
    const float* tab = (const float*)(F.ws + WS_TAB); unsigned* cnt = (unsigned*)(F.ws + WS_CTL) + CW_CNT;
    int* rt_e = (int*)(F.ws + WS_RT + RT_E); float* rt_g = (float*)(F.ws + WS_RT + RT_G); int* rt_pos = (int*)(F.ws + WS_RT + RT_POS);
    LAS unsigned* cntl = (LAS unsigned*)(F.lds + MISC_OFF); LAS unsigned* basel = cntl + 32;
    const int j = F.lane & 31, kh = F.lane >> 5;
    for (int tile = F.vcu; tile < TT / 128; tile += F.G) {
        if (F.tid < 32) cntl[F.tid] = 0u;
        __syncthreads();
        int te[4] = {0, 0, 0, 0}; float tg[4] = {0, 0, 0, 0}; unsigned lp[4] = {0, 0, 0, 0}; const int t = tile * 128 + 32 * F.wave + j;
        if (F.wave < 4) {
            const int b = t >> 13;
            const float* xr = F.out + (size_t)t * DM + 4 * kh;
            const float* wp = tab + TB_WR + (size_t)b * 32768 + (4 * kh) * 32 + j;
            f32x16 acc = f32x16{}; float ss = 0.f;
#pragma unroll 4
            for (int u = 0; u < 128; ++u) {
                const f32x4 xv = *(const f32x4*)(xr + 8 * u);
                const float w0 = wp[(8 * u + 0) * 32], w1 = wp[(8 * u + 1) * 32], w2 = wp[(8 * u + 2) * 32], w3 = wp[(8 * u + 3) * 32];
                ss += (xv.x * xv.x + xv.y * xv.y) + (xv.z * xv.z + xv.w * xv.w);
                acc = __builtin_amdgcn_mfma_f32_32x32x2f32(w0, xv.x, acc, 0, 0, 0);
                acc = __builtin_amdgcn_mfma_f32_32x32x2f32(w1, xv.y, acc, 0, 0, 0);
                acc = __builtin_amdgcn_mfma_f32_32x32x2f32(w2, xv.z, acc, 0, 0, 0);
                acc = __builtin_amdgcn_mfma_f32_32x32x2f32(w3, xv.w, acc, 0, 0, 0);
            }
            ss += __shfl_xor(ss, 32);
            const float rstd = 1.0f / sqrtf(ss * (1.f / DM) + NORM_EPS);
            float v[16];
#pragma unroll
            for (int r = 0; r < 16; ++r) v[r] = acc[r] * rstd + tab[TB_RC + b * 32 + att::crow(r, kh)];
            float cv[8]; int ce[8];
#pragma unroll
            for (int k = 0; k < 4; ++k) { float best = -INFINITY; int bi = 0;
#pragma unroll
                for (int r = 0; r < 16; ++r) if (v[r] > best) { best = v[r]; bi = r; }
#pragma unroll
                for (int r = 0; r < 16; ++r) if (r == bi) v[r] = -INFINITY;
                cv[k] = best; ce[k] = att::crow(bi, kh); }
#pragma unroll
            for (int k = 0; k < 4; ++k) { cv[4 + k] = __shfl_xor(cv[k], 32); ce[4 + k] = __shfl_xor(ce[k], 32); }
            float tv[4];
#pragma unroll
            for (int k = 0; k < 4; ++k) { float best = -INFINITY; int be = 1 << 30, bi = 0;
#pragma unroll
                for (int q = 0; q < 8; ++q) if (cv[q] > best || (cv[q] == best && ce[q] < be)) { best = cv[q]; be = ce[q]; bi = q; }
#pragma unroll
                for (int q = 0; q < 8; ++q) if (q == bi) cv[q] = -INFINITY;
                tv[k] = best; te[k] = be; }
            const float e1 = __expf(tv[1] - tv[0]), e2 = __expf(tv[2] - tv[0]), e3 = __expf(tv[3] - tv[0]); const float inv = 1.0f / (1.0f + e1 + e2 + e3);
            tg[0] = inv; tg[1] = e1 * inv; tg[2] = e2 * inv; tg[3] = e3 * inv;
            if (kh == 0) {
#pragma unroll
                for (int k = 0; k < 4; ++k) lp[k] = __hip_atomic_fetch_add(cntl + te[k], 1u, __ATOMIC_RELAXED, __HIP_MEMORY_SCOPE_WORKGROUP);
            }
        }
        __syncthreads();
        if (F.tid < 32) { const unsigned c = cntl[F.tid]; basel[F.tid] = c ? atomicAdd(cnt + F.tid, c) : 0u; }
        __syncthreads();
        if (F.wave < 4 && kh == 0) {
#pragma unroll
            for (int k = 0; k < 4; ++k) { rt_e[t * 4 + k] = te[k]; rt_g[t * 4 + k] = tg[k]; rt_pos[t * 4 + k] = (int)(basel[te[k]] + lp[k]); }
        }
        __syncthreads();
    }
}

__device__ __forceinline__ int pad_starts(const unsigned* cnt, int lane) {
    const int c = lane < 32 ? (int)__hip_atomic_load(cnt + lane, __ATOMIC_RELAXED, __HIP_MEMORY_SCOPE_AGENT) : 0;
    int p = (c + 255) & ~255, incl = p;
#pragma unroll
    for (int o = 1; o < 64; o <<= 1) { const int n = __shfl_up(incl, o); if (lane >= o) incl += n; }
    return incl - p;
}

__device__ __forceinline__ void p8_scatter(Frame& F) {
    const float* tab = (const float*)(F.ws + WS_TAB); const unsigned* cnt = (const unsigned*)(F.ws + WS_CTL) + CW_CNT;
    const int* rt_e = (const int*)(F.ws + WS_RT + RT_E); const int* rt_pos = (const int*)(F.ws + WS_RT + RT_POS); int* rt_slot = (int*)(F.ws + WS_RT + RT_SLOT);
    bf16* XG = (bf16*)(F.ws + WS_XG);
    const int gw = F.vcu * NWAVES + F.wave, NGW = F.G * NWAVES;
    const int pst = pad_starts(cnt, F.lane);
    const f32x4* gf = (const f32x4*)F.in[I_GFFN] + F.lane;
    for (int t = gw; t < TT; t += NGW) {
        const int b = t >> 13;
        const f32x4* xr = (const f32x4*)(F.out + (size_t)t * DM) + F.lane;
        const f32x4* sh = (const f32x4*)(tab + TB_MOD + b * 6144 + 3 * 1024) + F.lane; const f32x4* sc = (const f32x4*)(tab + TB_MOD + b * 6144 + 4 * 1024) + F.lane;
        f32x4 v[4]; float s = 0.f;
#pragma unroll
        for (int jj = 0; jj < 4; ++jj) { v[jj] = xr[64 * jj]; s += (v[jj].x * v[jj].x + v[jj].y * v[jj].y) + (v[jj].z * v[jj].z + v[jj].w * v[jj].w); }
        const float rstd = 1.0f / sqrtf(wave_sum(s) * (1.f / DM) + NORM_EPS);
        unsigned long long pk[4];
#pragma unroll
        for (int jj = 0; jj < 4; ++jj) { const f32x4 g = gf[64 * jj], a = sc[64 * jj], c = sh[64 * jj]; const f32x4 h = (v[jj] * rstd) * g * (a + 1.0f) + c;
            pk[jj] = (unsigned long long)pk2(h.x, h.y) | ((unsigned long long)pk2(h.z, h.w) << 32); }
        const int my_e = rt_e[t * 4 + (F.lane & 3)], my_pos = rt_pos[t * 4 + (F.lane & 3)];
#pragma unroll
        for (int k = 0; k < 4; ++k) { const int e = __shfl(my_e, k), pos = __shfl(my_pos, k); const int slot = __shfl(pst, e) + pos;
            unsigned long long* o8 = (unsigned long long*)(XG + (size_t)slot * DM) + F.lane;
#pragma unroll
            for (int jj = 0; jj < 4; ++jj) o8[64 * jj] = pk[jj];
            if (F.lane == 0) rt_slot[t * 4 + k] = slot; }
    }
}

__device__ __forceinline__ int moe_block_table(Frame& F, LAS int* bexp) {
    const unsigned* cnt = (const unsigned*)(F.ws + WS_CTL) + CW_CNT;
    const int pst = pad_starts(cnt, F.lane);
    const int total = __shfl(pst, 32) >> 8;
    if (F.wave == 0) {
        const int nxt = __shfl_down(pst, 1);
        if (F.lane < 32) for (int bl = pst >> 8; bl < (nxt >> 8); ++bl) bexp[bl] = F.lane;
    }
    __syncthreads();
    return __builtin_amdgcn_readfirstlane(total);
}

__device__ __forceinline__ void p11_combine(Frame& F) {
    const float* tab = (const float*)(F.ws + WS_TAB); const bf16* Y = (const bf16*)(F.ws + WS_Y);
    const float* rt_g = (const float*)(F.ws + WS_RT + RT_G); const int* rt_slot = (const int*)(F.ws + WS_RT + RT_SLOT);
    const int gw = F.vcu * NWAVES + F.wave, NGW = F.G * NWAVES;
    for (int t = gw; t < TT; t += NGW) {
        const int b = t >> 13;
        f32x4* xr = (f32x4*)(F.out + (size_t)t * DM) + F.lane;
        const f32x4* g2 = (const f32x4*)(tab + TB_MOD + b * 6144 + 5 * 1024) + F.lane;
        f32x4 acc[4];
#pragma unroll
        for (int jj = 0; jj < 4; ++jj) acc[jj] = (f32x4){0.f, 0.f, 0.f, 0.f};
        const int my_slot = rt_slot[t * 4 + (F.lane & 3)]; const float my_g = rt_g[t * 4 + (F.lane & 3)];
#pragma unroll
        for (int k = 0; k < 4; ++k) { const int slot = __shfl(my_slot, k); const float g = __shfl(my_g, k);
            const v2u* yr = (const v2u*)(Y + (size_t)slot * DM) + F.lane;
#pragma unroll
            for (int jj = 0; jj < 4; ++jj) { const v2u w = yr[64 * jj]; acc[jj] += (f32x4){bflo(w.x), bfhi(w.x), bflo(w.y), bfhi(w.y)} * g; } }
#pragma unroll
        for (int jj = 0; jj < 4; ++jj) xr[64 * jj] = xr[64 * jj] + g2[64 * jj] * acc[jj];
    }
}

#define XB_TMO      128
#define XB_XCNT(j)  (256  + 64 * (j))
#define XB_XSUB(j)  (1280 + 64 * (j))
#define XB_XGEN(j)  (2304 + 64 * (j))
#define XB_TOP      3328
#define XB_TOPGEN   3392
#define XCD_BAR_WORDS 3456
#define XB_SPIN_CAP (1u << 18)

__device__ __forceinline__ unsigned xb_ld(unsigned* p)              { return __hip_atomic_load(p, __ATOMIC_RELAXED, __HIP_MEMORY_SCOPE_AGENT); }
__device__ __forceinline__ unsigned xb_add(unsigned* p, unsigned v) { return __hip_atomic_fetch_add(p, v, __ATOMIC_RELAXED, __HIP_MEMORY_SCOPE_AGENT); }
__device__ __forceinline__ unsigned xb_xcc_id() { return (unsigned)__builtin_amdgcn_s_getreg((3 << 11) | 20) & 0xFu; }
#define XB_SPIN(cond, bar) do { unsigned _sp = 0; while (cond) { __builtin_amdgcn_s_sleep(1); \
    if ((++_sp & 255u) == 0u) { if (xb_ld(&(bar)[XB_TMO])) break; if (_sp > XB_SPIN_CAP) { atomicAdd(&(bar)[XB_TMO], 1u); break; } } } } while (0)

struct XcdBarrier {
    unsigned* bar; unsigned x;
    volatile LAS unsigned* st;
};

__device__ __forceinline__ XcdBarrier xcd_barrier_post(unsigned* bar, volatile LAS unsigned* st) {
    XcdBarrier b; b.bar = bar; b.x = xb_xcc_id(); b.st = st;
    if (threadIdx.x == 0) (void)xb_add(&bar[XB_XCNT(b.x)], 1u);
    return b;
}
__device__ __forceinline__ void xcd_barrier_complete(unsigned* bar, unsigned x, unsigned& nloc, unsigned& nx) {
    const unsigned G = gridDim.x * gridDim.y * gridDim.z;
    unsigned sum, cnt, mine, sp = 0u;
    for (;;) {
        sum = 0u; cnt = 0u; mine = 0u;
#pragma unroll
        for (unsigned j = 0; j < 16; ++j) { const unsigned c = xb_ld(&bar[XB_XCNT(j)]); sum += c; cnt += (c > 0u) ? 1u : 0u; mine = (j == x) ? c : mine; }
        if (sum == G) break;
        __builtin_amdgcn_s_sleep(1);
        if ((++sp & 255u) == 0u) { if (xb_ld(&bar[XB_TMO])) break; if (sp > XB_SPIN_CAP) { atomicAdd(&bar[XB_TMO], 1u); break; } }
    }
    nloc = mine > 0u ? mine : 1u; nx = cnt > 0u ? cnt : 1u;
}

__device__ __forceinline__ void xcd_barrier(const XcdBarrier& b) {
    asm volatile("s_waitcnt vmcnt(0)" ::: "memory");
    __syncthreads();
    if (threadIdx.x == 0) {
        unsigned* bar = b.bar;
        __builtin_amdgcn_s_waitcnt(0);
        unsigned nloc = b.st[0], nx = b.st[1];
        if (nloc == 0u) { xcd_barrier_complete(bar, b.x, nloc, nx); b.st[0] = nloc; b.st[1] = nx; }
        const unsigned old = xb_add(&bar[XB_XSUB(b.x)], 1u);
        const unsigned gen = old / nloc;
        if (old + 1u == (gen + 1u) * nloc) {
            __builtin_amdgcn_fence(__ATOMIC_RELEASE, "agent");
            asm volatile("s_waitcnt vmcnt(0)" ::: "memory");
            const unsigned og = xb_add(&bar[XB_TOP], 1u);
            const unsigned tg = og / nx;
            if (og + 1u == (tg + 1u) * nx) xb_add(&bar[XB_TOPGEN], 1u);
            else XB_SPIN(xb_ld(&bar[XB_TOPGEN]) == tg, bar);
            __builtin_amdgcn_fence(__ATOMIC_ACQUIRE, "agent");
            xb_add(&bar[XB_XGEN(b.x)], 1u);
            asm volatile("s_waitcnt vmcnt(0)" ::: "memory");
        } else {
            XB_SPIN(xb_ld(&bar[XB_XGEN(b.x)]) == gen, bar);
            __builtin_amdgcn_fence(__ATOMIC_ACQUIRE, "agent");
            asm volatile("s_waitcnt vmcnt(0)" ::: "memory");
        }
    }
    __syncthreads();
}

struct Args { const float* in[N_IN]; float* out; unsigned char* ws; int ph_lo, ph_hi; };
__global__ void __launch_bounds__(NWAVES * 64, 2) mk_fwd(Args args) {
    extern __shared__ __attribute__((aligned(16))) unsigned char lds[];
    Frame F;
    F.lds = (LAS unsigned char*)lds;
    F.tid = threadIdx.x; F.lane = F.tid & 63; F.wave = __builtin_amdgcn_readfirstlane(F.tid >> 6);
    F.G = gridDim.x; { const int bx = blockIdx.x; F.vcu = (F.G % 8 == 0) ? (bx % 8) * (F.G / 8) + bx / 8 : bx; }
#pragma unroll
    for (int i = 0; i < N_IN; ++i) F.in[i] = args.in[i];
    F.out = args.out; F.ws = args.ws;
    const int lo = args.ph_lo, hi = args.ph_hi;
    volatile LAS unsigned* bst = (volatile LAS unsigned*)(F.lds + MISC_OFF + 4096);
    if (F.tid < 2) bst[F.tid] = 0u;
    __syncthreads();
    XcdBarrier bar; bar.bar = (unsigned*)(F.ws + WS_CTL) + CW_BAR; bar.x = 0; bar.st = nullptr;
    if (hi - lo > 1) bar = xcd_barrier_post((unsigned*)(F.ws + WS_CTL) + CW_BAR, bst);
#define IN(k) (lo <= (k) && (k) < hi)
#define SEAM(k) do { if (IN(k) && IN((k) + 1)) { if ((k) == 0) cg::this_grid().sync(); else xcd_barrier(bar); } } while (0)
    if (IN(0)) { p0_prologue(F); } SEAM(0);
    if (IN(1)) { p1_norm(F); } SEAM(1);
    if (IN(2)) {
        pg8::Gemm g{(const bf16*)(F.ws + WS_XN), (const bf16*)(F.ws + WS_WQKV), MQ, NQKV, DM, 0};
        pg8::StaticOrder S; S.init(MQ, NQKV, F.G, (int)blockIdx.x);
        pg8::EpiBf16<0> E{(bf16*)(F.ws + WS_P), NQKV, nullptr, 0, 0, 1.f};
        pg8::gemm_phase<pg8::EpiBf16<0>, pg8::StaticOrder, true, true>(F.lds, g, S, E);
    } SEAM(2);
    if (IN(3)) { p3_qknorm(F); } SEAM(3);
    if (IN(4)) { p4_attention(F, (char*)lds); } SEAM(4);
    if (IN(5)) { p5_mix(F); } SEAM(5);
    if (IN(6)) {
        pg8::Gemm g{(const bf16*)(F.ws + WS_MIX), (const bf16*)(F.ws + WS_WO), TT, DM, DM, 0};
        pg8::StaticOrder S; S.init(TT, DM, F.G, (int)blockIdx.x);
        pg8::EpiOut E{F.in[I_X], F.out, (const float*)(F.ws + WS_TAB) + TB_MOD};
        pg8::gemm_phase<pg8::EpiOut, pg8::StaticOrder, true, true>(F.lds, g, S, E);
    } SEAM(6);
    if (IN(7)) { p7_router(F); } SEAM(7);
    if (IN(8)) { p8_scatter(F); } SEAM(8);
    if (IN(9)) {
        LAS int* bexp = (LAS int*)(F.lds + MISC_OFF + 1024);
        const int nblk = moe_block_table(F, bexp);
        pg8::Gemm g{(const bf16*)(F.ws + WS_XG), (const bf16*)(F.ws + WS_WGU), MPAD, 2048, DM, (size_t)2048 * 1024 * 2};
        pg8::MoeOrder S; S.init(nblk, 8, F.G, (int)blockIdx.x, bexp);
        pg8::EpiSwiGLU E{(bf16*)(F.ws + WS_ACT), F.in[I_BGU]};
        pg8::gemm_phase<pg8::EpiSwiGLU, pg8::MoeOrder, true, true>(F.lds, g, S, E);
    } SEAM(9);
    if (IN(10)) {
        LAS int* bexp = (LAS int*)(F.lds + MISC_OFF + 1024);
        const int nblk = moe_block_table(F, bexp);
        pg8::Gemm g{(const bf16*)(F.ws + WS_ACT), (const bf16*)(F.ws + WS_WDN), MPAD, 1024, DM, (size_t)1024 * 1024 * 2};
        pg8::MoeOrder S; S.init(nblk, 4, F.G, (int)blockIdx.x, bexp);
        pg8::EpiDown E{(bf16*)(F.ws + WS_Y), F.in[I_BD]};
        pg8::gemm_phase<pg8::EpiDown, pg8::MoeOrder, true, true>(F.lds, g, S, E);
    } SEAM(10);
    if (IN(11)) { p11_combine(F); }
#undef IN
#undef SEAM
}

extern "C" void kernel_launch(void* const* d_in, const int* in_sizes, int n_in, void* d_out, int out_size, void* d_ws, size_t ws_size, hipStream_t stream) {
    static int grid = 0;
    if (grid == 0) {
        if (n_in != N_IN || in_sizes[0] != TT * DM || out_size != TT * DM || ws_size < WS_END) { fprintf(stderr, "kernel_launch: unexpected shapes (n_in %d, in0 %d, out %d, ws %zu)\n", n_in, n_in > 0 ? in_sizes[0] : -1, out_size, ws_size); grid = -1; return; }
        int dev = 0, cus = 0, per_cu = 0;
        if (hipGetDevice(&dev) != hipSuccess || hipDeviceGetAttribute(&cus, hipDeviceAttributeMultiprocessorCount, dev) != hipSuccess) { grid = -1; return; }
        if (hipFuncSetAttribute((const void*)mk_fwd, hipFuncAttributeMaxDynamicSharedMemorySize, LDS_BYTES) != hipSuccess) { fprintf(stderr, "kernel_launch: hipFuncSetAttribute failed\n"); grid = -1; return; }
        if (hipOccupancyMaxActiveBlocksPerMultiprocessor(&per_cu, (const void*)mk_fwd, NWAVES * 64, LDS_BYTES) != hipSuccess || per_cu < 1) { fprintf(stderr, "kernel_launch: occupancy query reports %d\n", per_cu); (void)hipGetLastError(); per_cu = 1; }
        grid = cus;
    }
    if (grid < 0) return;
    (void)hipMemsetAsync((char*)d_ws + WS_CTL, 0, CTL_ZERO_BYTES, stream);
    Args a{};
    for (int i = 0; i < N_IN; ++i) a.in[i] = (const float*)d_in[i];
    a.out = (float*)d_out; a.ws = (unsigned char*)d_ws;
    if (MK_N_LAUNCHES == 1) {
        a.ph_lo = 0; a.ph_hi = N_PHASES;
        void* params[] = {&a};
        const hipError_t e = hipLaunchCooperativeKernel((const void*)mk_fwd, dim3(grid), dim3(NWAVES * 64), params, LDS_BYTES, stream);
        if (e != hipSuccess) fprintf(stderr, "kernel_launch: cooperative launch failed: %s (grid %d)\n", hipGetErrorString(e), grid);
    } else {
        for (int p = 0; p < N_PHASES; ++p) { a.ph_lo = p; a.ph_hi = p + 1; hipLaunchKernelGGL(mk_fwd, dim3(grid), dim3(NWAVES * 64), LDS_BYTES, stream, a); }
        const hipError_t le = hipPeekAtLastError();
        if (le != hipSuccess) fprintf(stderr, "kernel_launch: launch failed: %s\n", hipGetErrorName(le));
    }
}
```

```cpp
#include <hip/hip_runtime.h>
#include <hip/hip_cooperative_groups.h>
#include <cstdio>
#include <cstdint>
namespace cg = cooperative_groups;
namespace pg8 {
#define PG8_LAS __attribute__((address_space(3)))
typedef unsigned short bf16_t;
typedef short bf16x8 __attribute__((ext_vector_type(8)));
typedef float f32x4 __attribute__((ext_vector_type(4)));
typedef unsigned u32x4 __attribute__((ext_vector_type(4)));
constexpr int BM = 256, BK = 64, HALF = 128, HTB = HALF * BK * 2  , STAGE_BYTES = 8 * HTB, NXCD = 8, WGM = 8;

__host__ __device__ __forceinline__ int lds_byte(int r, int c) { const int st = (r >> 4) * 2 + (c >> 5), rr = r & 15, cc = c & 31, ob = rr * 64 + cc * 2; return st * 1024 + (ob ^ (((ob >> 9) & 1) << 5)); }
__host__ __device__ __forceinline__ void stage_rc(int b, int& R, int& C) { const int st = b / 1024, sb = b % 1024, swz = sb ^ (((sb >> 9) & 1) << 5); R = (st >> 1) * 16 + swz / 64; C = (st & 1) * 32 + (swz % 64) / 2; }
__host__ __device__ __forceinline__ int perm32(int rho) { const int n = rho >> 4, i = rho & 15; return 8 * (i >> 2) + 4 * n + (i & 3); }

struct Unit { int pm, pn, e; };
struct Gemm { const bf16_t* A; const bf16_t* Bt; int M, N, K; size_t estride; };

struct StaticOrder {
    int nM, nN, nwg, G, c;
    __host__ __device__ void init(int M, int N, int G_, int c_) { nM = M / BM; nN = N / BM; nwg = nM * nN; G = G_; c = c_; }
    __host__ __device__ bool next(int i, Unit& u) const {
        const long L = (long)i * G + c; if (L >= nwg) return false;
        int wgid = (int)L; { const int q = nwg / NXCD, r = nwg % NXCD, xcd = wgid % NXCD, off = wgid / NXCD; wgid = (xcd < r ? xcd * (q + 1) : r * (q + 1) + (xcd - r) * q) + off; }
        const int nig = WGM * nN, gid = wgid / nig, fm = gid * WGM, gsz = (nM - fm) < WGM ? (nM - fm) : WGM;
        u.pm = fm + ((wgid % nig) % gsz); u.pn = (wgid % nig) / gsz; u.e = 0; return true;
    }
    __device__ __forceinline__ void a_ready(const Unit&) const {}
    __device__ __forceinline__ void done(const Unit&) const {}
};

__device__ __forceinline__ unsigned cvt_pk_bf16(float lo, float hi) { unsigned r; asm volatile("v_cvt_pk_bf16_f32 %0, %1, %2" : "=v"(r) : "v"(lo), "v"(hi)); return r; }
typedef float f32x2 __attribute__((ext_vector_type(2)));
__device__ __forceinline__ f32x2 gelu_pk(f32x2 v) {
    const f32x2 av = __builtin_elementwise_abs(v), d = av * 0.2316418882f + 1.0f;
    f32x2 t; t.x = __builtin_amdgcn_rcpf(d.x); t.y = __builtin_amdgcn_rcpf(d.y);
    f32x2 q = t * 0.5307027145f + (-0.7265760135f); q = q * t + 0.7107068705f; q = q * t + (-0.142248368f); q = q * t + 0.127414796f; q = q * t;
    const f32x2 s = (v * v) * (-0.72134752044f);
    f32x2 e; e.x = __builtin_amdgcn_exp2f(s.x); e.y = __builtin_amdgcn_exp2f(s.y);
    const f32x2 m = v * (q * e), r = v - m;
    f32x2 o; o.x = v.x < 0.f ? m.x : r.x; o.y = v.y < 0.f ? m.y : r.y; return o;
}

template <int ACT  > struct EpiBf16 {
    static constexpr bool PERM = true, AFTER_DRAIN = false; static_assert(ACT == 0 || ACT == 1, "EpiBf16: ACT is 0 (none) or 1 (gelu_pk)");
    bf16_t* O; int ldc; const float* bias; int split_cols; size_t split_stride; float scale0;
    __device__ __forceinline__ void operator()(const f32x4 (&acc)[2][2][4][2], const Unit& u, int wr, int wc, int fr, int fq) const {
        const int row0 = u.pm * BM + wr * 64 + fr; int colt = u.pn * BM; bf16_t* base = O;
        float sc = 1.f; if (split_cols) { const int t = colt / split_cols; base += (size_t)t * split_stride; colt -= t * split_cols; if (t == 0) sc = scale0; }
        const int col0 = colt + wc * 32 + 8 * fq, bcol0 = u.pn * BM + wc * 32 + 8 * fq;
        f32x4 bv[2][2];
#pragma unroll
        for (int bj = 0; bj < 2; ++bj)
#pragma unroll
            for (int n = 0; n < 2; ++n) bv[bj][n] = bias ? *(const f32x4*)(bias + bcol0 + bj * HALF + 4 * n) : (f32x4){0.f, 0.f, 0.f, 0.f};
#pragma unroll
        for (int ai = 0; ai < 2; ++ai)
#pragma unroll
            for (int m = 0; m < 4; ++m) { bf16_t* rowp = base + (size_t)(row0 + ai * HALF + m * 16) * ldc + col0;
#pragma unroll
                for (int bj = 0; bj < 2; ++bj) { f32x4 v0 = acc[ai][bj][m][0] + bv[bj][0], v1 = acc[ai][bj][m][1] + bv[bj][1];
                    if (ACT == 1) { f32x2 a = gelu_pk((f32x2){v0[0], v0[1]}), b = gelu_pk((f32x2){v0[2], v0[3]}), c = gelu_pk((f32x2){v1[0], v1[1]}), d = gelu_pk((f32x2){v1[2], v1[3]});
                        v0 = (f32x4){a.x, a.y, b.x, b.y}; v1 = (f32x4){c.x, c.y, d.x, d.y}; }
                    v0 = v0 * sc; v1 = v1 * sc; u32x4 w; w.x = cvt_pk_bf16(v0[0], v0[1]); w.y = cvt_pk_bf16(v0[2], v0[3]); w.z = cvt_pk_bf16(v1[0], v1[1]); w.w = cvt_pk_bf16(v1[2], v1[3]);
                    *(u32x4*)(rowp + bj * HALF) = w; } }
    }
};

template <class Epi, class Sched, bool ALIGN_EPI = false, bool SP2 = false>
__device__ __forceinline__ void gemm_phase(PG8_LAS unsigned char* lds, const Gemm g, const Sched& S, const Epi& E) {
    const int tid = threadIdx.x, wid = __builtin_amdgcn_readfirstlane(tid >> 6), lane = tid & 63, wr = wid >> 2, wc = wid & 3, fr = lane & 15, fq = lane >> 4;
    const int K = g.K, nt = K / BK;
    unsigned voffA[2], voffB[2];
#pragma unroll
    for (int i = 0; i < 2; ++i) { int R, C; stage_rc(tid * 16 + i * 8192, R, C); const int Rb = Epi::PERM ? ((R & ~31) + perm32(R & 31)) : R;
        voffA[i] = (unsigned)(R * K + C) * 2u; voffB[i] = (unsigned)(Rb * K + C) * 2u; }
    const size_t kstep = (size_t)(BK * 2);
    const size_t hstep = (size_t)HALF * K * 2;
    const size_t tstep = 2 * hstep;
    const unsigned ldsw = (unsigned)wid * 1024u;
    const int aoff = lds_byte(wr * 64 + fr, fq * 8), boff = lds_byte(wc * 32 + fr, fq * 8);
#define PG8_SA(b, h) (((b) * 2 + (h)) * HTB)
#define PG8_SB(b, h) ((4 + (b) * 2 + (h)) * HTB)
#define PG8_STAGE(bufoff, gbase, voff) do { _Pragma("unroll") for (int _i = 0; _i < 2; ++_i) \
        __builtin_amdgcn_global_load_lds((const unsigned*)((const char*)(gbase) + (voff)[_i]), (PG8_LAS unsigned*)(lds + (bufoff) + ldsw + _i * 8192), 16, 0, 0); } while (0)
#define PG8_LDA(dst, b, h) do { _Pragma("unroll") for (int m = 0; m < 4; ++m) _Pragma("unroll") for (int k = 0; k < 2; ++k) dst[m][k] = *(const PG8_LAS bf16x8*)(lds + PG8_SA(b, h) + aoff + m * 2048 + k * 1024); } while (0)
#define PG8_LDB(dst, b, h) do { _Pragma("unroll") for (int n = 0; n < 2; ++n) _Pragma("unroll") for (int k = 0; k < 2; ++k) dst[n][k] = *(const PG8_LAS bf16x8*)(lds + PG8_SB(b, h) + boff + n * 2048 + k * 1024); } while (0)
#define PG8_MMA(ai, bj, At, Bt) do { __builtin_amdgcn_s_setprio(1); _Pragma("unroll") for (int m = 0; m < 4; ++m) _Pragma("unroll") for (int n = 0; n < 2; ++n) _Pragma("unroll") for (int k = 0; k < 2; ++k) \
        acc[ai][bj][m][n] = __builtin_amdgcn_mfma_f32_16x16x32_bf16(Bt[n][k], At[m][k], acc[ai][bj][m][n], 0, 0, 0); __builtin_amdgcn_s_setprio(0); } while (0)
#define PG8_WAIT_V(n) asm volatile("s_waitcnt vmcnt(" #n ")" ::: "memory")
#define PG8_WAIT_L(n) asm volatile("s_waitcnt lgkmcnt(" #n ")" ::: "memory")
#define PG8_BAR __builtin_amdgcn_s_barrier()
#define PG8_SCHED __builtin_amdgcn_sched_barrier(0)
    Unit cur, nxt; int ui = 0;
    if (!S.next(0, cur)) return;
    f32x4 acc[2][2][4][2];
#pragma unroll
    for (int a = 0; a < 2; ++a)
#pragma unroll
        for (int b = 0; b < 2; ++b)
#pragma unroll
            for (int m = 0; m < 4; ++m)
#pragma unroll
                for (int n = 0; n < 2; ++n) acc[a][b][m][n] = (f32x4){0.f, 0.f, 0.f, 0.f};
    bf16x8 At[4][2], B0[2][2], B1[2][2];
    const char* cA = (const char*)g.A + (size_t)cur.pm * tstep; const char* cB = (const char*)g.Bt + (size_t)cur.e * g.estride + (size_t)cur.pn * tstep;
    S.a_ready(cur);
    if constexpr (SP2) {
        PG8_STAGE(PG8_SB(0, 0), cB, voffB); PG8_STAGE(PG8_SB(0, 1), cB + hstep, voffB); PG8_STAGE(PG8_SA(0, 0), cA, voffA); PG8_STAGE(PG8_SA(0, 1), cA + hstep, voffA);
        if (wr == 1) PG8_BAR;
        PG8_WAIT_V(2); PG8_BAR;
        PG8_STAGE(PG8_SB(1, 0), cB + kstep, voffB); PG8_STAGE(PG8_SA(1, 0), cA + kstep, voffA); PG8_STAGE(PG8_SB(1, 1), cB + hstep + kstep, voffB);
        PG8_WAIT_V(6); PG8_BAR;
    } else {
        PG8_STAGE(PG8_SB(0, 0), cB, voffB); PG8_STAGE(PG8_SA(0, 0), cA, voffA); PG8_STAGE(PG8_SB(0, 1), cB + hstep, voffB); PG8_STAGE(PG8_SA(0, 1), cA + hstep, voffA);
        if (wr == 1) PG8_BAR;
        PG8_WAIT_V(4); PG8_BAR;
        PG8_STAGE(PG8_SB(1, 0), cB + kstep, voffB); PG8_STAGE(PG8_SA(1, 0), cA + kstep, voffA); PG8_STAGE(PG8_SB(1, 1), cB + hstep + kstep, voffB);
        PG8_WAIT_V(6); PG8_BAR;
    }
    for (;;) {
        const bool has_next = S.next(ui + 1, nxt);
        const char* nA = has_next ? (const char*)g.A + (size_t)nxt.pm * tstep : cA; const char* nB = has_next ? (const char*)g.Bt + (size_t)nxt.e * g.estride + (size_t)nxt.pn * tstep : cB;
        for (int t = 0; t < nt; t += 2) {
            const bool last = (t == nt - 2);
            const char* a1 = cA + (size_t)(t + 1) * kstep;
            const char* a2 = last ? nA : cA + (size_t)(t + 2) * kstep; const char* b2 = last ? nB : cB + (size_t)(t + 2) * kstep;
            const char* a3 = a2 + kstep; const char* b3 = b2 + kstep;
            if (last && has_next) S.a_ready(nxt);
            if constexpr (SP2) {
            PG8_LDB(B0, 0, 0); PG8_LDB(B1, 0, 1); PG8_SCHED; PG8_LDA(At, 0, 0); PG8_STAGE(PG8_SA(1, 1), a1 + hstep, voffA);
            PG8_WAIT_V(8); PG8_WAIT_L(0); PG8_BAR; PG8_MMA(0, 0, At, B0); PG8_MMA(0, 1, At, B1); PG8_BAR; PG8_SCHED;
            PG8_LDA(At, 0, 1); PG8_STAGE(PG8_SB(0, 0), b2, voffB); PG8_STAGE(PG8_SB(0, 1), b2 + hstep, voffB); PG8_STAGE(PG8_SA(0, 0), a2, voffA);
            PG8_WAIT_V(8); PG8_WAIT_L(0); PG8_BAR; PG8_MMA(1, 0, At, B0); PG8_MMA(1, 1, At, B1); PG8_BAR; PG8_SCHED;
            PG8_LDB(B0, 1, 0); PG8_LDB(B1, 1, 1); PG8_SCHED; PG8_LDA(At, 1, 0); PG8_STAGE(PG8_SA(0, 1), a2 + hstep, voffA);
            PG8_WAIT_V(8); PG8_WAIT_L(0); PG8_BAR; PG8_MMA(0, 0, At, B0); PG8_MMA(0, 1, At, B1); PG8_BAR; PG8_SCHED;
            PG8_LDA(At, 1, 1); PG8_STAGE(PG8_SB(1, 0), b3, voffB); PG8_STAGE(PG8_SB(1, 1), b3 + hstep, voffB); PG8_STAGE(PG8_SA(1, 0), a3, voffA);
            PG8_WAIT_V(8); PG8_WAIT_L(0); PG8_BAR; PG8_MMA(1, 0, At, B0); PG8_MMA(1, 1, At, B1); PG8_BAR; PG8_SCHED;
            } else {
            PG8_LDB(B0, 0, 0); PG8_SCHED; PG8_LDA(At, 0, 0); PG8_STAGE(PG8_SA(1, 1), a1 + hstep, voffA);
            PG8_WAIT_L(8); PG8_BAR; PG8_WAIT_L(0); PG8_MMA(0, 0, At, B0); PG8_BAR; PG8_SCHED;
            PG8_LDB(B1, 0, 1); PG8_STAGE(PG8_SB(0, 0), b2, voffB);
            PG8_BAR; PG8_WAIT_L(0); PG8_MMA(0, 1, At, B1); PG8_BAR;
            PG8_LDA(At, 0, 1); PG8_STAGE(PG8_SA(0, 0), a2, voffA);
            PG8_BAR; PG8_WAIT_L(0); PG8_MMA(1, 0, At, B0); PG8_BAR; PG8_SCHED;
            PG8_STAGE(PG8_SB(0, 1), b2 + hstep, voffB);
            PG8_WAIT_V(6); PG8_BAR; PG8_MMA(1, 1, At, B1); PG8_BAR;
            PG8_LDB(B0, 1, 0); PG8_SCHED; PG8_LDA(At, 1, 0); PG8_STAGE(PG8_SA(0, 1), a2 + hstep, voffA);
            PG8_WAIT_L(8); PG8_BAR; PG8_WAIT_L(0); PG8_MMA(0, 0, At, B0); PG8_BAR; PG8_SCHED;
            PG8_LDB(B1, 1, 1); PG8_STAGE(PG8_SB(1, 0), b3, voffB);
            PG8_BAR; PG8_WAIT_L(0); PG8_MMA(0, 1, At, B1); PG8_BAR;
            PG8_LDA(At, 1, 1); PG8_STAGE(PG8_SA(1, 0), a3, voffA);
            PG8_BAR; PG8_WAIT_L(0); PG8_MMA(1, 0, At, B0); PG8_BAR; PG8_SCHED;
            PG8_STAGE(PG8_SB(1, 1), b3 + hstep, voffB);
            PG8_WAIT_V(6); PG8_BAR; PG8_MMA(1, 1, At, B1); PG8_BAR;
            }
        }
        if constexpr (ALIGN_EPI) { if (wr == 0) PG8_BAR; }
        if constexpr (!Epi::AFTER_DRAIN) { E(acc, cur, wr, wc, fr, fq); S.done(cur); }
        if (!has_next) break;
#pragma unroll
        for (int a = 0; a < 2; ++a)
#pragma unroll
            for (int b = 0; b < 2; ++b)
#pragma unroll
                for (int m = 0; m < 4; ++m)
#pragma unroll
                    for (int n = 0; n < 2; ++n) acc[a][b][m][n] = (f32x4){0.f, 0.f, 0.f, 0.f};
        cur = nxt; cA = nA; cB = nB; ++ui;
        if constexpr (ALIGN_EPI) { if (wr == 1) PG8_BAR; }
    }
    PG8_WAIT_V(0);
    if constexpr (!ALIGN_EPI) { if (wr == 0) PG8_BAR; }
    PG8_BAR;
    if constexpr (Epi::AFTER_DRAIN) { E.fused(acc, cur, wr, wc, fr, fq, lds, wid, lane); S.done(cur); }
#undef PG8_SA
#undef PG8_SB
#undef PG8_STAGE
#undef PG8_LDA
#undef PG8_LDB
#undef PG8_MMA
#undef PG8_WAIT_V
#undef PG8_WAIT_L
#undef PG8_BAR
#undef PG8_SCHED
}
}

namespace pg8 {
struct MoeOrder {
    int nM, nN, nwg, G, c; const PG8_LAS int* bexp;
    __device__ __forceinline__ void init(int nM_, int nN_, int G_, int c_, const PG8_LAS int* bexp_) { nM = nM_; nN = nN_; nwg = nM_ * nN_; G = G_; c = c_; bexp = bexp_; }
    __device__ __forceinline__ bool next(int i, Unit& u) const {
        const long L = (long)i * G + c; if (L >= nwg) return false;
        int wgid = (int)L; { const int q = nwg / NXCD, r = nwg % NXCD, xcd = wgid % NXCD, off = wgid / NXCD; wgid = (xcd < r ? xcd * (q + 1) : r * (q + 1) + (xcd - r) * q) + off; }
        const int nig = WGM * nN, gid = wgid / nig, fm = gid * WGM, gsz = (nM - fm) < WGM ? (nM - fm) : WGM;
        u.pm = fm + ((wgid % nig) % gsz); u.pn = (wgid % nig) / gsz; u.e = __builtin_amdgcn_readfirstlane(bexp[u.pm]); return true;
    }
    __device__ __forceinline__ void a_ready(const Unit&) const {}
    __device__ __forceinline__ void done(const Unit&) const {}
};
struct EpiOut {
    static constexpr bool PERM = false, AFTER_DRAIN = false;
    const float* x; float* out; const float* mod;
    __device__ __forceinline__ void operator()(const f32x4 (&acc)[2][2][4][2], const Unit& u, int wr, int wc, int fr, int fq) const {
        const int row0 = u.pm * BM + wr * 64 + fr, col0 = u.pn * BM + wc * 32 + 4 * fq;
        const float* g = mod + (size_t)(u.pm >> 5) * 6144 + 2 * 1024;
        f32x4 gv[2][2];
#pragma unroll
        for (int bj = 0; bj < 2; ++bj)
#pragma unroll
            for (int n = 0; n < 2; ++n) gv[bj][n] = *(const f32x4*)(g + col0 + bj * HALF + n * 16);
#pragma unroll
        for (int ai = 0; ai < 2; ++ai)
#pragma unroll
            for (int m = 0; m < 4; ++m) { const size_t off = (size_t)(row0 + ai * HALF + m * 16) * 1024 + col0;
#pragma unroll
                for (int bj = 0; bj < 2; ++bj)
#pragma unroll
                    for (int n = 0; n < 2; ++n) { const f32x4 xv = *(const f32x4*)(x + off + bj * HALF + n * 16); *(f32x4*)(out + off + bj * HALF + n * 16) = xv + gv[bj][n] * acc[ai][bj][m][n]; } }
    }
};
__device__ __forceinline__ float swiglu1(float g, float l) {
    const float glu = fminf(g, 7.0f), lin = fminf(fmaxf(l, -7.0f), 7.0f);
    const float sg = __builtin_amdgcn_rcpf(1.0f + __builtin_amdgcn_exp2f(glu * (-1.702f * 1.4426950408889634f)));
    return glu * sg * (lin + 1.0f);
}
struct EpiSwiGLU {
    static constexpr bool PERM = true, AFTER_DRAIN = false;
    bf16_t* act; const float* bgu;
    __device__ __forceinline__ void operator()(const f32x4 (&acc)[2][2][4][2], const Unit& u, int wr, int wc, int fr, int fq) const {
        const int row0 = u.pm * BM + wr * 64 + fr, cg = u.pn * 128 + wc * 32 + 8 * fq;
        const float* bb = bgu + (size_t)u.e * 2048;
        f32x4 bg[2], bl[2];
#pragma unroll
        for (int n = 0; n < 2; ++n) { bg[n] = *(const f32x4*)(bb + cg + 4 * n); bl[n] = *(const f32x4*)(bb + 1024 + cg + 4 * n); }
#pragma unroll
        for (int ai = 0; ai < 2; ++ai)
#pragma unroll
            for (int m = 0; m < 4; ++m) { bf16_t* rowp = act + (size_t)(row0 + ai * HALF + m * 16) * 1024 + cg;
                const f32x4 g0 = acc[ai][0][m][0] + bg[0], g1 = acc[ai][0][m][1] + bg[1], l0 = acc[ai][1][m][0] + bl[0], l1 = acc[ai][1][m][1] + bl[1];
                u32x4 w; w.x = cvt_pk_bf16(swiglu1(g0[0], l0[0]), swiglu1(g0[1], l0[1])); w.y = cvt_pk_bf16(swiglu1(g0[2], l0[2]), swiglu1(g0[3], l0[3]));
                w.z = cvt_pk_bf16(swiglu1(g1[0], l1[0]), swiglu1(g1[1], l1[1])); w.w = cvt_pk_bf16(swiglu1(g1[2], l1[2]), swiglu1(g1[3], l1[3]));
                *(u32x4*)rowp = w; }
    }
};
struct EpiDown {
    static constexpr bool PERM = true, AFTER_DRAIN = false;
    bf16_t* y; const float* bd;
    __device__ __forceinline__ void operator()(const f32x4 (&acc)[2][2][4][2], const Unit& u, int wr, int wc, int fr, int fq) const {
        const int row0 = u.pm * BM + wr * 64 + fr, col0 = u.pn * BM + wc * 32 + 8 * fq;
        const float* bb = bd + (size_t)u.e * 1024 + col0;
        f32x4 bv[2][2];
#pragma unroll
        for (int bj = 0; bj < 2; ++bj)
#pragma unroll
            for (int n = 0; n < 2; ++n) bv[bj][n] = *(const f32x4*)(bb + bj * HALF + 4 * n);
#pragma unroll
        for (int ai = 0; ai < 2; ++ai)
#pragma unroll
            for (int m = 0; m < 4; ++m) { bf16_t* rowp = y + (size_t)(row0 + ai * HALF + m * 16) * 1024 + col0;
#pragma unroll
                for (int bj = 0; bj < 2; ++bj) { const f32x4 v0 = acc[ai][bj][m][0] + bv[bj][0], v1 = acc[ai][bj][m][1] + bv[bj][1];
                    u32x4 w; w.x = cvt_pk_bf16(v0[0], v0[1]); w.y = cvt_pk_bf16(v0[2], v0[3]); w.z = cvt_pk_bf16(v1[0], v1[1]); w.w = cvt_pk_bf16(v1[2], v1[3]);
                    *(u32x4*)(rowp + bj * HALF) = w; } }
    }
};
}

namespace att {
typedef unsigned short bf16_t;
using bf16x8 = __attribute__((ext_vector_type(8))) short;
using s16x4  = __attribute__((ext_vector_type(4))) short;
using f32x16 = __attribute__((ext_vector_type(16))) float;
using u32x4  = __attribute__((ext_vector_type(4))) unsigned;
constexpr int NW = 8, QBLK = 32, KVBLK = 64, LD = 3072;
constexpr float SCALE = 0.125f, C2 = 0.125f * 1.4426950408889634f;
#define KSWZ64(row, colB) ((row) * 128 + ((colB) ^ ((((row) >> 1) & 7) << 4)))
#define ASBAR() __builtin_amdgcn_sched_barrier(0)
__device__ __forceinline__ int crow(int r, int hi) { return (r & 3) + 8 * (r >> 2) + 4 * hi; }
__device__ __forceinline__ unsigned cvtpk(float lo, float hi) { unsigned r; asm volatile("v_cvt_pk_bf16_f32 %0, %1, %2" : "=v"(r) : "v"(lo), "v"(hi)); return r; }
__device__ __forceinline__ bf16x8 ld8(const bf16_t* p) { return *reinterpret_cast<const bf16x8*>(p); }
__device__ __forceinline__ void glds16(const void* gsrc, unsigned lds_dst) { unsigned keep;
  asm volatile("s_mov_b32 %0, m0\n\ts_mov_b32 m0, %2\n\ts_nop 0\n\tglobal_load_lds_dwordx4 %1, off\n\ts_mov_b32 m0, %0" : "=&s"(keep) : "v"(gsrc), "s"(lds_dst) : "memory"); }

__device__ __forceinline__ void exp16(f32x16& p, float mref) {
#pragma unroll
  for (int r = 0; r < 16; ++r) p[r] = __builtin_amdgcn_exp2f(p[r] - mref);
}
__device__ __forceinline__ void finishSM(f32x16& p0, f32x16& p1, float mref, float& l_reg, bf16x8& pa0, bf16x8& pa1, bf16x8& pa2, bf16x8& pa3) {
  exp16(p1, mref);
  float ps = 0;
#pragma unroll
  for (int r = 0; r < 16; ++r) ps += p0[r];
#pragma unroll
  for (int r = 0; r < 16; ++r) ps += p1[r];
  l_reg += ps;
#define PK4(P, BASE, OUT) do { u32x4 w = {cvtpk(P[BASE + 0], P[BASE + 1]), cvtpk(P[BASE + 2], P[BASE + 3]), cvtpk(P[BASE + 4], P[BASE + 5]), cvtpk(P[BASE + 6], P[BASE + 7])}; OUT = *reinterpret_cast<bf16x8*>(&w); } while (0)
  PK4(p0, 0, pa0); PK4(p0, 8, pa1); PK4(p1, 0, pa2); PK4(p1, 8, pa3);
#undef PK4
}
__device__ __forceinline__ void qkt(f32x16& p0, f32x16& p1, const char* Ks, const bf16x8* qr, int r32, int hi) {
#pragma unroll
  for (int d0 = 0; d0 < 4; ++d0) { const int cb = (d0 * 16 + hi * 8) * 2;
    const bf16x8 b0 = *reinterpret_cast<const bf16x8*>(Ks + KSWZ64(r32, cb));
    const bf16x8 b1 = *reinterpret_cast<const bf16x8*>(Ks + KSWZ64(32 + r32, cb));
    if (d0 == 0) { p0 = __builtin_amdgcn_mfma_f32_32x32x16_bf16(b0, qr[0], f32x16{}, 0, 0, 0); p1 = __builtin_amdgcn_mfma_f32_32x32x16_bf16(b1, qr[0], f32x16{}, 0, 0, 0); }
    else { p0 = __builtin_amdgcn_mfma_f32_32x32x16_bf16(b0, qr[d0], p0, 0, 0, 0); p1 = __builtin_amdgcn_mfma_f32_32x32x16_bf16(b1, qr[d0], p1, 0, 0, 0); } }
}
template <int NVB> __device__ __forceinline__ int v_st(int k, int c) { const int kk = k; return ((kk >> 3) * NVB + (c >> 5)) * 512 + ((kk & 7) * 32 + (c & 31)) * 2; }
__device__ __forceinline__ int v_rd_base(int lane) { return ((lane & 3) << 3) | (((lane >> 2) & 3) << 6) | (((lane >> 4) & 1) << 5) | (((lane >> 5) & 1) << 8); }
template <int NVB> constexpr int v_rd_off(int d0, int ks, int half) { return d0 * 512 + ks * (NVB * 1024) + half * (NVB * 512); }
template <int OFF> __device__ __forceinline__ s16x4 tr_read(int vb) {
  s16x4 r; asm volatile("ds_read_b64_tr_b16 %0, %1 offset:%2" : "=&v"(r) : "v"(vb), "i"(OFF) : "memory"); return r;
}
template <int NVB, int D0> __device__ __forceinline__ void pv_one(f32x16& od, int vb, bf16x8 pa0, bf16x8 pa1, bf16x8 pa2, bf16x8 pa3) {
  const s16x4 l0 = tr_read<v_rd_off<NVB>(D0, 0, 0)>(vb), h0 = tr_read<v_rd_off<NVB>(D0, 0, 1)>(vb), l1 = tr_read<v_rd_off<NVB>(D0, 1, 0)>(vb), h1 = tr_read<v_rd_off<NVB>(D0, 1, 1)>(vb);
  const s16x4 l2 = tr_read<v_rd_off<NVB>(D0, 2, 0)>(vb), h2 = tr_read<v_rd_off<NVB>(D0, 2, 1)>(vb), l3 = tr_read<v_rd_off<NVB>(D0, 3, 0)>(vb), h3 = tr_read<v_rd_off<NVB>(D0, 3, 1)>(vb);
  asm volatile("s_waitcnt lgkmcnt(0)" ::: "memory"); ASBAR();
#define PK(L, H) (bf16x8){L[0], L[1], L[2], L[3], H[0], H[1], H[2], H[3]}
  od = __builtin_amdgcn_mfma_f32_32x32x16_bf16(pa0, PK(l0, h0), od, 0, 0, 0);
  od = __builtin_amdgcn_mfma_f32_32x32x16_bf16(pa1, PK(l1, h1), od, 0, 0, 0);
  od = __builtin_amdgcn_mfma_f32_32x32x16_bf16(pa2, PK(l2, h2), od, 0, 0, 0);
  od = __builtin_amdgcn_mfma_f32_32x32x16_bf16(pa3, PK(l3, h3), od, 0, 0, 0);
#undef PK
}
template <int NVB> __device__ __forceinline__ void pv_all(f32x16* o, int vb, bf16x8 pa0, bf16x8 pa1, bf16x8 pa2, bf16x8 pa3) {
  pv_one<NVB, 0>(o[0], vb, pa0, pa1, pa2, pa3); pv_one<NVB, 1>(o[1], vb, pa0, pa1, pa2, pa3);
  if constexpr (NVB == 4) { pv_one<NVB, 2>(o[2], vb, pa0, pa1, pa2, pa3); pv_one<NVB, 3>(o[3], vb, pa0, pa1, pa2, pa3); }
}
struct DiffPol {
  const bf16_t* Kg; const bf16_t* Vg; long lat0, ctx0;
  __device__ __forceinline__ long krow(int t) const { return t < 128 ? lat0 + 64L * t : ctx0 + 64L * (t - 128); }
  __device__ __forceinline__ void mod(f32x16&, f32x16&, int, int, int, int) const {}
};
struct NaPol {
  const bf16_t* Kg; const bf16_t* Vg; long lat0, ctx0; int rbase, r; const float* tab;
  __device__ __forceinline__ long krow(int t) const { if (t < 12) { int kr = rbase + t; kr = kr > 127 ? 127 : kr; return lat0 + 64L * kr; } return ctx0 + 64L * (t - 12); }
  __device__ __forceinline__ void mod(f32x16& p0, f32x16& p1, int t, int wid, int r32, int hi) const {
    if (t >= 12) return;
    const float NEG = -INFINITY;
    const int kr = rbase + t, rq = r + (wid >> 1), c = 32 * (wid & 1) + r32;
    int r0q = rq - 4; r0q = r0q < 0 ? 0 : (r0q > 120 ? 120 : r0q);
    if (!((kr >= r0q) && (kr < r0q + 8))) {
#pragma unroll
      for (int i = 0; i < 16; ++i) { p0[i] = NEG; p1[i] = NEG; }
      return; }
    int c0 = c - 8; c0 = c0 < 0 ? 0 : (c0 > 48 ? 48 : c0);
    int d = 4 * hi - c0, off = (kr - rq + 7) * 31 + 15 - c + 4 * hi;
    asm volatile("" : "+v"(d), "+v"(off));
#pragma unroll
    for (int i = 0; i < 16; ++i) { const int ci = (i & 3) + 8 * (i >> 2);
      const bool v0 = (unsigned)(ci + d) < 16u, v1 = (unsigned)(ci + 32 + d) < 16u;
      const float b0 = tab[off + ci], b1 = tab[off + ci + 32];
      p0[i] = v0 ? p0[i] + b0 : NEG; p1[i] = v1 ? p1[i] + b1 : NEG; }
  }
};
template <int NVB> constexpr int lds_bytes() { return 3 * (64 * NVB * 64) + 3 * (64 * 128) + NW * 64 * 4; }
template <int NVB, class Pol>
__device__ __forceinline__ void attn_unit(const bf16_t* __restrict__ Qb, const Pol& pol, bf16_t* __restrict__ Ob, int ldo, int NT, float mref, char* lds) {
  constexpr int SHM_V = 64 * NVB * 64, SHM_K = 64 * 128;
  const int tid = threadIdx.x, lane = tid & 63, r32 = lane & 31, hi = lane >> 5; const int wid = __builtin_amdgcn_readfirstlane(tid >> 6);
  char* V_lds = lds; char* K_lds = lds + 3 * SHM_V;
  float* li_l = (float*)(lds + 3 * SHM_V + 3 * SHM_K) + wid * 64;
  const unsigned lds0 = (unsigned)(uintptr_t)lds;
  const int krow_ = 8 * wid + (lane >> 3), kch = (lane & 7) ^ ((krow_ >> 1) & 7);
  const bf16_t* ksrc = pol.Kg + (long)krow_ * LD + kch * 8;
  const bf16_t* vsrc = pol.Vg + (long)(8 * wid + ((lane >> 2) & 7)) * LD + (lane >> 5) * 32 + (lane & 3) * 8;
  const unsigned kdst = lds0 + 3 * SHM_V + wid * 1024, vdst = lds0 + wid * (NVB == 4 ? 2048 : 1024);
#define DMA_TILE(t, b) do { const long ro_ = pol.krow(t) * LD; glds16(ksrc + ro_, (unsigned)__builtin_amdgcn_readfirstlane(kdst + (b) * SHM_K)); \
    glds16(vsrc + ro_, (unsigned)__builtin_amdgcn_readfirstlane(vdst + (b) * SHM_V)); \
    if constexpr (NVB == 4) glds16(vsrc + ro_ + 64, (unsigned)__builtin_amdgcn_readfirstlane(vdst + (b) * SHM_V + 1024)); } while (0)
#define WAIT_BAR() do { asm volatile("s_waitcnt vmcnt(0)" ::: "memory"); __syncthreads(); } while (0)
  DMA_TILE(0, 0); DMA_TILE(1, 1);
  float l_reg = 0; f32x16 o[NVB]; bf16x8 qr[4];
#pragma unroll
  for (int d = 0; d < NVB; ++d) o[d] = f32x16{};
  const bf16_t* Qw = Qb + (long)(wid * QBLK + r32) * LD + hi * 8;
#pragma unroll
  for (int d0 = 0; d0 < 4; ++d0) qr[d0] = ld8(Qw + d0 * 16);
  const int vb0 = (int)(uintptr_t)V_lds + v_rd_base(lane);
  f32x16 pA0, pA1, pB0, pB1; bf16x8 pa0, pa1, pa2, pa3;
  int bp = 0, bc = 1, bn = 2;
  WAIT_BAR();
  qkt(pA0, pA1, K_lds, qr, r32, hi); pol.mod(pA0, pA1, 0, wid, r32, hi); exp16(pA0, mref);
#define STEP(C0, C1, P0, P1, j) do { \
    if ((j) + 1 < NT) DMA_TILE((j) + 1, bn); \
    ASBAR(); qkt(C0, C1, K_lds + bc * SHM_K, qr, r32, hi); \
    finishSM(P0, P1, mref, l_reg, pa0, pa1, pa2, pa3); ASBAR(); \
    pv_all<NVB>(o, vb0 + bp * SHM_V, pa0, pa1, pa2, pa3); pol.mod(C0, C1, (j), wid, r32, hi); exp16(C0, mref); \
    WAIT_BAR(); \
    bp = bc; bc = bn; bn = (bn == 2) ? 0 : bn + 1; } while (0)
  int j = 1;
#pragma nounroll
  for (; j + 1 < NT; j += 2) { STEP(pB0, pB1, pA0, pA1, j); STEP(pA0, pA1, pB0, pB1, j + 1); }
  STEP(pB0, pB1, pA0, pA1, NT - 1);
  finishSM(pB0, pB1, mref, l_reg, pa0, pa1, pa2, pa3); ASBAR();
  pv_all<NVB>(o, vb0 + bp * SHM_V, pa0, pa1, pa2, pa3);
  { auto rr = __builtin_amdgcn_permlane32_swap(__float_as_uint(l_reg), __float_as_uint(l_reg), false, false); l_reg = __uint_as_float(rr[0]) + __uint_as_float(rr[1]); }
  if (hi == 0) li_l[r32] = l_reg; asm volatile("s_waitcnt lgkmcnt(0)" ::: "memory");
  float rli[16];
#pragma unroll
  for (int r = 0; r < 16; ++r) rli[r] = __builtin_amdgcn_rcpf(li_l[crow(r, hi)]);
  bf16_t* Ow = Ob + (long)(wid * QBLK) * ldo;
#pragma unroll
  for (int r = 0; r < 16; ++r) { const int orow = crow(r, hi);
#pragma unroll
    for (int d0 = 0; d0 < NVB; ++d0) { const float v = o[d0][r] * rli[r]; const unsigned pk = cvtpk(v, v); Ow[(long)orow * ldo + d0 * 32 + r32] = (bf16_t)(pk & 0xffffu); } }
  __syncthreads();
#undef DMA_TILE
#undef WAIT_BAR
#undef STEP
}
}

#ifndef MK_PROBE_PHASE
#define MK_PROBE_PHASE -1
#endif
#ifndef MK_N_LAUNCHES
#define MK_N_LAUNCHES 1
#endif
constexpr int N_PHASES = 12;
constexpr int NWAVES = 8;
constexpr int DM = 1024, NB = 4, SEQ = 8192, TT = NB * SEQ, CTX = 256, TC = NB * CTX, MQ = TT + TC, NQKV = 3072;
constexpr int NE = 32, TOPK = 4, MPAD = TT * TOPK + NE * 256, MAXBLK = MPAD / 256;
constexpr float NORM_EPS = 1e-6f;
enum { I_X = 0, I_C, I_CTX, I_CCTX, I_WADA, I_BADA, I_GATTN, I_WIN, I_QND, I_KND, I_LQ1, I_LK1, I_LQ2, I_LK2, I_SUBLN, I_QNN, I_KNN, I_RPB, I_ONN, I_WOUT, I_GFFN, I_WR, I_BR, I_WGU, I_BGU, I_WD, I_BD, N_IN };

constexpr size_t MiB = 1u << 20;
constexpr size_t WS_CTL = 0, CTL_ZERO_BYTES = 64 * 1024;
constexpr size_t WS_TAB = 1 * MiB;
constexpr size_t WS_WQKV = 2 * MiB, WS_WO = 8 * MiB, WS_WGU = 10 * MiB, WS_WDN = 138 * MiB;
constexpr size_t WS_XN = 202 * MiB;
constexpr size_t WS_P = 268 * MiB;
constexpr size_t WS_OD = 499 * MiB, WS_ON = 563 * MiB, WS_MIX = 595 * MiB;
constexpr size_t WS_XG = 202 * MiB;
constexpr size_t WS_ACT = 659 * MiB;
constexpr size_t WS_Y = 202 * MiB;
constexpr size_t WS_RT = 931 * MiB;
constexpr size_t WS_END = 936 * MiB;
static_assert(WS_XN + (size_t)MQ * 2048 <= WS_P && WS_P + (size_t)MQ * 6144 <= WS_OD && WS_XG + (size_t)MPAD * 2048 <= WS_OD && WS_ACT + (size_t)MPAD * 2048 <= WS_RT, "d_ws map");
constexpr int TB_MOD = 0;
constexpr int TB_RCOS = 30720, TB_RSIN = TB_RCOS + 128 * 16, TB_CCOS = TB_RSIN + 128 * 16, TB_CSIN = TB_CCOS + 64 * 16;
constexpr int TB_LAM = TB_CSIN + 64 * 16;
constexpr int TB_WR = TB_LAM + 64;
constexpr int TB_RC = TB_WR + 4 * 1024 * 32;
static_assert((size_t)(TB_RC + 128) * 4 <= MiB, "TAB region");
constexpr int CW_CNT = 0;
constexpr int CW_BAR = 4096;
constexpr size_t RT_E = 0, RT_G = 512 * 1024, RT_POS = 1024 * 1024, RT_SLOT = 1536 * 1024;

constexpr int RING_BYTES = 131072;
constexpr int MISC_OFF = RING_BYTES;
constexpr int LDS_BYTES = 147456;

#define GAS __attribute__((address_space(1)))
#define LAS __attribute__((address_space(3)))
typedef unsigned short bf16;
typedef unsigned v4u __attribute__((ext_vector_type(4)));
typedef unsigned v2u __attribute__((ext_vector_type(2)));
typedef float f32x4 __attribute__((ext_vector_type(4)));
typedef float f32x16 __attribute__((ext_vector_type(16)));
#define LDS_WAIT() asm volatile("s_waitcnt lgkmcnt(0)" ::: "memory")
__device__ __forceinline__ unsigned f2bf(float f) { unsigned u = __builtin_bit_cast(unsigned, f); return (u + 0x7fffu + ((u >> 16) & 1u)) >> 16; }
__device__ __forceinline__ unsigned pk2(float lo, float hi) { return f2bf(lo) | (f2bf(hi) << 16); }
__device__ __forceinline__ float bflo(unsigned w) { return __uint_as_float(w << 16); }
__device__ __forceinline__ float bfhi(unsigned w) { return __uint_as_float(w & 0xffff0000u); }
__device__ __forceinline__ float wave_sum(float v) {
#pragma unroll
    for (int o = 1; o < 64; o <<= 1) v += __shfl_xor(v, o);
    return v;
}

struct Frame {
    LAS unsigned char* lds;
    int tid, lane, wave, vcu, G;
    const float* in[N_IN]; float* out; unsigned char* ws;
};

__device__ __forceinline__ void p0_transpose_item(const float* W, int K, int N, bf16* WT, int k0, int n0, int drow0, LAS float* scr, int lane) {
#pragma unroll 8
    for (int i = 0; i < 32; ++i) { const int kk = 2 * i + (lane >> 5); scr[kk * 33 + (lane & 31)] = W[(size_t)(k0 + kk) * N + n0 + (lane & 31)]; }
    LDS_WAIT(); asm volatile("" ::: "memory");
    const int c = lane & 7;
#pragma unroll
    for (int j = 0; j < 4; ++j) { const int n = (lane >> 3) + 8 * j; const LAS float* s = scr + (8 * c) * 33 + n;
        v4u o; o.x = pk2(s[0 * 33], s[1 * 33]); o.y = pk2(s[2 * 33], s[3 * 33]); o.z = pk2(s[4 * 33], s[5 * 33]); o.w = pk2(s[6 * 33], s[7 * 33]);
        *(v4u*)(WT + (size_t)(drow0 + n) * K + k0 + 8 * c) = o; }
    LDS_WAIT(); asm volatile("" ::: "memory");
}

__device__ __forceinline__ void p0_prologue(Frame& F) {
    float* tab = (float*)(F.ws + WS_TAB);
    for (int task = blockIdx.x; task < 96; task += F.G) {
        LAS float* ssilu = (LAS float*)F.lds;
        LAS float* part = ssilu + 5 * 1024;
        for (int i = F.tid; i < 5 * 1024; i += 512) { const int r = i >> 10, k = i & 1023; const float v = (r < 4) ? F.in[I_C][r * 1024 + k] : F.in[I_CCTX][k]; ssilu[i] = v / (1.0f + __expf(-v)); }
        __syncthreads();
        const int col = task * 64 + F.lane; const float* w = F.in[I_WADA] + col; float a0 = 0, a1 = 0, a2 = 0, a3 = 0, a4 = 0;
        const int kb = F.wave * 128;
#pragma unroll 8
        for (int k = kb; k < kb + 128; ++k) { const float wv = w[(size_t)k * 6144]; a0 += ssilu[k] * wv; a1 += ssilu[1024 + k] * wv; a2 += ssilu[2048 + k] * wv; a3 += ssilu[3072 + k] * wv; a4 += ssilu[4096 + k] * wv; }
        part[(F.wave * 5 + 0) * 64 + F.lane] = a0; part[(F.wave * 5 + 1) * 64 + F.lane] = a1; part[(F.wave * 5 + 2) * 64 + F.lane] = a2; part[(F.wave * 5 + 3) * 64 + F.lane] = a3; part[(F.wave * 5 + 4) * 64 + F.lane] = a4;
        __syncthreads();
        if (F.tid < 320) { const int r = F.tid >> 6, cl = F.tid & 63; float s = 0; for (int wv = 0; wv < 8; ++wv) s += part[(wv * 5 + r) * 64 + cl]; const int j = task * 64 + cl; tab[TB_MOD + r * 6144 + j] = s + F.in[I_BADA][j]; }
        __syncthreads();
    }
    if ((int)blockIdx.x == F.G - 1) {
        for (int i = F.tid; i < 192 * 16; i += 512) { const int p = i >> 4, f = i & 15; const float inv = 1.0f / powf(10000.0f, (float)f / 16.0f); const int pos = p < 128 ? p : p - 128; const float ang = (float)pos * inv;
            const float cv = cosf(ang), sv = sinf(ang);
            if (p < 128) { tab[TB_RCOS + pos * 16 + f] = cv; tab[TB_RSIN + pos * 16 + f] = sv; } else { tab[TB_CCOS + pos * 16 + f] = cv; tab[TB_CSIN + pos * 16 + f] = sv; } }
        if (F.wave == 0) { const float s1 = wave_sum(F.in[I_LQ1][F.lane] * F.in[I_LK1][F.lane]), s2 = wave_sum(F.in[I_LQ2][F.lane] * F.in[I_LK2][F.lane]);
            if (F.lane == 0) tab[TB_LAM] = expf(s1) - expf(s2) + 0.2f;
            float a = fabsf(F.in[I_QND][F.lane]), bq = fabsf(F.in[I_KND][F.lane]), c = fabsf(F.in[I_QNN][F.lane]), d = fabsf(F.in[I_KNN][F.lane]); float rm = -1e30f;
            for (int i = F.lane; i < 8 * 465; i += 64) rm = fmaxf(rm, F.in[I_RPB][i]);
#pragma unroll
            for (int o = 1; o < 64; o <<= 1) { a = fmaxf(a, __shfl_xor(a, o)); bq = fmaxf(bq, __shfl_xor(bq, o)); c = fmaxf(c, __shfl_xor(c, o)); d = fmaxf(d, __shfl_xor(d, o)); rm = fmaxf(rm, __shfl_xor(rm, o)); }
            if (F.lane == 0) { tab[TB_LAM + 1] = att::C2 * 64.0f * a * bq * 1.02f + 0.05f; tab[TB_LAM + 2] = att::C2 * 64.0f * c * d * 1.02f + 0.05f + fmaxf(rm, 0.f) * 1.4426950408889634f; } }
    }
    LAS float* scr = (LAS float*)(F.lds + 32768 + F.wave * 8704);
    const int gw = F.vcu * NWAVES + F.wave, NGW = F.G * NWAVES;
    constexpr int I_IN = 16 * 96, I_OUT = 16 * 32, I_GU = 16 * 64, I_DN = 16 * 32;
    constexpr int NITEMS = I_IN + I_OUT + NE * (I_GU + I_DN);
    bf16* wqkv = (bf16*)(F.ws + WS_WQKV); bf16* wo = (bf16*)(F.ws + WS_WO); bf16* wgu = (bf16*)(F.ws + WS_WGU); bf16* wdn = (bf16*)(F.ws + WS_WDN);
    for (int it = gw; it < NITEMS; it += NGW) {
        int r = it;
        if (r < I_IN) { const int kb = r / 96, nb = r % 96; p0_transpose_item(F.in[I_WIN], 1024, 3072, wqkv, 64 * kb, 32 * nb, 32 * nb, scr, F.lane); continue; } r -= I_IN;
        if (r < I_OUT) { const int kb = r / 32, nb = r % 32; p0_transpose_item(F.in[I_WOUT], 1024, 1024, wo, 64 * kb, 32 * nb, 32 * nb, scr, F.lane); continue; } r -= I_OUT;
        if (r < NE * I_GU) { const int e = r / I_GU, q = r % I_GU, kb = q / 64, nb = q % 64, n0 = 32 * nb;
            const int drow = (n0 < 1024) ? ((n0 >> 7) * 256 + (n0 & 127)) : (((n0 - 1024) >> 7) * 256 + 128 + ((n0 - 1024) & 127));
            p0_transpose_item(F.in[I_WGU] + (size_t)e * 1024 * 2048, 1024, 2048, wgu + (size_t)e * 2048 * 1024, 64 * kb, n0, drow, scr, F.lane); continue; } r -= NE * I_GU;
        { const int e = r / I_DN, q = r % I_DN, kb = q / 32, nb = q % 32;
            p0_transpose_item(F.in[I_WD] + (size_t)e * 1024 * 1024, 1024, 1024, wdn + (size_t)e * 1024 * 1024, 64 * kb, 32 * nb, 32 * nb, scr, F.lane); }
    }
}

__device__ __forceinline__ void p1_norm(Frame& F) {
    const float* tab = (const float*)(F.ws + WS_TAB); bf16* XN = (bf16*)(F.ws + WS_XN);
    const int gw = F.vcu * NWAVES + F.wave, NGW = F.G * NWAVES;
    const f32x4* gat = (const f32x4*)F.in[I_GATTN] + F.lane;
    for (int m = gw; m < MQ; m += NGW) {
        const int b = m < TT ? (m >> 13) : 4;
        const float* xrow = m < TT ? F.in[I_X] + (size_t)m * DM : F.in[I_CTX] + (size_t)(m - TT) * DM;
        const f32x4* xr = (const f32x4*)xrow + F.lane;
        const f32x4* sh = (const f32x4*)(tab + TB_MOD + b * 6144) + F.lane; const f32x4* sc = (const f32x4*)(tab + TB_MOD + b * 6144 + 1024) + F.lane;
        f32x4 v[4]; float s = 0.f;
#pragma unroll
        for (int j = 0; j < 4; ++j) { v[j] = xr[64 * j]; s += (v[j].x * v[j].x + v[j].y * v[j].y) + (v[j].z * v[j].z + v[j].w * v[j].w); }
        const float rstd = 1.0f / sqrtf(wave_sum(s) * (1.f / DM) + NORM_EPS);
        unsigned long long* o8 = (unsigned long long*)(XN + (size_t)m * DM) + F.lane;
#pragma unroll
        for (int j = 0; j < 4; ++j) { const f32x4 g = gat[64 * j], a = sc[64 * j], c = sh[64 * j];
            const f32x4 h = (v[j] * rstd) * g * (a + 1.0f) + c;
            o8[64 * j] = (unsigned long long)pk2(h.x, h.y) | ((unsigned long long)pk2(h.z, h.w) << 32); }
    }
    float* tw = (float*)(F.ws + WS_TAB);
    for (int i = (int)blockIdx.x * 512 + F.tid; i < 4 * 1024 * 32; i += F.G * 512) { const int b = i >> 15, k = (i >> 5) & 1023;
        tw[TB_WR + i] = F.in[I_GFFN][k] * (1.0f + tab[TB_MOD + b * 6144 + 4 * 1024 + k]) * F.in[I_WR][i & 32767]; }
    for (int t = gw; t < 128; t += NGW) { const int b = t >> 5, e = t & 31; float s = 0.f;
        for (int k = F.lane; k < 1024; k += 64) s += tab[TB_MOD + b * 6144 + 3 * 1024 + k] * F.in[I_WR][k * 32 + e];
        s = wave_sum(s); if (F.lane == 0) tw[TB_RC + t] = s + F.in[I_BR][e]; }
}

__device__ __forceinline__ void p3_qknorm(Frame& F) {
    const float* tab = (const float*)(F.ws + WS_TAB); bf16* P = (bf16*)(F.ws + WS_P);
    const int gw = F.vcu * NWAVES + F.wave, NGW = F.G * NWAVES;
    const int j = F.lane & 7;
    for (int task = gw; task < MQ * 4; task += NGW) {
        const int row = task >> 2, g = task & 3;
        const int colb = (g == 0) ? 0 : (g == 1) ? 512 : (g == 2) ? 1536 : 2048;
        const float* nw = ((g == 0) ? F.in[I_QND] : (g == 1) ? F.in[I_KND] : (g == 2) ? F.in[I_QNN] : F.in[I_KNN]) + 8 * j;
        bf16* p = P + (size_t)row * NQKV + colb + F.lane * 8;
        const v4u w = *(const v4u*)p;
        float v[8] = {bflo(w.x), bfhi(w.x), bflo(w.y), bfhi(w.y), bflo(w.z), bfhi(w.z), bflo(w.w), bfhi(w.w)};
        float ss = 0.f;
#pragma unroll
        for (int i = 0; i < 8; ++i) ss += v[i] * v[i];
        ss += __shfl_xor(ss, 1); ss += __shfl_xor(ss, 2); ss += __shfl_xor(ss, 4);
        const float rstd = 1.0f / sqrtf(ss * (1.f / 64.f) + NORM_EPS);
        const f32x4 n0 = *(const f32x4*)nw, n1 = *(const f32x4*)(nw + 4);
        v[0] *= rstd * n0.x; v[1] *= rstd * n0.y; v[2] *= rstd * n0.z; v[3] *= rstd * n0.w; v[4] *= rstd * n1.x; v[5] *= rstd * n1.y; v[6] *= rstd * n1.z; v[7] *= rstd * n1.w;
        if (g < 2 && row < TT) {
            const int s = row & (SEQ - 1), prow = s >> 6, pcol = s & 63, half = j >> 2, isx2 = (j >> 1) & 1;
            const float* ct = tab + (half ? TB_CCOS + pcol * 16 : TB_RCOS + prow * 16) + 8 * (j & 1);
            const float* st = tab + (half ? TB_CSIN + pcol * 16 : TB_RSIN + prow * 16) + 8 * (j & 1);
            const f32x4 c0 = *(const f32x4*)ct, c1 = *(const f32x4*)(ct + 4), s0 = *(const f32x4*)st, s1 = *(const f32x4*)(st + 4);
            const float cc[8] = {c0.x, c0.y, c0.z, c0.w, c1.x, c1.y, c1.z, c1.w}, sn[8] = {s0.x, s0.y, s0.z, s0.w, s1.x, s1.y, s1.z, s1.w};
#pragma unroll
            for (int i = 0; i < 8; ++i) { const float pr = __shfl_xor(v[i], 2); v[i] = isx2 ? (v[i] * cc[i] + pr * sn[i]) : (v[i] * cc[i] - pr * sn[i]); }
        }
        if (g == 0 || g == 2) {
#pragma unroll
            for (int i = 0; i < 8; ++i) v[i] *= att::C2;
        }
        v4u o; o.x = pk2(v[0], v[1]); o.y = pk2(v[2], v[3]); o.z = pk2(v[4], v[5]); o.w = pk2(v[6], v[7]);
        *(v4u*)p = o;
    }
}

__device__ __forceinline__ void p4_attention(Frame& F, char* lds) {
    const bf16* P = (const bf16*)(F.ws + WS_P); bf16* OD = (bf16*)(F.ws + WS_OD); bf16* ON = (bf16*)(F.ws + WS_ON);
    const float* tab = (const float*)(F.ws + WS_TAB); const float mref_d = tab[TB_LAM + 1], mref_n = tab[TB_LAM + 2];
#ifndef MK_NO_DIFF
    for (int unit = F.vcu; unit < 1024; unit += F.G) {
        const int bhm = unit >> 5, qb = unit & 31, b = bhm >> 3, h = (bhm >> 1) & 3, m = bhm & 1;
        att::DiffPol pol; pol.Kg = P + 512 + h * 128 + m * 64; pol.Vg = P + 1024 + h * 128; pol.lat0 = (long)b * SEQ; pol.ctx0 = (long)TT + b * CTX;
        att::attn_unit<4, att::DiffPol>(P + ((size_t)b * SEQ + qb * 256) * NQKV + h * 128 + m * 64, pol, OD + ((size_t)b * SEQ + qb * 256) * 1024 + h * 256 + m * 128, 1024, 132, mref_d, lds);
    }
#endif
#ifndef MK_NO_NA
    float* tabl = (float*)(lds + att::lds_bytes<4>());
    for (int unit = F.vcu; unit < 1024; unit += F.G) {
        const int bh = unit >> 5, rb = unit & 31, b = bh >> 3, hn = bh & 7, r = rb * 4;
        for (int i = F.tid; i < 15 * 31; i += 512) tabl[i] = F.in[I_RPB][hn * 465 + i] * 1.4426950408889634f;
        att::NaPol pol; pol.Kg = P + 2048 + hn * 64; pol.Vg = P + 2560 + hn * 64; pol.lat0 = (long)b * SEQ; pol.ctx0 = (long)TT + b * CTX;
        pol.r = r; pol.rbase = (r - 4) < 0 ? 0 : ((r - 4) > 120 ? 120 : (r - 4)); pol.tab = tabl;
        att::attn_unit<2, att::NaPol>(P + ((size_t)b * SEQ + r * 64) * NQKV + 1536 + hn * 64, pol, ON + ((size_t)b * SEQ + r * 64) * 512 + hn * 64, 512, 16, mref_n, lds);
    }
#endif
}

__device__ __forceinline__ void p5_mix(Frame& F) {
    const float* tab = (const float*)(F.ws + WS_TAB); const bf16* OD = (const bf16*)(F.ws + WS_OD); const bf16* ON = (const bf16*)(F.ws + WS_ON); bf16* MX = (bf16*)(F.ws + WS_MIX);
    const int gw = F.vcu * NWAVES + F.wave, NGW = F.G * NWAVES;
    const float lam = tab[TB_LAM];
    const int h = F.lane >> 4, e0 = (F.lane & 15) * 8;
    const f32x4 sl0 = *(const f32x4*)(F.in[I_SUBLN] + e0), sl1 = *(const f32x4*)(F.in[I_SUBLN] + e0 + 4);
    const f32x4 on0 = *(const f32x4*)(F.in[I_ONN] + F.lane * 8), on1 = *(const f32x4*)(F.in[I_ONN] + F.lane * 8 + 4);
    for (int t = gw; t < TT; t += NGW) {
        const v4u a = *(const v4u*)(OD + (size_t)t * 1024 + h * 256 + e0), c = *(const v4u*)(OD + (size_t)t * 1024 + h * 256 + 128 + e0);
        const v4u n = *(const v4u*)(ON + (size_t)t * 512 + F.lane * 8);
        float d[8] = {bflo(a.x) - lam * bflo(c.x), bfhi(a.x) - lam * bfhi(c.x), bflo(a.y) - lam * bflo(c.y), bfhi(a.y) - lam * bfhi(c.y),
                      bflo(a.z) - lam * bflo(c.z), bfhi(a.z) - lam * bfhi(c.z), bflo(a.w) - lam * bflo(c.w), bfhi(a.w) - lam * bfhi(c.w)};
        float ss = 0.f;
#pragma unroll
        for (int i = 0; i < 8; ++i) ss += d[i] * d[i];
        ss += __shfl_xor(ss, 1); ss += __shfl_xor(ss, 2); ss += __shfl_xor(ss, 4); ss += __shfl_xor(ss, 8);
        const float rs = 0.8f / sqrtf(ss * (1.f / 128.f) + NORM_EPS);
        v4u o; o.x = pk2(d[0] * rs * sl0.x, d[1] * rs * sl0.y); o.y = pk2(d[2] * rs * sl0.z, d[3] * rs * sl0.w); o.z = pk2(d[4] * rs * sl1.x, d[5] * rs * sl1.y); o.w = pk2(d[6] * rs * sl1.z, d[7] * rs * sl1.w);
        *(v4u*)(MX + (size_t)t * 1024 + h * 128 + e0) = o;
        float q[8] = {bflo(n.x), bfhi(n.x), bflo(n.y), bfhi(n.y), bflo(n.z), bfhi(n.z), bflo(n.w), bfhi(n.w)};
        float s2 = 0.f;
#pragma unroll
        for (int i = 0; i < 8; ++i) s2 += q[i] * q[i];
        s2 += __shfl_xor(s2, 1); s2 += __shfl_xor(s2, 2); s2 += __shfl_xor(s2, 4);
        const float r2 = 1.0f / sqrtf(s2 * (1.f / 64.f) + NORM_EPS);
        v4u o2; o2.x = pk2(q[0] * r2 * on0.x, q[1] * r2 * on0.y); o2.y = pk2(q[2] * r2 * on0.z, q[3] * r2 * on0.w); o2.z = pk2(q[4] * r2 * on1.x, q[5] * r2 * on1.y); o2.w = pk2(q[6] * r2 * on1.z, q[7] * r2 * on1.w);
        *(v4u*)(MX + (size_t)t * 1024 + 512 + F.lane * 8) = o2;
    }
}

__device__ __forceinline__ void p7_router(Frame& F) {
    const float* tab = (const float*)(F.ws + WS_TAB); unsigned* cnt = (unsigned*)(F.ws + WS_CTL) + CW_CNT;
    int* rt_e = (int*)(F.ws + WS_RT + RT_E); float* rt_g = (float*)(F.ws + WS_RT + RT_G); int* rt_pos = (int*)(F.ws + WS_RT + RT_POS);
    LAS unsigned* cntl = (LAS unsigned*)(F.lds + MISC_OFF); LAS unsigned* basel = cntl + 32;
    const int j = F.lane & 31, kh = F.lane >> 5;
    for (int tile = F.vcu; tile < TT / 128; tile += F.G) {
        if (F.tid < 32) cntl[F.tid] = 0u;
        __syncthreads();
        int te[4] = {0, 0, 0, 0}; float tg[4] = {0, 0, 0, 0}; unsigned lp[4] = {0, 0, 0, 0}; const int t = tile * 128 + 32 * F.wave + j;
        if (F.wave < 4) {
            const int b = t >> 13;
            const float* xr = F.out + (size_t)t * DM + 4 * kh;
            const float* wp = tab + TB_WR + (size_t)b * 32768 + (4 * kh) * 32 + j;
            f32x16 acc = f32x16{}; float ss = 0.f;
#pragma unroll 4
            for (int u = 0; u < 128; ++u) {
                const f32x4 xv = *(const f32x4*)(xr + 8 * u);
                const float w0 = wp[(8 * u + 0) * 32], w1 = wp[(8 * u + 1) * 32], w2 = wp[(8 * u + 2) * 32], w3 = wp[(8 * u + 3) * 32];
                ss += (xv.x * xv.x + xv.y * xv.y) + (xv.z * xv.z + xv.w * xv.w);
                acc = __builtin_amdgcn_mfma_f32_32x32x2f32(w0, xv.x, acc, 0, 0, 0);
                acc = __builtin_amdgcn_mfma_f32_32x32x2f32(w1, xv.y, acc, 0, 0, 0);
                acc = __builtin_amdgcn_mfma_f32_32x32x2f32(w2, xv.z, acc, 0, 0, 0);
                acc = __builtin_amdgcn_mfma_f32_32x32x2f32(w3, xv.w, acc, 0, 0, 0);
            }
            ss += __shfl_xor(ss, 32);
            const float rstd = 1.0f / sqrtf(ss * (1.f / DM) + NORM_EPS);
            float v[16];
#pragma unroll
            for (int r = 0; r < 16; ++r) v[r] = acc[r] * rstd + tab[TB_RC + b * 32 + att::crow(r, kh)];
            float cv[8]; int ce[8];
#pragma unroll
            for (int k = 0; k < 4; ++k) { float best = -INFINITY; int bi = 0;
#pragma unroll
                for (int r = 0; r < 16; ++r) if (v[r] > best) { best = v[r]; bi = r; }
#pragma unroll
                for (int r = 0; r < 16; ++r) if (r == bi) v[r] = -INFINITY;
                cv[k] = best; ce[k] = att::crow(bi, kh); }
#pragma unroll
            for (int k = 0; k < 4; ++k) { cv[4 + k] = __shfl_xor(cv[k], 32); ce[4 + k] = __shfl_xor(ce[k], 32); }
            float tv[4];
#pragma unroll
            for (int k = 0; k < 4; ++k) { float best = -INFINITY; int be = 1 << 30, bi = 0;
#pragma unroll
                for (int q = 0; q < 8; ++q) if (cv[q] > best || (cv[q] == best && ce[q] < be)) { best = cv[q]; be = ce[q]; bi = q; }
#pragma unroll
                for (int q = 0; q < 8; ++q) if (q == bi) cv[q] = -INFINITY;
                tv[k] = best; te[k] = be; }
            const float e1 = __expf(tv[1] - tv[0]), e2 = __expf(tv[2] - tv[0]), e3 = __expf(tv[3] - tv[0]); const float inv = 1.0f / (1.0f + e1 + e2 + e3);
            tg[0] = inv; tg[1] = e1 * inv; tg[2] = e2 * inv; tg[3] = e3 * inv;
            if (kh == 0) {
#pragma unroll
                for (int k = 0; k < 4; ++k) lp[k] = __hip_atomic_fetch_add(cntl + te[k], 1u, __ATOMIC_RELAXED, __HIP_MEMORY_SCOPE_WORKGROUP);
            }
        }
        __syncthreads();
        if (F.tid < 32) { const unsigned c = cntl[F.tid]; basel[F.tid] = c ? atomicAdd(cnt + F.tid, c) : 0u; }
        __syncthreads();
        if (F.wave < 4 && kh == 0) {
#pragma unroll
            for (int k = 0; k < 4; ++k) { rt_e[t * 4 + k] = te[k]; rt_g[t * 4 + k] = tg[k]; rt_pos[t * 4 + k] = (int)(basel[te[k]] + lp[k]); }
        }
        __syncthreads();
    }
}

__device__ __forceinline__ int pad_starts(const unsigned* cnt, int lane) {
    const int c = lane < 32 ? (int)__hip_atomic_load(cnt + lane, __ATOMIC_RELAXED, __HIP_MEMORY_SCOPE_AGENT) : 0;
    int p = (c + 255) & ~255, incl = p;
#pragma unroll
    for (int o = 1; o < 64; o <<= 1) { const int n = __shfl_up(incl, o); if (lane >= o) incl += n; }
    return incl - p;
}

__device__ __forceinline__ void p8_scatter(Frame& F) {
    const float* tab = (const float*)(F.ws + WS_TAB); const unsigned* cnt = (const unsigned*)(F.ws + WS_CTL) + CW_CNT;
    const int* rt_e = (const int*)(F.ws + WS_RT + RT_E); const int* rt_pos = (const int*)(F.ws + WS_RT + RT_POS); int* rt_slot = (int*)(F.ws + WS_RT + RT_SLOT);
    bf16* XG = (bf16*)(F.ws + WS_XG);
    const int gw = F.vcu * NWAVES + F.wave, NGW = F.G * NWAVES;
    const int pst = pad_starts(cnt, F.lane);
    const f32x4* gf = (const f32x4*)F.in[I_GFFN] + F.lane;
    for (int t = gw; t < TT; t += NGW) {
        const int b = t >> 13;
        const f32x4* xr = (const f32x4*)(F.out + (size_t)t * DM) + F.lane;
        const f32x4* sh = (const f32x4*)(tab + TB_MOD + b * 6144 + 3 * 1024) + F.lane; const f32x4* sc = (const f32x4*)(tab + TB_MOD + b * 6144 + 4 * 1024) + F.lane;
        f32x4 v[4]; float s = 0.f;
#pragma unroll
        for (int jj = 0; jj < 4; ++jj) { v[jj] = xr[64 * jj]; s += (v[jj].x * v[jj].x + v[jj].y * v[jj].y) + (v[jj].z * v[jj].z + v[jj].w * v[jj].w); }
        const float rstd = 1.0f / sqrtf(wave_sum(s) * (1.f / DM) + NORM_EPS);
        unsigned long long pk[4];
#pragma unroll
        for (int jj = 0; jj < 4; ++jj) { const f32x4 g = gf[64 * jj], a = sc[64 * jj], c = sh[64 * jj]; const f32x4 h = (v[jj] * rstd) * g * (a + 1.0f) + c;
            pk[jj] = (unsigned long long)pk2(h.x, h.y) | ((unsigned long long)pk2(h.z, h.w) << 32); }
        const int my_e = rt_e[t * 4 + (F.lane & 3)], my_pos = rt_pos[t * 4 + (F.lane & 3)];
#pragma unroll
        for (int k = 0; k < 4; ++k) { const int e = __shfl(my_e, k), pos = __shfl(my_pos, k); const int slot = __shfl(pst, e) + pos;
            unsigned long long* o8 = (unsigned long long*)(XG + (size_t)slot * DM) + F.lane;
#pragma unroll
            for (int jj = 0; jj < 4; ++jj) o8[64 * jj] = pk[jj];
            if (F.lane == 0) rt_slot[t * 4 + k] = slot; }
    }
}

__device__ __forceinline__ int moe_block_table(Frame& F, LAS int* bexp) {
    const unsigned* cnt = (const unsigned*)(F.ws + WS_CTL) + CW_CNT;
    const int pst = pad_starts(cnt, F.lane);
    const int total = __shfl(pst, 32) >> 8;
    if (F.wave == 0) {
        const int nxt = __shfl_down(pst, 1);
        if (F.lane < 32) for (int bl = pst >> 8; bl < (nxt >> 8); ++bl) bexp[bl] = F.lane;
    }
    __syncthreads();
    return __builtin_amdgcn_readfirstlane(total);
}

__device__ __forceinline__ void p11_combine(Frame& F) {
    const float* tab = (const float*)(F.ws + WS_TAB); const bf16* Y = (const bf16*)(F.ws + WS_Y);
    const float* rt_g = (const float*)(F.ws + WS_RT + RT_G); const int* rt_slot = (const int*)(F.ws + WS_RT + RT_SLOT);
    const int gw = F.vcu * NWAVES + F.wave, NGW = F.G * NWAVES;
    for (int t = gw; t < TT; t += NGW) {
        const int b = t >> 13;
        f32x4* xr = (f32x4*)(F.out + (size_t)t * DM) + F.lane;
        const f32x4* g2 = (const f32x4*)(tab + TB_MOD + b * 6144 + 5 * 1024) + F.lane;
        f32x4 acc[4];
#pragma unroll
        for (int jj = 0; jj < 4; ++jj) acc[jj] = (f32x4){0.f, 0.f, 0.f, 0.f};
        const int my_slot = rt_slot[t * 4 + (F.lane & 3)]; const float my_g = rt_g[t * 4 + (F.lane & 3)];
#pragma unroll
        for (int k = 0; k < 4; ++k) { const int slot = __shfl(my_slot, k); const float g = __shfl(my_g, k);
            const v2u* yr = (const v2u*)(Y + (size_t)slot * DM) + F.lane;
#pragma unroll
            for (int jj = 0; jj < 4; ++jj) { const v2u w = yr[64 * jj]; acc[jj] += (f32x4){bflo(w.x), bfhi(w.x), bflo(w.y), bfhi(w.y)} * g; } }
#pragma unroll
        for (int jj = 0; jj < 4; ++jj) xr[64 * jj] = xr[64 * jj] + g2[64 * jj] * acc[jj];
    }
}

#define XB_TMO      128
#define XB_XCNT(j)  (256  + 64 * (j))
#define XB_XSUB(j)  (1280 + 64 * (j))
#define XB_XGEN(j)  (2304 + 64 * (j))
#define XB_TOP      3328
#define XB_TOPGEN   3392
#define XCD_BAR_WORDS 3456
#define XB_SPIN_CAP (1u << 18)

__device__ __forceinline__ unsigned xb_ld(unsigned* p)              { return __hip_atomic_load(p, __ATOMIC_RELAXED, __HIP_MEMORY_SCOPE_AGENT); }
__device__ __forceinline__ unsigned xb_add(unsigned* p, unsigned v) { return __hip_atomic_fetch_add(p, v, __ATOMIC_RELAXED, __HIP_MEMORY_SCOPE_AGENT); }
__device__ __forceinline__ unsigned xb_xcc_id() { return (unsigned)__builtin_amdgcn_s_getreg((3 << 11) | 20) & 0xFu; }
#define XB_SPIN(cond, bar) do { unsigned _sp = 0; while (cond) { __builtin_amdgcn_s_sleep(1); \
    if ((++_sp & 255u) == 0u) { if (xb_ld(&(bar)[XB_TMO])) break; if (_sp > XB_SPIN_CAP) { atomicAdd(&(bar)[XB_TMO], 1u); break; } } } } while (0)

struct XcdBarrier {
    unsigned* bar; unsigned x;
    volatile LAS unsigned* st;
};

__device__ __forceinline__ XcdBarrier xcd_barrier_post(unsigned* bar, volatile LAS unsigned* st) {
    XcdBarrier b; b.bar = bar; b.x = xb_xcc_id(); b.st = st;
    if (threadIdx.x == 0) (void)xb_add(&bar[XB_XCNT(b.x)], 1u);
    return b;
}
__device__ __forceinline__ void xcd_barrier_complete(unsigned* bar, unsigned x, unsigned& nloc, unsigned& nx) {
    const unsigned G = gridDim.x * gridDim.y * gridDim.z;
    unsigned sum, cnt, mine, sp = 0u;
    for (;;) {
        sum = 0u; cnt = 0u; mine = 0u;
#pragma unroll
        for (unsigned j = 0; j < 16; ++j) { const unsigned c = xb_ld(&bar[XB_XCNT(j)]); sum += c; cnt += (c > 0u) ? 1u : 0u; mine = (j == x) ? c : mine; }
        if (sum == G) break;
        __builtin_amdgcn_s_sleep(1);
        if ((++sp & 255u) == 0u) { if (xb_ld(&bar[XB_TMO])) break; if (sp > XB_SPIN_CAP) { atomicAdd(&bar[XB_TMO], 1u); break; } }
    }
    nloc = mine > 0u ? mine : 1u; nx = cnt > 0u ? cnt : 1u;
}

__device__ __forceinline__ void xcd_barrier(const XcdBarrier& b) {
    asm volatile("s_waitcnt vmcnt(0)" ::: "memory");
    __syncthreads();
    if (threadIdx.x == 0) {
        unsigned* bar = b.bar;
        __builtin_amdgcn_s_waitcnt(0);
        unsigned nloc = b.st[0], nx = b.st[1];
        if (nloc == 0u) { xcd_barrier_complete(bar, b.x, nloc, nx); b.st[0] = nloc; b.st[1] = nx; }
        const unsigned old = xb_add(&bar[XB_XSUB(b.x)], 1u);
        const unsigned gen = old / nloc;
        if (old + 1u == (gen + 1u) * nloc) {
            __builtin_amdgcn_fence(__ATOMIC_RELEASE, "agent");
            asm volatile("s_waitcnt vmcnt(0)" ::: "memory");
            const unsigned og = xb_add(&bar[XB_TOP], 1u);
            const unsigned tg = og / nx;
            if (og + 1u == (tg + 1u) * nx) xb_add(&bar[XB_TOPGEN], 1u);
            else XB_SPIN(xb_ld(&bar[XB_TOPGEN]) == tg, bar);
            __builtin_amdgcn_fence(__ATOMIC_ACQUIRE, "agent");
            xb_add(&bar[XB_XGEN(b.x)], 1u);
            asm volatile("s_waitcnt vmcnt(0)" ::: "memory");
        } else {
            XB_SPIN(xb_ld(&bar[XB_XGEN(b.x)]) == gen, bar);
            __builtin_amdgcn_fence(__ATOMIC_ACQUIRE, "agent");
            asm volatile("s_waitcnt vmcnt(0)" ::: "memory");
        }
    }
    __syncthreads();
}

struct Args { const float* in[N_IN]; float* out; unsigned char* ws; int ph_lo, ph_hi, li, pad; };
__global__ void __launch_bounds__(NWAVES * 64, 2) mk_fwd(Args args) {
    extern __shared__ __attribute__((aligned(16))) unsigned char lds[];
    Frame F;
    F.lds = (LAS unsigned char*)lds;
    F.tid = threadIdx.x; F.lane = F.tid & 63; F.wave = __builtin_amdgcn_readfirstlane(F.tid >> 6);
    F.G = gridDim.x; { const int bx = blockIdx.x; F.vcu = (F.G % 8 == 0) ? (bx % 8) * (F.G / 8) + bx / 8 : bx; }
#pragma unroll
    for (int i = 0; i < N_IN; ++i) F.in[i] = args.in[i];
    F.out = args.out; F.ws = args.ws;
    const int lo = args.ph_lo, hi = args.ph_hi;
    volatile LAS unsigned* bst = (volatile LAS unsigned*)(F.lds + MISC_OFF + 4096);
    if (F.tid < 2) bst[F.tid] = 0u;
    __syncthreads();
    XcdBarrier bar; bar.bar = (unsigned*)(F.ws + WS_CTL) + CW_BAR + args.li * XCD_BAR_WORDS; bar.x = 0; bar.st = nullptr;
    if (hi - lo > 1) bar = xcd_barrier_post((unsigned*)(F.ws + WS_CTL) + CW_BAR + args.li * XCD_BAR_WORDS, bst);
#ifndef MK_PHASE_MASK
#define MK_PHASE_MASK 0xFFF
#endif
#define IN(k) (((MK_PHASE_MASK >> (k)) & 1) && lo <= (k) && (k) < hi)
#define SEAM(k) do { if (IN(k) && IN((k) + 1)) { if ((k) == 0) cg::this_grid().sync(); else xcd_barrier(bar); } } while (0)
    if (IN(0)) { p0_prologue(F); } SEAM(0);
    if (IN(1)) { p1_norm(F); } SEAM(1);
    if (IN(2)) {
        pg8::Gemm g{(const bf16*)(F.ws + WS_XN), (const bf16*)(F.ws + WS_WQKV), MQ, NQKV, DM, 0};
        pg8::StaticOrder S; S.init(MQ, NQKV, F.G, (int)blockIdx.x);
        pg8::EpiBf16<0> E{(bf16*)(F.ws + WS_P), NQKV, nullptr, 0, 0, 1.f};
        pg8::gemm_phase<pg8::EpiBf16<0>, pg8::StaticOrder, true, true>(F.lds, g, S, E);
    } SEAM(2);
    if (IN(3)) { p3_qknorm(F); } SEAM(3);
    if (IN(4)) { p4_attention(F, (char*)lds); } SEAM(4);
    if (IN(5)) { p5_mix(F); } SEAM(5);
    if (IN(6)) {
        pg8::Gemm g{(const bf16*)(F.ws + WS_MIX), (const bf16*)(F.ws + WS_WO), TT, DM, DM, 0};
        pg8::StaticOrder S; S.init(TT, DM, F.G, (int)blockIdx.x);
        pg8::EpiOut E{F.in[I_X], F.out, (const float*)(F.ws + WS_TAB) + TB_MOD};
        pg8::gemm_phase<pg8::EpiOut, pg8::StaticOrder, true, true>(F.lds, g, S, E);
    } SEAM(6);
    if (IN(7)) { p7_router(F); } SEAM(7);
    if (IN(8)) { p8_scatter(F); } SEAM(8);
    if (IN(9)) {
        LAS int* bexp = (LAS int*)(F.lds + MISC_OFF + 1024);
        const int nblk = moe_block_table(F, bexp);
        pg8::Gemm g{(const bf16*)(F.ws + WS_XG), (const bf16*)(F.ws + WS_WGU), MPAD, 2048, DM, (size_t)2048 * 1024 * 2};
        pg8::MoeOrder S; S.init(nblk, 8, F.G, (int)blockIdx.x, bexp);
        pg8::EpiSwiGLU E{(bf16*)(F.ws + WS_ACT), F.in[I_BGU]};
        pg8::gemm_phase<pg8::EpiSwiGLU, pg8::MoeOrder, true, true>(F.lds, g, S, E);
    } SEAM(9);
    if (IN(10)) {
        LAS int* bexp = (LAS int*)(F.lds + MISC_OFF + 1024);
        const int nblk = moe_block_table(F, bexp);
        pg8::Gemm g{(const bf16*)(F.ws + WS_ACT), (const bf16*)(F.ws + WS_WDN), MPAD, 1024, DM, (size_t)1024 * 1024 * 2};
        pg8::MoeOrder S; S.init(nblk, 4, F.G, (int)blockIdx.x, bexp);
        pg8::EpiDown E{(bf16*)(F.ws + WS_Y), F.in[I_BD]};
        pg8::gemm_phase<pg8::EpiDown, pg8::MoeOrder, true, true>(F.lds, g, S, E);
    } SEAM(10);
    if (IN(11)) { p11_combine(F); }
#undef IN
#undef SEAM
}

extern "C" void kernel_launch(void* const* d_in, const int* in_sizes, int n_in, void* d_out, int out_size, void* d_ws, size_t ws_size, hipStream_t stream) {
    static int grid = 0;
    if (grid == 0) {
        if (n_in != N_IN || in_sizes[0] != TT * DM || out_size != TT * DM || ws_size < WS_END) { fprintf(stderr, "kernel_launch: unexpected shapes (n_in %d, in0 %d, out %d, ws %zu)\n", n_in, n_in > 0 ? in_sizes[0] : -1, out_size, ws_size); grid = -1; return; }
        int dev = 0, cus = 0, per_cu = 0;
        if (hipGetDevice(&dev) != hipSuccess || hipDeviceGetAttribute(&cus, hipDeviceAttributeMultiprocessorCount, dev) != hipSuccess) { grid = -1; return; }
        if (hipFuncSetAttribute((const void*)mk_fwd, hipFuncAttributeMaxDynamicSharedMemorySize, LDS_BYTES) != hipSuccess) { fprintf(stderr, "kernel_launch: hipFuncSetAttribute failed\n"); grid = -1; return; }
        if (hipOccupancyMaxActiveBlocksPerMultiprocessor(&per_cu, (const void*)mk_fwd, NWAVES * 64, LDS_BYTES) != hipSuccess || per_cu < 1) { fprintf(stderr, "kernel_launch: occupancy query reports %d\n", per_cu); (void)hipGetLastError(); per_cu = 1; }
        grid = cus;
    }
    if (grid < 0) return;
    (void)hipMemsetAsync((char*)d_ws + WS_CTL, 0, CTL_ZERO_BYTES, stream);
    Args a{};
    for (int i = 0; i < N_IN; ++i) a.in[i] = (const float*)d_in[i];
    a.out = (float*)d_out; a.ws = (unsigned char*)d_ws;
    int lo_[3] = {0, 0, 0}, hi_[3] = {N_PHASES, 0, 0}, nl = 1;
    if (MK_PROBE_PHASE >= 0) { nl = 0; lo_[nl] = 0; hi_[nl] = MK_PROBE_PHASE + 1; ++nl; lo_[nl] = MK_PROBE_PHASE; hi_[nl] = MK_PROBE_PHASE + 1; ++nl; if (MK_PROBE_PHASE + 1 < N_PHASES) { lo_[nl] = MK_PROBE_PHASE + 1; hi_[nl] = N_PHASES; ++nl; } }
    for (int li = 0; li < nl; ++li) {
        a.ph_lo = lo_[li]; a.ph_hi = hi_[li]; a.li = li;
        void* params[] = {&a};
        const hipError_t e = hipLaunchCooperativeKernel((const void*)mk_fwd, dim3(grid), dim3(NWAVES * 64), params, LDS_BYTES, stream);
        if (e != hipSuccess) fprintf(stderr, "kernel_launch: cooperative launch failed: %s (grid %d)\n", hipGetErrorString(e), grid);
    }
}
```

```cpp
#include <hip/hip_runtime.h>
#include <hip/hip_cooperative_groups.h>
#include <cstdio>
#include <cstdint>
namespace cg = cooperative_groups;
namespace pg8 {
#define PG8_LAS __attribute__((address_space(3)))
typedef unsigned short bf16_t;
typedef short bf16x8 __attribute__((ext_vector_type(8)));
typedef float f32x4 __attribute__((ext_vector_type(4)));
typedef unsigned u32x4 __attribute__((ext_vector_type(4)));
constexpr int BM = 256, BK = 64, HALF = 128, HTB = HALF * BK * 2  , STAGE_BYTES = 8 * HTB, NXCD = 8, WGM = 8;

__host__ __device__ __forceinline__ int lds_byte(int r, int c) { const int st = (r >> 4) * 2 + (c >> 5), rr = r & 15, cc = c & 31, ob = rr * 64 + cc * 2; return st * 1024 + (ob ^ (((ob >> 9) & 1) << 5)); }
__host__ __device__ __forceinline__ void stage_rc(int b, int& R, int& C) { const int st = b / 1024, sb = b % 1024, swz = sb ^ (((sb >> 9) & 1) << 5); R = (st >> 1) * 16 + swz / 64; C = (st & 1) * 32 + (swz % 64) / 2; }
__host__ __device__ __forceinline__ int perm32(int rho) { const int n = rho >> 4, i = rho & 15; return 8 * (i >> 2) + 4 * n + (i & 3); }

struct Unit { int pm, pn, e; };
struct Gemm { const bf16_t* A; const bf16_t* Bt; int M, N, K; size_t estride; };

struct StaticOrder {
    int nM, nN, nwg, G, c;
    __host__ __device__ void init(int M, int N, int G_, int c_) { nM = M / BM; nN = N / BM; nwg = nM * nN; G = G_; c = c_; }
    __host__ __device__ bool next(int i, Unit& u) const {
        const long L = (long)i * G + c; if (L >= nwg) return false;
        int wgid = (int)L; { const int q = nwg / NXCD, r = nwg % NXCD, xcd = wgid % NXCD, off = wgid / NXCD; wgid = (xcd < r ? xcd * (q + 1) : r * (q + 1) + (xcd - r) * q) + off; }
        const int nig = WGM * nN, gid = wgid / nig, fm = gid * WGM, gsz = (nM - fm) < WGM ? (nM - fm) : WGM;
        u.pm = fm + ((wgid % nig) % gsz); u.pn = (wgid % nig) / gsz; u.e = 0; return true;
    }
    __device__ __forceinline__ void a_ready(const Unit&) const {}
    __device__ __forceinline__ void done(const Unit&) const {}
};

__device__ __forceinline__ unsigned cvt_pk_bf16(float lo, float hi) { unsigned r; asm volatile("v_cvt_pk_bf16_f32 %0, %1, %2" : "=v"(r) : "v"(lo), "v"(hi)); return r; }
typedef float f32x2 __attribute__((ext_vector_type(2)));
__device__ __forceinline__ f32x2 gelu_pk(f32x2 v) {
    const f32x2 av = __builtin_elementwise_abs(v), d = av * 0.2316418882f + 1.0f;
    f32x2 t; t.x = __builtin_amdgcn_rcpf(d.x); t.y = __builtin_amdgcn_rcpf(d.y);
    f32x2 q = t * 0.5307027145f + (-0.7265760135f); q = q * t + 0.7107068705f; q = q * t + (-0.142248368f); q = q * t + 0.127414796f; q = q * t;
    const f32x2 s = (v * v) * (-0.72134752044f);
    f32x2 e; e.x = __builtin_amdgcn_exp2f(s.x); e.y = __builtin_amdgcn_exp2f(s.y);
    const f32x2 m = v * (q * e), r = v - m;
    f32x2 o; o.x = v.x < 0.f ? m.x : r.x; o.y = v.y < 0.f ? m.y : r.y; return o;
}

template <int ACT  > struct EpiBf16 {
    static constexpr bool PERM = true, AFTER_DRAIN = false; static_assert(ACT == 0 || ACT == 1, "EpiBf16: ACT is 0 (none) or 1 (gelu_pk)");
    bf16_t* O; int ldc; const float* bias; int split_cols; size_t split_stride; float scale0;
    __device__ __forceinline__ void operator()(const f32x4 (&acc)[2][2][4][2], const Unit& u, int wr, int wc, int fr, int fq) const {
        const int row0 = u.pm * BM + wr * 64 + fr; int colt = u.pn * BM; bf16_t* base = O;
        float sc = 1.f; if (split_cols) { const int t = colt / split_cols; base += (size_t)t * split_stride; colt -= t * split_cols; if (t == 0) sc = scale0; }
        const int col0 = colt + wc * 32 + 8 * fq, bcol0 = u.pn * BM + wc * 32 + 8 * fq;
        f32x4 bv[2][2];
#pragma unroll
        for (int bj = 0; bj < 2; ++bj)
#pragma unroll
            for (int n = 0; n < 2; ++n) bv[bj][n] = bias ? *(const f32x4*)(bias + bcol0 + bj * HALF + 4 * n) : (f32x4){0.f, 0.f, 0.f, 0.f};
#pragma unroll
        for (int ai = 0; ai < 2; ++ai)
#pragma unroll
            for (int m = 0; m < 4; ++m) { bf16_t* rowp = base + (size_t)(row0 + ai * HALF + m * 16) * ldc + col0;
#pragma unroll
                for (int bj = 0; bj < 2; ++bj) { f32x4 v0 = acc[ai][bj][m][0] + bv[bj][0], v1 = acc[ai][bj][m][1] + bv[bj][1];
                    if (ACT == 1) { f32x2 a = gelu_pk((f32x2){v0[0], v0[1]}), b = gelu_pk((f32x2){v0[2], v0[3]}), c = gelu_pk((f32x2){v1[0], v1[1]}), d = gelu_pk((f32x2){v1[2], v1[3]});
                        v0 = (f32x4){a.x, a.y, b.x, b.y}; v1 = (f32x4){c.x, c.y, d.x, d.y}; }
                    v0 = v0 * sc; v1 = v1 * sc; u32x4 w; w.x = cvt_pk_bf16(v0[0], v0[1]); w.y = cvt_pk_bf16(v0[2], v0[3]); w.z = cvt_pk_bf16(v1[0], v1[1]); w.w = cvt_pk_bf16(v1[2], v1[3]);
                    *(u32x4*)(rowp + bj * HALF) = w; } }
    }
};

template <class Epi, class Sched, bool ALIGN_EPI = false, bool SP2 = false>
__device__ __forceinline__ void gemm_phase(PG8_LAS unsigned char* lds, const Gemm g, const Sched& S, const Epi& E) {
    const int tid = threadIdx.x, wid = __builtin_amdgcn_readfirstlane(tid >> 6), lane = tid & 63, wr = wid >> 2, wc = wid & 3, fr = lane & 15, fq = lane >> 4;
    const int K = g.K, nt = K / BK;
    unsigned voffA[2], voffB[2];
#pragma unroll
    for (int i = 0; i < 2; ++i) { int R, C; stage_rc(tid * 16 + i * 8192, R, C); const int Rb = Epi::PERM ? ((R & ~31) + perm32(R & 31)) : R;
        voffA[i] = (unsigned)(R * K + C) * 2u; voffB[i] = (unsigned)(Rb * K + C) * 2u; }
    const size_t kstep = (size_t)(BK * 2);
    const size_t hstep = (size_t)HALF * K * 2;
    const size_t tstep = 2 * hstep;
    const unsigned ldsw = (unsigned)wid * 1024u;
    const int aoff = lds_byte(wr * 64 + fr, fq * 8), boff = lds_byte(wc * 32 + fr, fq * 8);
#define PG8_SA(b, h) (((b) * 2 + (h)) * HTB)
#define PG8_SB(b, h) ((4 + (b) * 2 + (h)) * HTB)
#define PG8_STAGE(bufoff, gbase, voff) do { _Pragma("unroll") for (int _i = 0; _i < 2; ++_i) \
        __builtin_amdgcn_global_load_lds((const unsigned*)((const char*)(gbase) + (voff)[_i]), (PG8_LAS unsigned*)(lds + (bufoff) + ldsw + _i * 8192), 16, 0, 0); } while (0)
#define PG8_LDA(dst, b, h) do { _Pragma("unroll") for (int m = 0; m < 4; ++m) _Pragma("unroll") for (int k = 0; k < 2; ++k) dst[m][k] = *(const PG8_LAS bf16x8*)(lds + PG8_SA(b, h) + aoff + m * 2048 + k * 1024); } while (0)
#define PG8_LDB(dst, b, h) do { _Pragma("unroll") for (int n = 0; n < 2; ++n) _Pragma("unroll") for (int k = 0; k < 2; ++k) dst[n][k] = *(const PG8_LAS bf16x8*)(lds + PG8_SB(b, h) + boff + n * 2048 + k * 1024); } while (0)
#define PG8_MMA(ai, bj, At, Bt) do { __builtin_amdgcn_s_setprio(1); _Pragma("unroll") for (int m = 0; m < 4; ++m) _Pragma("unroll") for (int n = 0; n < 2; ++n) _Pragma("unroll") for (int k = 0; k < 2; ++k) \
        acc[ai][bj][m][n] = __builtin_amdgcn_mfma_f32_16x16x32_bf16(Bt[n][k], At[m][k], acc[ai][bj][m][n], 0, 0, 0); __builtin_amdgcn_s_setprio(0); } while (0)
#define PG8_WAIT_V(n) asm volatile("s_waitcnt vmcnt(" #n ")" ::: "memory")
#define PG8_WAIT_L(n) asm volatile("s_waitcnt lgkmcnt(" #n ")" ::: "memory")
#define PG8_BAR __builtin_amdgcn_s_barrier()
#define PG8_SCHED __builtin_amdgcn_sched_barrier(0)
    Unit cur, nxt; int ui = 0;
    if (!S.next(0, cur)) return;
    f32x4 acc[2][2][4][2];
#pragma unroll
    for (int a = 0; a < 2; ++a)
#pragma unroll
        for (int b = 0; b < 2; ++b)
#pragma unroll
            for (int m = 0; m < 4; ++m)
#pragma unroll
                for (int n = 0; n < 2; ++n) acc[a][b][m][n] = (f32x4){0.f, 0.f, 0.f, 0.f};
    bf16x8 At[4][2], B0[2][2], B1[2][2];
    const char* cA = (const char*)g.A + (size_t)cur.pm * tstep; const char* cB = (const char*)g.Bt + (size_t)cur.e * g.estride + (size_t)cur.pn * tstep;
    S.a_ready(cur);
    if constexpr (SP2) {
        PG8_STAGE(PG8_SB(0, 0), cB, voffB); PG8_STAGE(PG8_SB(0, 1), cB + hstep, voffB); PG8_STAGE(PG8_SA(0, 0), cA, voffA); PG8_STAGE(PG8_SA(0, 1), cA + hstep, voffA);
        if (wr == 1) PG8_BAR;
        PG8_WAIT_V(2); PG8_BAR;
        PG8_STAGE(PG8_SB(1, 0), cB + kstep, voffB); PG8_STAGE(PG8_SA(1, 0), cA + kstep, voffA); PG8_STAGE(PG8_SB(1, 1), cB + hstep + kstep, voffB);
        PG8_WAIT_V(6); PG8_BAR;
    } else {
        PG8_STAGE(PG8_SB(0, 0), cB, voffB); PG8_STAGE(PG8_SA(0, 0), cA, voffA); PG8_STAGE(PG8_SB(0, 1), cB + hstep, voffB); PG8_STAGE(PG8_SA(0, 1), cA + hstep, voffA);
        if (wr == 1) PG8_BAR;
        PG8_WAIT_V(4); PG8_BAR;
        PG8_STAGE(PG8_SB(1, 0), cB + kstep, voffB); PG8_STAGE(PG8_SA(1, 0), cA + kstep, voffA); PG8_STAGE(PG8_SB(1, 1), cB + hstep + kstep, voffB);
        PG8_WAIT_V(6); PG8_BAR;
    }
    for (;;) {
        const bool has_next = S.next(ui + 1, nxt);
        const char* nA = has_next ? (const char*)g.A + (size_t)nxt.pm * tstep : cA; const char* nB = has_next ? (const char*)g.Bt + (size_t)nxt.e * g.estride + (size_t)nxt.pn * tstep : cB;
        for (int t = 0; t < nt; t += 2) {
            const bool last = (t == nt - 2);
            const char* a1 = cA + (size_t)(t + 1) * kstep;
            const char* a2 = last ? nA : cA + (size_t)(t + 2) * kstep; const char* b2 = last ? nB : cB + (size_t)(t + 2) * kstep;
            const char* a3 = a2 + kstep; const char* b3 = b2 + kstep;
            if (last && has_next) S.a_ready(nxt);
            if constexpr (SP2) {
            PG8_LDB(B0, 0, 0); PG8_LDB(B1, 0, 1); PG8_SCHED; PG8_LDA(At, 0, 0); PG8_STAGE(PG8_SA(1, 1), a1 + hstep, voffA);
            PG8_WAIT_V(8); PG8_WAIT_L(0); PG8_BAR; PG8_MMA(0, 0, At, B0); PG8_MMA(0, 1, At, B1); PG8_BAR; PG8_SCHED;
            PG8_LDA(At, 0, 1); PG8_STAGE(PG8_SB(0, 0), b2, voffB); PG8_STAGE(PG8_SB(0, 1), b2 + hstep, voffB); PG8_STAGE(PG8_SA(0, 0), a2, voffA);
            PG8_WAIT_V(8); PG8_WAIT_L(0); PG8_BAR; PG8_MMA(1, 0, At, B0); PG8_MMA(1, 1, At, B1); PG8_BAR; PG8_SCHED;
            PG8_LDB(B0, 1, 0); PG8_LDB(B1, 1, 1); PG8_SCHED; PG8_LDA(At, 1, 0); PG8_STAGE(PG8_SA(0, 1), a2 + hstep, voffA);
            PG8_WAIT_V(8); PG8_WAIT_L(0); PG8_BAR; PG8_MMA(0, 0, At, B0); PG8_MMA(0, 1, At, B1); PG8_BAR; PG8_SCHED;
            PG8_LDA(At, 1, 1); PG8_STAGE(PG8_SB(1, 0), b3, voffB); PG8_STAGE(PG8_SB(1, 1), b3 + hstep, voffB); PG8_STAGE(PG8_SA(1, 0), a3, voffA);
            PG8_WAIT_V(8); PG8_WAIT_L(0); PG8_BAR; PG8_MMA(1, 0, At, B0); PG8_MMA(1, 1, At, B1); PG8_BAR; PG8_SCHED;
            } else {
            PG8_LDB(B0, 0, 0); PG8_SCHED; PG8_LDA(At, 0, 0); PG8_STAGE(PG8_SA(1, 1), a1 + hstep, voffA);
            PG8_WAIT_L(8); PG8_BAR; PG8_WAIT_L(0); PG8_MMA(0, 0, At, B0); PG8_BAR; PG8_SCHED;
            PG8_LDB(B1, 0, 1); PG8_STAGE(PG8_SB(0, 0), b2, voffB);
            PG8_BAR; PG8_WAIT_L(0); PG8_MMA(0, 1, At, B1); PG8_BAR;
            PG8_LDA(At, 0, 1); PG8_STAGE(PG8_SA(0, 0), a2, voffA);
            PG8_BAR; PG8_WAIT_L(0); PG8_MMA(1, 0, At, B0); PG8_BAR; PG8_SCHED;
            PG8_STAGE(PG8_SB(0, 1), b2 + hstep, voffB);
            PG8_WAIT_V(6); PG8_BAR; PG8_MMA(1, 1, At, B1); PG8_BAR;
            PG8_LDB(B0, 1, 0); PG8_SCHED; PG8_LDA(At, 1, 0); PG8_STAGE(PG8_SA(0, 1), a2 + hstep, voffA);
            PG8_WAIT_L(8); PG8_BAR; PG8_WAIT_L(0); PG8_MMA(0, 0, At, B0); PG8_BAR; PG8_SCHED;
            PG8_LDB(B1, 1, 1); PG8_STAGE(PG8_SB(1, 0), b3, voffB);
            PG8_BAR; PG8_WAIT_L(0); PG8_MMA(0, 1, At, B1); PG8_BAR;
            PG8_LDA(At, 1, 1); PG8_STAGE(PG8_SA(1, 0), a3, voffA);
            PG8_BAR; PG8_WAIT_L(0); PG8_MMA(1, 0, At, B0); PG8_BAR; PG8_SCHED;
            PG8_STAGE(PG8_SB(1, 1), b3 + hstep, voffB);
            PG8_WAIT_V(6); PG8_BAR; PG8_MMA(1, 1, At, B1); PG8_BAR;
            }
        }
        if constexpr (ALIGN_EPI) { if (wr == 0) PG8_BAR; }
        if constexpr (!Epi::AFTER_DRAIN) { E(acc, cur, wr, wc, fr, fq); S.done(cur); }
        if (!has_next) break;
#pragma unroll
        for (int a = 0; a < 2; ++a)
#pragma unroll
            for (int b = 0; b < 2; ++b)
#pragma unroll
                for (int m = 0; m < 4; ++m)
#pragma unroll
                    for (int n = 0; n < 2; ++n) acc[a][b][m][n] = (f32x4){0.f, 0.f, 0.f, 0.f};
        cur = nxt; cA = nA; cB = nB; ++ui;
        if constexpr (ALIGN_EPI) { if (wr == 1) PG8_BAR; }
    }
    PG8_WAIT_V(0);
    if constexpr (!ALIGN_EPI) { if (wr == 0) PG8_BAR; }
    PG8_BAR;
    if constexpr (Epi::AFTER_DRAIN) { E.fused(acc, cur, wr, wc, fr, fq, lds, wid, lane); S.done(cur); }
#undef PG8_SA
#undef PG8_SB
#undef PG8_STAGE
#undef PG8_LDA
#undef PG8_LDB
#undef PG8_MMA
#undef PG8_WAIT_V
#undef PG8_WAIT_L
#undef PG8_BAR
#undef PG8_SCHED
}
}

namespace pg8 {
struct MoeOrder {
    int nM, nN, nwg, G, c; const PG8_LAS int* bexp;
    __device__ __forceinline__ void init(int nM_, int nN_, int G_, int c_, const PG8_LAS int* bexp_) { nM = nM_; nN = nN_; nwg = nM_ * nN_; G = G_; c = c_; bexp = bexp_; }
    __device__ __forceinline__ bool next(int i, Unit& u) const {
        const long L = (long)i * G + c; if (L >= nwg) return false;
        int wgid = (int)L; { const int q = nwg / NXCD, r = nwg % NXCD, xcd = wgid % NXCD, off = wgid / NXCD; wgid = (xcd < r ? xcd * (q + 1) : r * (q + 1) + (xcd - r) * q) + off; }
        const int nig = WGM * nN, gid = wgid / nig, fm = gid * WGM, gsz = (nM - fm) < WGM ? (nM - fm) : WGM;
        u.pm = fm + ((wgid % nig) % gsz); u.pn = (wgid % nig) / gsz; u.e = __builtin_amdgcn_readfirstlane(bexp[u.pm]); return true;
    }
    __device__ __forceinline__ void a_ready(const Unit&) const {}
    __device__ __forceinline__ void done(const Unit&) const {}
};
struct EpiOut {
    static constexpr bool PERM = false, AFTER_DRAIN = false;
    const float* x; float* out; const float* mod;
    __device__ __forceinline__ void operator()(const f32x4 (&acc)[2][2][4][2], const Unit& u, int wr, int wc, int fr, int fq) const {
        const int row0 = u.pm * BM + wr * 64 + fr, col0 = u.pn * BM + wc * 32 + 4 * fq;
        const float* g = mod + (size_t)(u.pm >> 5) * 6144 + 2 * 1024;
        f32x4 gv[2][2];
#pragma unroll
        for (int bj = 0; bj < 2; ++bj)
#pragma unroll
            for (int n = 0; n < 2; ++n) gv[bj][n] = *(const f32x4*)(g + col0 + bj * HALF + n * 16);
#pragma unroll
        for (int ai = 0; ai < 2; ++ai)
#pragma unroll
            for (int m = 0; m < 4; ++m) { const size_t off = (size_t)(row0 + ai * HALF + m * 16) * 1024 + col0;
#pragma unroll
                for (int bj = 0; bj < 2; ++bj)
#pragma unroll
                    for (int n = 0; n < 2; ++n) { const f32x4 xv = *(const f32x4*)(x + off + bj * HALF + n * 16); *(f32x4*)(out + off + bj * HALF + n * 16) = xv + gv[bj][n] * acc[ai][bj][m][n]; } }
    }
};
__device__ __forceinline__ float swiglu1(float g, float l) {
    const float glu = fminf(g, 7.0f), lin = fminf(fmaxf(l, -7.0f), 7.0f);
    const float sg = __builtin_amdgcn_rcpf(1.0f + __builtin_amdgcn_exp2f(glu * (-1.702f * 1.4426950408889634f)));
    return glu * sg * (lin + 1.0f);
}
struct EpiSwiGLU {
    static constexpr bool PERM = true, AFTER_DRAIN = false;
    bf16_t* act; const float* bgu;
    __device__ __forceinline__ void operator()(const f32x4 (&acc)[2][2][4][2], const Unit& u, int wr, int wc, int fr, int fq) const {
        const int row0 = u.pm * BM + wr * 64 + fr, cg = u.pn * 128 + wc * 32 + 8 * fq;
        const float* bb = bgu + (size_t)u.e * 2048;
        f32x4 bg[2], bl[2];
#pragma unroll
        for (int n = 0; n < 2; ++n) { bg[n] = *(const f32x4*)(bb + cg + 4 * n); bl[n] = *(const f32x4*)(bb + 1024 + cg + 4 * n); }
#pragma unroll
        for (int ai = 0; ai < 2; ++ai)
#pragma unroll
            for (int m = 0; m < 4; ++m) { bf16_t* rowp = act + (size_t)(row0 + ai * HALF + m * 16) * 1024 + cg;
                const f32x4 g0 = acc[ai][0][m][0] + bg[0], g1 = acc[ai][0][m][1] + bg[1], l0 = acc[ai][1][m][0] + bl[0], l1 = acc[ai][1][m][1] + bl[1];
                u32x4 w; w.x = cvt_pk_bf16(swiglu1(g0[0], l0[0]), swiglu1(g0[1], l0[1])); w.y = cvt_pk_bf16(swiglu1(g0[2], l0[2]), swiglu1(g0[3], l0[3]));
                w.z = cvt_pk_bf16(swiglu1(g1[0], l1[0]), swiglu1(g1[1], l1[1])); w.w = cvt_pk_bf16(swiglu1(g1[2], l1[2]), swiglu1(g1[3], l1[3]));
                *(u32x4*)rowp = w; }
    }
};
struct EpiDown {
    static constexpr bool PERM = true, AFTER_DRAIN = false;
    bf16_t* y; const float* bd;
    __device__ __forceinline__ void operator()(const f32x4 (&acc)[2][2][4][2], const Unit& u, int wr, int wc, int fr, int fq) const {
        const int row0 = u.pm * BM + wr * 64 + fr, col0 = u.pn * BM + wc * 32 + 8 * fq;
        const float* bb = bd + (size_t)u.e * 1024 + col0;
        f32x4 bv[2][2];
#pragma unroll
        for (int bj = 0; bj < 2; ++bj)
#pragma unroll
            for (int n = 0; n < 2; ++n) bv[bj][n] = *(const f32x4*)(bb + bj * HALF + 4 * n);
#pragma unroll
        for (int ai = 0; ai < 2; ++ai)
#pragma unroll
            for (int m = 0; m < 4; ++m) { bf16_t* rowp = y + (size_t)(row0 + ai * HALF + m * 16) * 1024 + col0;
#pragma unroll
                for (int bj = 0; bj < 2; ++bj) { const f32x4 v0 = acc[ai][bj][m][0] + bv[bj][0], v1 = acc[ai][bj][m][1] + bv[bj][1];
                    u32x4 w; w.x = cvt_pk_bf16(v0[0], v0[1]); w.y = cvt_pk_bf16(v0[2], v0[3]); w.z = cvt_pk_bf16(v1[0], v1[1]); w.w = cvt_pk_bf16(v1[2], v1[3]);
                    *(u32x4*)(rowp + bj * HALF) = w; } }
    }
};
}

namespace att {
typedef unsigned short bf16_t;
using bf16x8 = __attribute__((ext_vector_type(8))) short;
using s16x4  = __attribute__((ext_vector_type(4))) short;
using f32x16 = __attribute__((ext_vector_type(16))) float;
using u32x4  = __attribute__((ext_vector_type(4))) unsigned;
constexpr int NW = 8, QBLK = 32, KVBLK = 64, LD = 3072;
constexpr float SCALE = 0.125f, C2 = 0.125f * 1.4426950408889634f;
#define KSWZ64(row, colB) ((row) * 128 + ((colB) ^ ((((row) >> 1) & 7) << 4)))
#define ASBAR() __builtin_amdgcn_sched_barrier(0)
__device__ __forceinline__ int crow(int r, int hi) { return (r & 3) + 8 * (r >> 2) + 4 * hi; }
__device__ __forceinline__ unsigned cvtpk(float lo, float hi) { unsigned r; asm volatile("v_cvt_pk_bf16_f32 %0, %1, %2" : "=v"(r) : "v"(lo), "v"(hi)); return r; }
__device__ __forceinline__ bf16x8 ld8(const bf16_t* p) { return *reinterpret_cast<const bf16x8*>(p); }
__device__ __forceinline__ void glds16(const void* gsrc, unsigned lds_dst) { unsigned keep;
  asm volatile("s_mov_b32 %0, m0\n\ts_mov_b32 m0, %2\n\ts_nop 0\n\tglobal_load_lds_dwordx4 %1, off\n\ts_mov_b32 m0, %0" : "=&s"(keep) : "v"(gsrc), "s"(lds_dst) : "memory"); }

__device__ __forceinline__ void exp16(f32x16& p, float mref) {
#pragma unroll
  for (int r = 0; r < 16; ++r) p[r] = __builtin_amdgcn_exp2f(p[r]);
}
__device__ __forceinline__ void finishSM(f32x16& p0, f32x16& p1, float mref, float& l_reg, bf16x8& pa0, bf16x8& pa1, bf16x8& pa2, bf16x8& pa3) {
  exp16(p1, mref);
  float ps = 0;
#pragma unroll
  for (int r = 0; r < 16; ++r) ps += p0[r];
#pragma unroll
  for (int r = 0; r < 16; ++r) ps += p1[r];
  l_reg += ps;
#define PK4(P, BASE, OUT) do { u32x4 w = {cvtpk(P[BASE + 0], P[BASE + 1]), cvtpk(P[BASE + 2], P[BASE + 3]), cvtpk(P[BASE + 4], P[BASE + 5]), cvtpk(P[BASE + 6], P[BASE + 7])}; OUT = *reinterpret_cast<bf16x8*>(&w); } while (0)
  PK4(p0, 0, pa0); PK4(p0, 8, pa1); PK4(p1, 0, pa2); PK4(p1, 8, pa3);
#undef PK4
}
template <bool NEGM> __device__ __forceinline__ void qkt(f32x16& p0, f32x16& p1, const char* Ks, const bf16x8* qr, const f32x16& negm, int r32, int hi) {
#pragma unroll
  for (int d0 = 0; d0 < 4; ++d0) { const int cb = (d0 * 16 + hi * 8) * 2;
    const bf16x8 b0 = *reinterpret_cast<const bf16x8*>(Ks + KSWZ64(r32, cb));
    const bf16x8 b1 = *reinterpret_cast<const bf16x8*>(Ks + KSWZ64(32 + r32, cb));
    if (d0 == 0) { if constexpr (NEGM) { p0 = __builtin_amdgcn_mfma_f32_32x32x16_bf16(b0, qr[0], negm, 0, 0, 0); p1 = __builtin_amdgcn_mfma_f32_32x32x16_bf16(b1, qr[0], negm, 0, 0, 0); }
      else { p0 = __builtin_amdgcn_mfma_f32_32x32x16_bf16(b0, qr[0], f32x16{}, 0, 0, 0); p1 = __builtin_amdgcn_mfma_f32_32x32x16_bf16(b1, qr[0], f32x16{}, 0, 0, 0); } }
    else { p0 = __builtin_amdgcn_mfma_f32_32x32x16_bf16(b0, qr[d0], p0, 0, 0, 0); p1 = __builtin_amdgcn_mfma_f32_32x32x16_bf16(b1, qr[d0], p1, 0, 0, 0); } }
}
template <int NVB> __device__ __forceinline__ int v_st(int k, int c) { const int kk = k; return ((kk >> 3) * NVB + (c >> 5)) * 512 + ((kk & 7) * 32 + (c & 31)) * 2; }
__device__ __forceinline__ int v_rd_base(int lane) { return ((lane & 3) << 3) | (((lane >> 2) & 3) << 6) | (((lane >> 4) & 1) << 5) | (((lane >> 5) & 1) << 8); }
template <int NVB> constexpr int v_rd_off(int d0, int ks, int half) { return d0 * 512 + ks * (NVB * 1024) + half * (NVB * 512); }
template <int OFF> __device__ __forceinline__ s16x4 tr_read(int vb) {
  s16x4 r; asm volatile("ds_read_b64_tr_b16 %0, %1 offset:%2" : "=&v"(r) : "v"(vb), "i"(OFF) : "memory"); return r;
}
template <int NVB, int D0> __device__ __forceinline__ void v_rd(s16x4* f, int vb) {
  f[0] = tr_read<v_rd_off<NVB>(D0, 0, 0)>(vb); f[1] = tr_read<v_rd_off<NVB>(D0, 0, 1)>(vb); f[2] = tr_read<v_rd_off<NVB>(D0, 1, 0)>(vb); f[3] = tr_read<v_rd_off<NVB>(D0, 1, 1)>(vb);
  f[4] = tr_read<v_rd_off<NVB>(D0, 2, 0)>(vb); f[5] = tr_read<v_rd_off<NVB>(D0, 2, 1)>(vb); f[6] = tr_read<v_rd_off<NVB>(D0, 3, 0)>(vb); f[7] = tr_read<v_rd_off<NVB>(D0, 3, 1)>(vb);
}
__device__ __forceinline__ void pv_mm(f32x16& od, const s16x4* f, bf16x8 pa0, bf16x8 pa1, bf16x8 pa2, bf16x8 pa3) {
#define PK(L, H) (bf16x8){L[0], L[1], L[2], L[3], H[0], H[1], H[2], H[3]}
  od = __builtin_amdgcn_mfma_f32_32x32x16_bf16(pa0, PK(f[0], f[1]), od, 0, 0, 0);
  od = __builtin_amdgcn_mfma_f32_32x32x16_bf16(pa1, PK(f[2], f[3]), od, 0, 0, 0);
  od = __builtin_amdgcn_mfma_f32_32x32x16_bf16(pa2, PK(f[4], f[5]), od, 0, 0, 0);
  od = __builtin_amdgcn_mfma_f32_32x32x16_bf16(pa3, PK(f[6], f[7]), od, 0, 0, 0);
#undef PK
}
template <int LO, int N> __device__ __forceinline__ void exp_part(f32x16& p, float mref) {
#pragma unroll
  for (int r = LO; r < LO + N; ++r) p[r] = __builtin_amdgcn_exp2f(p[r]);
}
#define LGKM0() do { asm volatile("s_waitcnt lgkmcnt(0)" ::: "memory"); ASBAR(); } while (0)
template <int NVB> __device__ __forceinline__ void pv_all(f32x16* o, int vb, s16x4* fa, s16x4* fb, bf16x8 pa0, bf16x8 pa1, bf16x8 pa2, bf16x8 pa3, f32x16& c, float mref) {
  if constexpr (NVB == 4) {
    LGKM0(); v_rd<NVB, 1>(fb, vb); pv_mm(o[0], fa, pa0, pa1, pa2, pa3); exp_part<0, 4>(c, mref);
    LGKM0(); v_rd<NVB, 2>(fa, vb); pv_mm(o[1], fb, pa0, pa1, pa2, pa3); exp_part<4, 4>(c, mref);
    LGKM0(); v_rd<NVB, 3>(fb, vb); pv_mm(o[2], fa, pa0, pa1, pa2, pa3); exp_part<8, 4>(c, mref);
    LGKM0();                       pv_mm(o[3], fb, pa0, pa1, pa2, pa3); exp_part<12, 4>(c, mref);
  } else {
    LGKM0(); v_rd<NVB, 1>(fb, vb); pv_mm(o[0], fa, pa0, pa1, pa2, pa3); exp_part<0, 8>(c, mref);
    LGKM0();                       pv_mm(o[1], fb, pa0, pa1, pa2, pa3); exp_part<8, 8>(c, mref);
  }
}
template <bool SHIFT> struct DiffPol {
  static constexpr bool NEGM = false;
  const bf16_t* Kg; const bf16_t* Vg; long lat0, ctx0; float mref;
  __device__ __forceinline__ long krow(int t) const { return t < 128 ? lat0 + 64L * t : ctx0 + 64L * (t - 128); }
  __device__ __forceinline__ void mod(f32x16& p0, f32x16& p1, int, int, int, int) const {
    if constexpr (SHIFT) {
#pragma unroll
      for (int i = 0; i < 16; ++i) { p0[i] -= mref; p1[i] -= mref; } }
  }
};
struct NaPol {
  static constexpr bool NEGM = false;
  const bf16_t* Kg; const bf16_t* Vg; long lat0, ctx0; int rbase, r; const float* tab; float mref;
  __device__ __forceinline__ long krow(int t) const { if (t < 12) { int kr = rbase + t; kr = kr > 127 ? 127 : kr; return lat0 + 64L * kr; } return ctx0 + 64L * (t - 12); }
  __device__ __forceinline__ void mod(f32x16& p0, f32x16& p1, int t, int wid, int r32, int hi) const {
    if (t >= 12) {
#pragma unroll
      for (int i = 0; i < 16; ++i) { p0[i] -= mref; p1[i] -= mref; }
      return; }
    const float NEG = -INFINITY;
    const int kr = rbase + t, rq = r + (wid >> 1), c = 32 * (wid & 1) + r32;
    int r0q = rq - 4; r0q = r0q < 0 ? 0 : (r0q > 120 ? 120 : r0q);
    if (!((kr >= r0q) && (kr < r0q + 8))) {
#pragma unroll
      for (int i = 0; i < 16; ++i) { p0[i] = NEG; p1[i] = NEG; }
      return; }
    int c0 = c - 8; c0 = c0 < 0 ? 0 : (c0 > 48 ? 48 : c0);
    int d = 4 * hi - c0, off = (kr - rq + 7) * 31 + 15 - c + 4 * hi;
    asm volatile("" : "+v"(d), "+v"(off));
#pragma unroll
    for (int i = 0; i < 16; ++i) { const int ci = (i & 3) + 8 * (i >> 2);
      const bool v0 = (unsigned)(ci + d) < 16u, v1 = (unsigned)(ci + 32 + d) < 16u;
      const float b0 = tab[off + ci], b1 = tab[off + ci + 32];
      p0[i] = v0 ? p0[i] + b0 : NEG; p1[i] = v1 ? p1[i] + b1 : NEG; }
  }
};
template <int NVB> constexpr int lds_bytes() { return 3 * (64 * NVB * 64) + 3 * (64 * 128) + NW * 64 * 4; }
template <int NVB, class Pol>
__device__ __forceinline__ void attn_unit(const bf16_t* __restrict__ Qb, const Pol& pol, bf16_t* __restrict__ Ob, int ldo, int NT, float mref, char* lds) {
  constexpr int SHM_V = 64 * NVB * 64, SHM_K = 64 * 128;
  const int tid = threadIdx.x, lane = tid & 63, r32 = lane & 31, hi = lane >> 5; const int wid = __builtin_amdgcn_readfirstlane(tid >> 6);
  char* V_lds = lds; char* K_lds = lds + 3 * SHM_V;
  float* li_l = (float*)(lds + 3 * SHM_V + 3 * SHM_K) + wid * 64;
  const unsigned lds0 = (unsigned)(uintptr_t)lds;
  const int krow_ = 8 * wid + (lane >> 3), kch = (lane & 7) ^ ((krow_ >> 1) & 7);
  const bf16_t* ksrc = pol.Kg + (long)krow_ * LD + kch * 8;
  const bf16_t* vsrc = pol.Vg + (long)(8 * wid + ((lane >> 2) & 7)) * LD + (lane >> 5) * 32 + (lane & 3) * 8;
  const unsigned kdst = lds0 + 3 * SHM_V + wid * 1024, vdst = lds0 + wid * (NVB == 4 ? 2048 : 1024);
#define DMA_TILE(t, b) do { const long ro_ = pol.krow(t) * LD; glds16(ksrc + ro_, (unsigned)__builtin_amdgcn_readfirstlane(kdst + (b) * SHM_K)); \
    glds16(vsrc + ro_, (unsigned)__builtin_amdgcn_readfirstlane(vdst + (b) * SHM_V)); \
    if constexpr (NVB == 4) glds16(vsrc + ro_ + 64, (unsigned)__builtin_amdgcn_readfirstlane(vdst + (b) * SHM_V + 1024)); } while (0)
#define WAIT_BAR() do { asm volatile("s_waitcnt vmcnt(0)" ::: "memory"); __syncthreads(); } while (0)
  DMA_TILE(0, 0); DMA_TILE(1, 1);
  float l_reg = 0; f32x16 o[NVB]; bf16x8 qr[4]; f32x16 negm;
#pragma unroll
  for (int r = 0; r < 16; ++r) negm[r] = -mref;
  if constexpr (Pol::NEGM) asm volatile("" : "+v"(negm));
#pragma unroll
  for (int d = 0; d < NVB; ++d) o[d] = f32x16{};
  const bf16_t* Qw = Qb + (long)(wid * QBLK + r32) * LD + hi * 8;
#pragma unroll
  for (int d0 = 0; d0 < 4; ++d0) qr[d0] = ld8(Qw + d0 * 16);
  const int vb0 = (int)(uintptr_t)V_lds + v_rd_base(lane);
  f32x16 pA0, pA1, pB0, pB1; bf16x8 pa0, pa1, pa2, pa3; s16x4 fa[8], fb[8];
  int bp = 0, bc = 1, bn = 2;
  WAIT_BAR();
  qkt<Pol::NEGM>(pA0, pA1, K_lds, qr, negm, r32, hi); pol.mod(pA0, pA1, 0, wid, r32, hi); exp16(pA0, mref);
#define STEP(C0, C1, P0, P1, j) do { \
    if ((j) + 1 < NT) DMA_TILE((j) + 1, bn); \
    ASBAR(); v_rd<NVB, 0>(fa, vb0 + bp * SHM_V); qkt<Pol::NEGM>(C0, C1, K_lds + bc * SHM_K, qr, negm, r32, hi); \
    finishSM(P0, P1, mref, l_reg, pa0, pa1, pa2, pa3); ASBAR(); \
    pol.mod(C0, C1, (j), wid, r32, hi); ASBAR(); \
    pv_all<NVB>(o, vb0 + bp * SHM_V, fa, fb, pa0, pa1, pa2, pa3, C0, mref); \
    WAIT_BAR(); \
    bp = bc; bc = bn; bn = (bn == 2) ? 0 : bn + 1; } while (0)
  int j = 1;
#pragma nounroll
  for (; j + 1 < NT; j += 2) { STEP(pB0, pB1, pA0, pA1, j); STEP(pA0, pA1, pB0, pB1, j + 1); }
  STEP(pB0, pB1, pA0, pA1, NT - 1);
  finishSM(pB0, pB1, mref, l_reg, pa0, pa1, pa2, pa3); ASBAR();
  v_rd<NVB, 0>(fa, vb0 + bp * SHM_V); pv_all<NVB>(o, vb0 + bp * SHM_V, fa, fb, pa0, pa1, pa2, pa3, pA0, 0.f);
  { auto rr = __builtin_amdgcn_permlane32_swap(__float_as_uint(l_reg), __float_as_uint(l_reg), false, false); l_reg = __uint_as_float(rr[0]) + __uint_as_float(rr[1]); }
  if (hi == 0) li_l[r32] = l_reg; asm volatile("s_waitcnt lgkmcnt(0)" ::: "memory");
  float rli[16];
#pragma unroll
  for (int r = 0; r < 16; ++r) rli[r] = __builtin_amdgcn_rcpf(li_l[crow(r, hi)]);
  bf16_t* Ow = Ob + (long)(wid * QBLK) * ldo;
#pragma unroll
  for (int r = 0; r < 16; ++r) { const int orow = crow(r, hi);
#pragma unroll
    for (int d0 = 0; d0 < NVB; ++d0) { const float v = o[d0][r] * rli[r]; const unsigned pk = cvtpk(v, v); Ow[(long)orow * ldo + d0 * 32 + r32] = (bf16_t)(pk & 0xffffu); } }
  __syncthreads();
#undef DMA_TILE
#undef WAIT_BAR
#undef STEP
}
}

#ifndef MK_PROBE_PHASE
#define MK_PROBE_PHASE -1
#endif
#ifndef MK_N_LAUNCHES
#define MK_N_LAUNCHES 1
#endif
constexpr int N_PHASES = 12;
constexpr int NWAVES = 8;
constexpr int DM = 1024, NB = 4, SEQ = 8192, TT = NB * SEQ, CTX = 256, TC = NB * CTX, MQ = TT + TC, NQKV = 3072;
constexpr int NE = 32, TOPK = 4, MPAD = TT * TOPK + NE * 256, MAXBLK = MPAD / 256;
constexpr float NORM_EPS = 1e-6f;
enum { I_X = 0, I_C, I_CTX, I_CCTX, I_WADA, I_BADA, I_GATTN, I_WIN, I_QND, I_KND, I_LQ1, I_LK1, I_LQ2, I_LK2, I_SUBLN, I_QNN, I_KNN, I_RPB, I_ONN, I_WOUT, I_GFFN, I_WR, I_BR, I_WGU, I_BGU, I_WD, I_BD, N_IN };

constexpr size_t MiB = 1u << 20;
constexpr size_t WS_CTL = 0, CTL_ZERO_BYTES = 64 * 1024;
constexpr size_t WS_TAB = 1 * MiB;
constexpr size_t WS_WQKV = 2 * MiB, WS_WO = 8 * MiB, WS_WGU = 10 * MiB, WS_WDN = 138 * MiB;
constexpr size_t WS_XN = 202 * MiB;
constexpr size_t WS_P = 268 * MiB;
constexpr size_t WS_OD = 499 * MiB, WS_ON = 563 * MiB, WS_MIX = 595 * MiB;
constexpr size_t WS_XG = 202 * MiB;
constexpr size_t WS_ACT = 659 * MiB;
constexpr size_t WS_Y = 202 * MiB;
constexpr size_t WS_RT = 931 * MiB;
constexpr size_t WS_END = 936 * MiB;
static_assert(WS_XN + (size_t)MQ * 2048 <= WS_P && WS_P + (size_t)MQ * 6144 <= WS_OD && WS_XG + (size_t)MPAD * 2048 <= WS_OD && WS_ACT + (size_t)MPAD * 2048 <= WS_RT, "d_ws map");
constexpr int TB_MOD = 0;
constexpr int TB_RCOS = 30720, TB_RSIN = TB_RCOS + 128 * 16, TB_CCOS = TB_RSIN + 128 * 16, TB_CSIN = TB_CCOS + 64 * 16;
constexpr int TB_LAM = TB_CSIN + 64 * 16;
constexpr int TB_WR = TB_LAM + 64;
constexpr int TB_RC = TB_WR + 4 * 1024 * 32;
static_assert((size_t)(TB_RC + 128 + 64) * 4 <= MiB, "TAB region");
constexpr int CW_CNT = 0;
constexpr int CW_BAR = 4096;
constexpr size_t RT_E = 0, RT_G = 512 * 1024, RT_POS = 1024 * 1024, RT_SLOT = 1536 * 1024;

constexpr int RING_BYTES = 131072;
constexpr int MISC_OFF = RING_BYTES;
constexpr int LDS_BYTES = 147456;

#define GAS __attribute__((address_space(1)))
#define LAS __attribute__((address_space(3)))
typedef unsigned short bf16;
typedef unsigned v4u __attribute__((ext_vector_type(4)));
typedef unsigned v2u __attribute__((ext_vector_type(2)));
typedef float f32x4 __attribute__((ext_vector_type(4)));
typedef float f32x16 __attribute__((ext_vector_type(16)));
#define LDS_WAIT() asm volatile("s_waitcnt lgkmcnt(0)" ::: "memory")
__device__ __forceinline__ unsigned f2bf(float f) { unsigned u = __builtin_bit_cast(unsigned, f); return (u + 0x7fffu + ((u >> 16) & 1u)) >> 16; }
__device__ __forceinline__ unsigned pk2(float lo, float hi) { return f2bf(lo) | (f2bf(hi) << 16); }
__device__ __forceinline__ float bflo(unsigned w) { return __uint_as_float(w << 16); }
__device__ __forceinline__ float bfhi(unsigned w) { return __uint_as_float(w & 0xffff0000u); }
__device__ __forceinline__ float wave_sum(float v) {
#pragma unroll
    for (int o = 1; o < 64; o <<= 1) v += __shfl_xor(v, o);
    return v;
}

struct Frame {
    LAS unsigned char* lds;
    int tid, lane, wave, vcu, G;
    const float* in[N_IN]; float* out; unsigned char* ws;
};

__device__ __forceinline__ void p0_transpose_item(const float* W, int K, int N, bf16* WT, int k0, int n0, int drow0, LAS float* scr, int lane) {
#pragma unroll 8
    for (int i = 0; i < 32; ++i) { const int kk = 2 * i + (lane >> 5); scr[kk * 33 + (lane & 31)] = W[(size_t)(k0 + kk) * N + n0 + (lane & 31)]; }
    LDS_WAIT(); asm volatile("" ::: "memory");
    const int c = lane & 7;
#pragma unroll
    for (int j = 0; j < 4; ++j) { const int n = (lane >> 3) + 8 * j; const LAS float* s = scr + (8 * c) * 33 + n;
        v4u o; o.x = pk2(s[0 * 33], s[1 * 33]); o.y = pk2(s[2 * 33], s[3 * 33]); o.z = pk2(s[4 * 33], s[5 * 33]); o.w = pk2(s[6 * 33], s[7 * 33]);
        *(v4u*)(WT + (size_t)(drow0 + n) * K + k0 + 8 * c) = o; }
    LDS_WAIT(); asm volatile("" ::: "memory");
}

__device__ __forceinline__ void p0_prologue(Frame& F) {
    float* tab = (float*)(F.ws + WS_TAB);
    for (int task = blockIdx.x; task < 96; task += F.G) {
        LAS float* ssilu = (LAS float*)F.lds;
        LAS float* part = ssilu + 5 * 1024;
        for (int i = F.tid; i < 5 * 1024; i += 512) { const int r = i >> 10, k = i & 1023; const float v = (r < 4) ? F.in[I_C][r * 1024 + k] : F.in[I_CCTX][k]; ssilu[i] = v / (1.0f + __expf(-v)); }
        __syncthreads();
        const int col = task * 64 + F.lane; const float* w = F.in[I_WADA] + col; float a0 = 0, a1 = 0, a2 = 0, a3 = 0, a4 = 0;
        const int kb = F.wave * 128;
#pragma unroll 8
        for (int k = kb; k < kb + 128; ++k) { const float wv = w[(size_t)k * 6144]; a0 += ssilu[k] * wv; a1 += ssilu[1024 + k] * wv; a2 += ssilu[2048 + k] * wv; a3 += ssilu[3072 + k] * wv; a4 += ssilu[4096 + k] * wv; }
        part[(F.wave * 5 + 0) * 64 + F.lane] = a0; part[(F.wave * 5 + 1) * 64 + F.lane] = a1; part[(F.wave * 5 + 2) * 64 + F.lane] = a2; part[(F.wave * 5 + 3) * 64 + F.lane] = a3; part[(F.wave * 5 + 4) * 64 + F.lane] = a4;
        __syncthreads();
        if (F.tid < 320) { const int r = F.tid >> 6, cl = F.tid & 63; float s = 0; for (int wv = 0; wv < 8; ++wv) s += part[(wv * 5 + r) * 64 + cl]; const int j = task * 64 + cl; tab[TB_MOD + r * 6144 + j] = s + F.in[I_BADA][j]; }
        __syncthreads();
    }
    if ((int)blockIdx.x == F.G - 1) {
        for (int i = F.tid; i < 192 * 16; i += 512) { const int p = i >> 4, f = i & 15; const float inv = 1.0f / powf(10000.0f, (float)f / 16.0f); const int pos = p < 128 ? p : p - 128; const float ang = (float)pos * inv;
            const float cv = cosf(ang), sv = sinf(ang);
            if (p < 128) { tab[TB_RCOS + pos * 16 + f] = cv; tab[TB_RSIN + pos * 16 + f] = sv; } else { tab[TB_CCOS + pos * 16 + f] = cv; tab[TB_CSIN + pos * 16 + f] = sv; } }
        if (F.wave == 0) { const float s1 = wave_sum(F.in[I_LQ1][F.lane] * F.in[I_LK1][F.lane]), s2 = wave_sum(F.in[I_LQ2][F.lane] * F.in[I_LK2][F.lane]);
            if (F.lane == 0) tab[TB_LAM] = expf(s1) - expf(s2) + 0.2f;
            float a = fabsf(F.in[I_QND][F.lane]), bq = fabsf(F.in[I_KND][F.lane]), c = fabsf(F.in[I_QNN][F.lane]), d = fabsf(F.in[I_KNN][F.lane]); float rm = -1e30f;
            for (int i = F.lane; i < 8 * 465; i += 64) rm = fmaxf(rm, F.in[I_RPB][i]);
#pragma unroll
            for (int o = 1; o < 64; o <<= 1) { a = fmaxf(a, __shfl_xor(a, o)); bq = fmaxf(bq, __shfl_xor(bq, o)); c = fmaxf(c, __shfl_xor(c, o)); d = fmaxf(d, __shfl_xor(d, o)); rm = fmaxf(rm, __shfl_xor(rm, o)); }
            if (F.lane == 0) { tab[TB_LAM + 1] = att::C2 * 64.0f * a * bq * 1.02f + 0.05f; tab[TB_LAM + 2] = att::C2 * 64.0f * c * d * 1.02f + 0.05f + fmaxf(rm, 0.f) * 1.4426950408889634f; } }
    }
    LAS float* scr = (LAS float*)(F.lds + 32768 + F.wave * 8704);
    const int gw = F.vcu * NWAVES + F.wave, NGW = F.G * NWAVES;
    constexpr int I_IN = 16 * 96, I_OUT = 16 * 32, I_GU = 16 * 64, I_DN = 16 * 32;
    constexpr int NITEMS = I_IN + I_OUT + NE * (I_GU + I_DN);
    bf16* wqkv = (bf16*)(F.ws + WS_WQKV); bf16* wo = (bf16*)(F.ws + WS_WO); bf16* wgu = (bf16*)(F.ws + WS_WGU); bf16* wdn = (bf16*)(F.ws + WS_WDN);
    for (int it = gw; it < NITEMS; it += NGW) {
        int r = it;
        if (r < I_IN) { const int kb = r / 96, nb = r % 96; p0_transpose_item(F.in[I_WIN], 1024, 3072, wqkv, 64 * kb, 32 * nb, 32 * nb, scr, F.lane); continue; } r -= I_IN;
        if (r < I_OUT) { const int kb = r / 32, nb = r % 32; p0_transpose_item(F.in[I_WOUT], 1024, 1024, wo, 64 * kb, 32 * nb, 32 * nb, scr, F.lane); continue; } r -= I_OUT;
        if (r < NE * I_GU) { const int e = r / I_GU, q = r % I_GU, kb = q / 64, nb = q % 64, n0 = 32 * nb;
            const int drow = (n0 < 1024) ? ((n0 >> 7) * 256 + (n0 & 127)) : (((n0 - 1024) >> 7) * 256 + 128 + ((n0 - 1024) & 127));
            p0_transpose_item(F.in[I_WGU] + (size_t)e * 1024 * 2048, 1024, 2048, wgu + (size_t)e * 2048 * 1024, 64 * kb, n0, drow, scr, F.lane); continue; } r -= NE * I_GU;
        { const int e = r / I_DN, q = r % I_DN, kb = q / 32, nb = q % 32;
            p0_transpose_item(F.in[I_WD] + (size_t)e * 1024 * 1024, 1024, 1024, wdn + (size_t)e * 1024 * 1024, 64 * kb, 32 * nb, 32 * nb, scr, F.lane); }
    }
}

__device__ __forceinline__ void p1_norm(Frame& F) {
    const float* tab = (const float*)(F.ws + WS_TAB); bf16* XN = (bf16*)(F.ws + WS_XN);
    const int gw = F.vcu * NWAVES + F.wave, NGW = F.G * NWAVES;
    const f32x4* gat = (const f32x4*)F.in[I_GATTN] + F.lane;
    for (int m = gw; m < MQ; m += NGW) {
        const int b = m < TT ? (m >> 13) : 4;
        const float* xrow = m < TT ? F.in[I_X] + (size_t)m * DM : F.in[I_CTX] + (size_t)(m - TT) * DM;
        const f32x4* xr = (const f32x4*)xrow + F.lane;
        const f32x4* sh = (const f32x4*)(tab + TB_MOD + b * 6144) + F.lane; const f32x4* sc = (const f32x4*)(tab + TB_MOD + b * 6144 + 1024) + F.lane;
        f32x4 v[4]; float s = 0.f;
#pragma unroll
        for (int j = 0; j < 4; ++j) { v[j] = xr[64 * j]; s += (v[j].x * v[j].x + v[j].y * v[j].y) + (v[j].z * v[j].z + v[j].w * v[j].w); }
        const float rstd = 1.0f / sqrtf(wave_sum(s) * (1.f / DM) + NORM_EPS);
        unsigned long long* o8 = (unsigned long long*)(XN + (size_t)m * DM) + F.lane;
#pragma unroll
        for (int j = 0; j < 4; ++j) { const f32x4 g = gat[64 * j], a = sc[64 * j], c = sh[64 * j];
            const f32x4 h = (v[j] * rstd) * g * (a + 1.0f) + c;
            o8[64 * j] = (unsigned long long)pk2(h.x, h.y) | ((unsigned long long)pk2(h.z, h.w) << 32); }
    }
    float* tw = (float*)(F.ws + WS_TAB);
    for (int i = (int)blockIdx.x * 512 + F.tid; i < 4 * 1024 * 32; i += F.G * 512) { const int b = i >> 15, k = (i >> 5) & 1023;
        tw[TB_WR + i] = F.in[I_GFFN][k] * (1.0f + tab[TB_MOD + b * 6144 + 4 * 1024 + k]) * F.in[I_WR][i & 32767]; }
    for (int t = gw; t < 128; t += NGW) { const int b = t >> 5, e = t & 31; float s = 0.f;
        for (int k = F.lane; k < 1024; k += 64) s += tab[TB_MOD + b * 6144 + 3 * 1024 + k] * F.in[I_WR][k * 32 + e];
        s = wave_sum(s); if (F.lane == 0) tw[TB_RC + t] = s + F.in[I_BR][e]; }
}

__device__ __forceinline__ void p3_qknorm(Frame& F) {
    const float* tab = (const float*)(F.ws + WS_TAB); bf16* P = (bf16*)(F.ws + WS_P);
    const int gw = F.vcu * NWAVES + F.wave, NGW = F.G * NWAVES;
    const int j = F.lane & 7;
    for (int task = gw; task < MQ * 4; task += NGW) {
        const int row = task >> 2, g = task & 3;
        const int colb = (g == 0) ? 0 : (g == 1) ? 512 : (g == 2) ? 1536 : 2048;
        const float* nw = ((g == 0) ? F.in[I_QND] : (g == 1) ? F.in[I_KND] : (g == 2) ? F.in[I_QNN] : F.in[I_KNN]) + 8 * j;
        bf16* p = P + (size_t)row * NQKV + colb + F.lane * 8;
        const v4u w = *(const v4u*)p;
        float v[8] = {bflo(w.x), bfhi(w.x), bflo(w.y), bfhi(w.y), bflo(w.z), bfhi(w.z), bflo(w.w), bfhi(w.w)};
        float ss = 0.f;
#pragma unroll
        for (int i = 0; i < 8; ++i) ss += v[i] * v[i];
        ss += __shfl_xor(ss, 1); ss += __shfl_xor(ss, 2); ss += __shfl_xor(ss, 4);
        const float rstd = 1.0f / sqrtf(ss * (1.f / 64.f) + NORM_EPS);
        const f32x4 n0 = *(const f32x4*)nw, n1 = *(const f32x4*)(nw + 4);
        v[0] *= rstd * n0.x; v[1] *= rstd * n0.y; v[2] *= rstd * n0.z; v[3] *= rstd * n0.w; v[4] *= rstd * n1.x; v[5] *= rstd * n1.y; v[6] *= rstd * n1.z; v[7] *= rstd * n1.w;
        if (g < 2 && row < TT) {
            const int s = row & (SEQ - 1), prow = s >> 6, pcol = s & 63, half = j >> 2, isx2 = (j >> 1) & 1;
            const float* ct = tab + (half ? TB_CCOS + pcol * 16 : TB_RCOS + prow * 16) + 8 * (j & 1);
            const float* st = tab + (half ? TB_CSIN + pcol * 16 : TB_RSIN + prow * 16) + 8 * (j & 1);
            const f32x4 c0 = *(const f32x4*)ct, c1 = *(const f32x4*)(ct + 4), s0 = *(const f32x4*)st, s1 = *(const f32x4*)(st + 4);
            const float cc[8] = {c0.x, c0.y, c0.z, c0.w, c1.x, c1.y, c1.z, c1.w}, sn[8] = {s0.x, s0.y, s0.z, s0.w, s1.x, s1.y, s1.z, s1.w};
#pragma unroll
            for (int i = 0; i < 8; ++i) { const float pr = __shfl_xor(v[i], 2); v[i] = isx2 ? (v[i] * cc[i] + pr * sn[i]) : (v[i] * cc[i] - pr * sn[i]); }
        }
        if (g == 0 || g == 2) {
#pragma unroll
            for (int i = 0; i < 8; ++i) v[i] *= att::C2;
        }
        v4u o; o.x = pk2(v[0], v[1]); o.y = pk2(v[2], v[3]); o.z = pk2(v[4], v[5]); o.w = pk2(v[6], v[7]);
        *(v4u*)p = o;
    }
}

__device__ __forceinline__ void p4_attention(Frame& F, char* lds) {
    const bf16* P = (const bf16*)(F.ws + WS_P); bf16* OD = (bf16*)(F.ws + WS_OD); bf16* ON = (bf16*)(F.ws + WS_ON);
    const float* tab = (const float*)(F.ws + WS_TAB); const float mref_d = tab[TB_LAM + 1], mref_n = tab[TB_LAM + 2];
#ifndef MK_NO_DIFF
#define DIFF_UNITS(SH) for (int unit = F.vcu; unit < 1024; unit += F.G) { \
        const int bhm = unit >> 5, qb = unit & 31, b = bhm >> 3, h = (bhm >> 1) & 3, m = bhm & 1; \
        att::DiffPol<SH> pol; pol.Kg = P + 512 + h * 128 + m * 64; pol.Vg = P + 1024 + h * 128; pol.lat0 = (long)b * SEQ; pol.ctx0 = (long)TT + b * CTX; pol.mref = mref_d; \
        att::attn_unit<4, att::DiffPol<SH> >(P + ((size_t)b * SEQ + qb * 256) * NQKV + h * 128 + m * 64, pol, OD + ((size_t)b * SEQ + qb * 256) * 1024 + h * 256 + m * 128, 1024, 132, mref_d, lds); }
    if (mref_d <= 100.0f) { DIFF_UNITS(false) } else { DIFF_UNITS(true) }
#undef DIFF_UNITS
#endif
#ifndef MK_NO_NA
    float* tabl = (float*)(lds + att::lds_bytes<4>());
    for (int unit = F.vcu; unit < 1024; unit += F.G) {
        const int bh = unit >> 5, rb = unit & 31, b = bh >> 3, hn = bh & 7, r = rb * 4;
        for (int i = F.tid; i < 15 * 31; i += 512) tabl[i] = F.in[I_RPB][hn * 465 + i] * 1.4426950408889634f - mref_n;
        att::NaPol pol; pol.Kg = P + 2048 + hn * 64; pol.Vg = P + 2560 + hn * 64; pol.lat0 = (long)b * SEQ; pol.ctx0 = (long)TT + b * CTX;
        pol.mref = mref_n; pol.r = r; pol.rbase = (r - 4) < 0 ? 0 : ((r - 4) > 120 ? 120 : (r - 4)); pol.tab = tabl;
        att::attn_unit<2, att::NaPol>(P + ((size_t)b * SEQ + r * 64) * NQKV + 1536 + hn * 64, pol, ON + ((size_t)b * SEQ + r * 64) * 512 + hn * 64, 512, 16, mref_n, lds);
    }
#endif
}

__device__ __forceinline__ void p5_mix(Frame& F) {
    const float* tab = (const float*)(F.ws + WS_TAB); const bf16* OD = (const bf16*)(F.ws + WS_OD); const bf16* ON = (const bf16*)(F.ws + WS_ON); bf16* MX = (bf16*)(F.ws + WS_MIX);
    const int gw = F.vcu * NWAVES + F.wave, NGW = F.G * NWAVES;
    const float lam = tab[TB_LAM];
    const int h = F.lane >> 4, e0 = (F.lane & 15) * 8;
    const f32x4 sl0 = *(const f32x4*)(F.in[I_SUBLN] + e0), sl1 = *(const f32x4*)(F.in[I_SUBLN] + e0 + 4);
    const f32x4 on0 = *(const f32x4*)(F.in[I_ONN] + F.lane * 8), on1 = *(const f32x4*)(F.in[I_ONN] + F.lane * 8 + 4);
    for (int t = gw; t < TT; t += NGW) {
        const v4u a = *(const v4u*)(OD + (size_t)t * 1024 + h * 256 + e0), c = *(const v4u*)(OD + (size_t)t * 1024 + h * 256 + 128 + e0);
        const v4u n = *(const v4u*)(ON + (size_t)t * 512 + F.lane * 8);
        float d[8] = {bflo(a.x) - lam * bflo(c.x), bfhi(a.x) - lam * bfhi(c.x), bflo(a.y) - lam * bflo(c.y), bfhi(a.y) - lam * bfhi(c.y),
                      bflo(a.z) - lam * bflo(c.z), bfhi(a.z) - lam * bfhi(c.z), bflo(a.w) - lam * bflo(c.w), bfhi(a.w) - lam * bfhi(c.w)};
        float ss = 0.f;
#pragma unroll
        for (int i = 0; i < 8; ++i) ss += d[i] * d[i];
        ss += __shfl_xor(ss, 1); ss += __shfl_xor(ss, 2); ss += __shfl_xor(ss, 4); ss += __shfl_xor(ss, 8);
        const float rs = 0.8f / sqrtf(ss * (1.f / 128.f) + NORM_EPS);
        v4u o; o.x = pk2(d[0] * rs * sl0.x, d[1] * rs * sl0.y); o.y = pk2(d[2] * rs * sl0.z, d[3] * rs * sl0.w); o.z = pk2(d[4] * rs * sl1.x, d[5] * rs * sl1.y); o.w = pk2(d[6] * rs * sl1.z, d[7] * rs * sl1.w);
        *(v4u*)(MX + (size_t)t * 1024 + h * 128 + e0) = o;
        float q[8] = {bflo(n.x), bfhi(n.x), bflo(n.y), bfhi(n.y), bflo(n.z), bfhi(n.z), bflo(n.w), bfhi(n.w)};
        float s2 = 0.f;
#pragma unroll
        for (int i = 0; i < 8; ++i) s2 += q[i] * q[i];
        s2 += __shfl_xor(s2, 1); s2 += __shfl_xor(s2, 2); s2 += __shfl_xor(s2, 4);
        const float r2 = 1.0f / sqrtf(s2 * (1.f / 64.f) + NORM_EPS);
        v4u o2; o2.x = pk2(q[0] * r2 * on0.x, q[1] * r2 * on0.y); o2.y = pk2(q[2] * r2 * on0.z, q[3] * r2 * on0.w); o2.z = pk2(q[4] * r2 * on1.x, q[5] * r2 * on1.y); o2.w = pk2(q[6] * r2 * on1.z, q[7] * r2 * on1.w);
        *(v4u*)(MX + (size_t)t * 1024 + 512 + F.lane * 8) = o2;
    }
}

__device__ __forceinline__ void p7_router(Frame& F) {
    const float* tab = (const float*)(F.ws + WS_TAB); unsigned* cnt = (unsigned*)(F.ws + WS_CTL) + CW_CNT;
    int* rt_e = (int*)(F.ws + WS_RT + RT_E); float* rt_g = (float*)(F.ws + WS_RT + RT_G); int* rt_pos = (int*)(F.ws + WS_RT + RT_POS);
    LAS unsigned* cntl = (LAS unsigned*)(F.lds + MISC_OFF); LAS unsigned* basel = cntl + 32;
    const int j = F.lane & 31, kh = F.lane >> 5;
    for (int tile = F.vcu; tile < TT / 128; tile += F.G) {
        if (F.tid < 32) cntl[F.tid] = 0u;
        __syncthreads();
        int te[4] = {0, 0, 0, 0}; float tg[4] = {0, 0, 0, 0}; unsigned lp[4] = {0, 0, 0, 0}; const int t = tile * 128 + 32 * F.wave + j;
        if (F.wave < 4) {
            const int b = t >> 13;
            const float* xr = F.out + (size_t)t * DM + 4 * kh;
            const float* wp = tab + TB_WR + (size_t)b * 32768 + (4 * kh) * 32 + j;
            f32x16 acc = f32x16{}; float ss = 0.f;
#pragma unroll 4
            for (int u = 0; u < 128; ++u) {
                const f32x4 xv = *(const f32x4*)(xr + 8 * u);
                const float w0 = wp[(8 * u + 0) * 32], w1 = wp[(8 * u + 1) * 32], w2 = wp[(8 * u + 2) * 32], w3 = wp[(8 * u + 3) * 32];
                ss += (xv.x * xv.x + xv.y * xv.y) + (xv.z * xv.z + xv.w * xv.w);
                acc = __builtin_amdgcn_mfma_f32_32x32x2f32(w0, xv.x, acc, 0, 0, 0);
                acc = __builtin_amdgcn_mfma_f32_32x32x2f32(w1, xv.y, acc, 0, 0, 0);
                acc = __builtin_amdgcn_mfma_f32_32x32x2f32(w2, xv.z, acc, 0, 0, 0);
                acc = __builtin_amdgcn_mfma_f32_32x32x2f32(w3, xv.w, acc, 0, 0, 0);
            }
            ss += __shfl_xor(ss, 32);
            const float rstd = 1.0f / sqrtf(ss * (1.f / DM) + NORM_EPS);
            float v[16];
#pragma unroll
            for (int r = 0; r < 16; ++r) v[r] = acc[r] * rstd + tab[TB_RC + b * 32 + att::crow(r, kh)];
            float cv[8]; int ce[8];
#pragma unroll
            for (int k = 0; k < 4; ++k) { float best = -INFINITY; int bi = 0;
#pragma unroll
                for (int r = 0; r < 16; ++r) if (v[r] > best) { best = v[r]; bi = r; }
#pragma unroll
                for (int r = 0; r < 16; ++r) if (r == bi) v[r] = -INFINITY;
                cv[k] = best; ce[k] = att::crow(bi, kh); }
#pragma unroll
            for (int k = 0; k < 4; ++k) { cv[4 + k] = __shfl_xor(cv[k], 32); ce[4 + k] = __shfl_xor(ce[k], 32); }
            float tv[4];
#pragma unroll
            for (int k = 0; k < 4; ++k) { float best = -INFINITY; int be = 1 << 30, bi = 0;
#pragma unroll
                for (int q = 0; q < 8; ++q) if (cv[q] > best || (cv[q] == best && ce[q] < be)) { best = cv[q]; be = ce[q]; bi = q; }
#pragma unroll
                for (int q = 0; q < 8; ++q) if (q == bi) cv[q] = -INFINITY;
                tv[k] = best; te[k] = be; }
            const float e1 = __expf(tv[1] - tv[0]), e2 = __expf(tv[2] - tv[0]), e3 = __expf(tv[3] - tv[0]); const float inv = 1.0f / (1.0f + e1 + e2 + e3);
            tg[0] = inv; tg[1] = e1 * inv; tg[2] = e2 * inv; tg[3] = e3 * inv;
            if (kh == 0) {
#pragma unroll
                for (int k = 0; k < 4; ++k) lp[k] = __hip_atomic_fetch_add(cntl + te[k], 1u, __ATOMIC_RELAXED, __HIP_MEMORY_SCOPE_WORKGROUP);
            }
        }
        __syncthreads();
        if (F.tid < 32) { const unsigned c = cntl[F.tid]; basel[F.tid] = c ? atomicAdd(cnt + F.tid, c) : 0u; }
        __syncthreads();
        if (F.wave < 4 && kh == 0) {
#pragma unroll
            for (int k = 0; k < 4; ++k) { rt_e[t * 4 + k] = te[k]; rt_g[t * 4 + k] = tg[k]; rt_pos[t * 4 + k] = (int)(basel[te[k]] + lp[k]); }
        }
        __syncthreads();
    }
}

__device__ __forceinline__ int pad_starts(const unsigned* cnt, int lane) {
    const int c = lane < 32 ? (int)__hip_atomic_load(cnt + lane, __ATOMIC_RELAXED, __HIP_MEMORY_SCOPE_AGENT) : 0;
    int p = (c + 255) & ~255, incl = p;
#pragma unroll
    for (int o = 1; o < 64; o <<= 1) { const int n = __shfl_up(incl, o); if (lane >= o) incl += n; }
    return incl - p;
}

__device__ __forceinline__ void p8_scatter(Frame& F) {
    const float* tab = (const float*)(F.ws + WS_TAB); const unsigned* cnt = (const unsigned*)(F.ws + WS_CTL) + CW_CNT;
    const int* rt_e = (const int*)(F.ws + WS_RT + RT_E); const int* rt_pos = (const int*)(F.ws + WS_RT + RT_POS); int* rt_slot = (int*)(F.ws + WS_RT + RT_SLOT);
    bf16* XG = (bf16*)(F.ws + WS_XG);
    const int gw = F.vcu * NWAVES + F.wave, NGW = F.G * NWAVES;
    const int pst = pad_starts(cnt, F.lane);
    const f32x4* gf = (const f32x4*)F.in[I_GFFN] + F.lane;
    for (int t = gw; t < TT; t += NGW) {
        const int b = t >> 13;
        const f32x4* xr = (const f32x4*)(F.out + (size_t)t * DM) + F.lane;
        const f32x4* sh = (const f32x4*)(tab + TB_MOD + b * 6144 + 3 * 1024) + F.lane; const f32x4* sc = (const f32x4*)(tab + TB_MOD + b * 6144 + 4 * 1024) + F.lane;
        f32x4 v[4]; float s = 0.f;
#pragma unroll
        for (int jj = 0; jj < 4; ++jj) { v[jj] = xr[64 * jj]; s += (v[jj].x * v[jj].x + v[jj].y * v[jj].y) + (v[jj].z * v[jj].z + v[jj].w * v[jj].w); }
        const float rstd = 1.0f / sqrtf(wave_sum(s) * (1.f / DM) + NORM_EPS);
        unsigned long long pk[4];
#pragma unroll
        for (int jj = 0; jj < 4; ++jj) { const f32x4 g = gf[64 * jj], a = sc[64 * jj], c = sh[64 * jj]; const f32x4 h = (v[jj] * rstd) * g * (a + 1.0f) + c;
            pk[jj] = (unsigned long long)pk2(h.x, h.y) | ((unsigned long long)pk2(h.z, h.w) << 32); }
        const int my_e = rt_e[t * 4 + (F.lane & 3)], my_pos = rt_pos[t * 4 + (F.lane & 3)];
#pragma unroll
        for (int k = 0; k < 4; ++k) { const int e = __shfl(my_e, k), pos = __shfl(my_pos, k); const int slot = __shfl(pst, e) + pos;
            unsigned long long* o8 = (unsigned long long*)(XG + (size_t)slot * DM) + F.lane;
#pragma unroll
            for (int jj = 0; jj < 4; ++jj) o8[64 * jj] = pk[jj];
            if (F.lane == 0) rt_slot[t * 4 + k] = slot; }
    }
}

__device__ __forceinline__ int moe_block_table(Frame& F, LAS int* bexp) {
    const unsigned* cnt = (const unsigned*)(F.ws + WS_CTL) + CW_CNT;
    const int pst = pad_starts(cnt, F.lane);
    const int total = __shfl(pst, 32) >> 8;
    if (F.wave == 0) {
        const int nxt = __shfl_down(pst, 1);
        if (F.lane < 32) for (int bl = pst >> 8; bl < (nxt >> 8); ++bl) bexp[bl] = F.lane;
    }
    __syncthreads();
    return __builtin_amdgcn_readfirstlane(total);
}

__device__ __forceinline__ void p11_combine(Frame& F) {
    const float* tab = (const float*)(F.ws + WS_TAB); const bf16* Y = (const bf16*)(F.ws + WS_Y);
    const float* rt_g = (const float*)(F.ws + WS_RT + RT_G); const int* rt_slot = (const int*)(F.ws + WS_RT + RT_SLOT);
    const int gw = F.vcu * NWAVES + F.wave, NGW = F.G * NWAVES;
    for (int t = gw; t < TT; t += NGW) {
        const int b = t >> 13;
        f32x4* xr = (f32x4*)(F.out + (size_t)t * DM) + F.lane;
        const f32x4* g2 = (const f32x4*)(tab + TB_MOD + b * 6144 + 5 * 1024) + F.lane;
        f32x4 acc[4];
#pragma unroll
        for (int jj = 0; jj < 4; ++jj) acc[jj] = (f32x4){0.f, 0.f, 0.f, 0.f};
        const int my_slot = rt_slot[t * 4 + (F.lane & 3)]; const float my_g = rt_g[t * 4 + (F.lane & 3)];
#pragma unroll
        for (int k = 0; k < 4; ++k) { const int slot = __shfl(my_slot, k); const float g = __shfl(my_g, k);
            const v2u* yr = (const v2u*)(Y + (size_t)slot * DM) + F.lane;
#pragma unroll
            for (int jj = 0; jj < 4; ++jj) { const v2u w = yr[64 * jj]; acc[jj] += (f32x4){bflo(w.x), bfhi(w.x), bflo(w.y), bfhi(w.y)} * g; } }
#pragma unroll
        for (int jj = 0; jj < 4; ++jj) xr[64 * jj] = xr[64 * jj] + g2[64 * jj] * acc[jj];
#ifdef MK_DBG_ATT
        if (t == 0 && F.lane == 0) { const float* dbg = tab + TB_RC + 128; F.out[0] += 8.0f + 120.0f * (dbg[0] / dbg[1]); }
#endif
    }
}

#define XB_TMO      128
#define XB_XCNT(j)  (256  + 64 * (j))
#define XB_XSUB(j)  (1280 + 64 * (j))
#define XB_XGEN(j)  (2304 + 64 * (j))
#define XB_TOP      3328
#define XB_TOPGEN   3392
#define XCD_BAR_WORDS 3456
#define XB_SPIN_CAP (1u << 18)

__device__ __forceinline__ unsigned xb_ld(unsigned* p)              { return __hip_atomic_load(p, __ATOMIC_RELAXED, __HIP_MEMORY_SCOPE_AGENT); }
__device__ __forceinline__ unsigned xb_add(unsigned* p, unsigned v) { return __hip_atomic_fetch_add(p, v, __ATOMIC_RELAXED, __HIP_MEMORY_SCOPE_AGENT); }
__device__ __forceinline__ unsigned xb_xcc_id() { return (unsigned)__builtin_amdgcn_s_getreg((3 << 11) | 20) & 0xFu; }
#define XB_SPIN(cond, bar) do { unsigned _sp = 0; while (cond) { __builtin_amdgcn_s_sleep(1); \
    if ((++_sp & 255u) == 0u) { if (xb_ld(&(bar)[XB_TMO])) break; if (_sp > XB_SPIN_CAP) { atomicAdd(&(bar)[XB_TMO], 1u); break; } } } } while (0)

struct XcdBarrier {
    unsigned* bar; unsigned x;
    volatile LAS unsigned* st;
};

__device__ __forceinline__ XcdBarrier xcd_barrier_post(unsigned* bar, volatile LAS unsigned* st) {
    XcdBarrier b; b.bar = bar; b.x = xb_xcc_id(); b.st = st;
    if (threadIdx.x == 0) (void)xb_add(&bar[XB_XCNT(b.x)], 1u);
    return b;
}
__device__ __forceinline__ void xcd_barrier_complete(unsigned* bar, unsigned x, unsigned& nloc, unsigned& nx) {
    const unsigned G = gridDim.x * gridDim.y * gridDim.z;
    unsigned sum, cnt, mine, sp = 0u;
    for (;;) {
        sum = 0u; cnt = 0u; mine = 0u;
#pragma unroll
        for (unsigned j = 0; j < 16; ++j) { const unsigned c = xb_ld(&bar[XB_XCNT(j)]); sum += c; cnt += (c > 0u) ? 1u : 0u; mine = (j == x) ? c : mine; }
        if (sum == G) break;
        __builtin_amdgcn_s_sleep(1);
        if ((++sp & 255u) == 0u) { if (xb_ld(&bar[XB_TMO])) break; if (sp > XB_SPIN_CAP) { atomicAdd(&bar[XB_TMO], 1u); break; } }
    }
    nloc = mine > 0u ? mine : 1u; nx = cnt > 0u ? cnt : 1u;
}

__device__ __forceinline__ void xcd_barrier(const XcdBarrier& b) {
    asm volatile("s_waitcnt vmcnt(0)" ::: "memory");
    __syncthreads();
    if (threadIdx.x == 0) {
        unsigned* bar = b.bar;
        __builtin_amdgcn_s_waitcnt(0);
        unsigned nloc = b.st[0], nx = b.st[1];
        if (nloc == 0u) { xcd_barrier_complete(bar, b.x, nloc, nx); b.st[0] = nloc; b.st[1] = nx; }
        const unsigned old = xb_add(&bar[XB_XSUB(b.x)], 1u);
        const unsigned gen = old / nloc;
        if (old + 1u == (gen + 1u) * nloc) {
            __builtin_amdgcn_fence(__ATOMIC_RELEASE, "agent");
            asm volatile("s_waitcnt vmcnt(0)" ::: "memory");
            const unsigned og = xb_add(&bar[XB_TOP], 1u);
            const unsigned tg = og / nx;
            if (og + 1u == (tg + 1u) * nx) xb_add(&bar[XB_TOPGEN], 1u);
            else XB_SPIN(xb_ld(&bar[XB_TOPGEN]) == tg, bar);
            __builtin_amdgcn_fence(__ATOMIC_ACQUIRE, "agent");
            xb_add(&bar[XB_XGEN(b.x)], 1u);
            asm volatile("s_waitcnt vmcnt(0)" ::: "memory");
        } else {
            XB_SPIN(xb_ld(&bar[XB_XGEN(b.x)]) == gen, bar);
            __builtin_amdgcn_fence(__ATOMIC_ACQUIRE, "agent");
            asm volatile("s_waitcnt vmcnt(0)" ::: "memory");
        }
    }
    __syncthreads();
}

struct Args { const float* in[N_IN]; float* out; unsigned char* ws; int ph_lo, ph_hi, li, pad; };
__global__ void __launch_bounds__(NWAVES * 64, 2) mk_fwd(Args args) {
    extern __shared__ __attribute__((aligned(16))) unsigned char lds[];
    Frame F;
    F.lds = (LAS unsigned char*)lds;
    F.tid = threadIdx.x; F.lane = F.tid & 63; F.wave = __builtin_amdgcn_readfirstlane(F.tid >> 6);
    F.G = gridDim.x; { const int bx = blockIdx.x; F.vcu = (F.G % 8 == 0) ? (bx % 8) * (F.G / 8) + bx / 8 : bx; }
#pragma unroll
    for (int i = 0; i < N_IN; ++i) F.in[i] = args.in[i];
    F.out = args.out; F.ws = args.ws;
    const int lo = args.ph_lo, hi = args.ph_hi;
    volatile LAS unsigned* bst = (volatile LAS unsigned*)(F.lds + MISC_OFF + 4096);
    if (F.tid < 2) bst[F.tid] = 0u;
    __syncthreads();
    XcdBarrier bar; bar.bar = (unsigned*)(F.ws + WS_CTL) + CW_BAR + args.li * XCD_BAR_WORDS; bar.x = 0; bar.st = nullptr;
    if (hi - lo > 1) bar = xcd_barrier_post((unsigned*)(F.ws + WS_CTL) + CW_BAR + args.li * XCD_BAR_WORDS, bst);
#ifndef MK_PHASE_MASK
#define MK_PHASE_MASK 0xFFF
#endif
#define IN(k) (((MK_PHASE_MASK >> (k)) & 1) && lo <= (k) && (k) < hi)
#define SEAM(k) do { if (IN(k) && IN((k) + 1)) { if ((k) == 0) cg::this_grid().sync(); else xcd_barrier(bar); } } while (0)
    if (IN(0)) { p0_prologue(F); } SEAM(0);
    if (IN(1)) { p1_norm(F); } SEAM(1);
    if (IN(2)) {
        pg8::Gemm g{(const bf16*)(F.ws + WS_XN), (const bf16*)(F.ws + WS_WQKV), MQ, NQKV, DM, 0};
        pg8::StaticOrder S; S.init(MQ, NQKV, F.G, (int)blockIdx.x);
        pg8::EpiBf16<0> E{(bf16*)(F.ws + WS_P), NQKV, nullptr, 0, 0, 1.f};
        pg8::gemm_phase<pg8::EpiBf16<0>, pg8::StaticOrder, true, true>(F.lds, g, S, E);
    } SEAM(2);
    if (IN(3)) { p3_qknorm(F); } SEAM(3);
    if (IN(4)) { p4_attention(F, (char*)lds); } SEAM(4);
    if (IN(5)) { p5_mix(F); } SEAM(5);
    if (IN(6)) {
        pg8::Gemm g{(const bf16*)(F.ws + WS_MIX), (const bf16*)(F.ws + WS_WO), TT, DM, DM, 0};
        pg8::StaticOrder S; S.init(TT, DM, F.G, (int)blockIdx.x);
        pg8::EpiOut E{F.in[I_X], F.out, (const float*)(F.ws + WS_TAB) + TB_MOD};
        pg8::gemm_phase<pg8::EpiOut, pg8::StaticOrder, true, true>(F.lds, g, S, E);
    } SEAM(6);
    if (IN(7)) { p7_router(F); } SEAM(7);
    if (IN(8)) { p8_scatter(F); } SEAM(8);
    if (IN(9)) {
        LAS int* bexp = (LAS int*)(F.lds + MISC_OFF + 1024);
        const int nblk = moe_block_table(F, bexp);
        pg8::Gemm g{(const bf16*)(F.ws + WS_XG), (const bf16*)(F.ws + WS_WGU), MPAD, 2048, DM, (size_t)2048 * 1024 * 2};
        pg8::MoeOrder S; S.init(nblk, 8, F.G, (int)blockIdx.x, bexp);
        pg8::EpiSwiGLU E{(bf16*)(F.ws + WS_ACT), F.in[I_BGU]};
        pg8::gemm_phase<pg8::EpiSwiGLU, pg8::MoeOrder, true, true>(F.lds, g, S, E);
    } SEAM(9);
    if (IN(10)) {
        LAS int* bexp = (LAS int*)(F.lds + MISC_OFF + 1024);
        const int nblk = moe_block_table(F, bexp);
        pg8::Gemm g{(const bf16*)(F.ws + WS_ACT), (const bf16*)(F.ws + WS_WDN), MPAD, 1024, DM, (size_t)1024 * 1024 * 2};
        pg8::MoeOrder S; S.init(nblk, 4, F.G, (int)blockIdx.x, bexp);
        pg8::EpiDown E{(bf16*)(F.ws + WS_Y), F.in[I_BD]};
        pg8::gemm_phase<pg8::EpiDown, pg8::MoeOrder, true, true>(F.lds, g, S, E);
    } SEAM(10);
    if (IN(11)) { p11_combine(F); }
#undef IN
#undef SEAM
}

extern "C" void kernel_launch(void* const* d_in, const int* in_sizes, int n_in, void* d_out, int out_size, void* d_ws, size_t ws_size, hipStream_t stream) {
    static int grid = 0;
    if (grid == 0) {
        if (n_in != N_IN || in_sizes[0] != TT * DM || out_size != TT * DM || ws_size < WS_END) { fprintf(stderr, "kernel_launch: unexpected shapes (n_in %d, in0 %d, out %d, ws %zu)\n", n_in, n_in > 0 ? in_sizes[0] : -1, out_size, ws_size); grid = -1; return; }
        int dev = 0, cus = 0, per_cu = 0;
        if (hipGetDevice(&dev) != hipSuccess || hipDeviceGetAttribute(&cus, hipDeviceAttributeMultiprocessorCount, dev) != hipSuccess) { grid = -1; return; }
        if (hipFuncSetAttribute((const void*)mk_fwd, hipFuncAttributeMaxDynamicSharedMemorySize, LDS_BYTES) != hipSuccess) { fprintf(stderr, "kernel_launch: hipFuncSetAttribute failed\n"); grid = -1; return; }
        if (hipOccupancyMaxActiveBlocksPerMultiprocessor(&per_cu, (const void*)mk_fwd, NWAVES * 64, LDS_BYTES) != hipSuccess || per_cu < 1) { fprintf(stderr, "kernel_launch: occupancy query reports %d\n", per_cu); (void)hipGetLastError(); per_cu = 1; }
        grid = cus;
    }
    if (grid < 0) return;
    (void)hipMemsetAsync((char*)d_ws + WS_CTL, 0, CTL_ZERO_BYTES, stream);
    Args a{};
    for (int i = 0; i < N_IN; ++i) a.in[i] = (const float*)d_in[i];
    a.out = (float*)d_out; a.ws = (unsigned char*)d_ws;
    int lo_[3] = {0, 0, 0}, hi_[3] = {N_PHASES, 0, 0}, nl = 1;
    if (MK_PROBE_PHASE >= 0) { nl = 0; lo_[nl] = 0; hi_[nl] = MK_PROBE_PHASE + 1; ++nl; lo_[nl] = MK_PROBE_PHASE; hi_[nl] = MK_PROBE_PHASE + 1; ++nl; if (MK_PROBE_PHASE + 1 < N_PHASES) { lo_[nl] = MK_PROBE_PHASE + 1; hi_[nl] = N_PHASES; ++nl; } }
    for (int li = 0; li < nl; ++li) {
        a.ph_lo = lo_[li]; a.ph_hi = hi_[li]; a.li = li;
        void* params[] = {&a};
        const hipError_t e = hipLaunchCooperativeKernel((const void*)mk_fwd, dim3(grid), dim3(NWAVES * 64), params, LDS_BYTES, stream);
        if (e != hipSuccess) fprintf(stderr, "kernel_launch: cooperative launch failed: %s (grid %d)\n", hipGetErrorString(e), grid);
    }
}
```

```cpp
#include <hip/hip_runtime.h>
#include <hip/hip_cooperative_groups.h>
#include <cstdio>
#include <cstdint>
namespace cg = cooperative_groups;
namespace pg8 {
#define PG8_LAS __attribute__((address_space(3)))
typedef unsigned short bf16_t;
typedef short bf16x8 __attribute__((ext_vector_type(8)));
typedef float f32x4 __attribute__((ext_vector_type(4)));
typedef unsigned u32x4 __attribute__((ext_vector_type(4)));
constexpr int BM = 256, BK = 64, HALF = 128, HTB = HALF * BK * 2  , STAGE_BYTES = 8 * HTB, NXCD = 8, WGM = 8;

__host__ __device__ __forceinline__ int lds_byte(int r, int c) { const int st = (r >> 4) * 2 + (c >> 5), rr = r & 15, cc = c & 31, ob = rr * 64 + cc * 2; return st * 1024 + (ob ^ (((ob >> 9) & 1) << 5)); }
__host__ __device__ __forceinline__ void stage_rc(int b, int& R, int& C) { const int st = b / 1024, sb = b % 1024, swz = sb ^ (((sb >> 9) & 1) << 5); R = (st >> 1) * 16 + swz / 64; C = (st & 1) * 32 + (swz % 64) / 2; }
__host__ __device__ __forceinline__ int perm32(int rho) { const int n = rho >> 4, i = rho & 15; return 8 * (i >> 2) + 4 * n + (i & 3); }

struct Unit { int pm, pn, e; };
struct Gemm { const bf16_t* A; const bf16_t* Bt; int M, N, K; size_t estride; };

struct StaticOrder {
    int nM, nN, nwg, G, c;
    __host__ __device__ void init(int M, int N, int G_, int c_) { nM = M / BM; nN = N / BM; nwg = nM * nN; G = G_; c = c_; }
    __host__ __device__ bool next(int i, Unit& u) const {
        const long L = (long)i * G + c; if (L >= nwg) return false;
        int wgid = (int)L; { const int q = nwg / NXCD, r = nwg % NXCD, xcd = wgid % NXCD, off = wgid / NXCD; wgid = (xcd < r ? xcd * (q + 1) : r * (q + 1) + (xcd - r) * q) + off; }
        const int nig = WGM * nN, gid = wgid / nig, fm = gid * WGM, gsz = (nM - fm) < WGM ? (nM - fm) : WGM;
        u.pm = fm + ((wgid % nig) % gsz); u.pn = (wgid % nig) / gsz; u.e = 0; return true;
    }
    __device__ __forceinline__ void a_ready(const Unit&) const {}
    __device__ __forceinline__ void done(const Unit&) const {}
};

__device__ __forceinline__ unsigned cvt_pk_bf16(float lo, float hi) { unsigned r; asm volatile("v_cvt_pk_bf16_f32 %0, %1, %2" : "=v"(r) : "v"(lo), "v"(hi)); return r; }
typedef float f32x2 __attribute__((ext_vector_type(2)));
__device__ __forceinline__ f32x2 gelu_pk(f32x2 v) {
    const f32x2 av = __builtin_elementwise_abs(v), d = av * 0.2316418882f + 1.0f;
    f32x2 t; t.x = __builtin_amdgcn_rcpf(d.x); t.y = __builtin_amdgcn_rcpf(d.y);
    f32x2 q = t * 0.5307027145f + (-0.7265760135f); q = q * t + 0.7107068705f; q = q * t + (-0.142248368f); q = q * t + 0.127414796f; q = q * t;
    const f32x2 s = (v * v) * (-0.72134752044f);
    f32x2 e; e.x = __builtin_amdgcn_exp2f(s.x); e.y = __builtin_amdgcn_exp2f(s.y);
    const f32x2 m = v * (q * e), r = v - m;
    f32x2 o; o.x = v.x < 0.f ? m.x : r.x; o.y = v.y < 0.f ? m.y : r.y; return o;
}

template <int ACT  > struct EpiBf16 {
    static constexpr bool PERM = true, AFTER_DRAIN = false; static_assert(ACT == 0 || ACT == 1, "EpiBf16: ACT is 0 (none) or 1 (gelu_pk)");
    bf16_t* O; int ldc; const float* bias; int split_cols; size_t split_stride; float scale0;
    __device__ __forceinline__ void operator()(const f32x4 (&acc)[2][2][4][2], const Unit& u, int wr, int wc, int fr, int fq) const {
        const int row0 = u.pm * BM + wr * 64 + fr; int colt = u.pn * BM; bf16_t* base = O;
        float sc = 1.f; if (split_cols) { const int t = colt / split_cols; base += (size_t)t * split_stride; colt -= t * split_cols; if (t == 0) sc = scale0; }
        const int col0 = colt + wc * 32 + 8 * fq, bcol0 = u.pn * BM + wc * 32 + 8 * fq;
        f32x4 bv[2][2];
#pragma unroll
        for (int bj = 0; bj < 2; ++bj)
#pragma unroll
            for (int n = 0; n < 2; ++n) bv[bj][n] = bias ? *(const f32x4*)(bias + bcol0 + bj * HALF + 4 * n) : (f32x4){0.f, 0.f, 0.f, 0.f};
#pragma unroll
        for (int ai = 0; ai < 2; ++ai)
#pragma unroll
            for (int m = 0; m < 4; ++m) { bf16_t* rowp = base + (size_t)(row0 + ai * HALF + m * 16) * ldc + col0;
#pragma unroll
                for (int bj = 0; bj < 2; ++bj) { f32x4 v0 = acc[ai][bj][m][0] + bv[bj][0], v1 = acc[ai][bj][m][1] + bv[bj][1];
                    if (ACT == 1) { f32x2 a = gelu_pk((f32x2){v0[0], v0[1]}), b = gelu_pk((f32x2){v0[2], v0[3]}), c = gelu_pk((f32x2){v1[0], v1[1]}), d = gelu_pk((f32x2){v1[2], v1[3]});
                        v0 = (f32x4){a.x, a.y, b.x, b.y}; v1 = (f32x4){c.x, c.y, d.x, d.y}; }
                    v0 = v0 * sc; v1 = v1 * sc; u32x4 w; w.x = cvt_pk_bf16(v0[0], v0[1]); w.y = cvt_pk_bf16(v0[2], v0[3]); w.z = cvt_pk_bf16(v1[0], v1[1]); w.w = cvt_pk_bf16(v1[2], v1[3]);
                    *(u32x4*)(rowp + bj * HALF) = w; } }
    }
};

typedef int i32x4 __attribute__((ext_vector_type(4)));
typedef int i32x8 __attribute__((ext_vector_type(8)));
__device__ __forceinline__ i32x8 cat8(bf16x8 lo, bf16x8 hi) { const i32x4 a = __builtin_bit_cast(i32x4, lo), b = __builtin_bit_cast(i32x4, hi); return __builtin_shufflevector(a, b, 0, 1, 2, 3, 4, 5, 6, 7); }
template <class Epi, class Sched, bool ALIGN_EPI = false, bool SP2 = false, int ESZ = 2>
__device__ __forceinline__ void gemm_phase(PG8_LAS unsigned char* lds, const Gemm g, const Sched& S, const Epi& E) {
    const int tid = threadIdx.x, wid = __builtin_amdgcn_readfirstlane(tid >> 6), lane = tid & 63, wr = wid >> 2, wc = wid & 3, fr = lane & 15, fq = lane >> 4;
    const int K = g.K, nt = K * ESZ / (BK * 2);
    unsigned voffA[2], voffB[2];
#pragma unroll
    for (int i = 0; i < 2; ++i) { int R, C; stage_rc(tid * 16 + i * 8192, R, C); const int Rb = Epi::PERM ? ((R & ~31) + perm32(R & 31)) : R;
        voffA[i] = (unsigned)(R * K * ESZ + C * 2); voffB[i] = (unsigned)(Rb * K * ESZ + C * 2); }
    const size_t kstep = (size_t)(BK * 2);
    const size_t hstep = (size_t)HALF * K * ESZ;
    const size_t tstep = 2 * hstep;
    const unsigned ldsw = (unsigned)wid * 1024u;
    const int aoff = lds_byte(wr * 64 + fr, fq * 8), boff = lds_byte(wc * 32 + fr, fq * 8);
#define PG8_SA(b, h) (((b) * 2 + (h)) * HTB)
#define PG8_SB(b, h) ((4 + (b) * 2 + (h)) * HTB)
#define PG8_STAGE(bufoff, gbase, voff) do { _Pragma("unroll") for (int _i = 0; _i < 2; ++_i) \
        __builtin_amdgcn_global_load_lds((const unsigned*)((const char*)(gbase) + (voff)[_i]), (PG8_LAS unsigned*)(lds + (bufoff) + ldsw + _i * 8192), 16, 0, 0); } while (0)
#define PG8_LDA(dst, b, h) do { _Pragma("unroll") for (int m = 0; m < 4; ++m) _Pragma("unroll") for (int k = 0; k < 2; ++k) dst[m][k] = *(const PG8_LAS bf16x8*)(lds + PG8_SA(b, h) + aoff + m * 2048 + k * 1024); } while (0)
#define PG8_LDB(dst, b, h) do { _Pragma("unroll") for (int n = 0; n < 2; ++n) _Pragma("unroll") for (int k = 0; k < 2; ++k) dst[n][k] = *(const PG8_LAS bf16x8*)(lds + PG8_SB(b, h) + boff + n * 2048 + k * 1024); } while (0)
#define PG8_MMA(ai, bj, At, Bt) do { __builtin_amdgcn_s_setprio(1); _Pragma("unroll") for (int m = 0; m < 4; ++m) _Pragma("unroll") for (int n = 0; n < 2; ++n) { \
        if constexpr (ESZ == 2) { _Pragma("unroll") for (int k = 0; k < 2; ++k) acc[ai][bj][m][n] = __builtin_amdgcn_mfma_f32_16x16x32_bf16(Bt[n][k], At[m][k], acc[ai][bj][m][n], 0, 0, 0); } \
        else { acc[ai][bj][m][n] = __builtin_amdgcn_mfma_scale_f32_16x16x128_f8f6f4(cat8(Bt[n][0], Bt[n][1]), cat8(At[m][0], At[m][1]), acc[ai][bj][m][n], 0, 0, 0, 0x7f7f7f7f, 0, 0x7f7f7f7f); } } \
        if constexpr (ESZ == 1) {   \
            _Pragma("unroll") for (int m = 0; m < 4; ++m) asm volatile("" : "+v"(acc[ai][bj][m][0]), "+v"(acc[ai][bj][m][1])); } \
        __builtin_amdgcn_s_setprio(0); } while (0)
#define PG8_WAIT_V(n) asm volatile("s_waitcnt vmcnt(" #n ")" ::: "memory")
#define PG8_WAIT_L(n) asm volatile("s_waitcnt lgkmcnt(" #n ")" ::: "memory")
#define PG8_BAR __builtin_amdgcn_s_barrier()
#define PG8_SCHED __builtin_amdgcn_sched_barrier(0)
    Unit cur, nxt; int ui = 0;
    if (!S.next(0, cur)) return;
    f32x4 acc[2][2][4][2];
#pragma unroll
    for (int a = 0; a < 2; ++a)
#pragma unroll
        for (int b = 0; b < 2; ++b)
#pragma unroll
            for (int m = 0; m < 4; ++m)
#pragma unroll
                for (int n = 0; n < 2; ++n) acc[a][b][m][n] = (f32x4){0.f, 0.f, 0.f, 0.f};
    bf16x8 At[4][2], B0[2][2], B1[2][2];
    const char* cA = (const char*)g.A + (size_t)cur.pm * tstep; const char* cB = (const char*)g.Bt + (size_t)cur.e * g.estride + (size_t)cur.pn * tstep;
    S.a_ready(cur);
    if constexpr (SP2) {
        PG8_STAGE(PG8_SB(0, 0), cB, voffB); PG8_STAGE(PG8_SB(0, 1), cB + hstep, voffB); PG8_STAGE(PG8_SA(0, 0), cA, voffA); PG8_STAGE(PG8_SA(0, 1), cA + hstep, voffA);
        if (wr == 1) PG8_BAR;
        PG8_WAIT_V(2); PG8_BAR;
        PG8_STAGE(PG8_SB(1, 0), cB + kstep, voffB); PG8_STAGE(PG8_SA(1, 0), cA + kstep, voffA); PG8_STAGE(PG8_SB(1, 1), cB + hstep + kstep, voffB);
        PG8_WAIT_V(6); PG8_BAR;
    } else {
        PG8_STAGE(PG8_SB(0, 0), cB, voffB); PG8_STAGE(PG8_SA(0, 0), cA, voffA); PG8_STAGE(PG8_SB(0, 1), cB + hstep, voffB); PG8_STAGE(PG8_SA(0, 1), cA + hstep, voffA);
        if (wr == 1) PG8_BAR;
        PG8_WAIT_V(4); PG8_BAR;
        PG8_STAGE(PG8_SB(1, 0), cB + kstep, voffB); PG8_STAGE(PG8_SA(1, 0), cA + kstep, voffA); PG8_STAGE(PG8_SB(1, 1), cB + hstep + kstep, voffB);
        PG8_WAIT_V(6); PG8_BAR;
    }
    for (;;) {
        const bool has_next = S.next(ui + 1, nxt);
        const char* nA = has_next ? (const char*)g.A + (size_t)nxt.pm * tstep : cA; const char* nB = has_next ? (const char*)g.Bt + (size_t)nxt.e * g.estride + (size_t)nxt.pn * tstep : cB;
        for (int t = 0; t < nt; t += 2) {
            const bool last = (t == nt - 2);
            const char* a1 = cA + (size_t)(t + 1) * kstep;
            const char* a2 = last ? nA : cA + (size_t)(t + 2) * kstep; const char* b2 = last ? nB : cB + (size_t)(t + 2) * kstep;
            const char* a3 = a2 + kstep; const char* b3 = b2 + kstep;
            if (last && has_next) S.a_ready(nxt);
            if constexpr (SP2) {
            PG8_LDB(B0, 0, 0); PG8_LDB(B1, 0, 1); PG8_SCHED; PG8_LDA(At, 0, 0); PG8_STAGE(PG8_SA(1, 1), a1 + hstep, voffA);
            PG8_WAIT_V(8); PG8_WAIT_L(0); PG8_BAR; PG8_MMA(0, 0, At, B0); PG8_MMA(0, 1, At, B1); PG8_BAR; PG8_SCHED;
            PG8_LDA(At, 0, 1); PG8_STAGE(PG8_SB(0, 0), b2, voffB); PG8_STAGE(PG8_SB(0, 1), b2 + hstep, voffB); PG8_STAGE(PG8_SA(0, 0), a2, voffA);
            PG8_WAIT_V(8); PG8_WAIT_L(0); PG8_BAR; PG8_MMA(1, 0, At, B0); PG8_MMA(1, 1, At, B1); PG8_BAR; PG8_SCHED;
            PG8_LDB(B0, 1, 0); PG8_LDB(B1, 1, 1); PG8_SCHED; PG8_LDA(At, 1, 0); PG8_STAGE(PG8_SA(0, 1), a2 + hstep, voffA);
            PG8_WAIT_V(8); PG8_WAIT_L(0); PG8_BAR; PG8_MMA(0, 0, At, B0); PG8_MMA(0, 1, At, B1); PG8_BAR; PG8_SCHED;
            PG8_LDA(At, 1, 1); PG8_STAGE(PG8_SB(1, 0), b3, voffB); PG8_STAGE(PG8_SB(1, 1), b3 + hstep, voffB); PG8_STAGE(PG8_SA(1, 0), a3, voffA);
            PG8_WAIT_V(8); PG8_WAIT_L(0); PG8_BAR; PG8_MMA(1, 0, At, B0); PG8_MMA(1, 1, At, B1); PG8_BAR; PG8_SCHED;
            } else {
            PG8_LDB(B0, 0, 0); PG8_SCHED; PG8_LDA(At, 0, 0); PG8_STAGE(PG8_SA(1, 1), a1 + hstep, voffA);
            PG8_WAIT_L(8); PG8_BAR; PG8_WAIT_L(0); PG8_MMA(0, 0, At, B0); PG8_BAR; PG8_SCHED;
            PG8_LDB(B1, 0, 1); PG8_STAGE(PG8_SB(0, 0), b2, voffB);
            PG8_BAR; PG8_WAIT_L(0); PG8_MMA(0, 1, At, B1); PG8_BAR;
            PG8_LDA(At, 0, 1); PG8_STAGE(PG8_SA(0, 0), a2, voffA);
            PG8_BAR; PG8_WAIT_L(0); PG8_MMA(1, 0, At, B0); PG8_BAR; PG8_SCHED;
            PG8_STAGE(PG8_SB(0, 1), b2 + hstep, voffB);
            PG8_WAIT_V(6); PG8_BAR; PG8_MMA(1, 1, At, B1); PG8_BAR;
            PG8_LDB(B0, 1, 0); PG8_SCHED; PG8_LDA(At, 1, 0); PG8_STAGE(PG8_SA(0, 1), a2 + hstep, voffA);
            PG8_WAIT_L(8); PG8_BAR; PG8_WAIT_L(0); PG8_MMA(0, 0, At, B0); PG8_BAR; PG8_SCHED;
            PG8_LDB(B1, 1, 1); PG8_STAGE(PG8_SB(1, 0), b3, voffB);
            PG8_BAR; PG8_WAIT_L(0); PG8_MMA(0, 1, At, B1); PG8_BAR;
            PG8_LDA(At, 1, 1); PG8_STAGE(PG8_SA(1, 0), a3, voffA);
            PG8_BAR; PG8_WAIT_L(0); PG8_MMA(1, 0, At, B0); PG8_BAR; PG8_SCHED;
            PG8_STAGE(PG8_SB(1, 1), b3 + hstep, voffB);
            PG8_WAIT_V(6); PG8_BAR; PG8_MMA(1, 1, At, B1); PG8_BAR;
            }
        }
        if constexpr (ALIGN_EPI) { if (wr == 0) PG8_BAR; }
        if constexpr (!Epi::AFTER_DRAIN) { E(acc, cur, wr, wc, fr, fq); S.done(cur); }
        if (!has_next) break;
#pragma unroll
        for (int a = 0; a < 2; ++a)
#pragma unroll
            for (int b = 0; b < 2; ++b)
#pragma unroll
                for (int m = 0; m < 4; ++m)
#pragma unroll
                    for (int n = 0; n < 2; ++n) acc[a][b][m][n] = (f32x4){0.f, 0.f, 0.f, 0.f};
        cur = nxt; cA = nA; cB = nB; ++ui;
        if constexpr (ALIGN_EPI) { if (wr == 1) PG8_BAR; }
    }
    PG8_WAIT_V(0);
    if constexpr (!ALIGN_EPI) { if (wr == 0) PG8_BAR; }
    PG8_BAR;
    if constexpr (Epi::AFTER_DRAIN) { E.fused(acc, cur, wr, wc, fr, fq, lds, wid, lane); S.done(cur); }
#undef PG8_SA
#undef PG8_SB
#undef PG8_STAGE
#undef PG8_LDA
#undef PG8_LDB
#undef PG8_MMA
#undef PG8_WAIT_V
#undef PG8_WAIT_L
#undef PG8_BAR
#undef PG8_SCHED
}
}

namespace pg8 {
struct MoeOrder {
    int nM, nN, nwg, G, c; const PG8_LAS int* bexp;
    __device__ __forceinline__ void init(int nM_, int nN_, int G_, int c_, const PG8_LAS int* bexp_) { nM = nM_; nN = nN_; nwg = nM_ * nN_; G = G_; c = c_; bexp = bexp_; }
    __device__ __forceinline__ bool next(int i, Unit& u) const {
        const long L = (long)i * G + c; if (L >= nwg) return false;
        int wgid = (int)L; { const int q = nwg / NXCD, r = nwg % NXCD, xcd = wgid % NXCD, off = wgid / NXCD; wgid = (xcd < r ? xcd * (q + 1) : r * (q + 1) + (xcd - r) * q) + off; }
        const int nig = WGM * nN, gid = wgid / nig, fm = gid * WGM, gsz = (nM - fm) < WGM ? (nM - fm) : WGM;
        u.pm = fm + ((wgid % nig) % gsz); u.pn = (wgid % nig) / gsz; u.e = __builtin_amdgcn_readfirstlane(bexp[u.pm]); return true;
    }
    __device__ __forceinline__ void a_ready(const Unit&) const {}
    __device__ __forceinline__ void done(const Unit&) const {}
};
struct EpiOut {
    static constexpr bool PERM = false, AFTER_DRAIN = false;
    const float* x; float* out; const float* mod;
    __device__ __forceinline__ void operator()(const f32x4 (&acc)[2][2][4][2], const Unit& u, int wr, int wc, int fr, int fq) const {
        const int row0 = u.pm * BM + wr * 64 + fr, col0 = u.pn * BM + wc * 32 + 4 * fq;
        const float* g = mod + (size_t)(u.pm >> 5) * 6144 + 2 * 1024;
        f32x4 gv[2][2];
#pragma unroll
        for (int bj = 0; bj < 2; ++bj)
#pragma unroll
            for (int n = 0; n < 2; ++n) gv[bj][n] = *(const f32x4*)(g + col0 + bj * HALF + n * 16);
#pragma unroll
        for (int ai = 0; ai < 2; ++ai)
#pragma unroll
            for (int m = 0; m < 4; ++m) { const size_t off = (size_t)(row0 + ai * HALF + m * 16) * 1024 + col0;
#pragma unroll
                for (int bj = 0; bj < 2; ++bj)
#pragma unroll
                    for (int n = 0; n < 2; ++n) { const f32x4 xv = *(const f32x4*)(x + off + bj * HALF + n * 16); *(f32x4*)(out + off + bj * HALF + n * 16) = xv + gv[bj][n] * acc[ai][bj][m][n]; } }
    }
};
__device__ __forceinline__ float swiglu1(float g, float l) {
    const float glu = fminf(g, 7.0f), lin = fminf(fmaxf(l, -7.0f), 7.0f);
    const float sg = __builtin_amdgcn_rcpf(1.0f + __builtin_amdgcn_exp2f(glu * (-1.702f * 1.4426950408889634f)));
    return glu * sg * (lin + 1.0f);
}
__device__ __forceinline__ unsigned pk4_fp8(float a, float b, float c, float d) { int w = 0; w = __builtin_amdgcn_cvt_pk_fp8_f32(a, b, w, false); w = __builtin_amdgcn_cvt_pk_fp8_f32(c, d, w, true); return (unsigned)w; }
constexpr float W8_SCALE = 32.0f, W8_INV = 1.0f / 32.0f;
struct EpiSwiGLU {
    static constexpr bool PERM = true, AFTER_DRAIN = false;
    unsigned char* act; const float* bgu;
    __device__ __forceinline__ void operator()(const f32x4 (&acc)[2][2][4][2], const Unit& u, int wr, int wc, int fr, int fq) const {
        const int row0 = u.pm * BM + wr * 64 + fr, cg = u.pn * 128 + wc * 32 + 8 * fq;
        const float* bb = bgu + (size_t)u.e * 2048;
        f32x4 bg[2], bl[2];
#pragma unroll
        for (int n = 0; n < 2; ++n) { bg[n] = *(const f32x4*)(bb + cg + 4 * n); bl[n] = *(const f32x4*)(bb + 1024 + cg + 4 * n); }
#pragma unroll
        for (int ai = 0; ai < 2; ++ai)
#pragma unroll
            for (int m = 0; m < 4; ++m) { unsigned char* rowp = act + (size_t)(row0 + ai * HALF + m * 16) * 1024 + cg;
                const f32x4 g0 = acc[ai][0][m][0] * W8_INV + bg[0], g1 = acc[ai][0][m][1] * W8_INV + bg[1], l0 = acc[ai][1][m][0] * W8_INV + bl[0], l1 = acc[ai][1][m][1] * W8_INV + bl[1];
                typedef unsigned u32x2 __attribute__((ext_vector_type(2)));
                u32x2 w; w.x = pk4_fp8(swiglu1(g0[0], l0[0]), swiglu1(g0[1], l0[1]), swiglu1(g0[2], l0[2]), swiglu1(g0[3], l0[3]));
                w.y = pk4_fp8(swiglu1(g1[0], l1[0]), swiglu1(g1[1], l1[1]), swiglu1(g1[2], l1[2]), swiglu1(g1[3], l1[3]));
                *(u32x2*)rowp = w; }
    }
};
struct EpiDown {
    static constexpr bool PERM = true, AFTER_DRAIN = false;
    bf16_t* y; const float* bd;
    __device__ __forceinline__ void operator()(const f32x4 (&acc)[2][2][4][2], const Unit& u, int wr, int wc, int fr, int fq) const {
        const int row0 = u.pm * BM + wr * 64 + fr, col0 = u.pn * BM + wc * 32 + 8 * fq;
        const float* bb = bd + (size_t)u.e * 1024 + col0;
        f32x4 bv[2][2];
#pragma unroll
        for (int bj = 0; bj < 2; ++bj)
#pragma unroll
            for (int n = 0; n < 2; ++n) bv[bj][n] = *(const f32x4*)(bb + bj * HALF + 4 * n);
#pragma unroll
        for (int ai = 0; ai < 2; ++ai)
#pragma unroll
            for (int m = 0; m < 4; ++m) { bf16_t* rowp = y + (size_t)(row0 + ai * HALF + m * 16) * 1024 + col0;
#pragma unroll
                for (int bj = 0; bj < 2; ++bj) { const f32x4 v0 = acc[ai][bj][m][0] * W8_INV + bv[bj][0], v1 = acc[ai][bj][m][1] * W8_INV + bv[bj][1];
                    u32x4 w; w.x = cvt_pk_bf16(v0[0], v0[1]); w.y = cvt_pk_bf16(v0[2], v0[3]); w.z = cvt_pk_bf16(v1[0], v1[1]); w.w = cvt_pk_bf16(v1[2], v1[3]);
                    *(u32x4*)(rowp + bj * HALF) = w; } }
    }
};
}

namespace att {
typedef unsigned short bf16_t;
using bf16x8 = __attribute__((ext_vector_type(8))) short;
using s16x4  = __attribute__((ext_vector_type(4))) short;
using f32x16 = __attribute__((ext_vector_type(16))) float;
using u32x4  = __attribute__((ext_vector_type(4))) unsigned;
constexpr int NW = 8, QBLK = 32, KVBLK = 64, LD = 3072;
constexpr float SCALE = 0.125f, C2 = 0.125f * 1.4426950408889634f;
#define KSWZ64(row, colB) ((row) * 128 + ((colB) ^ ((((row) >> 1) & 7) << 4)))
#define ASBAR() __builtin_amdgcn_sched_barrier(0)
__device__ __forceinline__ int crow(int r, int hi) { return (r & 3) + 8 * (r >> 2) + 4 * hi; }
__device__ __forceinline__ unsigned cvtpk(float lo, float hi) { unsigned r; asm volatile("v_cvt_pk_bf16_f32 %0, %1, %2" : "=v"(r) : "v"(lo), "v"(hi)); return r; }
__device__ __forceinline__ bf16x8 ld8(const bf16_t* p) { return *reinterpret_cast<const bf16x8*>(p); }
__device__ __forceinline__ void glds16(const void* gsrc, unsigned lds_dst) { unsigned keep;
  asm volatile("s_mov_b32 %0, m0\n\ts_mov_b32 m0, %2\n\ts_nop 0\n\tglobal_load_lds_dwordx4 %1, off\n\ts_mov_b32 m0, %0" : "=&s"(keep) : "v"(gsrc), "s"(lds_dst) : "memory"); }

__device__ __forceinline__ void exp16(f32x16& p, float mref) {
#pragma unroll
  for (int r = 0; r < 16; ++r) p[r] = __builtin_amdgcn_exp2f(p[r]);
}
__device__ __forceinline__ void finishSM(f32x16& p0, f32x16& p1, float mref, float& l_reg, bf16x8& pa0, bf16x8& pa1, bf16x8& pa2, bf16x8& pa3) {
  exp16(p1, mref);
  float ps = 0;
#pragma unroll
  for (int r = 0; r < 16; ++r) ps += p0[r];
#pragma unroll
  for (int r = 0; r < 16; ++r) ps += p1[r];
  l_reg += ps;
#define PK4(P, BASE, OUT) do { u32x4 w = {cvtpk(P[BASE + 0], P[BASE + 1]), cvtpk(P[BASE + 2], P[BASE + 3]), cvtpk(P[BASE + 4], P[BASE + 5]), cvtpk(P[BASE + 6], P[BASE + 7])}; OUT = *reinterpret_cast<bf16x8*>(&w); } while (0)
  PK4(p0, 0, pa0); PK4(p0, 8, pa1); PK4(p1, 0, pa2); PK4(p1, 8, pa3);
#undef PK4
}
template <bool NEGM> __device__ __forceinline__ void qkt(f32x16& p0, f32x16& p1, const char* Ks, const bf16x8* qr, const f32x16& negm, int r32, int hi) {
#pragma unroll
  for (int d0 = 0; d0 < 4; ++d0) { const int cb = (d0 * 16 + hi * 8) * 2;
    const bf16x8 b0 = *reinterpret_cast<const bf16x8*>(Ks + KSWZ64(r32, cb));
    const bf16x8 b1 = *reinterpret_cast<const bf16x8*>(Ks + KSWZ64(32 + r32, cb));
    if (d0 == 0) { if constexpr (NEGM) { p0 = __builtin_amdgcn_mfma_f32_32x32x16_bf16(b0, qr[0], negm, 0, 0, 0); p1 = __builtin_amdgcn_mfma_f32_32x32x16_bf16(b1, qr[0], negm, 0, 0, 0); }
      else { p0 = __builtin_amdgcn_mfma_f32_32x32x16_bf16(b0, qr[0], f32x16{}, 0, 0, 0); p1 = __builtin_amdgcn_mfma_f32_32x32x16_bf16(b1, qr[0], f32x16{}, 0, 0, 0); } }
    else { p0 = __builtin_amdgcn_mfma_f32_32x32x16_bf16(b0, qr[d0], p0, 0, 0, 0); p1 = __builtin_amdgcn_mfma_f32_32x32x16_bf16(b1, qr[d0], p1, 0, 0, 0); } }
}
template <int NVB> __device__ __forceinline__ int v_st(int k, int c) { const int kk = k; return ((kk >> 3) * NVB + (c >> 5)) * 512 + ((kk & 7) * 32 + (c & 31)) * 2; }
__device__ __forceinline__ int v_rd_base(int lane) { return ((lane & 3) << 3) | (((lane >> 2) & 3) << 6) | (((lane >> 4) & 1) << 5) | (((lane >> 5) & 1) << 8); }
template <int NVB> constexpr int v_rd_off(int d0, int ks, int half) { return d0 * 512 + ks * (NVB * 1024) + half * (NVB * 512); }
template <int OFF> __device__ __forceinline__ s16x4 tr_read(int vb) {
  s16x4 r; asm volatile("ds_read_b64_tr_b16 %0, %1 offset:%2" : "=&v"(r) : "v"(vb), "i"(OFF) : "memory"); return r;
}
template <int NVB, int D0> __device__ __forceinline__ void v_rd(s16x4* f, int vb) {
  f[0] = tr_read<v_rd_off<NVB>(D0, 0, 0)>(vb); f[1] = tr_read<v_rd_off<NVB>(D0, 0, 1)>(vb); f[2] = tr_read<v_rd_off<NVB>(D0, 1, 0)>(vb); f[3] = tr_read<v_rd_off<NVB>(D0, 1, 1)>(vb);
  f[4] = tr_read<v_rd_off<NVB>(D0, 2, 0)>(vb); f[5] = tr_read<v_rd_off<NVB>(D0, 2, 1)>(vb); f[6] = tr_read<v_rd_off<NVB>(D0, 3, 0)>(vb); f[7] = tr_read<v_rd_off<NVB>(D0, 3, 1)>(vb);
}
__device__ __forceinline__ void pv_mm(f32x16& od, const s16x4* f, bf16x8 pa0, bf16x8 pa1, bf16x8 pa2, bf16x8 pa3) {
#define PK(L, H) (bf16x8){L[0], L[1], L[2], L[3], H[0], H[1], H[2], H[3]}
  od = __builtin_amdgcn_mfma_f32_32x32x16_bf16(pa0, PK(f[0], f[1]), od, 0, 0, 0);
  od = __builtin_amdgcn_mfma_f32_32x32x16_bf16(pa1, PK(f[2], f[3]), od, 0, 0, 0);
  od = __builtin_amdgcn_mfma_f32_32x32x16_bf16(pa2, PK(f[4], f[5]), od, 0, 0, 0);
  od = __builtin_amdgcn_mfma_f32_32x32x16_bf16(pa3, PK(f[6], f[7]), od, 0, 0, 0);
#undef PK
}
template <int LO, int N> __device__ __forceinline__ void exp_part(f32x16& p, float mref) {
#pragma unroll
  for (int r = LO; r < LO + N; ++r) p[r] = __builtin_amdgcn_exp2f(p[r]);
}
#define LGKM0() do { asm volatile("s_waitcnt lgkmcnt(0)" ::: "memory"); ASBAR(); } while (0)
template <int NVB> __device__ __forceinline__ void pv_all(f32x16* o, int vb, s16x4* fa, s16x4* fb, bf16x8 pa0, bf16x8 pa1, bf16x8 pa2, bf16x8 pa3, f32x16& c, float mref) {
  if constexpr (NVB == 4) {
    LGKM0(); v_rd<NVB, 1>(fb, vb); pv_mm(o[0], fa, pa0, pa1, pa2, pa3); exp_part<0, 4>(c, mref);
    LGKM0(); v_rd<NVB, 2>(fa, vb); pv_mm(o[1], fb, pa0, pa1, pa2, pa3); exp_part<4, 4>(c, mref);
    LGKM0(); v_rd<NVB, 3>(fb, vb); pv_mm(o[2], fa, pa0, pa1, pa2, pa3); exp_part<8, 4>(c, mref);
    LGKM0();                       pv_mm(o[3], fb, pa0, pa1, pa2, pa3); exp_part<12, 4>(c, mref);
  } else {
    LGKM0(); v_rd<NVB, 1>(fb, vb); pv_mm(o[0], fa, pa0, pa1, pa2, pa3); exp_part<0, 8>(c, mref);
    LGKM0();                       pv_mm(o[1], fb, pa0, pa1, pa2, pa3); exp_part<8, 8>(c, mref);
  }
}
template <bool SHIFT> struct DiffPol {
  static constexpr bool NEGM = false;
  const bf16_t* Kg; const bf16_t* Vg; long lat0, ctx0; float mref;
  __device__ __forceinline__ long krow(int t) const { return t < 128 ? lat0 + 64L * t : ctx0 + 64L * (t - 128); }
  __device__ __forceinline__ void mod(f32x16& p0, f32x16& p1, int, int, int, int) const {
    if constexpr (SHIFT) {
#pragma unroll
      for (int i = 0; i < 16; ++i) { p0[i] -= mref; p1[i] -= mref; } }
  }
};
struct NaPol {
  static constexpr bool NEGM = false;
  const bf16_t* Kg; const bf16_t* Vg; long lat0, ctx0; int rbase, r; const float* tab; float mref;
  __device__ __forceinline__ long krow(int t) const { if (t < 12) { int kr = rbase + t; kr = kr > 127 ? 127 : kr; return lat0 + 64L * kr; } return ctx0 + 64L * (t - 12); }
  __device__ __forceinline__ void mod(f32x16& p0, f32x16& p1, int t, int wid, int r32, int hi) const {
    if (t >= 12) {
#pragma unroll
      for (int i = 0; i < 16; ++i) { p0[i] -= mref; p1[i] -= mref; }
      return; }
    const float NEG = -INFINITY;
    const int kr = rbase + t, rq = r + (wid >> 1), c = 32 * (wid & 1) + r32;
    int r0q = rq - 4; r0q = r0q < 0 ? 0 : (r0q > 120 ? 120 : r0q);
    if (!((kr >= r0q) && (kr < r0q + 8))) {
#pragma unroll
      for (int i = 0; i < 16; ++i) { p0[i] = NEG; p1[i] = NEG; }
      return; }
    int c0 = c - 8; c0 = c0 < 0 ? 0 : (c0 > 48 ? 48 : c0);
    int d = 4 * hi - c0, off = (kr - rq + 7) * 31 + 15 - c + 4 * hi;
    asm volatile("" : "+v"(d), "+v"(off));
#pragma unroll
    for (int i = 0; i < 16; ++i) { const int ci = (i & 3) + 8 * (i >> 2);
      const bool v0 = (unsigned)(ci + d) < 16u, v1 = (unsigned)(ci + 32 + d) < 16u;
      const float b0 = tab[off + ci], b1 = tab[off + ci + 32];
      p0[i] = v0 ? p0[i] + b0 : NEG; p1[i] = v1 ? p1[i] + b1 : NEG; }
  }
};
template <int NVB> constexpr int lds_bytes() { return 3 * (64 * NVB * 64) + 3 * (64 * 128) + NW * 64 * 4; }
template <int NVB, class Pol>
__device__ __forceinline__ void attn_unit(const bf16_t* __restrict__ Qb, const Pol& pol, bf16_t* __restrict__ Ob, int ldo, int NT, float mref, char* lds) {
  constexpr int SHM_V = 64 * NVB * 64, SHM_K = 64 * 128;
  const int tid = threadIdx.x, lane = tid & 63, r32 = lane & 31, hi = lane >> 5; const int wid = __builtin_amdgcn_readfirstlane(tid >> 6);
  char* V_lds = lds; char* K_lds = lds + 3 * SHM_V;
  float* li_l = (float*)(lds + 3 * SHM_V + 3 * SHM_K) + wid * 64;
  const unsigned lds0 = (unsigned)(uintptr_t)lds;
  const int krow_ = 8 * wid + (lane >> 3), kch = (lane & 7) ^ ((krow_ >> 1) & 7);
  const bf16_t* ksrc = pol.Kg + (long)krow_ * LD + kch * 8;
  const bf16_t* vsrc = pol.Vg + (long)(8 * wid + ((lane >> 2) & 7)) * LD + (lane >> 5) * 32 + (lane & 3) * 8;
  const unsigned kdst = lds0 + 3 * SHM_V + wid * 1024, vdst = lds0 + wid * (NVB == 4 ? 2048 : 1024);
#define DMA_TILE(t, b) do { const long ro_ = pol.krow(t) * LD; glds16(ksrc + ro_, (unsigned)__builtin_amdgcn_readfirstlane(kdst + (b) * SHM_K)); \
    glds16(vsrc + ro_, (unsigned)__builtin_amdgcn_readfirstlane(vdst + (b) * SHM_V)); \
    if constexpr (NVB == 4) glds16(vsrc + ro_ + 64, (unsigned)__builtin_amdgcn_readfirstlane(vdst + (b) * SHM_V + 1024)); } while (0)
#define WAIT_BAR() do { asm volatile("s_waitcnt vmcnt(0)" ::: "memory"); __syncthreads(); } while (0)
  DMA_TILE(0, 0); DMA_TILE(1, 1);
  float l_reg = 0; f32x16 o[NVB]; bf16x8 qr[4]; f32x16 negm;
#pragma unroll
  for (int r = 0; r < 16; ++r) negm[r] = -mref;
  if constexpr (Pol::NEGM) asm volatile("" : "+v"(negm));
#pragma unroll
  for (int d = 0; d < NVB; ++d) o[d] = f32x16{};
  const bf16_t* Qw = Qb + (long)(wid * QBLK + r32) * LD + hi * 8;
#pragma unroll
  for (int d0 = 0; d0 < 4; ++d0) qr[d0] = ld8(Qw + d0 * 16);
  const int vb0 = (int)(uintptr_t)V_lds + v_rd_base(lane);
  f32x16 pA0, pA1, pB0, pB1; bf16x8 pa0, pa1, pa2, pa3; s16x4 fa[8], fb[8];
  int bp = 0, bc = 1, bn = 2;
  WAIT_BAR();
  qkt<Pol::NEGM>(pA0, pA1, K_lds, qr, negm, r32, hi); pol.mod(pA0, pA1, 0, wid, r32, hi); exp16(pA0, mref);
#define STEP(C0, C1, P0, P1, j) do { \
    if ((j) + 1 < NT) DMA_TILE((j) + 1, bn); \
    ASBAR(); v_rd<NVB, 0>(fa, vb0 + bp * SHM_V); qkt<Pol::NEGM>(C0, C1, K_lds + bc * SHM_K, qr, negm, r32, hi); \
    finishSM(P0, P1, mref, l_reg, pa0, pa1, pa2, pa3); ASBAR(); \
    pol.mod(C0, C1, (j), wid, r32, hi); ASBAR(); \
    pv_all<NVB>(o, vb0 + bp * SHM_V, fa, fb, pa0, pa1, pa2, pa3, C0, mref); \
    WAIT_BAR(); \
    bp = bc; bc = bn; bn = (bn == 2) ? 0 : bn + 1; } while (0)
  int j = 1;
#pragma nounroll
  for (; j + 1 < NT; j += 2) { STEP(pB0, pB1, pA0, pA1, j); STEP(pA0, pA1, pB0, pB1, j + 1); }
  STEP(pB0, pB1, pA0, pA1, NT - 1);
  finishSM(pB0, pB1, mref, l_reg, pa0, pa1, pa2, pa3); ASBAR();
  v_rd<NVB, 0>(fa, vb0 + bp * SHM_V); pv_all<NVB>(o, vb0 + bp * SHM_V, fa, fb, pa0, pa1, pa2, pa3, pA0, 0.f);
  { auto rr = __builtin_amdgcn_permlane32_swap(__float_as_uint(l_reg), __float_as_uint(l_reg), false, false); l_reg = __uint_as_float(rr[0]) + __uint_as_float(rr[1]); }
  if (hi == 0) li_l[r32] = l_reg; asm volatile("s_waitcnt lgkmcnt(0)" ::: "memory");
  float rli[16];
#pragma unroll
  for (int r = 0; r < 16; ++r) rli[r] = __builtin_amdgcn_rcpf(li_l[crow(r, hi)]);
  bf16_t* Ow = Ob + (long)(wid * QBLK) * ldo;
#pragma unroll
  for (int r = 0; r < 16; ++r) { const int orow = crow(r, hi);
#pragma unroll
    for (int d0 = 0; d0 < NVB; ++d0) { const float v = o[d0][r] * rli[r]; const unsigned pk = cvtpk(v, v); Ow[(long)orow * ldo + d0 * 32 + r32] = (bf16_t)(pk & 0xffffu); } }
  __syncthreads();
#undef DMA_TILE
#undef WAIT_BAR
#undef STEP
}
}

#ifndef MK_PROBE_PHASE
#define MK_PROBE_PHASE -1
#endif
#ifndef MK_N_LAUNCHES
#define MK_N_LAUNCHES 1
#endif
constexpr int N_PHASES = 12;
constexpr int NWAVES = 8;
constexpr int DM = 1024, NB = 4, SEQ = 8192, TT = NB * SEQ, CTX = 256, TC = NB * CTX, MQ = TT + TC, NQKV = 3072;
constexpr int NE = 32, TOPK = 4, MPAD = TT * TOPK + NE * 256, MAXBLK = MPAD / 256;
constexpr float NORM_EPS = 1e-6f;
enum { I_X = 0, I_C, I_CTX, I_CCTX, I_WADA, I_BADA, I_GATTN, I_WIN, I_QND, I_KND, I_LQ1, I_LK1, I_LQ2, I_LK2, I_SUBLN, I_QNN, I_KNN, I_RPB, I_ONN, I_WOUT, I_GFFN, I_WR, I_BR, I_WGU, I_BGU, I_WD, I_BD, N_IN };

constexpr size_t MiB = 1u << 20;
constexpr size_t WS_CTL = 0, CTL_ZERO_BYTES = 64 * 1024;
constexpr size_t WS_TAB = 1 * MiB;
constexpr size_t WS_WQKV = 2 * MiB, WS_WO = 8 * MiB, WS_WGU = 10 * MiB, WS_WDN = 138 * MiB;
constexpr size_t WS_XN = 202 * MiB;
constexpr size_t WS_P = 268 * MiB;
constexpr size_t WS_OD = 499 * MiB, WS_ON = 563 * MiB, WS_MIX = 595 * MiB;
constexpr size_t WS_XG = 202 * MiB;
constexpr size_t WS_ACT = 659 * MiB;
constexpr size_t WS_Y = 202 * MiB;
constexpr size_t WS_RT = 931 * MiB;
constexpr size_t WS_END = 936 * MiB;
static_assert(WS_XN + (size_t)MQ * 2048 <= WS_P && WS_P + (size_t)MQ * 6144 <= WS_OD && WS_XG + (size_t)MPAD * 2048 <= WS_OD && WS_ACT + (size_t)MPAD * 2048 <= WS_RT, "d_ws map");
constexpr int TB_MOD = 0;
constexpr int TB_RCOS = 30720, TB_RSIN = TB_RCOS + 128 * 16, TB_CCOS = TB_RSIN + 128 * 16, TB_CSIN = TB_CCOS + 64 * 16;
constexpr int TB_LAM = TB_CSIN + 64 * 16;
constexpr int TB_WR = TB_LAM + 64;
constexpr int TB_RC = TB_WR + 4 * 1024 * 32;
static_assert((size_t)(TB_RC + 128 + 64) * 4 <= MiB, "TAB region");
constexpr int CW_CNT = 0;
constexpr int CW_BAR = 4096;
constexpr size_t RT_E = 0, RT_G = 512 * 1024, RT_POS = 1024 * 1024, RT_SLOT = 1536 * 1024;

constexpr int RING_BYTES = 131072;
constexpr int MISC_OFF = RING_BYTES;
constexpr int LDS_BYTES = 147456;

#define GAS __attribute__((address_space(1)))
#define LAS __attribute__((address_space(3)))
typedef unsigned short bf16;
typedef unsigned v4u __attribute__((ext_vector_type(4)));
typedef unsigned v2u __attribute__((ext_vector_type(2)));
typedef float f32x4 __attribute__((ext_vector_type(4)));
typedef float f32x16 __attribute__((ext_vector_type(16)));
#define LDS_WAIT() asm volatile("s_waitcnt lgkmcnt(0)" ::: "memory")
__device__ __forceinline__ unsigned f2bf(float f) { unsigned u = __builtin_bit_cast(unsigned, f); return (u + 0x7fffu + ((u >> 16) & 1u)) >> 16; }
__device__ __forceinline__ unsigned pk2(float lo, float hi) { return f2bf(lo) | (f2bf(hi) << 16); }
__device__ __forceinline__ float bflo(unsigned w) { return __uint_as_float(w << 16); }
__device__ __forceinline__ float bfhi(unsigned w) { return __uint_as_float(w & 0xffff0000u); }
__device__ __forceinline__ float wave_sum(float v) {
#pragma unroll
    for (int o = 1; o < 64; o <<= 1) v += __shfl_xor(v, o);
    return v;
}

struct Frame {
    LAS unsigned char* lds;
    int tid, lane, wave, vcu, G;
    const float* in[N_IN]; float* out; unsigned char* ws;
};

__device__ __forceinline__ void p0_transpose_item(const float* W, int K, int N, bf16* WT, int k0, int n0, int drow0, LAS float* scr, int lane) {
#pragma unroll 8
    for (int i = 0; i < 32; ++i) { const int kk = 2 * i + (lane >> 5); scr[kk * 33 + (lane & 31)] = W[(size_t)(k0 + kk) * N + n0 + (lane & 31)]; }
    LDS_WAIT(); asm volatile("" ::: "memory");
    const int c = lane & 7;
#pragma unroll
    for (int j = 0; j < 4; ++j) { const int n = (lane >> 3) + 8 * j; const LAS float* s = scr + (8 * c) * 33 + n;
        v4u o; o.x = pk2(s[0 * 33], s[1 * 33]); o.y = pk2(s[2 * 33], s[3 * 33]); o.z = pk2(s[4 * 33], s[5 * 33]); o.w = pk2(s[6 * 33], s[7 * 33]);
        *(v4u*)(WT + (size_t)(drow0 + n) * K + k0 + 8 * c) = o; }
    LDS_WAIT(); asm volatile("" ::: "memory");
}

__device__ __forceinline__ void p0_transpose_item8(const float* W, int K, int N, unsigned char* WT, int k0, int n0, int drow0, LAS float* scr, int lane) {
#pragma unroll 8
    for (int i = 0; i < 32; ++i) { const int kk = 2 * i + (lane >> 5); scr[kk * 33 + (lane & 31)] = W[(size_t)(k0 + kk) * N + n0 + (lane & 31)]; }
    LDS_WAIT(); asm volatile("" ::: "memory");
    const int n = lane & 31, hf = lane >> 5; const LAS float* s = scr + (32 * hf) * 33 + n;
    v4u o0, o1;
#define P4(j) pg8::pk4_fp8(s[(j) * 33] * pg8::W8_SCALE, s[((j) + 1) * 33] * pg8::W8_SCALE, s[((j) + 2) * 33] * pg8::W8_SCALE, s[((j) + 3) * 33] * pg8::W8_SCALE)
    o0.x = P4(0); o0.y = P4(4); o0.z = P4(8); o0.w = P4(12); o1.x = P4(16); o1.y = P4(20); o1.z = P4(24); o1.w = P4(28);
#undef P4
    unsigned char* dst = WT + (size_t)(drow0 + n) * K + k0 + 32 * hf;
    *(v4u*)dst = o0; *(v4u*)(dst + 16) = o1;
    LDS_WAIT(); asm volatile("" ::: "memory");
}

__device__ __forceinline__ void p0_prologue(Frame& F) {
    float* tab = (float*)(F.ws + WS_TAB);
    for (int task = blockIdx.x; task < 96; task += F.G) {
        LAS float* ssilu = (LAS float*)F.lds;
        LAS float* part = ssilu + 5 * 1024;
        for (int i = F.tid; i < 5 * 1024; i += 512) { const int r = i >> 10, k = i & 1023; const float v = (r < 4) ? F.in[I_C][r * 1024 + k] : F.in[I_CCTX][k]; ssilu[i] = v / (1.0f + __expf(-v)); }
        __syncthreads();
        const int col = task * 64 + F.lane; const float* w = F.in[I_WADA] + col; float a0 = 0, a1 = 0, a2 = 0, a3 = 0, a4 = 0;
        const int kb = F.wave * 128;
#pragma unroll 8
        for (int k = kb; k < kb + 128; ++k) { const float wv = w[(size_t)k * 6144]; a0 += ssilu[k] * wv; a1 += ssilu[1024 + k] * wv; a2 += ssilu[2048 + k] * wv; a3 += ssilu[3072 + k] * wv; a4 += ssilu[4096 + k] * wv; }
        part[(F.wave * 5 + 0) * 64 + F.lane] = a0; part[(F.wave * 5 + 1) * 64 + F.lane] = a1; part[(F.wave * 5 + 2) * 64 + F.lane] = a2; part[(F.wave * 5 + 3) * 64 + F.lane] = a3; part[(F.wave * 5 + 4) * 64 + F.lane] = a4;
        __syncthreads();
        if (F.tid < 320) { const int r = F.tid >> 6, cl = F.tid & 63; float s = 0; for (int wv = 0; wv < 8; ++wv) s += part[(wv * 5 + r) * 64 + cl]; const int j = task * 64 + cl; tab[TB_MOD + r * 6144 + j] = s + F.in[I_BADA][j]; }
        __syncthreads();
    }
    if ((int)blockIdx.x == F.G - 1) {
        for (int i = F.tid; i < 192 * 16; i += 512) { const int p = i >> 4, f = i & 15; const float inv = 1.0f / powf(10000.0f, (float)f / 16.0f); const int pos = p < 128 ? p : p - 128; const float ang = (float)pos * inv;
            const float cv = cosf(ang), sv = sinf(ang);
            if (p < 128) { tab[TB_RCOS + pos * 16 + f] = cv; tab[TB_RSIN + pos * 16 + f] = sv; } else { tab[TB_CCOS + pos * 16 + f] = cv; tab[TB_CSIN + pos * 16 + f] = sv; } }
        if (F.wave == 0) { const float s1 = wave_sum(F.in[I_LQ1][F.lane] * F.in[I_LK1][F.lane]), s2 = wave_sum(F.in[I_LQ2][F.lane] * F.in[I_LK2][F.lane]);
            if (F.lane == 0) tab[TB_LAM] = expf(s1) - expf(s2) + 0.2f;
            float a = fabsf(F.in[I_QND][F.lane]), bq = fabsf(F.in[I_KND][F.lane]), c = fabsf(F.in[I_QNN][F.lane]), d = fabsf(F.in[I_KNN][F.lane]); float rm = -1e30f;
            for (int i = F.lane; i < 8 * 465; i += 64) rm = fmaxf(rm, F.in[I_RPB][i]);
#pragma unroll
            for (int o = 1; o < 64; o <<= 1) { a = fmaxf(a, __shfl_xor(a, o)); bq = fmaxf(bq, __shfl_xor(bq, o)); c = fmaxf(c, __shfl_xor(c, o)); d = fmaxf(d, __shfl_xor(d, o)); rm = fmaxf(rm, __shfl_xor(rm, o)); }
            if (F.lane == 0) { tab[TB_LAM + 1] = att::C2 * 64.0f * a * bq * 1.02f + 0.05f; tab[TB_LAM + 2] = att::C2 * 64.0f * c * d * 1.02f + 0.05f + fmaxf(rm, 0.f) * 1.4426950408889634f; } }
    }
    LAS float* scr = (LAS float*)(F.lds + 32768 + F.wave * 8704);
    const int gw = F.vcu * NWAVES + F.wave, NGW = F.G * NWAVES;
    constexpr int I_IN = 16 * 96, I_OUT = 16 * 32, I_GU = 16 * 64, I_DN = 16 * 32;
    constexpr int NITEMS = I_IN + I_OUT + NE * (I_GU + I_DN);
    bf16* wqkv = (bf16*)(F.ws + WS_WQKV); bf16* wo = (bf16*)(F.ws + WS_WO); unsigned char* wgu = F.ws + WS_WGU; unsigned char* wdn = F.ws + WS_WDN;
    for (int it = gw; it < NITEMS; it += NGW) {
        int r = it;
        if (r < I_IN) { const int kb = r / 96, nb = r % 96; p0_transpose_item(F.in[I_WIN], 1024, 3072, wqkv, 64 * kb, 32 * nb, 32 * nb, scr, F.lane); continue; } r -= I_IN;
        if (r < I_OUT) { const int kb = r / 32, nb = r % 32; p0_transpose_item(F.in[I_WOUT], 1024, 1024, wo, 64 * kb, 32 * nb, 32 * nb, scr, F.lane); continue; } r -= I_OUT;
        if (r < NE * I_GU) { const int e = r / I_GU, q = r % I_GU, kb = q / 64, nb = q % 64, n0 = 32 * nb;
            const int drow = (n0 < 1024) ? ((n0 >> 7) * 256 + (n0 & 127)) : (((n0 - 1024) >> 7) * 256 + 128 + ((n0 - 1024) & 127));
            p0_transpose_item8(F.in[I_WGU] + (size_t)e * 1024 * 2048, 1024, 2048, wgu + (size_t)e * 2048 * 1024, 64 * kb, n0, drow, scr, F.lane); continue; } r -= NE * I_GU;
        { const int e = r / I_DN, q = r % I_DN, kb = q / 32, nb = q % 32;
            p0_transpose_item8(F.in[I_WD] + (size_t)e * 1024 * 1024, 1024, 1024, wdn + (size_t)e * 1024 * 1024, 64 * kb, 32 * nb, 32 * nb, scr, F.lane); }
    }
}

__device__ __forceinline__ void p1_norm(Frame& F) {
    const float* tab = (const float*)(F.ws + WS_TAB); bf16* XN = (bf16*)(F.ws + WS_XN);
    const int gw = F.vcu * NWAVES + F.wave, NGW = F.G * NWAVES;
    const f32x4* gat = (const f32x4*)F.in[I_GATTN] + F.lane;
    for (int m = gw; m < MQ; m += NGW) {
        const int b = m < TT ? (m >> 13) : 4;
        const float* xrow = m < TT ? F.in[I_X] + (size_t)m * DM : F.in[I_CTX] + (size_t)(m - TT) * DM;
        const f32x4* xr = (const f32x4*)xrow + F.lane;
        const f32x4* sh = (const f32x4*)(tab + TB_MOD + b * 6144) + F.lane; const f32x4* sc = (const f32x4*)(tab + TB_MOD + b * 6144 + 1024) + F.lane;
        f32x4 v[4]; float s = 0.f;
#pragma unroll
        for (int j = 0; j < 4; ++j) { v[j] = xr[64 * j]; s += (v[j].x * v[j].x + v[j].y * v[j].y) + (v[j].z * v[j].z + v[j].w * v[j].w); }
        const float rstd = 1.0f / sqrtf(wave_sum(s) * (1.f / DM) + NORM_EPS);
        unsigned long long* o8 = (unsigned long long*)(XN + (size_t)m * DM) + F.lane;
#pragma unroll
        for (int j = 0; j < 4; ++j) { const f32x4 g = gat[64 * j], a = sc[64 * j], c = sh[64 * j];
            const f32x4 h = (v[j] * rstd) * g * (a + 1.0f) + c;
            o8[64 * j] = (unsigned long long)pk2(h.x, h.y) | ((unsigned long long)pk2(h.z, h.w) << 32); }
    }
    float* tw = (float*)(F.ws + WS_TAB);
    for (int i = (int)blockIdx.x * 512 + F.tid; i < 4 * 1024 * 32; i += F.G * 512) { const int b = i >> 15, k = (i >> 5) & 1023;
        tw[TB_WR + i] = F.in[I_GFFN][k] * (1.0f + tab[TB_MOD + b * 6144 + 4 * 1024 + k]) * F.in[I_WR][i & 32767]; }
    for (int t = gw; t < 128; t += NGW) { const int b = t >> 5, e = t & 31; float s = 0.f;
        for (int k = F.lane; k < 1024; k += 64) s += tab[TB_MOD + b * 6144 + 3 * 1024 + k] * F.in[I_WR][k * 32 + e];
        s = wave_sum(s); if (F.lane == 0) tw[TB_RC + t] = s + F.in[I_BR][e]; }
}

__device__ __forceinline__ void p3_qknorm(Frame& F) {
    const float* tab = (const float*)(F.ws + WS_TAB); bf16* P = (bf16*)(F.ws + WS_P);
    const int gw = F.vcu * NWAVES + F.wave, NGW = F.G * NWAVES;
    const int j = F.lane & 7;
    for (int task = gw; task < MQ * 4; task += NGW) {
        const int row = task >> 2, g = task & 3;
        const int colb = (g == 0) ? 0 : (g == 1) ? 512 : (g == 2) ? 1536 : 2048;
        const float* nw = ((g == 0) ? F.in[I_QND] : (g == 1) ? F.in[I_KND] : (g == 2) ? F.in[I_QNN] : F.in[I_KNN]) + 8 * j;
        bf16* p = P + (size_t)row * NQKV + colb + F.lane * 8;
        const v4u w = *(const v4u*)p;
        float v[8] = {bflo(w.x), bfhi(w.x), bflo(w.y), bfhi(w.y), bflo(w.z), bfhi(w.z), bflo(w.w), bfhi(w.w)};
        float ss = 0.f;
#pragma unroll
        for (int i = 0; i < 8; ++i) ss += v[i] * v[i];
        ss += __shfl_xor(ss, 1); ss += __shfl_xor(ss, 2); ss += __shfl_xor(ss, 4);
        const float rstd = 1.0f / sqrtf(ss * (1.f / 64.f) + NORM_EPS);
        const f32x4 n0 = *(const f32x4*)nw, n1 = *(const f32x4*)(nw + 4);
        v[0] *= rstd * n0.x; v[1] *= rstd * n0.y; v[2] *= rstd * n0.z; v[3] *= rstd * n0.w; v[4] *= rstd * n1.x; v[5] *= rstd * n1.y; v[6] *= rstd * n1.z; v[7] *= rstd * n1.w;
        if (g < 2 && row < TT) {
            const int s = row & (SEQ - 1), prow = s >> 6, pcol = s & 63, half = j >> 2, isx2 = (j >> 1) & 1;
            const float* ct = tab + (half ? TB_CCOS + pcol * 16 : TB_RCOS + prow * 16) + 8 * (j & 1);
            const float* st = tab + (half ? TB_CSIN + pcol * 16 : TB_RSIN + prow * 16) + 8 * (j & 1);
            const f32x4 c0 = *(const f32x4*)ct, c1 = *(const f32x4*)(ct + 4), s0 = *(const f32x4*)st, s1 = *(const f32x4*)(st + 4);
            const float cc[8] = {c0.x, c0.y, c0.z, c0.w, c1.x, c1.y, c1.z, c1.w}, sn[8] = {s0.x, s0.y, s0.z, s0.w, s1.x, s1.y, s1.z, s1.w};
#pragma unroll
            for (int i = 0; i < 8; ++i) { const float pr = __shfl_xor(v[i], 2); v[i] = isx2 ? (v[i] * cc[i] + pr * sn[i]) : (v[i] * cc[i] - pr * sn[i]); }
        }
        if (g == 0 || g == 2) {
#pragma unroll
            for (int i = 0; i < 8; ++i) v[i] *= att::C2;
        }
        v4u o; o.x = pk2(v[0], v[1]); o.y = pk2(v[2], v[3]); o.z = pk2(v[4], v[5]); o.w = pk2(v[6], v[7]);
        *(v4u*)p = o;
    }
}

__device__ __forceinline__ void p4_attention(Frame& F, char* lds) {
    const bf16* P = (const bf16*)(F.ws + WS_P); bf16* OD = (bf16*)(F.ws + WS_OD); bf16* ON = (bf16*)(F.ws + WS_ON);
    const float* tab = (const float*)(F.ws + WS_TAB); const float mref_d = tab[TB_LAM + 1], mref_n = tab[TB_LAM + 2];
#ifndef MK_NO_DIFF
#define DIFF_UNITS(SH) for (int unit = F.vcu; unit < 1024; unit += F.G) { \
        const int bhm = unit >> 5, qb = unit & 31, b = bhm >> 3, h = (bhm >> 1) & 3, m = bhm & 1; \
        att::DiffPol<SH> pol; pol.Kg = P + 512 + h * 128 + m * 64; pol.Vg = P + 1024 + h * 128; pol.lat0 = (long)b * SEQ; pol.ctx0 = (long)TT + b * CTX; pol.mref = mref_d; \
        att::attn_unit<4, att::DiffPol<SH> >(P + ((size_t)b * SEQ + qb * 256) * NQKV + h * 128 + m * 64, pol, OD + ((size_t)b * SEQ + qb * 256) * 1024 + h * 256 + m * 128, 1024, 132, mref_d, lds); }
    if (mref_d <= 100.0f) { DIFF_UNITS(false) } else { DIFF_UNITS(true) }
#undef DIFF_UNITS
#endif
#ifndef MK_NO_NA
    float* tabl = (float*)(lds + att::lds_bytes<4>());
    for (int unit = F.vcu; unit < 1024; unit += F.G) {
        const int bh = unit >> 5, rb = unit & 31, b = bh >> 3, hn = bh & 7, r = rb * 4;
        for (int i = F.tid; i < 15 * 31; i += 512) tabl[i] = F.in[I_RPB][hn * 465 + i] * 1.4426950408889634f - mref_n;
        att::NaPol pol; pol.Kg = P + 2048 + hn * 64; pol.Vg = P + 2560 + hn * 64; pol.lat0 = (long)b * SEQ; pol.ctx0 = (long)TT + b * CTX;
        pol.mref = mref_n; pol.r = r; pol.rbase = (r - 4) < 0 ? 0 : ((r - 4) > 120 ? 120 : (r - 4)); pol.tab = tabl;
        att::attn_unit<2, att::NaPol>(P + ((size_t)b * SEQ + r * 64) * NQKV + 1536 + hn * 64, pol, ON + ((size_t)b * SEQ + r * 64) * 512 + hn * 64, 512, 16, mref_n, lds);
    }
#endif
}

__device__ __forceinline__ void p5_mix(Frame& F) {
    const float* tab = (const float*)(F.ws + WS_TAB); const bf16* OD = (const bf16*)(F.ws + WS_OD); const bf16* ON = (const bf16*)(F.ws + WS_ON); bf16* MX = (bf16*)(F.ws + WS_MIX);
    const int gw = F.vcu * NWAVES + F.wave, NGW = F.G * NWAVES;
    const float lam = tab[TB_LAM];
    const int h = F.lane >> 4, e0 = (F.lane & 15) * 8;
    const f32x4 sl0 = *(const f32x4*)(F.in[I_SUBLN] + e0), sl1 = *(const f32x4*)(F.in[I_SUBLN] + e0 + 4);
    const f32x4 on0 = *(const f32x4*)(F.in[I_ONN] + F.lane * 8), on1 = *(const f32x4*)(F.in[I_ONN] + F.lane * 8 + 4);
    for (int t = gw; t < TT; t += NGW) {
        const v4u a = *(const v4u*)(OD + (size_t)t * 1024 + h * 256 + e0), c = *(const v4u*)(OD + (size_t)t * 1024 + h * 256 + 128 + e0);
        const v4u n = *(const v4u*)(ON + (size_t)t * 512 + F.lane * 8);
        float d[8] = {bflo(a.x) - lam * bflo(c.x), bfhi(a.x) - lam * bfhi(c.x), bflo(a.y) - lam * bflo(c.y), bfhi(a.y) - lam * bfhi(c.y),
                      bflo(a.z) - lam * bflo(c.z), bfhi(a.z) - lam * bfhi(c.z), bflo(a.w) - lam * bflo(c.w), bfhi(a.w) - lam * bfhi(c.w)};
        float ss = 0.f;
#pragma unroll
        for (int i = 0; i < 8; ++i) ss += d[i] * d[i];
        ss += __shfl_xor(ss, 1); ss += __shfl_xor(ss, 2); ss += __shfl_xor(ss, 4); ss += __shfl_xor(ss, 8);
        const float rs = 0.8f / sqrtf(ss * (1.f / 128.f) + NORM_EPS);
        v4u o; o.x = pk2(d[0] * rs * sl0.x, d[1] * rs * sl0.y); o.y = pk2(d[2] * rs * sl0.z, d[3] * rs * sl0.w); o.z = pk2(d[4] * rs * sl1.x, d[5] * rs * sl1.y); o.w = pk2(d[6] * rs * sl1.z, d[7] * rs * sl1.w);
        *(v4u*)(MX + (size_t)t * 1024 + h * 128 + e0) = o;
        float q[8] = {bflo(n.x), bfhi(n.x), bflo(n.y), bfhi(n.y), bflo(n.z), bfhi(n.z), bflo(n.w), bfhi(n.w)};
        float s2 = 0.f;
#pragma unroll
        for (int i = 0; i < 8; ++i) s2 += q[i] * q[i];
        s2 += __shfl_xor(s2, 1); s2 += __shfl_xor(s2, 2); s2 += __shfl_xor(s2, 4);
        const float r2 = 1.0f / sqrtf(s2 * (1.f / 64.f) + NORM_EPS);
        v4u o2; o2.x = pk2(q[0] * r2 * on0.x, q[1] * r2 * on0.y); o2.y = pk2(q[2] * r2 * on0.z, q[3] * r2 * on0.w); o2.z = pk2(q[4] * r2 * on1.x, q[5] * r2 * on1.y); o2.w = pk2(q[6] * r2 * on1.z, q[7] * r2 * on1.w);
        *(v4u*)(MX + (size_t)t * 1024 + 512 + F.lane * 8) = o2;
    }
}

__device__ __forceinline__ void p7_router(Frame& F) {
    const float* tab = (const float*)(F.ws + WS_TAB); unsigned* cnt = (unsigned*)(F.ws + WS_CTL) + CW_CNT;
    int* rt_e = (int*)(F.ws + WS_RT + RT_E); float* rt_g = (float*)(F.ws + WS_RT + RT_G); int* rt_pos = (int*)(F.ws + WS_RT + RT_POS);
    LAS unsigned* cntl = (LAS unsigned*)(F.lds + MISC_OFF); LAS unsigned* basel = cntl + 32;
    const int j = F.lane & 31, kh = F.lane >> 5;
    for (int tile = F.vcu; tile < TT / 128; tile += F.G) {
        if (F.tid < 32) cntl[F.tid] = 0u;
        __syncthreads();
        int te[4] = {0, 0, 0, 0}; float tg[4] = {0, 0, 0, 0}; unsigned lp[4] = {0, 0, 0, 0}; const int t = tile * 128 + 32 * F.wave + j;
        if (F.wave < 4) {
            const int b = t >> 13;
            const float* xr = F.out + (size_t)t * DM + 4 * kh;
            const float* wp = tab + TB_WR + (size_t)b * 32768 + (4 * kh) * 32 + j;
            f32x16 acc = f32x16{}; float ss = 0.f;
#pragma unroll 4
            for (int u = 0; u < 128; ++u) {
                const f32x4 xv = *(const f32x4*)(xr + 8 * u);
                const float w0 = wp[(8 * u + 0) * 32], w1 = wp[(8 * u + 1) * 32], w2 = wp[(8 * u + 2) * 32], w3 = wp[(8 * u + 3) * 32];
                ss += (xv.x * xv.x + xv.y * xv.y) + (xv.z * xv.z + xv.w * xv.w);
                acc = __builtin_amdgcn_mfma_f32_32x32x2f32(w0, xv.x, acc, 0, 0, 0);
                acc = __builtin_amdgcn_mfma_f32_32x32x2f32(w1, xv.y, acc, 0, 0, 0);
                acc = __builtin_amdgcn_mfma_f32_32x32x2f32(w2, xv.z, acc, 0, 0, 0);
                acc = __builtin_amdgcn_mfma_f32_32x32x2f32(w3, xv.w, acc, 0, 0, 0);
            }
            ss += __shfl_xor(ss, 32);
            const float rstd = 1.0f / sqrtf(ss * (1.f / DM) + NORM_EPS);
            float v[16];
#pragma unroll
            for (int r = 0; r < 16; ++r) v[r] = acc[r] * rstd + tab[TB_RC + b * 32 + att::crow(r, kh)];
            float cv[8]; int ce[8];
#pragma unroll
            for (int k = 0; k < 4; ++k) { float best = -INFINITY; int bi = 0;
#pragma unroll
                for (int r = 0; r < 16; ++r) if (v[r] > best) { best = v[r]; bi = r; }
#pragma unroll
                for (int r = 0; r < 16; ++r) if (r == bi) v[r] = -INFINITY;
                cv[k] = best; ce[k] = att::crow(bi, kh); }
#pragma unroll
            for (int k = 0; k < 4; ++k) { cv[4 + k] = __shfl_xor(cv[k], 32); ce[4 + k] = __shfl_xor(ce[k], 32); }
            float tv[4];
#pragma unroll
            for (int k = 0; k < 4; ++k) { float best = -INFINITY; int be = 1 << 30, bi = 0;
#pragma unroll
                for (int q = 0; q < 8; ++q) if (cv[q] > best || (cv[q] == best && ce[q] < be)) { best = cv[q]; be = ce[q]; bi = q; }
#pragma unroll
                for (int q = 0; q < 8; ++q) if (q == bi) cv[q] = -INFINITY;
                tv[k] = best; te[k] = be; }
            const float e1 = __expf(tv[1] - tv[0]), e2 = __expf(tv[2] - tv[0]), e3 = __expf(tv[3] - tv[0]); const float inv = 1.0f / (1.0f + e1 + e2 + e3);
            tg[0] = inv; tg[1] = e1 * inv; tg[2] = e2 * inv; tg[3] = e3 * inv;
            if (kh == 0) {
#pragma unroll
                for (int k = 0; k < 4; ++k) lp[k] = __hip_atomic_fetch_add(cntl + te[k], 1u, __ATOMIC_RELAXED, __HIP_MEMORY_SCOPE_WORKGROUP);
            }
        }
        __syncthreads();
        if (F.tid < 32) { const unsigned c = cntl[F.tid]; basel[F.tid] = c ? atomicAdd(cnt + F.tid, c) : 0u; }
        __syncthreads();
        if (F.wave < 4 && kh == 0) {
#pragma unroll
            for (int k = 0; k < 4; ++k) { rt_e[t * 4 + k] = te[k]; rt_g[t * 4 + k] = tg[k]; rt_pos[t * 4 + k] = (int)(basel[te[k]] + lp[k]); }
        }
        __syncthreads();
    }
}

__device__ __forceinline__ int pad_starts(const unsigned* cnt, int lane) {
    const int c = lane < 32 ? (int)__hip_atomic_load(cnt + lane, __ATOMIC_RELAXED, __HIP_MEMORY_SCOPE_AGENT) : 0;
    int p = (c + 255) & ~255, incl = p;
#pragma unroll
    for (int o = 1; o < 64; o <<= 1) { const int n = __shfl_up(incl, o); if (lane >= o) incl += n; }
    return incl - p;
}

__device__ __forceinline__ void p8_scatter(Frame& F) {
    const float* tab = (const float*)(F.ws + WS_TAB); const unsigned* cnt = (const unsigned*)(F.ws + WS_CTL) + CW_CNT;
    const int* rt_e = (const int*)(F.ws + WS_RT + RT_E); const int* rt_pos = (const int*)(F.ws + WS_RT + RT_POS); int* rt_slot = (int*)(F.ws + WS_RT + RT_SLOT);
    unsigned char* XG = F.ws + WS_XG;
    const int gw = F.vcu * NWAVES + F.wave, NGW = F.G * NWAVES;
    const int pst = pad_starts(cnt, F.lane);
    const f32x4* gf = (const f32x4*)F.in[I_GFFN] + F.lane;
    for (int t = gw; t < TT; t += NGW) {
        const int b = t >> 13;
        const f32x4* xr = (const f32x4*)(F.out + (size_t)t * DM) + F.lane;
        const f32x4* sh = (const f32x4*)(tab + TB_MOD + b * 6144 + 3 * 1024) + F.lane; const f32x4* sc = (const f32x4*)(tab + TB_MOD + b * 6144 + 4 * 1024) + F.lane;
        f32x4 v[4]; float s = 0.f;
#pragma unroll
        for (int jj = 0; jj < 4; ++jj) { v[jj] = xr[64 * jj]; s += (v[jj].x * v[jj].x + v[jj].y * v[jj].y) + (v[jj].z * v[jj].z + v[jj].w * v[jj].w); }
        const float rstd = 1.0f / sqrtf(wave_sum(s) * (1.f / DM) + NORM_EPS);
        unsigned pk[4];
#pragma unroll
        for (int jj = 0; jj < 4; ++jj) { const f32x4 g = gf[64 * jj], a = sc[64 * jj], c = sh[64 * jj]; const f32x4 h = (v[jj] * rstd) * g * (a + 1.0f) + c;
            pk[jj] = pg8::pk4_fp8(h.x, h.y, h.z, h.w); }
        const int my_e = rt_e[t * 4 + (F.lane & 3)], my_pos = rt_pos[t * 4 + (F.lane & 3)];
#pragma unroll
        for (int k = 0; k < 4; ++k) { const int e = __shfl(my_e, k), pos = __shfl(my_pos, k); const int slot = __shfl(pst, e) + pos;
            unsigned* o4 = (unsigned*)(XG + (size_t)slot * DM) + F.lane;
#pragma unroll
            for (int jj = 0; jj < 4; ++jj) o4[64 * jj] = pk[jj];
            if (F.lane == 0) rt_slot[t * 4 + k] = slot; }
    }
}

__device__ __forceinline__ int moe_block_table(Frame& F, LAS int* bexp) {
    const unsigned* cnt = (const unsigned*)(F.ws + WS_CTL) + CW_CNT;
    const int pst = pad_starts(cnt, F.lane);
    const int total = __shfl(pst, 32) >> 8;
    if (F.wave == 0) {
        const int nxt = __shfl_down(pst, 1);
        if (F.lane < 32) for (int bl = pst >> 8; bl < (nxt >> 8); ++bl) bexp[bl] = F.lane;
    }
    __syncthreads();
    return __builtin_amdgcn_readfirstlane(total);
}

__device__ __forceinline__ void p11_combine(Frame& F) {
    const float* tab = (const float*)(F.ws + WS_TAB); const bf16* Y = (const bf16*)(F.ws + WS_Y);
    const float* rt_g = (const float*)(F.ws + WS_RT + RT_G); const int* rt_slot = (const int*)(F.ws + WS_RT + RT_SLOT);
    const int gw = F.vcu * NWAVES + F.wave, NGW = F.G * NWAVES;
    for (int t = gw; t < TT; t += NGW) {
        const int b = t >> 13;
        f32x4* xr = (f32x4*)(F.out + (size_t)t * DM) + F.lane;
        const f32x4* g2 = (const f32x4*)(tab + TB_MOD + b * 6144 + 5 * 1024) + F.lane;
        f32x4 acc[4];
#pragma unroll
        for (int jj = 0; jj < 4; ++jj) acc[jj] = (f32x4){0.f, 0.f, 0.f, 0.f};
        const int my_slot = rt_slot[t * 4 + (F.lane & 3)]; const float my_g = rt_g[t * 4 + (F.lane & 3)];
#pragma unroll
        for (int k = 0; k < 4; ++k) { const int slot = __shfl(my_slot, k); const float g = __shfl(my_g, k);
            const v2u* yr = (const v2u*)(Y + (size_t)slot * DM) + F.lane;
#pragma unroll
            for (int jj = 0; jj < 4; ++jj) { const v2u w = yr[64 * jj]; acc[jj] += (f32x4){bflo(w.x), bfhi(w.x), bflo(w.y), bfhi(w.y)} * g; } }
#pragma unroll
        for (int jj = 0; jj < 4; ++jj) xr[64 * jj] = xr[64 * jj] + g2[64 * jj] * acc[jj];
#ifdef MK_DBG_ATT
        if (t == 0 && F.lane == 0) { const float* dbg = tab + TB_RC + 128; F.out[0] += 8.0f + 120.0f * (dbg[0] / dbg[1]); }
#endif
    }
}

#define XB_TMO      128
#define XB_XCNT(j)  (256  + 64 * (j))
#define XB_XSUB(j)  (1280 + 64 * (j))
#define XB_XGEN(j)  (2304 + 64 * (j))
#define XB_TOP      3328
#define XB_TOPGEN   3392
#define XCD_BAR_WORDS 3456
#define XB_SPIN_CAP (1u << 18)

__device__ __forceinline__ unsigned xb_ld(unsigned* p)              { return __hip_atomic_load(p, __ATOMIC_RELAXED, __HIP_MEMORY_SCOPE_AGENT); }
__device__ __forceinline__ unsigned xb_add(unsigned* p, unsigned v) { return __hip_atomic_fetch_add(p, v, __ATOMIC_RELAXED, __HIP_MEMORY_SCOPE_AGENT); }
__device__ __forceinline__ unsigned xb_xcc_id() { return (unsigned)__builtin_amdgcn_s_getreg((3 << 11) | 20) & 0xFu; }
#define XB_SPIN(cond, bar) do { unsigned _sp = 0; while (cond) { __builtin_amdgcn_s_sleep(1); \
    if ((++_sp & 255u) == 0u) { if (xb_ld(&(bar)[XB_TMO])) break; if (_sp > XB_SPIN_CAP) { atomicAdd(&(bar)[XB_TMO], 1u); break; } } } } while (0)

struct XcdBarrier {
    unsigned* bar; unsigned x;
    volatile LAS unsigned* st;
};

__device__ __forceinline__ XcdBarrier xcd_barrier_post(unsigned* bar, volatile LAS unsigned* st) {
    XcdBarrier b; b.bar = bar; b.x = xb_xcc_id(); b.st = st;
    if (threadIdx.x == 0) (void)xb_add(&bar[XB_XCNT(b.x)], 1u);
    return b;
}
__device__ __forceinline__ void xcd_barrier_complete(unsigned* bar, unsigned x, unsigned& nloc, unsigned& nx) {
    const unsigned G = gridDim.x * gridDim.y * gridDim.z;
    unsigned sum, cnt, mine, sp = 0u;
    for (;;) {
        sum = 0u; cnt = 0u; mine = 0u;
#pragma unroll
        for (unsigned j = 0; j < 16; ++j) { const unsigned c = xb_ld(&bar[XB_XCNT(j)]); sum += c; cnt += (c > 0u) ? 1u : 0u; mine = (j == x) ? c : mine; }
        if (sum == G) break;
        __builtin_amdgcn_s_sleep(1);
        if ((++sp & 255u) == 0u) { if (xb_ld(&bar[XB_TMO])) break; if (sp > XB_SPIN_CAP) { atomicAdd(&bar[XB_TMO], 1u); break; } }
    }
    nloc = mine > 0u ? mine : 1u; nx = cnt > 0u ? cnt : 1u;
}

__device__ __forceinline__ void xcd_barrier(const XcdBarrier& b) {
    asm volatile("s_waitcnt vmcnt(0)" ::: "memory");
    __syncthreads();
    if (threadIdx.x == 0) {
        unsigned* bar = b.bar;
        __builtin_amdgcn_s_waitcnt(0);
        unsigned nloc = b.st[0], nx = b.st[1];
        if (nloc == 0u) { xcd_barrier_complete(bar, b.x, nloc, nx); b.st[0] = nloc; b.st[1] = nx; }
        const unsigned old = xb_add(&bar[XB_XSUB(b.x)], 1u);
        const unsigned gen = old / nloc;
        if (old + 1u == (gen + 1u) * nloc) {
            __builtin_amdgcn_fence(__ATOMIC_RELEASE, "agent");
            asm volatile("s_waitcnt vmcnt(0)" ::: "memory");
            const unsigned og = xb_add(&bar[XB_TOP], 1u);
            const unsigned tg = og / nx;
            if (og + 1u == (tg + 1u) * nx) xb_add(&bar[XB_TOPGEN], 1u);
            else XB_SPIN(xb_ld(&bar[XB_TOPGEN]) == tg, bar);
            __builtin_amdgcn_fence(__ATOMIC_ACQUIRE, "agent");
            xb_add(&bar[XB_XGEN(b.x)], 1u);
            asm volatile("s_waitcnt vmcnt(0)" ::: "memory");
        } else {
            XB_SPIN(xb_ld(&bar[XB_XGEN(b.x)]) == gen, bar);
            __builtin_amdgcn_fence(__ATOMIC_ACQUIRE, "agent");
            asm volatile("s_waitcnt vmcnt(0)" ::: "memory");
        }
    }
    __syncthreads();
}

struct Args { const float* in[N_IN]; float* out; unsigned char* ws; int ph_lo, ph_hi, li, pad; };
__global__ void __launch_bounds__(NWAVES * 64, 2) mk_fwd(Args args) {
    extern __shared__ __attribute__((aligned(16))) unsigned char lds[];
    Frame F;
    F.lds = (LAS unsigned char*)lds;
    F.tid = threadIdx.x; F.lane = F.tid & 63; F.wave = __builtin_amdgcn_readfirstlane(F.tid >> 6);
    F.G = gridDim.x; { const int bx = blockIdx.x; F.vcu = (F.G % 8 == 0) ? (bx % 8) * (F.G / 8) + bx / 8 : bx; }
#pragma unroll
    for (int i = 0; i < N_IN; ++i) F.in[i] = args.in[i];
    F.out = args.out; F.ws = args.ws;
    const int lo = args.ph_lo, hi = args.ph_hi;
    volatile LAS unsigned* bst = (volatile LAS unsigned*)(F.lds + MISC_OFF + 4096);
    if (F.tid < 2) bst[F.tid] = 0u;
    __syncthreads();
    XcdBarrier bar; bar.bar = (unsigned*)(F.ws + WS_CTL) + CW_BAR + args.li * XCD_BAR_WORDS; bar.x = 0; bar.st = nullptr;
    if (hi - lo > 1) bar = xcd_barrier_post((unsigned*)(F.ws + WS_CTL) + CW_BAR + args.li * XCD_BAR_WORDS, bst);
#ifndef MK_PHASE_MASK
#define MK_PHASE_MASK 0xFFF
#endif
#define IN(k) (((MK_PHASE_MASK >> (k)) & 1) && lo <= (k) && (k) < hi)
#define SEAM(k) do { if (IN(k) && IN((k) + 1)) { if ((k) == 0) cg::this_grid().sync(); else xcd_barrier(bar); } } while (0)
    if (IN(0)) { p0_prologue(F); } SEAM(0);
    if (IN(1)) { p1_norm(F); } SEAM(1);
    if (IN(2)) {
        pg8::Gemm g{(const bf16*)(F.ws + WS_XN), (const bf16*)(F.ws + WS_WQKV), MQ, NQKV, DM, 0};
        pg8::StaticOrder S; S.init(MQ, NQKV, F.G, (int)blockIdx.x);
        pg8::EpiBf16<0> E{(bf16*)(F.ws + WS_P), NQKV, nullptr, 0, 0, 1.f};
        pg8::gemm_phase<pg8::EpiBf16<0>, pg8::StaticOrder, true, true>(F.lds, g, S, E);
    } SEAM(2);
    if (IN(3)) { p3_qknorm(F); } SEAM(3);
    if (IN(4)) { p4_attention(F, (char*)lds); } SEAM(4);
    if (IN(5)) { p5_mix(F); } SEAM(5);
    if (IN(6)) {
        pg8::Gemm g{(const bf16*)(F.ws + WS_MIX), (const bf16*)(F.ws + WS_WO), TT, DM, DM, 0};
        pg8::StaticOrder S; S.init(TT, DM, F.G, (int)blockIdx.x);
        pg8::EpiOut E{F.in[I_X], F.out, (const float*)(F.ws + WS_TAB) + TB_MOD};
        pg8::gemm_phase<pg8::EpiOut, pg8::StaticOrder, true, true>(F.lds, g, S, E);
    } SEAM(6);
    if (IN(7)) { p7_router(F); } SEAM(7);
    if (IN(8)) { p8_scatter(F); } SEAM(8);
    if (IN(9)) {
        LAS int* bexp = (LAS int*)(F.lds + MISC_OFF + 1024);
        const int nblk = moe_block_table(F, bexp);
        pg8::Gemm g{(const bf16*)(F.ws + WS_XG), (const bf16*)(F.ws + WS_WGU), MPAD, 2048, DM, (size_t)2048 * 1024};
        pg8::MoeOrder S; S.init(nblk, 8, F.G, (int)blockIdx.x, bexp);
        pg8::EpiSwiGLU E{F.ws + WS_ACT, F.in[I_BGU]};
        pg8::gemm_phase<pg8::EpiSwiGLU, pg8::MoeOrder, true, true, 1>(F.lds, g, S, E);
    } SEAM(9);
    if (IN(10)) {
        LAS int* bexp = (LAS int*)(F.lds + MISC_OFF + 1024);
        const int nblk = moe_block_table(F, bexp);
        pg8::Gemm g{(const bf16*)(F.ws + WS_ACT), (const bf16*)(F.ws + WS_WDN), MPAD, 1024, DM, (size_t)1024 * 1024};
        pg8::MoeOrder S; S.init(nblk, 4, F.G, (int)blockIdx.x, bexp);
        pg8::EpiDown E{(bf16*)(F.ws + WS_Y), F.in[I_BD]};
        pg8::gemm_phase<pg8::EpiDown, pg8::MoeOrder, true, true, 1>(F.lds, g, S, E);
    } SEAM(10);
    if (IN(11)) { p11_combine(F); }
#undef IN
#undef SEAM
}

extern "C" void kernel_launch(void* const* d_in, const int* in_sizes, int n_in, void* d_out, int out_size, void* d_ws, size_t ws_size, hipStream_t stream) {
    static int grid = 0;
    if (grid == 0) {
        if (n_in != N_IN || in_sizes[0] != TT * DM || out_size != TT * DM || ws_size < WS_END) { fprintf(stderr, "kernel_launch: unexpected shapes (n_in %d, in0 %d, out %d, ws %zu)\n", n_in, n_in > 0 ? in_sizes[0] : -1, out_size, ws_size); grid = -1; return; }
        int dev = 0, cus = 0, per_cu = 0;
        if (hipGetDevice(&dev) != hipSuccess || hipDeviceGetAttribute(&cus, hipDeviceAttributeMultiprocessorCount, dev) != hipSuccess) { grid = -1; return; }
        if (hipFuncSetAttribute((const void*)mk_fwd, hipFuncAttributeMaxDynamicSharedMemorySize, LDS_BYTES) != hipSuccess) { fprintf(stderr, "kernel_launch: hipFuncSetAttribute failed\n"); grid = -1; return; }
        if (hipOccupancyMaxActiveBlocksPerMultiprocessor(&per_cu, (const void*)mk_fwd, NWAVES * 64, LDS_BYTES) != hipSuccess || per_cu < 1) { fprintf(stderr, "kernel_launch: occupancy query reports %d\n", per_cu); (void)hipGetLastError(); per_cu = 1; }
        grid = cus;
    }
    if (grid < 0) return;
    (void)hipMemsetAsync((char*)d_ws + WS_CTL, 0, CTL_ZERO_BYTES, stream);
    Args a{};
    for (int i = 0; i < N_IN; ++i) a.in[i] = (const float*)d_in[i];
    a.out = (float*)d_out; a.ws = (unsigned char*)d_ws;
    int lo_[3] = {0, 0, 0}, hi_[3] = {N_PHASES, 0, 0}, nl = 1;
    if (MK_PROBE_PHASE >= 0) { nl = 0; lo_[nl] = 0; hi_[nl] = MK_PROBE_PHASE + 1; ++nl; lo_[nl] = MK_PROBE_PHASE; hi_[nl] = MK_PROBE_PHASE + 1; ++nl; if (MK_PROBE_PHASE + 1 < N_PHASES) { lo_[nl] = MK_PROBE_PHASE + 1; hi_[nl] = N_PHASES; ++nl; } }
    for (int li = 0; li < nl; ++li) {
        a.ph_lo = lo_[li]; a.ph_hi = hi_[li]; a.li = li;
        void* params[] = {&a};
        const hipError_t e = hipLaunchCooperativeKernel((const void*)mk_fwd, dim3(grid), dim3(NWAVES * 64), params, LDS_BYTES, stream);
        if (e != hipSuccess) fprintf(stderr, "kernel_launch: cooperative launch failed: %s (grid %d)\n", hipGetErrorString(e), grid);
    }
}
```

```cpp
#include <hip/hip_runtime.h>
#include <hip/hip_cooperative_groups.h>
#include <cstdio>
#include <cstdint>
namespace cg = cooperative_groups;
namespace pg8 {
#define PG8_LAS __attribute__((address_space(3)))
typedef unsigned short bf16_t;
typedef short bf16x8 __attribute__((ext_vector_type(8)));
typedef float f32x4 __attribute__((ext_vector_type(4)));
typedef unsigned u32x4 __attribute__((ext_vector_type(4)));
constexpr int BM = 256, BK = 64, HALF = 128, HTB = HALF * BK * 2  , STAGE_BYTES = 8 * HTB, NXCD = 8, WGM = 8;

__host__ __device__ __forceinline__ int lds_byte(int r, int c) { const int st = (r >> 4) * 2 + (c >> 5), rr = r & 15, cc = c & 31, ob = rr * 64 + cc * 2; return st * 1024 + (ob ^ (((ob >> 9) & 1) << 5)); }
__host__ __device__ __forceinline__ void stage_rc(int b, int& R, int& C) { const int st = b / 1024, sb = b % 1024, swz = sb ^ (((sb >> 9) & 1) << 5); R = (st >> 1) * 16 + swz / 64; C = (st & 1) * 32 + (swz % 64) / 2; }
__host__ __device__ __forceinline__ int perm32(int rho) { const int n = rho >> 4, i = rho & 15; return 8 * (i >> 2) + 4 * n + (i & 3); }

struct Unit { int pm, pn, e; };
struct Gemm { const bf16_t* A; const bf16_t* Bt; int M, N, K; size_t estride; };

struct StaticOrder {
    int nM, nN, nwg, G, c;
    __host__ __device__ void init(int M, int N, int G_, int c_) { nM = M / BM; nN = N / BM; nwg = nM * nN; G = G_; c = c_; }
    __host__ __device__ bool next(int i, Unit& u) const {
        const long L = (long)i * G + c; if (L >= nwg) return false;
        int wgid = (int)L; { const int q = nwg / NXCD, r = nwg % NXCD, xcd = wgid % NXCD, off = wgid / NXCD; wgid = (xcd < r ? xcd * (q + 1) : r * (q + 1) + (xcd - r) * q) + off; }
        const int nig = WGM * nN, gid = wgid / nig, fm = gid * WGM, gsz = (nM - fm) < WGM ? (nM - fm) : WGM;
        u.pm = fm + ((wgid % nig) % gsz); u.pn = (wgid % nig) / gsz; u.e = 0; return true;
    }
    __device__ __forceinline__ void a_ready(const Unit&) const {}
    __device__ __forceinline__ void done(const Unit&) const {}
};

__device__ __forceinline__ unsigned cvt_pk_bf16(float lo, float hi) { unsigned r; asm volatile("v_cvt_pk_bf16_f32 %0, %1, %2" : "=v"(r) : "v"(lo), "v"(hi)); return r; }
typedef float f32x2 __attribute__((ext_vector_type(2)));
__device__ __forceinline__ f32x2 gelu_pk(f32x2 v) {
    const f32x2 av = __builtin_elementwise_abs(v), d = av * 0.2316418882f + 1.0f;
    f32x2 t; t.x = __builtin_amdgcn_rcpf(d.x); t.y = __builtin_amdgcn_rcpf(d.y);
    f32x2 q = t * 0.5307027145f + (-0.7265760135f); q = q * t + 0.7107068705f; q = q * t + (-0.142248368f); q = q * t + 0.127414796f; q = q * t;
    const f32x2 s = (v * v) * (-0.72134752044f);
    f32x2 e; e.x = __builtin_amdgcn_exp2f(s.x); e.y = __builtin_amdgcn_exp2f(s.y);
    const f32x2 m = v * (q * e), r = v - m;
    f32x2 o; o.x = v.x < 0.f ? m.x : r.x; o.y = v.y < 0.f ? m.y : r.y; return o;
}

template <int ACT  > struct EpiBf16 {
    static constexpr bool PERM = true, AFTER_DRAIN = false; static_assert(ACT == 0 || ACT == 1, "EpiBf16: ACT is 0 (none) or 1 (gelu_pk)");
    bf16_t* O; int ldc; const float* bias; int split_cols; size_t split_stride; float scale0;
    __device__ __forceinline__ void operator()(const f32x4 (&acc)[2][2][4][2], const Unit& u, int wr, int wc, int fr, int fq) const {
        const int row0 = u.pm * BM + wr * 64 + fr; int colt = u.pn * BM; bf16_t* base = O;
        float sc = 1.f; if (split_cols) { const int t = colt / split_cols; base += (size_t)t * split_stride; colt -= t * split_cols; if (t == 0) sc = scale0; }
        const int col0 = colt + wc * 32 + 8 * fq, bcol0 = u.pn * BM + wc * 32 + 8 * fq;
        f32x4 bv[2][2];
#pragma unroll
        for (int bj = 0; bj < 2; ++bj)
#pragma unroll
            for (int n = 0; n < 2; ++n) bv[bj][n] = bias ? *(const f32x4*)(bias + bcol0 + bj * HALF + 4 * n) : (f32x4){0.f, 0.f, 0.f, 0.f};
#pragma unroll
        for (int ai = 0; ai < 2; ++ai)
#pragma unroll
            for (int m = 0; m < 4; ++m) { bf16_t* rowp = base + (size_t)(row0 + ai * HALF + m * 16) * ldc + col0;
#pragma unroll
                for (int bj = 0; bj < 2; ++bj) { f32x4 v0 = acc[ai][bj][m][0] + bv[bj][0], v1 = acc[ai][bj][m][1] + bv[bj][1];
                    if (ACT == 1) { f32x2 a = gelu_pk((f32x2){v0[0], v0[1]}), b = gelu_pk((f32x2){v0[2], v0[3]}), c = gelu_pk((f32x2){v1[0], v1[1]}), d = gelu_pk((f32x2){v1[2], v1[3]});
                        v0 = (f32x4){a.x, a.y, b.x, b.y}; v1 = (f32x4){c.x, c.y, d.x, d.y}; }
                    v0 = v0 * sc; v1 = v1 * sc; u32x4 w; w.x = cvt_pk_bf16(v0[0], v0[1]); w.y = cvt_pk_bf16(v0[2], v0[3]); w.z = cvt_pk_bf16(v1[0], v1[1]); w.w = cvt_pk_bf16(v1[2], v1[3]);
                    *(u32x4*)(rowp + bj * HALF) = w; } }
    }
};

typedef int i32x4 __attribute__((ext_vector_type(4)));
typedef int i32x8 __attribute__((ext_vector_type(8)));
__device__ __forceinline__ i32x8 cat8(bf16x8 lo, bf16x8 hi) { const i32x4 a = __builtin_bit_cast(i32x4, lo), b = __builtin_bit_cast(i32x4, hi); return __builtin_shufflevector(a, b, 0, 1, 2, 3, 4, 5, 6, 7); }
template <class Epi, class Sched, bool ALIGN_EPI = false, bool SP2 = false, int ESZ = 2>
__device__ __forceinline__ void gemm_phase(PG8_LAS unsigned char* lds, const Gemm g, const Sched& S, const Epi& E) {
    const int tid = threadIdx.x, wid = __builtin_amdgcn_readfirstlane(tid >> 6), lane = tid & 63, wr = wid >> 2, wc = wid & 3, fr = lane & 15, fq = lane >> 4;
    const int K = g.K, nt = K * ESZ / (BK * 2);
    unsigned voffA[2], voffB[2];
#pragma unroll
    for (int i = 0; i < 2; ++i) { int R, C; stage_rc(tid * 16 + i * 8192, R, C); const int Rb = Epi::PERM ? ((R & ~31) + perm32(R & 31)) : R;
        voffA[i] = (unsigned)(R * K * ESZ + C * 2); voffB[i] = (unsigned)(Rb * K * ESZ + C * 2); }
    const size_t kstep = (size_t)(BK * 2);
    const size_t hstep = (size_t)HALF * K * ESZ;
    const size_t tstep = 2 * hstep;
    const unsigned ldsw = (unsigned)wid * 1024u;
    const int aoff = lds_byte(wr * 64 + fr, fq * 8), boff = lds_byte(wc * 32 + fr, fq * 8);
#define PG8_SA(b, h) (((b) * 2 + (h)) * HTB)
#define PG8_SB(b, h) ((4 + (b) * 2 + (h)) * HTB)
#define PG8_STAGE(bufoff, gbase, voff) do { _Pragma("unroll") for (int _i = 0; _i < 2; ++_i) \
        __builtin_amdgcn_global_load_lds((const unsigned*)((const char*)(gbase) + (voff)[_i]), (PG8_LAS unsigned*)(lds + (bufoff) + ldsw + _i * 8192), 16, 0, 0); } while (0)
#define PG8_LDA(dst, b, h) do { _Pragma("unroll") for (int m = 0; m < 4; ++m) _Pragma("unroll") for (int k = 0; k < 2; ++k) dst[m][k] = *(const PG8_LAS bf16x8*)(lds + PG8_SA(b, h) + aoff + m * 2048 + k * 1024); } while (0)
#define PG8_LDB(dst, b, h) do { _Pragma("unroll") for (int n = 0; n < 2; ++n) _Pragma("unroll") for (int k = 0; k < 2; ++k) dst[n][k] = *(const PG8_LAS bf16x8*)(lds + PG8_SB(b, h) + boff + n * 2048 + k * 1024); } while (0)
#define PG8_MMA(ai, bj, At, Bt) do { __builtin_amdgcn_s_setprio(1); _Pragma("unroll") for (int m = 0; m < 4; ++m) _Pragma("unroll") for (int n = 0; n < 2; ++n) { \
        if constexpr (ESZ == 2) { _Pragma("unroll") for (int k = 0; k < 2; ++k) acc[ai][bj][m][n] = __builtin_amdgcn_mfma_f32_16x16x32_bf16(Bt[n][k], At[m][k], acc[ai][bj][m][n], 0, 0, 0); } \
        else { acc[ai][bj][m][n] = __builtin_amdgcn_mfma_scale_f32_16x16x128_f8f6f4(cat8(Bt[n][0], Bt[n][1]), cat8(At[m][0], At[m][1]), acc[ai][bj][m][n], 0, 0, 0, 0x7f7f7f7f, 0, 0x7f7f7f7f); } } \
        if constexpr (ESZ == 1) {   \
            _Pragma("unroll") for (int m = 0; m < 4; ++m) asm volatile("" : "+v"(acc[ai][bj][m][0]), "+v"(acc[ai][bj][m][1])); } \
        __builtin_amdgcn_s_setprio(0); } while (0)
#define PG8_WAIT_V(n) asm volatile("s_waitcnt vmcnt(" #n ")" ::: "memory")
#define PG8_WAIT_L(n) asm volatile("s_waitcnt lgkmcnt(" #n ")" ::: "memory")
#define PG8_BAR __builtin_amdgcn_s_barrier()
#define PG8_SCHED __builtin_amdgcn_sched_barrier(0)
    Unit cur, nxt; int ui = 0;
    if (!S.next(0, cur)) return;
    f32x4 acc[2][2][4][2];
#pragma unroll
    for (int a = 0; a < 2; ++a)
#pragma unroll
        for (int b = 0; b < 2; ++b)
#pragma unroll
            for (int m = 0; m < 4; ++m)
#pragma unroll
                for (int n = 0; n < 2; ++n) acc[a][b][m][n] = (f32x4){0.f, 0.f, 0.f, 0.f};
    bf16x8 At[4][2], B0[2][2], B1[2][2];
    const char* cA = (const char*)g.A + (size_t)cur.pm * tstep; const char* cB = (const char*)g.Bt + (size_t)cur.e * g.estride + (size_t)cur.pn * tstep;
    S.a_ready(cur);
    if constexpr (SP2) {
        PG8_STAGE(PG8_SB(0, 0), cB, voffB); PG8_STAGE(PG8_SB(0, 1), cB + hstep, voffB); PG8_STAGE(PG8_SA(0, 0), cA, voffA); PG8_STAGE(PG8_SA(0, 1), cA + hstep, voffA);
        if (wr == 1) PG8_BAR;
        PG8_WAIT_V(2); PG8_BAR;
        PG8_STAGE(PG8_SB(1, 0), cB + kstep, voffB); PG8_STAGE(PG8_SA(1, 0), cA + kstep, voffA); PG8_STAGE(PG8_SB(1, 1), cB + hstep + kstep, voffB);
        PG8_WAIT_V(6); PG8_BAR;
    } else {
        PG8_STAGE(PG8_SB(0, 0), cB, voffB); PG8_STAGE(PG8_SA(0, 0), cA, voffA); PG8_STAGE(PG8_SB(0, 1), cB + hstep, voffB); PG8_STAGE(PG8_SA(0, 1), cA + hstep, voffA);
        if (wr == 1) PG8_BAR;
        PG8_WAIT_V(4); PG8_BAR;
        PG8_STAGE(PG8_SB(1, 0), cB + kstep, voffB); PG8_STAGE(PG8_SA(1, 0), cA + kstep, voffA); PG8_STAGE(PG8_SB(1, 1), cB + hstep + kstep, voffB);
        PG8_WAIT_V(6); PG8_BAR;
    }
    for (;;) {
        const bool has_next = S.next(ui + 1, nxt);
        const char* nA = has_next ? (const char*)g.A + (size_t)nxt.pm * tstep : cA; const char* nB = has_next ? (const char*)g.Bt + (size_t)nxt.e * g.estride + (size_t)nxt.pn * tstep : cB;
        for (int t = 0; t < nt; t += 2) {
            const bool last = (t == nt - 2);
            const char* a1 = cA + (size_t)(t + 1) * kstep;
            const char* a2 = last ? nA : cA + (size_t)(t + 2) * kstep; const char* b2 = last ? nB : cB + (size_t)(t + 2) * kstep;
            const char* a3 = a2 + kstep; const char* b3 = b2 + kstep;
            if (last && has_next) S.a_ready(nxt);
            if constexpr (SP2) {
            PG8_LDB(B0, 0, 0); PG8_LDB(B1, 0, 1); PG8_SCHED; PG8_LDA(At, 0, 0); PG8_STAGE(PG8_SA(1, 1), a1 + hstep, voffA);
            PG8_WAIT_V(8); PG8_WAIT_L(0); PG8_BAR; PG8_MMA(0, 0, At, B0); PG8_MMA(0, 1, At, B1); PG8_BAR; PG8_SCHED;
            PG8_LDA(At, 0, 1); PG8_STAGE(PG8_SB(0, 0), b2, voffB); PG8_STAGE(PG8_SB(0, 1), b2 + hstep, voffB); PG8_STAGE(PG8_SA(0, 0), a2, voffA);
            PG8_WAIT_V(8); PG8_WAIT_L(0); PG8_BAR; PG8_MMA(1, 0, At, B0); PG8_MMA(1, 1, At, B1); PG8_BAR; PG8_SCHED;
            PG8_LDB(B0, 1, 0); PG8_LDB(B1, 1, 1); PG8_SCHED; PG8_LDA(At, 1, 0); PG8_STAGE(PG8_SA(0, 1), a2 + hstep, voffA);
            PG8_WAIT_V(8); PG8_WAIT_L(0); PG8_BAR; PG8_MMA(0, 0, At, B0); PG8_MMA(0, 1, At, B1); PG8_BAR; PG8_SCHED;
            PG8_LDA(At, 1, 1); PG8_STAGE(PG8_SB(1, 0), b3, voffB); PG8_STAGE(PG8_SB(1, 1), b3 + hstep, voffB); PG8_STAGE(PG8_SA(1, 0), a3, voffA);
            PG8_WAIT_V(8); PG8_WAIT_L(0); PG8_BAR; PG8_MMA(1, 0, At, B0); PG8_MMA(1, 1, At, B1); PG8_BAR; PG8_SCHED;
            } else {
            PG8_LDB(B0, 0, 0); PG8_SCHED; PG8_LDA(At, 0, 0); PG8_STAGE(PG8_SA(1, 1), a1 + hstep, voffA);
            PG8_WAIT_L(8); PG8_BAR; PG8_WAIT_L(0); PG8_MMA(0, 0, At, B0); PG8_BAR; PG8_SCHED;
            PG8_LDB(B1, 0, 1); PG8_STAGE(PG8_SB(0, 0), b2, voffB);
            PG8_BAR; PG8_WAIT_L(0); PG8_MMA(0, 1, At, B1); PG8_BAR;
            PG8_LDA(At, 0, 1); PG8_STAGE(PG8_SA(0, 0), a2, voffA);
            PG8_BAR; PG8_WAIT_L(0); PG8_MMA(1, 0, At, B0); PG8_BAR; PG8_SCHED;
            PG8_STAGE(PG8_SB(0, 1), b2 + hstep, voffB);
            PG8_WAIT_V(6); PG8_BAR; PG8_MMA(1, 1, At, B1); PG8_BAR;
            PG8_LDB(B0, 1, 0); PG8_SCHED; PG8_LDA(At, 1, 0); PG8_STAGE(PG8_SA(0, 1), a2 + hstep, voffA);
            PG8_WAIT_L(8); PG8_BAR; PG8_WAIT_L(0); PG8_MMA(0, 0, At, B0); PG8_BAR; PG8_SCHED;
            PG8_LDB(B1, 1, 1); PG8_STAGE(PG8_SB(1, 0), b3, voffB);
            PG8_BAR; PG8_WAIT_L(0); PG8_MMA(0, 1, At, B1); PG8_BAR;
            PG8_LDA(At, 1, 1); PG8_STAGE(PG8_SA(1, 0), a3, voffA);
            PG8_BAR; PG8_WAIT_L(0); PG8_MMA(1, 0, At, B0); PG8_BAR; PG8_SCHED;
            PG8_STAGE(PG8_SB(1, 1), b3 + hstep, voffB);
            PG8_WAIT_V(6); PG8_BAR; PG8_MMA(1, 1, At, B1); PG8_BAR;
            }
        }
        if constexpr (ALIGN_EPI) { if (wr == 0) PG8_BAR; }
        if constexpr (!Epi::AFTER_DRAIN) { E(acc, cur, wr, wc, fr, fq); S.done(cur); }
        if (!has_next) break;
#pragma unroll
        for (int a = 0; a < 2; ++a)
#pragma unroll
            for (int b = 0; b < 2; ++b)
#pragma unroll
                for (int m = 0; m < 4; ++m)
#pragma unroll
                    for (int n = 0; n < 2; ++n) acc[a][b][m][n] = (f32x4){0.f, 0.f, 0.f, 0.f};
        cur = nxt; cA = nA; cB = nB; ++ui;
        if constexpr (ALIGN_EPI) { if (wr == 1) PG8_BAR; }
    }
    PG8_WAIT_V(0);
    if constexpr (!ALIGN_EPI) { if (wr == 0) PG8_BAR; }
    PG8_BAR;
    if constexpr (Epi::AFTER_DRAIN) { E.fused(acc, cur, wr, wc, fr, fq, lds, wid, lane); S.done(cur); }
#undef PG8_SA
#undef PG8_SB
#undef PG8_STAGE
#undef PG8_LDA
#undef PG8_LDB
#undef PG8_MMA
#undef PG8_WAIT_V
#undef PG8_WAIT_L
#undef PG8_BAR
#undef PG8_SCHED
}
}

namespace pg8 {
struct MoeOrder {
    int nM, nN, nwg, G, c; const PG8_LAS int* bexp;
    __device__ __forceinline__ void init(int nM_, int nN_, int G_, int c_, const PG8_LAS int* bexp_) { nM = nM_; nN = nN_; nwg = nM_ * nN_; G = G_; c = c_; bexp = bexp_; }
    __device__ __forceinline__ bool next(int i, Unit& u) const {
        const long L = (long)i * G + c; if (L >= nwg) return false;
        int wgid = (int)L; { const int q = nwg / NXCD, r = nwg % NXCD, xcd = wgid % NXCD, off = wgid / NXCD; wgid = (xcd < r ? xcd * (q + 1) : r * (q + 1) + (xcd - r) * q) + off; }
        const int nig = WGM * nN, gid = wgid / nig, fm = gid * WGM, gsz = (nM - fm) < WGM ? (nM - fm) : WGM;
        u.pm = fm + ((wgid % nig) % gsz); u.pn = (wgid % nig) / gsz; u.e = __builtin_amdgcn_readfirstlane(bexp[u.pm]); return true;
    }
    __device__ __forceinline__ void a_ready(const Unit&) const {}
    __device__ __forceinline__ void done(const Unit&) const {}
};
struct EpiOut {
    static constexpr bool PERM = false, AFTER_DRAIN = false;
    const float* x; float* out; const float* mod;
    __device__ __forceinline__ void operator()(const f32x4 (&acc)[2][2][4][2], const Unit& u, int wr, int wc, int fr, int fq) const {
        const int row0 = u.pm * BM + wr * 64 + fr, col0 = u.pn * BM + wc * 32 + 4 * fq;
        const float* g = mod + (size_t)(u.pm >> 5) * 6144 + 2 * 1024;
        f32x4 gv[2][2];
#pragma unroll
        for (int bj = 0; bj < 2; ++bj)
#pragma unroll
            for (int n = 0; n < 2; ++n) gv[bj][n] = *(const f32x4*)(g + col0 + bj * HALF + n * 16);
#pragma unroll
        for (int ai = 0; ai < 2; ++ai)
#pragma unroll
            for (int m = 0; m < 4; ++m) { const size_t off = (size_t)(row0 + ai * HALF + m * 16) * 1024 + col0;
#pragma unroll
                for (int bj = 0; bj < 2; ++bj)
#pragma unroll
                    for (int n = 0; n < 2; ++n) { const f32x4 xv = *(const f32x4*)(x + off + bj * HALF + n * 16); *(f32x4*)(out + off + bj * HALF + n * 16) = xv + gv[bj][n] * acc[ai][bj][m][n]; } }
    }
};
__device__ __forceinline__ float swiglu1(float g, float l) {
    const float glu = fminf(g, 7.0f), lin = fminf(fmaxf(l, -7.0f), 7.0f);
    const float sg = __builtin_amdgcn_rcpf(1.0f + __builtin_amdgcn_exp2f(glu * (-1.702f * 1.4426950408889634f)));
    return glu * sg * (lin + 1.0f);
}
__device__ __forceinline__ unsigned pk4_fp8(float a, float b, float c, float d) { int w = 0; w = __builtin_amdgcn_cvt_pk_fp8_f32(a, b, w, false); w = __builtin_amdgcn_cvt_pk_fp8_f32(c, d, w, true); return (unsigned)w; }
constexpr float W8_SCALE = 32.0f, W8_INV = 1.0f / 32.0f;
struct EpiSwiGLU {
    static constexpr bool PERM = true, AFTER_DRAIN = false;
    unsigned char* act; const float* bgu;
    __device__ __forceinline__ void operator()(const f32x4 (&acc)[2][2][4][2], const Unit& u, int wr, int wc, int fr, int fq) const {
        const int row0 = u.pm * BM + wr * 64 + fr, cg = u.pn * 128 + wc * 32 + 8 * fq;
        const float* bb = bgu + (size_t)u.e * 2048;
        f32x4 bg[2], bl[2];
#pragma unroll
        for (int n = 0; n < 2; ++n) { bg[n] = *(const f32x4*)(bb + cg + 4 * n); bl[n] = *(const f32x4*)(bb + 1024 + cg + 4 * n); }
#pragma unroll
        for (int ai = 0; ai < 2; ++ai)
#pragma unroll
            for (int m = 0; m < 4; ++m) { unsigned char* rowp = act + (size_t)(row0 + ai * HALF + m * 16) * 1024 + cg;
                const f32x4 g0 = acc[ai][0][m][0] * W8_INV + bg[0], g1 = acc[ai][0][m][1] * W8_INV + bg[1], l0 = acc[ai][1][m][0] * W8_INV + bl[0], l1 = acc[ai][1][m][1] * W8_INV + bl[1];
                typedef unsigned u32x2 __attribute__((ext_vector_type(2)));
                u32x2 w; w.x = pk4_fp8(swiglu1(g0[0], l0[0]), swiglu1(g0[1], l0[1]), swiglu1(g0[2], l0[2]), swiglu1(g0[3], l0[3]));
                w.y = pk4_fp8(swiglu1(g1[0], l1[0]), swiglu1(g1[1], l1[1]), swiglu1(g1[2], l1[2]), swiglu1(g1[3], l1[3]));
                *(u32x2*)rowp = w; }
    }
};
struct EpiDown {
    static constexpr bool PERM = true, AFTER_DRAIN = false;
    bf16_t* y; const float* bd;
    __device__ __forceinline__ void operator()(const f32x4 (&acc)[2][2][4][2], const Unit& u, int wr, int wc, int fr, int fq) const {
        const int row0 = u.pm * BM + wr * 64 + fr, col0 = u.pn * BM + wc * 32 + 8 * fq;
        const float* bb = bd + (size_t)u.e * 1024 + col0;
        f32x4 bv[2][2];
#pragma unroll
        for (int bj = 0; bj < 2; ++bj)
#pragma unroll
            for (int n = 0; n < 2; ++n) bv[bj][n] = *(const f32x4*)(bb + bj * HALF + 4 * n);
#pragma unroll
        for (int ai = 0; ai < 2; ++ai)
#pragma unroll
            for (int m = 0; m < 4; ++m) { bf16_t* rowp = y + (size_t)(row0 + ai * HALF + m * 16) * 1024 + col0;
#pragma unroll
                for (int bj = 0; bj < 2; ++bj) { const f32x4 v0 = acc[ai][bj][m][0] * W8_INV + bv[bj][0], v1 = acc[ai][bj][m][1] * W8_INV + bv[bj][1];
                    u32x4 w; w.x = cvt_pk_bf16(v0[0], v0[1]); w.y = cvt_pk_bf16(v0[2], v0[3]); w.z = cvt_pk_bf16(v1[0], v1[1]); w.w = cvt_pk_bf16(v1[2], v1[3]);
                    *(u32x4*)(rowp + bj * HALF) = w; } }
    }
};
}

namespace att {
typedef unsigned short bf16_t;
using bf16x8 = __attribute__((ext_vector_type(8))) short;
using s16x4  = __attribute__((ext_vector_type(4))) short;
using f32x16 = __attribute__((ext_vector_type(16))) float;
using u32x4  = __attribute__((ext_vector_type(4))) unsigned;
constexpr int NW = 8, QBLK = 32, KVBLK = 64, LD = 3072;
constexpr float SCALE = 0.125f, C2 = 0.125f * 1.4426950408889634f;
#define KSWZ64(row, colB) ((row) * 128 + ((colB) ^ ((((row) >> 1) & 7) << 4)))
#define ASBAR() __builtin_amdgcn_sched_barrier(0)
__device__ __forceinline__ int crow(int r, int hi) { return (r & 3) + 8 * (r >> 2) + 4 * hi; }
__device__ __forceinline__ unsigned cvtpk(float lo, float hi) { unsigned r; asm volatile("v_cvt_pk_bf16_f32 %0, %1, %2" : "=v"(r) : "v"(lo), "v"(hi)); return r; }
__device__ __forceinline__ bf16x8 ld8(const bf16_t* p) { return *reinterpret_cast<const bf16x8*>(p); }
__device__ __forceinline__ void glds16(const void* gsrc, unsigned lds_dst) { unsigned keep;
  asm volatile("s_mov_b32 %0, m0\n\ts_mov_b32 m0, %2\n\ts_nop 0\n\tglobal_load_lds_dwordx4 %1, off\n\ts_mov_b32 m0, %0" : "=&s"(keep) : "v"(gsrc), "s"(lds_dst) : "memory"); }

__device__ __forceinline__ void exp16(f32x16& p, float mref) {
#pragma unroll
  for (int r = 0; r < 16; ++r) p[r] = __builtin_amdgcn_exp2f(p[r]);
}
__device__ __forceinline__ void finishSM(f32x16& p0, f32x16& p1, float mref, float& l_reg, bf16x8& pa0, bf16x8& pa1, bf16x8& pa2, bf16x8& pa3) {
  exp16(p1, mref);
  float ps = 0;
#pragma unroll
  for (int r = 0; r < 16; ++r) ps += p0[r];
#pragma unroll
  for (int r = 0; r < 16; ++r) ps += p1[r];
  l_reg += ps;
#define PK4(P, BASE, OUT) do { u32x4 w = {cvtpk(P[BASE + 0], P[BASE + 1]), cvtpk(P[BASE + 2], P[BASE + 3]), cvtpk(P[BASE + 4], P[BASE + 5]), cvtpk(P[BASE + 6], P[BASE + 7])}; OUT = *reinterpret_cast<bf16x8*>(&w); } while (0)
  PK4(p0, 0, pa0); PK4(p0, 8, pa1); PK4(p1, 0, pa2); PK4(p1, 8, pa3);
#undef PK4
}
template <bool NEGM> __device__ __forceinline__ void qkt(f32x16& p0, f32x16& p1, const char* Ks, const bf16x8* qr, const f32x16& negm, int r32, int hi) {
#pragma unroll
  for (int d0 = 0; d0 < 4; ++d0) { const int cb = (d0 * 16 + hi * 8) * 2;
    const bf16x8 b0 = *reinterpret_cast<const bf16x8*>(Ks + KSWZ64(r32, cb));
    const bf16x8 b1 = *reinterpret_cast<const bf16x8*>(Ks + KSWZ64(32 + r32, cb));
    if (d0 == 0) { if constexpr (NEGM) { p0 = __builtin_amdgcn_mfma_f32_32x32x16_bf16(b0, qr[0], negm, 0, 0, 0); p1 = __builtin_amdgcn_mfma_f32_32x32x16_bf16(b1, qr[0], negm, 0, 0, 0); }
      else { p0 = __builtin_amdgcn_mfma_f32_32x32x16_bf16(b0, qr[0], f32x16{}, 0, 0, 0); p1 = __builtin_amdgcn_mfma_f32_32x32x16_bf16(b1, qr[0], f32x16{}, 0, 0, 0); } }
    else { p0 = __builtin_amdgcn_mfma_f32_32x32x16_bf16(b0, qr[d0], p0, 0, 0, 0); p1 = __builtin_amdgcn_mfma_f32_32x32x16_bf16(b1, qr[d0], p1, 0, 0, 0); } }
}
template <int NVB> __device__ __forceinline__ int v_st(int k, int c) { const int kk = k; return ((kk >> 3) * NVB + (c >> 5)) * 512 + ((kk & 7) * 32 + (c & 31)) * 2; }
__device__ __forceinline__ int v_rd_base(int lane) { return ((lane & 3) << 3) | (((lane >> 2) & 3) << 6) | (((lane >> 4) & 1) << 5) | (((lane >> 5) & 1) << 8); }
template <int NVB> constexpr int v_rd_off(int d0, int ks, int half) { return d0 * 512 + ks * (NVB * 1024) + half * (NVB * 512); }
template <int OFF> __device__ __forceinline__ s16x4 tr_read(int vb) {
  s16x4 r; asm volatile("ds_read_b64_tr_b16 %0, %1 offset:%2" : "=&v"(r) : "v"(vb), "i"(OFF) : "memory"); return r;
}
template <int NVB, int D0> __device__ __forceinline__ void v_rd(s16x4* f, int vb) {
  f[0] = tr_read<v_rd_off<NVB>(D0, 0, 0)>(vb); f[1] = tr_read<v_rd_off<NVB>(D0, 0, 1)>(vb); f[2] = tr_read<v_rd_off<NVB>(D0, 1, 0)>(vb); f[3] = tr_read<v_rd_off<NVB>(D0, 1, 1)>(vb);
  f[4] = tr_read<v_rd_off<NVB>(D0, 2, 0)>(vb); f[5] = tr_read<v_rd_off<NVB>(D0, 2, 1)>(vb); f[6] = tr_read<v_rd_off<NVB>(D0, 3, 0)>(vb); f[7] = tr_read<v_rd_off<NVB>(D0, 3, 1)>(vb);
}
__device__ __forceinline__ void pv_mm(f32x16& od, const s16x4* f, bf16x8 pa0, bf16x8 pa1, bf16x8 pa2, bf16x8 pa3) {
#define PK(L, H) (bf16x8){L[0], L[1], L[2], L[3], H[0], H[1], H[2], H[3]}
  od = __builtin_amdgcn_mfma_f32_32x32x16_bf16(pa0, PK(f[0], f[1]), od, 0, 0, 0);
  od = __builtin_amdgcn_mfma_f32_32x32x16_bf16(pa1, PK(f[2], f[3]), od, 0, 0, 0);
  od = __builtin_amdgcn_mfma_f32_32x32x16_bf16(pa2, PK(f[4], f[5]), od, 0, 0, 0);
  od = __builtin_amdgcn_mfma_f32_32x32x16_bf16(pa3, PK(f[6], f[7]), od, 0, 0, 0);
#undef PK
}
template <int LO, int N> __device__ __forceinline__ void exp_part(f32x16& p, float mref) {
#pragma unroll
  for (int r = LO; r < LO + N; ++r) p[r] = __builtin_amdgcn_exp2f(p[r]);
}
#define LGKM0() do { asm volatile("s_waitcnt lgkmcnt(0)" ::: "memory"); ASBAR(); } while (0)
template <int NVB> __device__ __forceinline__ void pv_all(f32x16* o, int vb, s16x4* fa, s16x4* fb, bf16x8 pa0, bf16x8 pa1, bf16x8 pa2, bf16x8 pa3, f32x16& c, float mref) {
  if constexpr (NVB == 4) {
    LGKM0(); v_rd<NVB, 1>(fb, vb); pv_mm(o[0], fa, pa0, pa1, pa2, pa3); exp_part<0, 4>(c, mref);
    LGKM0(); v_rd<NVB, 2>(fa, vb); pv_mm(o[1], fb, pa0, pa1, pa2, pa3); exp_part<4, 4>(c, mref);
    LGKM0(); v_rd<NVB, 3>(fb, vb); pv_mm(o[2], fa, pa0, pa1, pa2, pa3); exp_part<8, 4>(c, mref);
    LGKM0();                       pv_mm(o[3], fb, pa0, pa1, pa2, pa3); exp_part<12, 4>(c, mref);
  } else {
    LGKM0(); v_rd<NVB, 1>(fb, vb); pv_mm(o[0], fa, pa0, pa1, pa2, pa3); exp_part<0, 8>(c, mref);
    LGKM0();                       pv_mm(o[1], fb, pa0, pa1, pa2, pa3); exp_part<8, 8>(c, mref);
  }
}
template <bool SHIFT> struct DiffPol {
  static constexpr bool NEGM = false;
  const bf16_t* Kg; const bf16_t* Vg; long lat0, ctx0; float mref;
  __device__ __forceinline__ long krow(int t) const { return t < 128 ? lat0 + 64L * t : ctx0 + 64L * (t - 128); }
  __device__ __forceinline__ void mod(f32x16& p0, f32x16& p1, int, int, int, int) const {
    if constexpr (SHIFT) {
#pragma unroll
      for (int i = 0; i < 16; ++i) { p0[i] -= mref; p1[i] -= mref; } }
  }
};
struct NaPol {
  static constexpr bool NEGM = false;
  const bf16_t* Kg; const bf16_t* Vg; long lat0, ctx0; int rbase, r; const float* tab; float mref;
  __device__ __forceinline__ long krow(int t) const { if (t < 12) { int kr = rbase + t; kr = kr > 127 ? 127 : kr; return lat0 + 64L * kr; } return ctx0 + 64L * (t - 12); }
  __device__ __forceinline__ void mod(f32x16& p0, f32x16& p1, int t, int wid, int r32, int hi) const {
    if (t >= 12) {
#pragma unroll
      for (int i = 0; i < 16; ++i) { p0[i] -= mref; p1[i] -= mref; }
      return; }
    const float NEG = -INFINITY;
    const int kr = rbase + t, rq = r + (wid >> 1), c = 32 * (wid & 1) + r32;
    int r0q = rq - 4; r0q = r0q < 0 ? 0 : (r0q > 120 ? 120 : r0q);
    if (!((kr >= r0q) && (kr < r0q + 8))) {
#pragma unroll
      for (int i = 0; i < 16; ++i) { p0[i] = NEG; p1[i] = NEG; }
      return; }
    int c0 = c - 8; c0 = c0 < 0 ? 0 : (c0 > 48 ? 48 : c0);
    int d = 4 * hi - c0, off = (kr - rq + 7) * 31 + 15 - c + 4 * hi;
    asm volatile("" : "+v"(d), "+v"(off));
#pragma unroll
    for (int i = 0; i < 16; ++i) { const int ci = (i & 3) + 8 * (i >> 2);
      const bool v0 = (unsigned)(ci + d) < 16u, v1 = (unsigned)(ci + 32 + d) < 16u;
      const float b0 = tab[off + ci], b1 = tab[off + ci + 32];
      p0[i] = v0 ? p0[i] + b0 : NEG; p1[i] = v1 ? p1[i] + b1 : NEG; }
  }
};
template <int NVB> constexpr int lds_bytes() { return 3 * (64 * NVB * 64) + 3 * (64 * 128) + NW * 64 * 4; }
template <int NVB, class Pol>
__device__ __forceinline__ void attn_unit(const bf16_t* __restrict__ Qb, const Pol& pol, bf16_t* __restrict__ Ob, int ldo, int NT, float mref, char* lds) {
  constexpr int SHM_V = 64 * NVB * 64, SHM_K = 64 * 128;
  const int tid = threadIdx.x, lane = tid & 63, r32 = lane & 31, hi = lane >> 5; const int wid = __builtin_amdgcn_readfirstlane(tid >> 6);
  char* V_lds = lds; char* K_lds = lds + 3 * SHM_V;
  float* li_l = (float*)(lds + 3 * SHM_V + 3 * SHM_K) + wid * 64;
  const unsigned lds0 = (unsigned)(uintptr_t)lds;
  const int krow_ = 8 * wid + (lane >> 3), kch = (lane & 7) ^ ((krow_ >> 1) & 7);
  const bf16_t* ksrc = pol.Kg + (long)krow_ * LD + kch * 8;
  const bf16_t* vsrc = pol.Vg + (long)(8 * wid + ((lane >> 2) & 7)) * LD + (lane >> 5) * 32 + (lane & 3) * 8;
  const unsigned kdst = lds0 + 3 * SHM_V + wid * 1024, vdst = lds0 + wid * (NVB == 4 ? 2048 : 1024);
#define DMA_TILE(t, b) do { const long ro_ = pol.krow(t) * LD; glds16(ksrc + ro_, (unsigned)__builtin_amdgcn_readfirstlane(kdst + (b) * SHM_K)); \
    glds16(vsrc + ro_, (unsigned)__builtin_amdgcn_readfirstlane(vdst + (b) * SHM_V)); \
    if constexpr (NVB == 4) glds16(vsrc + ro_ + 64, (unsigned)__builtin_amdgcn_readfirstlane(vdst + (b) * SHM_V + 1024)); } while (0)
#define WAIT_BAR() do { asm volatile("s_waitcnt vmcnt(0)" ::: "memory"); __syncthreads(); } while (0)
  DMA_TILE(0, 0); DMA_TILE(1, 1);
  float l_reg = 0; f32x16 o[NVB]; bf16x8 qr[4]; f32x16 negm;
#pragma unroll
  for (int r = 0; r < 16; ++r) negm[r] = -mref;
  if constexpr (Pol::NEGM) asm volatile("" : "+v"(negm));
#pragma unroll
  for (int d = 0; d < NVB; ++d) o[d] = f32x16{};
  const bf16_t* Qw = Qb + (long)(wid * QBLK + r32) * LD + hi * 8;
#pragma unroll
  for (int d0 = 0; d0 < 4; ++d0) qr[d0] = ld8(Qw + d0 * 16);
  const int vb0 = (int)(uintptr_t)V_lds + v_rd_base(lane);
  f32x16 pA0, pA1, pB0, pB1; bf16x8 pa0, pa1, pa2, pa3; s16x4 fa[8], fb[8];
  int bp = 0, bc = 1, bn = 2;
  WAIT_BAR();
  qkt<Pol::NEGM>(pA0, pA1, K_lds, qr, negm, r32, hi); pol.mod(pA0, pA1, 0, wid, r32, hi); exp16(pA0, mref);
#define STEP(C0, C1, P0, P1, j) do { \
    if ((j) + 1 < NT) DMA_TILE((j) + 1, bn); \
    ASBAR(); v_rd<NVB, 0>(fa, vb0 + bp * SHM_V); qkt<Pol::NEGM>(C0, C1, K_lds + bc * SHM_K, qr, negm, r32, hi); \
    finishSM(P0, P1, mref, l_reg, pa0, pa1, pa2, pa3); ASBAR(); \
    pol.mod(C0, C1, (j), wid, r32, hi); ASBAR(); \
    pv_all<NVB>(o, vb0 + bp * SHM_V, fa, fb, pa0, pa1, pa2, pa3, C0, mref); \
    WAIT_BAR(); \
    bp = bc; bc = bn; bn = (bn == 2) ? 0 : bn + 1; } while (0)
  int j = 1;
#pragma nounroll
  for (; j + 1 < NT; j += 2) { STEP(pB0, pB1, pA0, pA1, j); STEP(pA0, pA1, pB0, pB1, j + 1); }
  STEP(pB0, pB1, pA0, pA1, NT - 1);
  finishSM(pB0, pB1, mref, l_reg, pa0, pa1, pa2, pa3); ASBAR();
  v_rd<NVB, 0>(fa, vb0 + bp * SHM_V); pv_all<NVB>(o, vb0 + bp * SHM_V, fa, fb, pa0, pa1, pa2, pa3, pA0, 0.f);
  { auto rr = __builtin_amdgcn_permlane32_swap(__float_as_uint(l_reg), __float_as_uint(l_reg), false, false); l_reg = __uint_as_float(rr[0]) + __uint_as_float(rr[1]); }
  if (hi == 0) li_l[r32] = l_reg; asm volatile("s_waitcnt lgkmcnt(0)" ::: "memory");
  float rli[16];
#pragma unroll
  for (int r = 0; r < 16; ++r) rli[r] = __builtin_amdgcn_rcpf(li_l[crow(r, hi)]);
  bf16_t* Ow = Ob + (long)(wid * QBLK) * ldo;
#pragma unroll
  for (int r = 0; r < 16; ++r) { const int orow = crow(r, hi);
#pragma unroll
    for (int d0 = 0; d0 < NVB; ++d0) { const float v = o[d0][r] * rli[r]; const unsigned pk = cvtpk(v, v); Ow[(long)orow * ldo + d0 * 32 + r32] = (bf16_t)(pk & 0xffffu); } }
  __syncthreads();
#undef DMA_TILE
#undef WAIT_BAR
#undef STEP
}
}

#ifndef MK_PROBE_PHASE
#define MK_PROBE_PHASE -1
#endif
#ifndef MK_N_LAUNCHES
#define MK_N_LAUNCHES 1
#endif
constexpr int N_PHASES = 12;
constexpr int NWAVES = 8;
constexpr int DM = 1024, NB = 4, SEQ = 8192, TT = NB * SEQ, CTX = 256, TC = NB * CTX, MQ = TT + TC, NQKV = 3072;
constexpr int NE = 32, TOPK = 4, MPAD = TT * TOPK + NE * 256, MAXBLK = MPAD / 256;
constexpr float NORM_EPS = 1e-6f;
enum { I_X = 0, I_C, I_CTX, I_CCTX, I_WADA, I_BADA, I_GATTN, I_WIN, I_QND, I_KND, I_LQ1, I_LK1, I_LQ2, I_LK2, I_SUBLN, I_QNN, I_KNN, I_RPB, I_ONN, I_WOUT, I_GFFN, I_WR, I_BR, I_WGU, I_BGU, I_WD, I_BD, N_IN };

constexpr size_t MiB = 1u << 20;
constexpr size_t WS_CTL = 0, CTL_ZERO_BYTES = 64 * 1024;
constexpr size_t WS_TAB = 1 * MiB;
constexpr size_t WS_WQKV = 2 * MiB, WS_WO = 8 * MiB, WS_WGU = 10 * MiB, WS_WDN = 138 * MiB;
constexpr size_t WS_XN = 202 * MiB;
constexpr size_t WS_P = 268 * MiB;
constexpr size_t WS_OD = 499 * MiB, WS_ON = 563 * MiB, WS_MIX = 595 * MiB;
constexpr size_t WS_XG = 202 * MiB;
constexpr size_t WS_ACT = 659 * MiB;
constexpr size_t WS_Y = 202 * MiB;
constexpr size_t WS_RT = 931 * MiB;
constexpr size_t WS_END = 936 * MiB;
static_assert(WS_XN + (size_t)MQ * 2048 <= WS_P && WS_P + (size_t)MQ * 6144 <= WS_OD && WS_XG + (size_t)MPAD * 2048 <= WS_OD && WS_ACT + (size_t)MPAD * 2048 <= WS_RT, "d_ws map");
constexpr int TB_MOD = 0;
constexpr int TB_RCOS = 30720, TB_RSIN = TB_RCOS + 128 * 16, TB_CCOS = TB_RSIN + 128 * 16, TB_CSIN = TB_CCOS + 64 * 16;
constexpr int TB_LAM = TB_CSIN + 64 * 16;
constexpr int TB_WR = TB_LAM + 64;
constexpr int TB_RC = TB_WR + 4 * 1024 * 32;
static_assert((size_t)(TB_RC + 128 + 64) * 4 <= MiB, "TAB region");
constexpr int CW_CNT = 0;
constexpr int CW_BAR = 4096;
constexpr size_t RT_E = 0, RT_G = 512 * 1024, RT_POS = 1024 * 1024, RT_SLOT = 1536 * 1024;

constexpr int RING_BYTES = 131072;
constexpr int MISC_OFF = RING_BYTES;
constexpr int LDS_BYTES = 147456;

#define GAS __attribute__((address_space(1)))
#define LAS __attribute__((address_space(3)))
typedef unsigned short bf16;
typedef unsigned v4u __attribute__((ext_vector_type(4)));
typedef unsigned v2u __attribute__((ext_vector_type(2)));
typedef float f32x4 __attribute__((ext_vector_type(4)));
typedef float f32x16 __attribute__((ext_vector_type(16)));
#define LDS_WAIT() asm volatile("s_waitcnt lgkmcnt(0)" ::: "memory")
__device__ __forceinline__ unsigned f2bf(float f) { unsigned u = __builtin_bit_cast(unsigned, f); return (u + 0x7fffu + ((u >> 16) & 1u)) >> 16; }
__device__ __forceinline__ unsigned pk2(float lo, float hi) { return f2bf(lo) | (f2bf(hi) << 16); }
__device__ __forceinline__ float bflo(unsigned w) { return __uint_as_float(w << 16); }
__device__ __forceinline__ float bfhi(unsigned w) { return __uint_as_float(w & 0xffff0000u); }
__device__ __forceinline__ float wave_sum(float v) {
#pragma unroll
    for (int o = 1; o < 64; o <<= 1) v += __shfl_xor(v, o);
    return v;
}

struct Frame {
    LAS unsigned char* lds;
    int tid, lane, wave, vcu, G;
    const float* in[N_IN]; float* out; unsigned char* ws;
};

__device__ __forceinline__ void p0_transpose_item(const float* W, int K, int N, bf16* WT, int k0, int n0, int drow0, LAS float* scr, int lane) {
#pragma unroll 8
    for (int i = 0; i < 32; ++i) { const int kk = 2 * i + (lane >> 5); scr[kk * 33 + (lane & 31)] = W[(size_t)(k0 + kk) * N + n0 + (lane & 31)]; }
    LDS_WAIT(); asm volatile("" ::: "memory");
    const int c = lane & 7;
#pragma unroll
    for (int j = 0; j < 4; ++j) { const int n = (lane >> 3) + 8 * j; const LAS float* s = scr + (8 * c) * 33 + n;
        v4u o; o.x = pk2(s[0 * 33], s[1 * 33]); o.y = pk2(s[2 * 33], s[3 * 33]); o.z = pk2(s[4 * 33], s[5 * 33]); o.w = pk2(s[6 * 33], s[7 * 33]);
        *(v4u*)(WT + (size_t)(drow0 + n) * K + k0 + 8 * c) = o; }
    LDS_WAIT(); asm volatile("" ::: "memory");
}

__device__ __forceinline__ void p0_transpose_item8(const float* W, int K, int N, unsigned char* WT, int k0, int n0, int drow0, LAS float* scr, int lane) {
#pragma unroll 8
    for (int i = 0; i < 32; ++i) { const int kk = 2 * i + (lane >> 5); scr[kk * 33 + (lane & 31)] = W[(size_t)(k0 + kk) * N + n0 + (lane & 31)]; }
    LDS_WAIT(); asm volatile("" ::: "memory");
    const int n = lane & 31, hf = lane >> 5; const LAS float* s = scr + (32 * hf) * 33 + n;
    v4u o0, o1;
#define P4(j) pg8::pk4_fp8(s[(j) * 33] * pg8::W8_SCALE, s[((j) + 1) * 33] * pg8::W8_SCALE, s[((j) + 2) * 33] * pg8::W8_SCALE, s[((j) + 3) * 33] * pg8::W8_SCALE)
    o0.x = P4(0); o0.y = P4(4); o0.z = P4(8); o0.w = P4(12); o1.x = P4(16); o1.y = P4(20); o1.z = P4(24); o1.w = P4(28);
#undef P4
    unsigned char* dst = WT + (size_t)(drow0 + n) * K + k0 + 32 * hf;
    *(v4u*)dst = o0; *(v4u*)(dst + 16) = o1;
    LDS_WAIT(); asm volatile("" ::: "memory");
}

__device__ __forceinline__ void p0_prologue(Frame& F) {
    float* tab = (float*)(F.ws + WS_TAB);
    for (int task = blockIdx.x; task < 96; task += F.G) {
        LAS float* ssilu = (LAS float*)F.lds;
        LAS float* part = ssilu + 5 * 1024;
        for (int i = F.tid; i < 5 * 1024; i += 512) { const int r = i >> 10, k = i & 1023; const float v = (r < 4) ? F.in[I_C][r * 1024 + k] : F.in[I_CCTX][k]; ssilu[i] = v / (1.0f + __expf(-v)); }
        __syncthreads();
        const int col = task * 64 + F.lane; const float* w = F.in[I_WADA] + col; float a0 = 0, a1 = 0, a2 = 0, a3 = 0, a4 = 0;
        const int kb = F.wave * 128;
#pragma unroll 8
        for (int k = kb; k < kb + 128; ++k) { const float wv = w[(size_t)k * 6144]; a0 += ssilu[k] * wv; a1 += ssilu[1024 + k] * wv; a2 += ssilu[2048 + k] * wv; a3 += ssilu[3072 + k] * wv; a4 += ssilu[4096 + k] * wv; }
        part[(F.wave * 5 + 0) * 64 + F.lane] = a0; part[(F.wave * 5 + 1) * 64 + F.lane] = a1; part[(F.wave * 5 + 2) * 64 + F.lane] = a2; part[(F.wave * 5 + 3) * 64 + F.lane] = a3; part[(F.wave * 5 + 4) * 64 + F.lane] = a4;
        __syncthreads();
        if (F.tid < 320) { const int r = F.tid >> 6, cl = F.tid & 63; float s = 0; for (int wv = 0; wv < 8; ++wv) s += part[(wv * 5 + r) * 64 + cl]; const int j = task * 64 + cl; tab[TB_MOD + r * 6144 + j] = s + F.in[I_BADA][j]; }
        __syncthreads();
    }
    if ((int)blockIdx.x == F.G - 1) {
        for (int i = F.tid; i < 192 * 16; i += 512) { const int p = i >> 4, f = i & 15; const float inv = 1.0f / powf(10000.0f, (float)f / 16.0f); const int pos = p < 128 ? p : p - 128; const float ang = (float)pos * inv;
            const float cv = cosf(ang), sv = sinf(ang);
            if (p < 128) { tab[TB_RCOS + pos * 16 + f] = cv; tab[TB_RSIN + pos * 16 + f] = sv; } else { tab[TB_CCOS + pos * 16 + f] = cv; tab[TB_CSIN + pos * 16 + f] = sv; } }
        if (F.wave == 0) { const float s1 = wave_sum(F.in[I_LQ1][F.lane] * F.in[I_LK1][F.lane]), s2 = wave_sum(F.in[I_LQ2][F.lane] * F.in[I_LK2][F.lane]);
            if (F.lane == 0) tab[TB_LAM] = expf(s1) - expf(s2) + 0.2f;
            float a = fabsf(F.in[I_QND][F.lane]), bq = fabsf(F.in[I_KND][F.lane]), c = fabsf(F.in[I_QNN][F.lane]), d = fabsf(F.in[I_KNN][F.lane]); float rm = -1e30f;
            for (int i = F.lane; i < 8 * 465; i += 64) rm = fmaxf(rm, F.in[I_RPB][i]);
#pragma unroll
            for (int o = 1; o < 64; o <<= 1) { a = fmaxf(a, __shfl_xor(a, o)); bq = fmaxf(bq, __shfl_xor(bq, o)); c = fmaxf(c, __shfl_xor(c, o)); d = fmaxf(d, __shfl_xor(d, o)); rm = fmaxf(rm, __shfl_xor(rm, o)); }
            if (F.lane == 0) { tab[TB_LAM + 1] = att::C2 * 64.0f * a * bq * 1.02f + 0.05f; tab[TB_LAM + 2] = att::C2 * 64.0f * c * d * 1.02f + 0.05f + fmaxf(rm, 0.f) * 1.4426950408889634f; } }
    }
    LAS float* scr = (LAS float*)(F.lds + 32768 + F.wave * 8704);
    const int gw = F.vcu * NWAVES + F.wave, NGW = F.G * NWAVES;
    constexpr int I_IN = 16 * 96, I_OUT = 16 * 32, I_GU = 16 * 64, I_DN = 16 * 32;
    constexpr int NITEMS = I_IN + I_OUT + NE * (I_GU + I_DN);
    bf16* wqkv = (bf16*)(F.ws + WS_WQKV); bf16* wo = (bf16*)(F.ws + WS_WO); unsigned char* wgu = F.ws + WS_WGU; unsigned char* wdn = F.ws + WS_WDN;
    for (int it = gw; it < NITEMS; it += NGW) {
        int r = it;
        if (r < I_IN) { const int kb = r / 96, nb = r % 96; p0_transpose_item8(F.in[I_WIN], 1024, 3072, (unsigned char*)wqkv, 64 * kb, 32 * nb, 32 * nb, scr, F.lane); continue; } r -= I_IN;
        if (r < I_OUT) { const int kb = r / 32, nb = r % 32; p0_transpose_item(F.in[I_WOUT], 1024, 1024, wo, 64 * kb, 32 * nb, 32 * nb, scr, F.lane); continue; } r -= I_OUT;
        if (r < NE * I_GU) { const int e = r / I_GU, q = r % I_GU, kb = q / 64, nb = q % 64, n0 = 32 * nb;
            const int drow = (n0 < 1024) ? ((n0 >> 7) * 256 + (n0 & 127)) : (((n0 - 1024) >> 7) * 256 + 128 + ((n0 - 1024) & 127));
            p0_transpose_item8(F.in[I_WGU] + (size_t)e * 1024 * 2048, 1024, 2048, wgu + (size_t)e * 2048 * 1024, 64 * kb, n0, drow, scr, F.lane); continue; } r -= NE * I_GU;
        { const int e = r / I_DN, q = r % I_DN, kb = q / 32, nb = q % 32;
            p0_transpose_item8(F.in[I_WD] + (size_t)e * 1024 * 1024, 1024, 1024, wdn + (size_t)e * 1024 * 1024, 64 * kb, 32 * nb, 32 * nb, scr, F.lane); }
    }
}

__device__ __forceinline__ void p1_norm(Frame& F) {
    const float* tab = (const float*)(F.ws + WS_TAB); unsigned char* XN = F.ws + WS_XN;
    const int gw = F.vcu * NWAVES + F.wave, NGW = F.G * NWAVES;
    const f32x4* gat = (const f32x4*)F.in[I_GATTN] + F.lane;
    for (int m = gw; m < MQ; m += NGW) {
        const int b = m < TT ? (m >> 13) : 4;
        const float* xrow = m < TT ? F.in[I_X] + (size_t)m * DM : F.in[I_CTX] + (size_t)(m - TT) * DM;
        const f32x4* xr = (const f32x4*)xrow + F.lane;
        const f32x4* sh = (const f32x4*)(tab + TB_MOD + b * 6144) + F.lane; const f32x4* sc = (const f32x4*)(tab + TB_MOD + b * 6144 + 1024) + F.lane;
        f32x4 v[4]; float s = 0.f;
#pragma unroll
        for (int j = 0; j < 4; ++j) { v[j] = xr[64 * j]; s += (v[j].x * v[j].x + v[j].y * v[j].y) + (v[j].z * v[j].z + v[j].w * v[j].w); }
        const float rstd = 1.0f / sqrtf(wave_sum(s) * (1.f / DM) + NORM_EPS);
        unsigned* o4 = (unsigned*)(XN + (size_t)m * DM) + F.lane;
#pragma unroll
        for (int j = 0; j < 4; ++j) { const f32x4 g = gat[64 * j], a = sc[64 * j], c = sh[64 * j];
            const f32x4 h = (v[j] * rstd) * g * (a + 1.0f) + c;
            o4[64 * j] = pg8::pk4_fp8(h.x, h.y, h.z, h.w); }
    }
    float* tw = (float*)(F.ws + WS_TAB);
    for (int i = (int)blockIdx.x * 512 + F.tid; i < 4 * 1024 * 32; i += F.G * 512) { const int b = i >> 15, k = (i >> 5) & 1023;
        tw[TB_WR + i] = F.in[I_GFFN][k] * (1.0f + tab[TB_MOD + b * 6144 + 4 * 1024 + k]) * F.in[I_WR][i & 32767]; }
    for (int t = gw; t < 128; t += NGW) { const int b = t >> 5, e = t & 31; float s = 0.f;
        for (int k = F.lane; k < 1024; k += 64) s += tab[TB_MOD + b * 6144 + 3 * 1024 + k] * F.in[I_WR][k * 32 + e];
        s = wave_sum(s); if (F.lane == 0) tw[TB_RC + t] = s + F.in[I_BR][e]; }
}

__device__ __forceinline__ void p3_qknorm(Frame& F) {
    const float* tab = (const float*)(F.ws + WS_TAB); bf16* P = (bf16*)(F.ws + WS_P);
    const int gw = F.vcu * NWAVES + F.wave, NGW = F.G * NWAVES;
    const int j = F.lane & 7;
    for (int task = gw; task < MQ * 4; task += NGW) {
        const int row = task >> 2, g = task & 3;
        const int colb = (g == 0) ? 0 : (g == 1) ? 512 : (g == 2) ? 1536 : 2048;
        const float* nw = ((g == 0) ? F.in[I_QND] : (g == 1) ? F.in[I_KND] : (g == 2) ? F.in[I_QNN] : F.in[I_KNN]) + 8 * j;
        bf16* p = P + (size_t)row * NQKV + colb + F.lane * 8;
        const v4u w = *(const v4u*)p;
        float v[8] = {bflo(w.x), bfhi(w.x), bflo(w.y), bfhi(w.y), bflo(w.z), bfhi(w.z), bflo(w.w), bfhi(w.w)};
        float ss = 0.f;
#pragma unroll
        for (int i = 0; i < 8; ++i) ss += v[i] * v[i];
        ss += __shfl_xor(ss, 1); ss += __shfl_xor(ss, 2); ss += __shfl_xor(ss, 4);
        const float rstd = 1.0f / sqrtf(ss * (1.f / 64.f) + NORM_EPS);
        const f32x4 n0 = *(const f32x4*)nw, n1 = *(const f32x4*)(nw + 4);
        v[0] *= rstd * n0.x; v[1] *= rstd * n0.y; v[2] *= rstd * n0.z; v[3] *= rstd * n0.w; v[4] *= rstd * n1.x; v[5] *= rstd * n1.y; v[6] *= rstd * n1.z; v[7] *= rstd * n1.w;
        if (g < 2 && row < TT) {
            const int s = row & (SEQ - 1), prow = s >> 6, pcol = s & 63, half = j >> 2, isx2 = (j >> 1) & 1;
            const float* ct = tab + (half ? TB_CCOS + pcol * 16 : TB_RCOS + prow * 16) + 8 * (j & 1);
            const float* st = tab + (half ? TB_CSIN + pcol * 16 : TB_RSIN + prow * 16) + 8 * (j & 1);
            const f32x4 c0 = *(const f32x4*)ct, c1 = *(const f32x4*)(ct + 4), s0 = *(const f32x4*)st, s1 = *(const f32x4*)(st + 4);
            const float cc[8] = {c0.x, c0.y, c0.z, c0.w, c1.x, c1.y, c1.z, c1.w}, sn[8] = {s0.x, s0.y, s0.z, s0.w, s1.x, s1.y, s1.z, s1.w};
#pragma unroll
            for (int i = 0; i < 8; ++i) { const float pr = __shfl_xor(v[i], 2); v[i] = isx2 ? (v[i] * cc[i] + pr * sn[i]) : (v[i] * cc[i] - pr * sn[i]); }
        }
        if (g == 0 || g == 2) {
#pragma unroll
            for (int i = 0; i < 8; ++i) v[i] *= att::C2;
        }
        v4u o; o.x = pk2(v[0], v[1]); o.y = pk2(v[2], v[3]); o.z = pk2(v[4], v[5]); o.w = pk2(v[6], v[7]);
        *(v4u*)p = o;
    }
}

__device__ __forceinline__ void p4_attention(Frame& F, char* lds) {
    const bf16* P = (const bf16*)(F.ws + WS_P); bf16* OD = (bf16*)(F.ws + WS_OD); bf16* ON = (bf16*)(F.ws + WS_ON);
    const float* tab = (const float*)(F.ws + WS_TAB); const float mref_d = tab[TB_LAM + 1], mref_n = tab[TB_LAM + 2];
#ifndef MK_NO_DIFF
#define DIFF_UNITS(SH) for (int unit = F.vcu; unit < 1024; unit += F.G) { \
        const int bhm = unit >> 5, qb = unit & 31, b = bhm >> 3, h = (bhm >> 1) & 3, m = bhm & 1; \
        att::DiffPol<SH> pol; pol.Kg = P + 512 + h * 128 + m * 64; pol.Vg = P + 1024 + h * 128; pol.lat0 = (long)b * SEQ; pol.ctx0 = (long)TT + b * CTX; pol.mref = mref_d; \
        att::attn_unit<4, att::DiffPol<SH> >(P + ((size_t)b * SEQ + qb * 256) * NQKV + h * 128 + m * 64, pol, OD + ((size_t)b * SEQ + qb * 256) * 1024 + h * 256 + m * 128, 1024, 132, mref_d, lds); }
    if (mref_d <= 100.0f) { DIFF_UNITS(false) } else { DIFF_UNITS(true) }
#undef DIFF_UNITS
#endif
#ifndef MK_NO_NA
    float* tabl = (float*)(lds + att::lds_bytes<4>());
    for (int unit = F.vcu; unit < 1024; unit += F.G) {
        const int bh = unit >> 5, rb = unit & 31, b = bh >> 3, hn = bh & 7, r = rb * 4;
        for (int i = F.tid; i < 15 * 31; i += 512) tabl[i] = F.in[I_RPB][hn * 465 + i] * 1.4426950408889634f - mref_n;
        att::NaPol pol; pol.Kg = P + 2048 + hn * 64; pol.Vg = P + 2560 + hn * 64; pol.lat0 = (long)b * SEQ; pol.ctx0 = (long)TT + b * CTX;
        pol.mref = mref_n; pol.r = r; pol.rbase = (r - 4) < 0 ? 0 : ((r - 4) > 120 ? 120 : (r - 4)); pol.tab = tabl;
        att::attn_unit<2, att::NaPol>(P + ((size_t)b * SEQ + r * 64) * NQKV + 1536 + hn * 64, pol, ON + ((size_t)b * SEQ + r * 64) * 512 + hn * 64, 512, 16, mref_n, lds);
    }
#endif
}

__device__ __forceinline__ void p5_mix(Frame& F) {
    const float* tab = (const float*)(F.ws + WS_TAB); const bf16* OD = (const bf16*)(F.ws + WS_OD); const bf16* ON = (const bf16*)(F.ws + WS_ON); bf16* MX = (bf16*)(F.ws + WS_MIX);
    const int gw = F.vcu * NWAVES + F.wave, NGW = F.G * NWAVES;
    const float lam = tab[TB_LAM];
    const int h = F.lane >> 4, e0 = (F.lane & 15) * 8;
    const f32x4 sl0 = *(const f32x4*)(F.in[I_SUBLN] + e0), sl1 = *(const f32x4*)(F.in[I_SUBLN] + e0 + 4);
    const f32x4 on0 = *(const f32x4*)(F.in[I_ONN] + F.lane * 8), on1 = *(const f32x4*)(F.in[I_ONN] + F.lane * 8 + 4);
    for (int t = gw; t < TT; t += NGW) {
        const v4u a = *(const v4u*)(OD + (size_t)t * 1024 + h * 256 + e0), c = *(const v4u*)(OD + (size_t)t * 1024 + h * 256 + 128 + e0);
        const v4u n = *(const v4u*)(ON + (size_t)t * 512 + F.lane * 8);
        float d[8] = {bflo(a.x) - lam * bflo(c.x), bfhi(a.x) - lam * bfhi(c.x), bflo(a.y) - lam * bflo(c.y), bfhi(a.y) - lam * bfhi(c.y),
                      bflo(a.z) - lam * bflo(c.z), bfhi(a.z) - lam * bfhi(c.z), bflo(a.w) - lam * bflo(c.w), bfhi(a.w) - lam * bfhi(c.w)};
        float ss = 0.f;
#pragma unroll
        for (int i = 0; i < 8; ++i) ss += d[i] * d[i];
        ss += __shfl_xor(ss, 1); ss += __shfl_xor(ss, 2); ss += __shfl_xor(ss, 4); ss += __shfl_xor(ss, 8);
        const float rs = 0.8f / sqrtf(ss * (1.f / 128.f) + NORM_EPS);
        v4u o; o.x = pk2(d[0] * rs * sl0.x, d[1] * rs * sl0.y); o.y = pk2(d[2] * rs * sl0.z, d[3] * rs * sl0.w); o.z = pk2(d[4] * rs * sl1.x, d[5] * rs * sl1.y); o.w = pk2(d[6] * rs * sl1.z, d[7] * rs * sl1.w);
        *(v4u*)(MX + (size_t)t * 1024 + h * 128 + e0) = o;
        float q[8] = {bflo(n.x), bfhi(n.x), bflo(n.y), bfhi(n.y), bflo(n.z), bfhi(n.z), bflo(n.w), bfhi(n.w)};
        float s2 = 0.f;
#pragma unroll
        for (int i = 0; i < 8; ++i) s2 += q[i] * q[i];
        s2 += __shfl_xor(s2, 1); s2 += __shfl_xor(s2, 2); s2 += __shfl_xor(s2, 4);
        const float r2 = 1.0f / sqrtf(s2 * (1.f / 64.f) + NORM_EPS);
        v4u o2; o2.x = pk2(q[0] * r2 * on0.x, q[1] * r2 * on0.y); o2.y = pk2(q[2] * r2 * on0.z, q[3] * r2 * on0.w); o2.z = pk2(q[4] * r2 * on1.x, q[5] * r2 * on1.y); o2.w = pk2(q[6] * r2 * on1.z, q[7] * r2 * on1.w);
        *(v4u*)(MX + (size_t)t * 1024 + 512 + F.lane * 8) = o2;
    }
}

__device__ __forceinline__ void p7_router(Frame& F) {
    const float* tab = (const float*)(F.ws + WS_TAB); unsigned* cnt = (unsigned*)(F.ws + WS_CTL) + CW_CNT;
    int* rt_e = (int*)(F.ws + WS_RT + RT_E); float* rt_g = (float*)(F.ws + WS_RT + RT_G); int* rt_pos = (int*)(F.ws + WS_RT + RT_POS);
    LAS unsigned* cntl = (LAS unsigned*)(F.lds + MISC_OFF); LAS unsigned* basel = cntl + 32;
    const int j = F.lane & 31, kh = F.lane >> 5;
    for (int tile = F.vcu; tile < TT / 128; tile += F.G) {
        if (F.tid < 32) cntl[F.tid] = 0u;
        __syncthreads();
        int te[4] = {0, 0, 0, 0}; float tg[4] = {0, 0, 0, 0}; unsigned lp[4] = {0, 0, 0, 0}; const int t = tile * 128 + 32 * F.wave + j;
        if (F.wave < 4) {
            const int b = t >> 13;
            const float* xr = F.out + (size_t)t * DM + 4 * kh;
            const float* wp = tab + TB_WR + (size_t)b * 32768 + (4 * kh) * 32 + j;
            f32x16 acc = f32x16{}; float ss = 0.f;
#pragma unroll 4
            for (int u = 0; u < 128; ++u) {
                const f32x4 xv = *(const f32x4*)(xr + 8 * u);
                const float w0 = wp[(8 * u + 0) * 32], w1 = wp[(8 * u + 1) * 32], w2 = wp[(8 * u + 2) * 32], w3 = wp[(8 * u + 3) * 32];
                ss += (xv.x * xv.x + xv.y * xv.y) + (xv.z * xv.z + xv.w * xv.w);
                acc = __builtin_amdgcn_mfma_f32_32x32x2f32(w0, xv.x, acc, 0, 0, 0);
                acc = __builtin_amdgcn_mfma_f32_32x32x2f32(w1, xv.y, acc, 0, 0, 0);
                acc = __builtin_amdgcn_mfma_f32_32x32x2f32(w2, xv.z, acc, 0, 0, 0);
                acc = __builtin_amdgcn_mfma_f32_32x32x2f32(w3, xv.w, acc, 0, 0, 0);
            }
            ss += __shfl_xor(ss, 32);
            const float rstd = 1.0f / sqrtf(ss * (1.f / DM) + NORM_EPS);
            float v[16];
#pragma unroll
            for (int r = 0; r < 16; ++r) v[r] = acc[r] * rstd + tab[TB_RC + b * 32 + att::crow(r, kh)];
            float cv[8]; int ce[8];
#pragma unroll
            for (int k = 0; k < 4; ++k) { float best = -INFINITY; int bi = 0;
#pragma unroll
                for (int r = 0; r < 16; ++r) if (v[r] > best) { best = v[r]; bi = r; }
#pragma unroll
                for (int r = 0; r < 16; ++r) if (r == bi) v[r] = -INFINITY;
                cv[k] = best; ce[k] = att::crow(bi, kh); }
#pragma unroll
            for (int k = 0; k < 4; ++k) { cv[4 + k] = __shfl_xor(cv[k], 32); ce[4 + k] = __shfl_xor(ce[k], 32); }
            float tv[4];
#pragma unroll
            for (int k = 0; k < 4; ++k) { float best = -INFINITY; int be = 1 << 30, bi = 0;
#pragma unroll
                for (int q = 0; q < 8; ++q) if (cv[q] > best || (cv[q] == best && ce[q] < be)) { best = cv[q]; be = ce[q]; bi = q; }
#pragma unroll
                for (int q = 0; q < 8; ++q) if (q == bi) cv[q] = -INFINITY;
                tv[k] = best; te[k] = be; }
            const float e1 = __expf(tv[1] - tv[0]), e2 = __expf(tv[2] - tv[0]), e3 = __expf(tv[3] - tv[0]); const float inv = 1.0f / (1.0f + e1 + e2 + e3);
            tg[0] = inv; tg[1] = e1 * inv; tg[2] = e2 * inv; tg[3] = e3 * inv;
            if (kh == 0) {
#pragma unroll
                for (int k = 0; k < 4; ++k) lp[k] = __hip_atomic_fetch_add(cntl + te[k], 1u, __ATOMIC_RELAXED, __HIP_MEMORY_SCOPE_WORKGROUP);
            }
        }
        __syncthreads();
        if (F.tid < 32) { const unsigned c = cntl[F.tid]; basel[F.tid] = c ? atomicAdd(cnt + F.tid, c) : 0u; }
        __syncthreads();
        if (F.wave < 4 && kh == 0) {
#pragma unroll
            for (int k = 0; k < 4; ++k) { rt_e[t * 4 + k] = te[k]; rt_g[t * 4 + k] = tg[k]; rt_pos[t * 4 + k] = (int)(basel[te[k]] + lp[k]); }
        }
        __syncthreads();
    }
}

__device__ __forceinline__ int pad_starts(const unsigned* cnt, int lane) {
    const int c = lane < 32 ? (int)__hip_atomic_load(cnt + lane, __ATOMIC_RELAXED, __HIP_MEMORY_SCOPE_AGENT) : 0;
    int p = (c + 255) & ~255, incl = p;
#pragma unroll
    for (int o = 1; o < 64; o <<= 1) { const int n = __shfl_up(incl, o); if (lane >= o) incl += n; }
    return incl - p;
}

__device__ __forceinline__ void p8_scatter(Frame& F) {
    const float* tab = (const float*)(F.ws + WS_TAB); const unsigned* cnt = (const unsigned*)(F.ws + WS_CTL) + CW_CNT;
    const int* rt_e = (const int*)(F.ws + WS_RT + RT_E); const int* rt_pos = (const int*)(F.ws + WS_RT + RT_POS); int* rt_slot = (int*)(F.ws + WS_RT + RT_SLOT);
    unsigned char* XG = F.ws + WS_XG;
    const int gw = F.vcu * NWAVES + F.wave, NGW = F.G * NWAVES;
    const int pst = pad_starts(cnt, F.lane);
    const f32x4* gf = (const f32x4*)F.in[I_GFFN] + F.lane;
    for (int t = gw; t < TT; t += NGW) {
        const int b = t >> 13;
        const f32x4* xr = (const f32x4*)(F.out + (size_t)t * DM) + F.lane;
        const f32x4* sh = (const f32x4*)(tab + TB_MOD + b * 6144 + 3 * 1024) + F.lane; const f32x4* sc = (const f32x4*)(tab + TB_MOD + b * 6144 + 4 * 1024) + F.lane;
        f32x4 v[4]; float s = 0.f;
#pragma unroll
        for (int jj = 0; jj < 4; ++jj) { v[jj] = xr[64 * jj]; s += (v[jj].x * v[jj].x + v[jj].y * v[jj].y) + (v[jj].z * v[jj].z + v[jj].w * v[jj].w); }
        const float rstd = 1.0f / sqrtf(wave_sum(s) * (1.f / DM) + NORM_EPS);
        unsigned pk[4];
#pragma unroll
        for (int jj = 0; jj < 4; ++jj) { const f32x4 g = gf[64 * jj], a = sc[64 * jj], c = sh[64 * jj]; const f32x4 h = (v[jj] * rstd) * g * (a + 1.0f) + c;
            pk[jj] = pg8::pk4_fp8(h.x, h.y, h.z, h.w); }
        const int my_e = rt_e[t * 4 + (F.lane & 3)], my_pos = rt_pos[t * 4 + (F.lane & 3)];
#pragma unroll
        for (int k = 0; k < 4; ++k) { const int e = __shfl(my_e, k), pos = __shfl(my_pos, k); const int slot = __shfl(pst, e) + pos;
            unsigned* o4 = (unsigned*)(XG + (size_t)slot * DM) + F.lane;
#pragma unroll
            for (int jj = 0; jj < 4; ++jj) o4[64 * jj] = pk[jj];
            if (F.lane == 0) rt_slot[t * 4 + k] = slot; }
    }
}

__device__ __forceinline__ int moe_block_table(Frame& F, LAS int* bexp) {
    const unsigned* cnt = (const unsigned*)(F.ws + WS_CTL) + CW_CNT;
    const int pst = pad_starts(cnt, F.lane);
    const int total = __shfl(pst, 32) >> 8;
    if (F.wave == 0) {
        const int nxt = __shfl_down(pst, 1);
        if (F.lane < 32) for (int bl = pst >> 8; bl < (nxt >> 8); ++bl) bexp[bl] = F.lane;
    }
    __syncthreads();
    return __builtin_amdgcn_readfirstlane(total);
}

__device__ __forceinline__ void p11_combine(Frame& F) {
    const float* tab = (const float*)(F.ws + WS_TAB); const bf16* Y = (const bf16*)(F.ws + WS_Y);
    const float* rt_g = (const float*)(F.ws + WS_RT + RT_G); const int* rt_slot = (const int*)(F.ws + WS_RT + RT_SLOT);
    const int gw = F.vcu * NWAVES + F.wave, NGW = F.G * NWAVES;
    for (int t = gw; t < TT; t += NGW) {
        const int b = t >> 13;
        f32x4* xr = (f32x4*)(F.out + (size_t)t * DM) + F.lane;
        const f32x4* g2 = (const f32x4*)(tab + TB_MOD + b * 6144 + 5 * 1024) + F.lane;
        f32x4 acc[4];
#pragma unroll
        for (int jj = 0; jj < 4; ++jj) acc[jj] = (f32x4){0.f, 0.f, 0.f, 0.f};
        const int my_slot = rt_slot[t * 4 + (F.lane & 3)]; const float my_g = rt_g[t * 4 + (F.lane & 3)];
#pragma unroll
        for (int k = 0; k < 4; ++k) { const int slot = __shfl(my_slot, k); const float g = __shfl(my_g, k);
            const v2u* yr = (const v2u*)(Y + (size_t)slot * DM) + F.lane;
#pragma unroll
            for (int jj = 0; jj < 4; ++jj) { const v2u w = yr[64 * jj]; acc[jj] += (f32x4){bflo(w.x), bfhi(w.x), bflo(w.y), bfhi(w.y)} * g; } }
#pragma unroll
        for (int jj = 0; jj < 4; ++jj) xr[64 * jj] = xr[64 * jj] + g2[64 * jj] * acc[jj];
#ifdef MK_DBG_ATT
        if (t == 0 && F.lane == 0) { const float* dbg = tab + TB_RC + 128; F.out[0] += 8.0f + 120.0f * (dbg[0] / dbg[1]); }
#endif
    }
}

#define XB_TMO      128
#define XB_XCNT(j)  (256  + 64 * (j))
#define XB_XSUB(j)  (1280 + 64 * (j))
#define XB_XGEN(j)  (2304 + 64 * (j))
#define XB_TOP      3328
#define XB_TOPGEN   3392
#define XCD_BAR_WORDS 3456
#define XB_SPIN_CAP (1u << 18)

__device__ __forceinline__ unsigned xb_ld(unsigned* p)              { return __hip_atomic_load(p, __ATOMIC_RELAXED, __HIP_MEMORY_SCOPE_AGENT); }
__device__ __forceinline__ unsigned xb_add(unsigned* p, unsigned v) { return __hip_atomic_fetch_add(p, v, __ATOMIC_RELAXED, __HIP_MEMORY_SCOPE_AGENT); }
__device__ __forceinline__ unsigned xb_xcc_id() { return (unsigned)__builtin_amdgcn_s_getreg((3 << 11) | 20) & 0xFu; }
#define XB_SPIN(cond, bar) do { unsigned _sp = 0; while (cond) { __builtin_amdgcn_s_sleep(1); \
    if ((++_sp & 255u) == 0u) { if (xb_ld(&(bar)[XB_TMO])) break; if (_sp > XB_SPIN_CAP) { atomicAdd(&(bar)[XB_TMO], 1u); break; } } } } while (0)

struct XcdBarrier {
    unsigned* bar; unsigned x;
    volatile LAS unsigned* st;
};

__device__ __forceinline__ XcdBarrier xcd_barrier_post(unsigned* bar, volatile LAS unsigned* st) {
    XcdBarrier b; b.bar = bar; b.x = xb_xcc_id(); b.st = st;
    if (threadIdx.x == 0) (void)xb_add(&bar[XB_XCNT(b.x)], 1u);
    return b;
}
__device__ __forceinline__ void xcd_barrier_complete(unsigned* bar, unsigned x, unsigned& nloc, unsigned& nx) {
    const unsigned G = gridDim.x * gridDim.y * gridDim.z;
    unsigned sum, cnt, mine, sp = 0u;
    for (;;) {
        sum = 0u; cnt = 0u; mine = 0u;
#pragma unroll
        for (unsigned j = 0; j < 16; ++j) { const unsigned c = xb_ld(&bar[XB_XCNT(j)]); sum += c; cnt += (c > 0u) ? 1u : 0u; mine = (j == x) ? c : mine; }
        if (sum == G) break;
        __builtin_amdgcn_s_sleep(1);
        if ((++sp & 255u) == 0u) { if (xb_ld(&bar[XB_TMO])) break; if (sp > XB_SPIN_CAP) { atomicAdd(&bar[XB_TMO], 1u); break; } }
    }
    nloc = mine > 0u ? mine : 1u; nx = cnt > 0u ? cnt : 1u;
}

__device__ __forceinline__ void xcd_barrier(const XcdBarrier& b) {
    asm volatile("s_waitcnt vmcnt(0)" ::: "memory");
    __syncthreads();
    if (threadIdx.x == 0) {
        unsigned* bar = b.bar;
        __builtin_amdgcn_s_waitcnt(0);
        unsigned nloc = b.st[0], nx = b.st[1];
        if (nloc == 0u) { xcd_barrier_complete(bar, b.x, nloc, nx); b.st[0] = nloc; b.st[1] = nx; }
        const unsigned old = xb_add(&bar[XB_XSUB(b.x)], 1u);
        const unsigned gen = old / nloc;
        if (old + 1u == (gen + 1u) * nloc) {
            __builtin_amdgcn_fence(__ATOMIC_RELEASE, "agent");
            asm volatile("s_waitcnt vmcnt(0)" ::: "memory");
            const unsigned og = xb_add(&bar[XB_TOP], 1u);
            const unsigned tg = og / nx;
            if (og + 1u == (tg + 1u) * nx) xb_add(&bar[XB_TOPGEN], 1u);
            else XB_SPIN(xb_ld(&bar[XB_TOPGEN]) == tg, bar);
            __builtin_amdgcn_fence(__ATOMIC_ACQUIRE, "agent");
            xb_add(&bar[XB_XGEN(b.x)], 1u);
            asm volatile("s_waitcnt vmcnt(0)" ::: "memory");
        } else {
            XB_SPIN(xb_ld(&bar[XB_XGEN(b.x)]) == gen, bar);
            __builtin_amdgcn_fence(__ATOMIC_ACQUIRE, "agent");
            asm volatile("s_waitcnt vmcnt(0)" ::: "memory");
        }
    }
    __syncthreads();
}

struct Args { const float* in[N_IN]; float* out; unsigned char* ws; int ph_lo, ph_hi, li, pad; };
__global__ void __launch_bounds__(NWAVES * 64, 2) mk_fwd(Args args) {
    extern __shared__ __attribute__((aligned(16))) unsigned char lds[];
    Frame F;
    F.lds = (LAS unsigned char*)lds;
    F.tid = threadIdx.x; F.lane = F.tid & 63; F.wave = __builtin_amdgcn_readfirstlane(F.tid >> 6);
    F.G = gridDim.x; { const int bx = blockIdx.x; F.vcu = (F.G % 8 == 0) ? (bx % 8) * (F.G / 8) + bx / 8 : bx; }
#pragma unroll
    for (int i = 0; i < N_IN; ++i) F.in[i] = args.in[i];
    F.out = args.out; F.ws = args.ws;
    const int lo = args.ph_lo, hi = args.ph_hi;
    volatile LAS unsigned* bst = (volatile LAS unsigned*)(F.lds + MISC_OFF + 4096);
    if (F.tid < 2) bst[F.tid] = 0u;
    __syncthreads();
    XcdBarrier bar; bar.bar = (unsigned*)(F.ws + WS_CTL) + CW_BAR + args.li * XCD_BAR_WORDS; bar.x = 0; bar.st = nullptr;
    if (hi - lo > 1) bar = xcd_barrier_post((unsigned*)(F.ws + WS_CTL) + CW_BAR + args.li * XCD_BAR_WORDS, bst);
#ifndef MK_PHASE_MASK
#define MK_PHASE_MASK 0xFFF
#endif
#define IN(k) (((MK_PHASE_MASK >> (k)) & 1) && lo <= (k) && (k) < hi)
#define SEAM(k) do { if (IN(k) && IN((k) + 1)) { if ((k) == 0) cg::this_grid().sync(); else xcd_barrier(bar); } } while (0)
    if (IN(0)) { p0_prologue(F); } SEAM(0);
    if (IN(1)) { p1_norm(F); } SEAM(1);
    if (IN(2)) {
        pg8::Gemm g{(const bf16*)(F.ws + WS_XN), (const bf16*)(F.ws + WS_WQKV), MQ, NQKV, DM, 0};
        pg8::StaticOrder S; S.init(MQ, NQKV, F.G, (int)blockIdx.x);
        pg8::EpiBf16<0> E{(bf16*)(F.ws + WS_P), NQKV, nullptr, NQKV, 0, pg8::W8_INV};
        pg8::gemm_phase<pg8::EpiBf16<0>, pg8::StaticOrder, true, true, 1>(F.lds, g, S, E);
    } SEAM(2);
    if (IN(3)) { p3_qknorm(F); } SEAM(3);
    if (IN(4)) { p4_attention(F, (char*)lds); } SEAM(4);
    if (IN(5)) { p5_mix(F); } SEAM(5);
    if (IN(6)) {
        pg8::Gemm g{(const bf16*)(F.ws + WS_MIX), (const bf16*)(F.ws + WS_WO), TT, DM, DM, 0};
        pg8::StaticOrder S; S.init(TT, DM, F.G, (int)blockIdx.x);
        pg8::EpiOut E{F.in[I_X], F.out, (const float*)(F.ws + WS_TAB) + TB_MOD};
        pg8::gemm_phase<pg8::EpiOut, pg8::StaticOrder, true, true>(F.lds, g, S, E);
    } SEAM(6);
    if (IN(7)) { p7_router(F); } SEAM(7);
    if (IN(8)) { p8_scatter(F); } SEAM(8);
    if (IN(9)) {
        LAS int* bexp = (LAS int*)(F.lds + MISC_OFF + 1024);
        const int nblk = moe_block_table(F, bexp);
        pg8::Gemm g{(const bf16*)(F.ws + WS_XG), (const bf16*)(F.ws + WS_WGU), MPAD, 2048, DM, (size_t)2048 * 1024};
        pg8::MoeOrder S; S.init(nblk, 8, F.G, (int)blockIdx.x, bexp);
        pg8::EpiSwiGLU E{F.ws + WS_ACT, F.in[I_BGU]};
        pg8::gemm_phase<pg8::EpiSwiGLU, pg8::MoeOrder, true, true, 1>(F.lds, g, S, E);
    } SEAM(9);
    if (IN(10)) {
        LAS int* bexp = (LAS int*)(F.lds + MISC_OFF + 1024);
        const int nblk = moe_block_table(F, bexp);
        pg8::Gemm g{(const bf16*)(F.ws + WS_ACT), (const bf16*)(F.ws + WS_WDN), MPAD, 1024, DM, (size_t)1024 * 1024};
        pg8::MoeOrder S; S.init(nblk, 4, F.G, (int)blockIdx.x, bexp);
        pg8::EpiDown E{(bf16*)(F.ws + WS_Y), F.in[I_BD]};
        pg8::gemm_phase<pg8::EpiDown, pg8::MoeOrder, true, true, 1>(F.lds, g, S, E);
    } SEAM(10);
    if (IN(11)) { p11_combine(F); }
#undef IN
#undef SEAM
}

extern "C" void kernel_launch(void* const* d_in, const int* in_sizes, int n_in, void* d_out, int out_size, void* d_ws, size_t ws_size, hipStream_t stream) {
    static int grid = 0;
    if (grid == 0) {
        if (n_in != N_IN || in_sizes[0] != TT * DM || out_size != TT * DM || ws_size < WS_END) { fprintf(stderr, "kernel_launch: unexpected shapes (n_in %d, in0 %d, out %d, ws %zu)\n", n_in, n_in > 0 ? in_sizes[0] : -1, out_size, ws_size); grid = -1; return; }
        int dev = 0, cus = 0, per_cu = 0;
        if (hipGetDevice(&dev) != hipSuccess || hipDeviceGetAttribute(&cus, hipDeviceAttributeMultiprocessorCount, dev) != hipSuccess) { grid = -1; return; }
        if (hipFuncSetAttribute((const void*)mk_fwd, hipFuncAttributeMaxDynamicSharedMemorySize, LDS_BYTES) != hipSuccess) { fprintf(stderr, "kernel_launch: hipFuncSetAttribute failed\n"); grid = -1; return; }
        if (hipOccupancyMaxActiveBlocksPerMultiprocessor(&per_cu, (const void*)mk_fwd, NWAVES * 64, LDS_BYTES) != hipSuccess || per_cu < 1) { fprintf(stderr, "kernel_launch: occupancy query reports %d\n", per_cu); (void)hipGetLastError(); per_cu = 1; }
        grid = cus;
    }
    if (grid < 0) return;
    (void)hipMemsetAsync((char*)d_ws + WS_CTL, 0, CTL_ZERO_BYTES, stream);
    Args a{};
    for (int i = 0; i < N_IN; ++i) a.in[i] = (const float*)d_in[i];
    a.out = (float*)d_out; a.ws = (unsigned char*)d_ws;
    int lo_[3] = {0, 0, 0}, hi_[3] = {N_PHASES, 0, 0}, nl = 1;
    if (MK_PROBE_PHASE >= 0) { nl = 0; lo_[nl] = 0; hi_[nl] = MK_PROBE_PHASE + 1; ++nl; lo_[nl] = MK_PROBE_PHASE; hi_[nl] = MK_PROBE_PHASE + 1; ++nl; if (MK_PROBE_PHASE + 1 < N_PHASES) { lo_[nl] = MK_PROBE_PHASE + 1; hi_[nl] = N_PHASES; ++nl; } }
    for (int li = 0; li < nl; ++li) {
        a.ph_lo = lo_[li]; a.ph_hi = hi_[li]; a.li = li;
        void* params[] = {&a};
        const hipError_t e = hipLaunchCooperativeKernel((const void*)mk_fwd, dim3(grid), dim3(NWAVES * 64), params, LDS_BYTES, stream);
        if (e != hipSuccess) fprintf(stderr, "kernel_launch: cooperative launch failed: %s (grid %d)\n", hipGetErrorString(e), grid);
    }
}
```

```cpp
#include <hip/hip_runtime.h>
#include <hip/hip_cooperative_groups.h>
#include <cstdio>
#include <cstdint>
namespace cg = cooperative_groups;
namespace pg8 {
#define PG8_LAS __attribute__((address_space(3)))
typedef unsigned short bf16_t;
typedef short bf16x8 __attribute__((ext_vector_type(8)));
typedef float f32x4 __attribute__((ext_vector_type(4)));
typedef unsigned u32x4 __attribute__((ext_vector_type(4)));
constexpr int BM = 256, BK = 64, HALF = 128, HTB = HALF * BK * 2  , STAGE_BYTES = 8 * HTB, NXCD = 8, WGM = 8;

__host__ __device__ __forceinline__ int lds_byte(int r, int c) { const int st = (r >> 4) * 2 + (c >> 5), rr = r & 15, cc = c & 31, ob = rr * 64 + cc * 2; return st * 1024 + (ob ^ (((ob >> 9) & 1) << 5)); }
__host__ __device__ __forceinline__ void stage_rc(int b, int& R, int& C) { const int st = b / 1024, sb = b % 1024, swz = sb ^ (((sb >> 9) & 1) << 5); R = (st >> 1) * 16 + swz / 64; C = (st & 1) * 32 + (swz % 64) / 2; }
__host__ __device__ __forceinline__ int perm32(int rho) { const int n = rho >> 4, i = rho & 15; return 8 * (i >> 2) + 4 * n + (i & 3); }

struct Unit { int pm, pn, e; };
struct Gemm { const bf16_t* A; const bf16_t* Bt; int M, N, K; size_t estride; };

struct StaticOrder {
    int nM, nN, nwg, G, c;
    __host__ __device__ void init(int M, int N, int G_, int c_) { nM = M / BM; nN = N / BM; nwg = nM * nN; G = G_; c = c_; }
    __host__ __device__ bool next(int i, Unit& u) const {
        const long L = (long)i * G + c; if (L >= nwg) return false;
        int wgid = (int)L; { const int q = nwg / NXCD, r = nwg % NXCD, xcd = wgid % NXCD, off = wgid / NXCD; wgid = (xcd < r ? xcd * (q + 1) : r * (q + 1) + (xcd - r) * q) + off; }
        const int nig = WGM * nN, gid = wgid / nig, fm = gid * WGM, gsz = (nM - fm) < WGM ? (nM - fm) : WGM;
        u.pm = fm + ((wgid % nig) % gsz); u.pn = (wgid % nig) / gsz; u.e = 0; return true;
    }
    __device__ __forceinline__ void a_ready(const Unit&) const {}
    __device__ __forceinline__ void done(const Unit&) const {}
};

__device__ __forceinline__ unsigned cvt_pk_bf16(float lo, float hi) { unsigned r; asm volatile("v_cvt_pk_bf16_f32 %0, %1, %2" : "=v"(r) : "v"(lo), "v"(hi)); return r; }
typedef float f32x2 __attribute__((ext_vector_type(2)));
__device__ __forceinline__ f32x2 gelu_pk(f32x2 v) {
    const f32x2 av = __builtin_elementwise_abs(v), d = av * 0.2316418882f + 1.0f;
    f32x2 t; t.x = __builtin_amdgcn_rcpf(d.x); t.y = __builtin_amdgcn_rcpf(d.y);
    f32x2 q = t * 0.5307027145f + (-0.7265760135f); q = q * t + 0.7107068705f; q = q * t + (-0.142248368f); q = q * t + 0.127414796f; q = q * t;
    const f32x2 s = (v * v) * (-0.72134752044f);
    f32x2 e; e.x = __builtin_amdgcn_exp2f(s.x); e.y = __builtin_amdgcn_exp2f(s.y);
    const f32x2 m = v * (q * e), r = v - m;
    f32x2 o; o.x = v.x < 0.f ? m.x : r.x; o.y = v.y < 0.f ? m.y : r.y; return o;
}

template <int ACT  > struct EpiBf16 {
    static constexpr bool PERM = true, AFTER_DRAIN = false; static_assert(ACT == 0 || ACT == 1, "EpiBf16: ACT is 0 (none) or 1 (gelu_pk)");
    bf16_t* O; int ldc; const float* bias; int split_cols; size_t split_stride; float scale0;
    __device__ __forceinline__ void operator()(const f32x4 (&acc)[2][2][4][2], const Unit& u, int wr, int wc, int fr, int fq) const {
        const int row0 = u.pm * BM + wr * 64 + fr; int colt = u.pn * BM; bf16_t* base = O;
        float sc = 1.f; if (split_cols) { const int t = colt / split_cols; base += (size_t)t * split_stride; colt -= t * split_cols; if (t == 0) sc = scale0; }
        const int col0 = colt + wc * 32 + 8 * fq, bcol0 = u.pn * BM + wc * 32 + 8 * fq;
        f32x4 bv[2][2];
#pragma unroll
        for (int bj = 0; bj < 2; ++bj)
#pragma unroll
            for (int n = 0; n < 2; ++n) bv[bj][n] = bias ? *(const f32x4*)(bias + bcol0 + bj * HALF + 4 * n) : (f32x4){0.f, 0.f, 0.f, 0.f};
#pragma unroll
        for (int ai = 0; ai < 2; ++ai)
#pragma unroll
            for (int m = 0; m < 4; ++m) { bf16_t* rowp = base + (size_t)(row0 + ai * HALF + m * 16) * ldc + col0;
#pragma unroll
                for (int bj = 0; bj < 2; ++bj) { f32x4 v0 = acc[ai][bj][m][0] + bv[bj][0], v1 = acc[ai][bj][m][1] + bv[bj][1];
                    if (ACT == 1) { f32x2 a = gelu_pk((f32x2){v0[0], v0[1]}), b = gelu_pk((f32x2){v0[2], v0[3]}), c = gelu_pk((f32x2){v1[0], v1[1]}), d = gelu_pk((f32x2){v1[2], v1[3]});
                        v0 = (f32x4){a.x, a.y, b.x, b.y}; v1 = (f32x4){c.x, c.y, d.x, d.y}; }
                    v0 = v0 * sc; v1 = v1 * sc; u32x4 w; w.x = cvt_pk_bf16(v0[0], v0[1]); w.y = cvt_pk_bf16(v0[2], v0[3]); w.z = cvt_pk_bf16(v1[0], v1[1]); w.w = cvt_pk_bf16(v1[2], v1[3]);
                    *(u32x4*)(rowp + bj * HALF) = w; } }
    }
};

typedef int i32x4 __attribute__((ext_vector_type(4)));
typedef int i32x8 __attribute__((ext_vector_type(8)));
__device__ __forceinline__ i32x8 cat8(bf16x8 lo, bf16x8 hi) { const i32x4 a = __builtin_bit_cast(i32x4, lo), b = __builtin_bit_cast(i32x4, hi); return __builtin_shufflevector(a, b, 0, 1, 2, 3, 4, 5, 6, 7); }
template <class Epi, class Sched, bool ALIGN_EPI = false, bool SP2 = false, int ESZ = 2>
__device__ __forceinline__ void gemm_phase(PG8_LAS unsigned char* lds, const Gemm g, const Sched& S, const Epi& E) {
    const int tid = threadIdx.x, wid = __builtin_amdgcn_readfirstlane(tid >> 6), lane = tid & 63, wr = wid >> 2, wc = wid & 3, fr = lane & 15, fq = lane >> 4;
    const int K = g.K, nt = K * ESZ / (BK * 2);
    unsigned voffA[2], voffB[2];
#pragma unroll
    for (int i = 0; i < 2; ++i) { int R, C; stage_rc(tid * 16 + i * 8192, R, C); const int Rb = Epi::PERM ? ((R & ~31) + perm32(R & 31)) : R;
        voffA[i] = (unsigned)(R * K * ESZ + C * 2); voffB[i] = (unsigned)(Rb * K * ESZ + C * 2); }
    const size_t kstep = (size_t)(BK * 2);
    const size_t hstep = (size_t)HALF * K * ESZ;
    const size_t tstep = 2 * hstep;
    const unsigned ldsw = (unsigned)wid * 1024u;
    const int aoff = lds_byte(wr * 64 + fr, fq * 8), boff = lds_byte(wc * 32 + fr, fq * 8);
#define PG8_SA(b, h) (((b) * 2 + (h)) * HTB)
#define PG8_SB(b, h) ((4 + (b) * 2 + (h)) * HTB)
#define PG8_STAGE(bufoff, gbase, voff) do { _Pragma("unroll") for (int _i = 0; _i < 2; ++_i) \
        __builtin_amdgcn_global_load_lds((const unsigned*)((const char*)(gbase) + (voff)[_i]), (PG8_LAS unsigned*)(lds + (bufoff) + ldsw + _i * 8192), 16, 0, 0); } while (0)
#define PG8_LDA(dst, b, h) do { _Pragma("unroll") for (int m = 0; m < 4; ++m) _Pragma("unroll") for (int k = 0; k < 2; ++k) dst[m][k] = *(const PG8_LAS bf16x8*)(lds + PG8_SA(b, h) + aoff + m * 2048 + k * 1024); } while (0)
#define PG8_LDB(dst, b, h) do { _Pragma("unroll") for (int n = 0; n < 2; ++n) _Pragma("unroll") for (int k = 0; k < 2; ++k) dst[n][k] = *(const PG8_LAS bf16x8*)(lds + PG8_SB(b, h) + boff + n * 2048 + k * 1024); } while (0)
#define PG8_MMA(ai, bj, At, Bt) do { __builtin_amdgcn_s_setprio(1); _Pragma("unroll") for (int m = 0; m < 4; ++m) _Pragma("unroll") for (int n = 0; n < 2; ++n) { \
        if constexpr (ESZ == 2) { _Pragma("unroll") for (int k = 0; k < 2; ++k) acc[ai][bj][m][n] = __builtin_amdgcn_mfma_f32_16x16x32_bf16(Bt[n][k], At[m][k], acc[ai][bj][m][n], 0, 0, 0); } \
        else { acc[ai][bj][m][n] = __builtin_amdgcn_mfma_scale_f32_16x16x128_f8f6f4(cat8(Bt[n][0], Bt[n][1]), cat8(At[m][0], At[m][1]), acc[ai][bj][m][n], 0, 0, 0, 0x7f7f7f7f, 0, 0x7f7f7f7f); } } \
        if constexpr (ESZ == 1) {   \
            _Pragma("unroll") for (int m = 0; m < 4; ++m) asm volatile("" : "+v"(acc[ai][bj][m][0]), "+v"(acc[ai][bj][m][1])); } \
        __builtin_amdgcn_s_setprio(0); } while (0)
#define PG8_WAIT_V(n) asm volatile("s_waitcnt vmcnt(" #n ")" ::: "memory")
#define PG8_WAIT_L(n) asm volatile("s_waitcnt lgkmcnt(" #n ")" ::: "memory")
#define PG8_BAR __builtin_amdgcn_s_barrier()
#define PG8_SCHED __builtin_amdgcn_sched_barrier(0)
    Unit cur, nxt; int ui = 0;
    if (!S.next(0, cur)) return;
    f32x4 acc[2][2][4][2];
#pragma unroll
    for (int a = 0; a < 2; ++a)
#pragma unroll
        for (int b = 0; b < 2; ++b)
#pragma unroll
            for (int m = 0; m < 4; ++m)
#pragma unroll
                for (int n = 0; n < 2; ++n) acc[a][b][m][n] = (f32x4){0.f, 0.f, 0.f, 0.f};
    bf16x8 At[4][2], B0[2][2], B1[2][2];
    const char* cA = (const char*)g.A + (size_t)cur.pm * tstep; const char* cB = (const char*)g.Bt + (size_t)cur.e * g.estride + (size_t)cur.pn * tstep;
    S.a_ready(cur);
    if constexpr (SP2) {
        PG8_STAGE(PG8_SB(0, 0), cB, voffB); PG8_STAGE(PG8_SB(0, 1), cB + hstep, voffB); PG8_STAGE(PG8_SA(0, 0), cA, voffA); PG8_STAGE(PG8_SA(0, 1), cA + hstep, voffA);
        if (wr == 1) PG8_BAR;
        PG8_WAIT_V(2); PG8_BAR;
        PG8_STAGE(PG8_SB(1, 0), cB + kstep, voffB); PG8_STAGE(PG8_SA(1, 0), cA + kstep, voffA); PG8_STAGE(PG8_SB(1, 1), cB + hstep + kstep, voffB);
        PG8_WAIT_V(6); PG8_BAR;
    } else {
        PG8_STAGE(PG8_SB(0, 0), cB, voffB); PG8_STAGE(PG8_SA(0, 0), cA, voffA); PG8_STAGE(PG8_SB(0, 1), cB + hstep, voffB); PG8_STAGE(PG8_SA(0, 1), cA + hstep, voffA);
        if (wr == 1) PG8_BAR;
        PG8_WAIT_V(4); PG8_BAR;
        PG8_STAGE(PG8_SB(1, 0), cB + kstep, voffB); PG8_STAGE(PG8_SA(1, 0), cA + kstep, voffA); PG8_STAGE(PG8_SB(1, 1), cB + hstep + kstep, voffB);
        PG8_WAIT_V(6); PG8_BAR;
    }
    for (;;) {
        const bool has_next = S.next(ui + 1, nxt);
        const char* nA = has_next ? (const char*)g.A + (size_t)nxt.pm * tstep : cA; const char* nB = has_next ? (const char*)g.Bt + (size_t)nxt.e * g.estride + (size_t)nxt.pn * tstep : cB;
        for (int t = 0; t < nt; t += 2) {
            const bool last = (t == nt - 2);
            const char* a1 = cA + (size_t)(t + 1) * kstep;
            const char* a2 = last ? nA : cA + (size_t)(t + 2) * kstep; const char* b2 = last ? nB : cB + (size_t)(t + 2) * kstep;
            const char* a3 = a2 + kstep; const char* b3 = b2 + kstep;
            if (last && has_next) S.a_ready(nxt);
            if constexpr (SP2) {
            PG8_LDB(B0, 0, 0); PG8_LDB(B1, 0, 1); PG8_SCHED; PG8_LDA(At, 0, 0); PG8_STAGE(PG8_SA(1, 1), a1 + hstep, voffA);
            PG8_WAIT_V(8); PG8_WAIT_L(0); PG8_BAR; PG8_MMA(0, 0, At, B0); PG8_MMA(0, 1, At, B1); PG8_BAR; PG8_SCHED;
            PG8_LDA(At, 0, 1); PG8_STAGE(PG8_SB(0, 0), b2, voffB); PG8_STAGE(PG8_SB(0, 1), b2 + hstep, voffB); PG8_STAGE(PG8_SA(0, 0), a2, voffA);
            PG8_WAIT_V(8); PG8_WAIT_L(0); PG8_BAR; PG8_MMA(1, 0, At, B0); PG8_MMA(1, 1, At, B1); PG8_BAR; PG8_SCHED;
            PG8_LDB(B0, 1, 0); PG8_LDB(B1, 1, 1); PG8_SCHED; PG8_LDA(At, 1, 0); PG8_STAGE(PG8_SA(0, 1), a2 + hstep, voffA);
            PG8_WAIT_V(8); PG8_WAIT_L(0); PG8_BAR; PG8_MMA(0, 0, At, B0); PG8_MMA(0, 1, At, B1); PG8_BAR; PG8_SCHED;
            PG8_LDA(At, 1, 1); PG8_STAGE(PG8_SB(1, 0), b3, voffB); PG8_STAGE(PG8_SB(1, 1), b3 + hstep, voffB); PG8_STAGE(PG8_SA(1, 0), a3, voffA);
            PG8_WAIT_V(8); PG8_WAIT_L(0); PG8_BAR; PG8_MMA(1, 0, At, B0); PG8_MMA(1, 1, At, B1); PG8_BAR; PG8_SCHED;
            } else {
            PG8_LDB(B0, 0, 0); PG8_SCHED; PG8_LDA(At, 0, 0); PG8_STAGE(PG8_SA(1, 1), a1 + hstep, voffA);
            PG8_WAIT_L(8); PG8_BAR; PG8_WAIT_L(0); PG8_MMA(0, 0, At, B0); PG8_BAR; PG8_SCHED;
            PG8_LDB(B1, 0, 1); PG8_STAGE(PG8_SB(0, 0), b2, voffB);
            PG8_BAR; PG8_WAIT_L(0); PG8_MMA(0, 1, At, B1); PG8_BAR;
            PG8_LDA(At, 0, 1); PG8_STAGE(PG8_SA(0, 0), a2, voffA);
            PG8_BAR; PG8_WAIT_L(0); PG8_MMA(1, 0, At, B0); PG8_BAR; PG8_SCHED;
            PG8_STAGE(PG8_SB(0, 1), b2 + hstep, voffB);
            PG8_WAIT_V(6); PG8_BAR; PG8_MMA(1, 1, At, B1); PG8_BAR;
            PG8_LDB(B0, 1, 0); PG8_SCHED; PG8_LDA(At, 1, 0); PG8_STAGE(PG8_SA(0, 1), a2 + hstep, voffA);
            PG8_WAIT_L(8); PG8_BAR; PG8_WAIT_L(0); PG8_MMA(0, 0, At, B0); PG8_BAR; PG8_SCHED;
            PG8_LDB(B1, 1, 1); PG8_STAGE(PG8_SB(1, 0), b3, voffB);
            PG8_BAR; PG8_WAIT_L(0); PG8_MMA(0, 1, At, B1); PG8_BAR;
            PG8_LDA(At, 1, 1); PG8_STAGE(PG8_SA(1, 0), a3, voffA);
            PG8_BAR; PG8_WAIT_L(0); PG8_MMA(1, 0, At, B0); PG8_BAR; PG8_SCHED;
            PG8_STAGE(PG8_SB(1, 1), b3 + hstep, voffB);
            PG8_WAIT_V(6); PG8_BAR; PG8_MMA(1, 1, At, B1); PG8_BAR;
            }
        }
        if constexpr (ALIGN_EPI) { if (wr == 0) PG8_BAR; }
        if constexpr (!Epi::AFTER_DRAIN) { E(acc, cur, wr, wc, fr, fq); S.done(cur); }
        if (!has_next) break;
#pragma unroll
        for (int a = 0; a < 2; ++a)
#pragma unroll
            for (int b = 0; b < 2; ++b)
#pragma unroll
                for (int m = 0; m < 4; ++m)
#pragma unroll
                    for (int n = 0; n < 2; ++n) acc[a][b][m][n] = (f32x4){0.f, 0.f, 0.f, 0.f};
        cur = nxt; cA = nA; cB = nB; ++ui;
        if constexpr (ALIGN_EPI) { if (wr == 1) PG8_BAR; }
    }
    PG8_WAIT_V(0);
    if constexpr (!ALIGN_EPI) { if (wr == 0) PG8_BAR; }
    PG8_BAR;
    if constexpr (Epi::AFTER_DRAIN) { E.fused(acc, cur, wr, wc, fr, fq, lds, wid, lane); S.done(cur); }
#undef PG8_SA
#undef PG8_SB
#undef PG8_STAGE
#undef PG8_LDA
#undef PG8_LDB
#undef PG8_MMA
#undef PG8_WAIT_V
#undef PG8_WAIT_L
#undef PG8_BAR
#undef PG8_SCHED
}
}

namespace pg8 {
struct MoeOrder {
    int nM, nN, nwg, G, c; const PG8_LAS int* bexp;
    __device__ __forceinline__ void init(int nM_, int nN_, int G_, int c_, const PG8_LAS int* bexp_) { nM = nM_; nN = nN_; nwg = nM_ * nN_; G = G_; c = c_; bexp = bexp_; }
    __device__ __forceinline__ bool next(int i, Unit& u) const {
        const long L = (long)i * G + c; if (L >= nwg) return false;
        int wgid = (int)L; { const int q = nwg / NXCD, r = nwg % NXCD, xcd = wgid % NXCD, off = wgid / NXCD; wgid = (xcd < r ? xcd * (q + 1) : r * (q + 1) + (xcd - r) * q) + off; }
        const int nig = WGM * nN, gid = wgid / nig, fm = gid * WGM, gsz = (nM - fm) < WGM ? (nM - fm) : WGM;
        u.pm = fm + ((wgid % nig) % gsz); u.pn = (wgid % nig) / gsz; u.e = __builtin_amdgcn_readfirstlane(bexp[u.pm]); return true;
    }
    __device__ __forceinline__ void a_ready(const Unit&) const {}
    __device__ __forceinline__ void done(const Unit&) const {}
};
struct EpiOut {
    static constexpr bool PERM = false, AFTER_DRAIN = false;
    const float* x; float* out; const float* mod;
    __device__ __forceinline__ void operator()(const f32x4 (&acc)[2][2][4][2], const Unit& u, int wr, int wc, int fr, int fq) const {
        const int row0 = u.pm * BM + wr * 64 + fr, col0 = u.pn * BM + wc * 32 + 4 * fq;
        const float* g = mod + (size_t)(u.pm >> 5) * 6144 + 2 * 1024;
        f32x4 gv[2][2];
#pragma unroll
        for (int bj = 0; bj < 2; ++bj)
#pragma unroll
            for (int n = 0; n < 2; ++n) gv[bj][n] = *(const f32x4*)(g + col0 + bj * HALF + n * 16);
#pragma unroll
        for (int ai = 0; ai < 2; ++ai)
#pragma unroll
            for (int m = 0; m < 4; ++m) { const size_t off = (size_t)(row0 + ai * HALF + m * 16) * 1024 + col0;
#pragma unroll
                for (int bj = 0; bj < 2; ++bj)
#pragma unroll
                    for (int n = 0; n < 2; ++n) { const f32x4 xv = *(const f32x4*)(x + off + bj * HALF + n * 16); *(f32x4*)(out + off + bj * HALF + n * 16) = xv + gv[bj][n] * acc[ai][bj][m][n]; } }
    }
};
__device__ __forceinline__ float swiglu1(float g, float l) {
    const float glu = fminf(g, 7.0f), lin = fminf(fmaxf(l, -7.0f), 7.0f);
    const float sg = __builtin_amdgcn_rcpf(1.0f + __builtin_amdgcn_exp2f(glu * (-1.702f * 1.4426950408889634f)));
    return glu * sg * (lin + 1.0f);
}
__device__ __forceinline__ unsigned pk4_fp8(float a, float b, float c, float d) { int w = 0; w = __builtin_amdgcn_cvt_pk_fp8_f32(a, b, w, false); w = __builtin_amdgcn_cvt_pk_fp8_f32(c, d, w, true); return (unsigned)w; }
constexpr float W8_SCALE = 32.0f, W8_INV = 1.0f / 32.0f;
struct EpiSwiGLU {
    static constexpr bool PERM = true, AFTER_DRAIN = false;
    unsigned char* act; const float* bgu;
    __device__ __forceinline__ void operator()(const f32x4 (&acc)[2][2][4][2], const Unit& u, int wr, int wc, int fr, int fq) const {
        const int row0 = u.pm * BM + wr * 64 + fr, cg = u.pn * 128 + wc * 32 + 8 * fq;
        const float* bb = bgu + (size_t)u.e * 2048;
        f32x4 bg[2], bl[2];
#pragma unroll
        for (int n = 0; n < 2; ++n) { bg[n] = *(const f32x4*)(bb + cg + 4 * n); bl[n] = *(const f32x4*)(bb + 1024 + cg + 4 * n); }
#pragma unroll
        for (int ai = 0; ai < 2; ++ai)
#pragma unroll
            for (int m = 0; m < 4; ++m) { unsigned char* rowp = act + (size_t)(row0 + ai * HALF + m * 16) * 1024 + cg;
                const f32x4 g0 = acc[ai][0][m][0] * W8_INV + bg[0], g1 = acc[ai][0][m][1] * W8_INV + bg[1], l0 = acc[ai][1][m][0] * W8_INV + bl[0], l1 = acc[ai][1][m][1] * W8_INV + bl[1];
                typedef unsigned u32x2 __attribute__((ext_vector_type(2)));
                u32x2 w; w.x = pk4_fp8(swiglu1(g0[0], l0[0]), swiglu1(g0[1], l0[1]), swiglu1(g0[2], l0[2]), swiglu1(g0[3], l0[3]));
                w.y = pk4_fp8(swiglu1(g1[0], l1[0]), swiglu1(g1[1], l1[1]), swiglu1(g1[2], l1[2]), swiglu1(g1[3], l1[3]));
                *(u32x2*)rowp = w; }
    }
};
struct EpiDown {
    static constexpr bool PERM = true, AFTER_DRAIN = false;
    bf16_t* y; const float* bd;
    __device__ __forceinline__ void operator()(const f32x4 (&acc)[2][2][4][2], const Unit& u, int wr, int wc, int fr, int fq) const {
        const int row0 = u.pm * BM + wr * 64 + fr, col0 = u.pn * BM + wc * 32 + 8 * fq;
        const float* bb = bd + (size_t)u.e * 1024 + col0;
        f32x4 bv[2][2];
#pragma unroll
        for (int bj = 0; bj < 2; ++bj)
#pragma unroll
            for (int n = 0; n < 2; ++n) bv[bj][n] = *(const f32x4*)(bb + bj * HALF + 4 * n);
#pragma unroll
        for (int ai = 0; ai < 2; ++ai)
#pragma unroll
            for (int m = 0; m < 4; ++m) { bf16_t* rowp = y + (size_t)(row0 + ai * HALF + m * 16) * 1024 + col0;
#pragma unroll
                for (int bj = 0; bj < 2; ++bj) { const f32x4 v0 = acc[ai][bj][m][0] * W8_INV + bv[bj][0], v1 = acc[ai][bj][m][1] * W8_INV + bv[bj][1];
                    u32x4 w; w.x = cvt_pk_bf16(v0[0], v0[1]); w.y = cvt_pk_bf16(v0[2], v0[3]); w.z = cvt_pk_bf16(v1[0], v1[1]); w.w = cvt_pk_bf16(v1[2], v1[3]);
                    *(u32x4*)(rowp + bj * HALF) = w; } }
    }
};

template <int NWOFF, int RCOS, int RSIN, int CCOS, int CSIN> struct EpiQKV {
    static constexpr bool PERM = true, AFTER_DRAIN = false;
    bf16_t* P; const float* tab;
    PG8_LAS float* xch;
    float qscale;
    __device__ __forceinline__ void operator()(const f32x4 (&acc)[2][2][4][2], const Unit& u, int wr, int wc, int fr, int fq) const {
        const int type = u.pn >> 1, row0 = u.pm * BM + wr * 64 + fr, col0 = u.pn * BM + wc * 32 + 8 * fq;
        if (type == 2 || type == 5) {
#pragma unroll
            for (int ai = 0; ai < 2; ++ai)
#pragma unroll
                for (int m = 0; m < 4; ++m) { bf16_t* rowp = P + (size_t)(row0 + ai * HALF + m * 16) * 3072 + col0;
#pragma unroll
                    for (int bj = 0; bj < 2; ++bj) { const f32x4 v0 = acc[ai][bj][m][0] * W8_INV, v1 = acc[ai][bj][m][1] * W8_INV;
                        u32x4 w; w.x = cvt_pk_bf16(v0[0], v0[1]); w.y = cvt_pk_bf16(v0[2], v0[3]); w.z = cvt_pk_bf16(v1[0], v1[1]); w.w = cvt_pk_bf16(v1[2], v1[3]);
                        *(u32x4*)(rowp + bj * HALF) = w; } }
            return;
        }
        const int wid = wr * 4 + wc;
        float ss[16];
#pragma unroll
        for (int ai = 0; ai < 2; ++ai)
#pragma unroll
            for (int m = 0; m < 4; ++m)
#pragma unroll
                for (int bj = 0; bj < 2; ++bj) { const f32x4 a = acc[ai][bj][m][0], b = acc[ai][bj][m][1];
                    float s = (a[0] * a[0] + a[1] * a[1]) + (a[2] * a[2] + a[3] * a[3]) + (b[0] * b[0] + b[1] * b[1]) + (b[2] * b[2] + b[3] * b[3]);
                    s += __shfl_xor(s, 16); s += __shfl_xor(s, 32); ss[(ai * 4 + m) * 2 + bj] = s; }
        if (fq == 0) {
#pragma unroll
            for (int i = 0; i < 16; ++i) xch[(wid * 16 + i) * 16 + fr] = ss[i]; }
        asm volatile("s_waitcnt lgkmcnt(0)" ::: "memory"); __builtin_amdgcn_s_barrier(); asm volatile("" ::: "memory");
#pragma unroll
        for (int i = 0; i < 16; ++i) ss[i] += xch[((wid ^ 1) * 16 + i) * 16 + fr];
        const int d0 = 32 * (wc & 1) + 8 * fq;
        const float* nwp = tab + NWOFF + (type - (type > 2 ? 1 : 0)) * 64 + d0;
        const f32x4 w0 = *(const f32x4*)nwp, w1 = *(const f32x4*)(nwp + 4);
        const float qs = (type == 0 || type == 3) ? qscale : 1.0f;
        const bool rope = (type < 2) && (u.pm < 128);
        const int half = wc & 1, f0 = 8 * (fq & 1); const bool isx2 = fq >= 2;
#pragma unroll
        for (int ai = 0; ai < 2; ++ai)
#pragma unroll
            for (int m = 0; m < 4; ++m) { const int row = row0 + ai * HALF + m * 16; bf16_t* rowp = P + (size_t)row * 3072 + col0;
                f32x4 cs0 = {1.f, 1.f, 1.f, 1.f}, cs1 = cs0, sn0 = {0.f, 0.f, 0.f, 0.f}, sn1 = sn0;
                if (rope) { const int s = row & 8191, pp = half ? (s & 63) : (s >> 6); const float* ct = tab + RCOS + half * (CCOS - RCOS) + pp * 16 + f0; const float* st = tab + RSIN + half * (CSIN - RSIN) + pp * 16 + f0;
                    cs0 = *(const f32x4*)ct; cs1 = *(const f32x4*)(ct + 4); sn0 = *(const f32x4*)st; sn1 = *(const f32x4*)(st + 4); if (!isx2) { sn0 = -sn0; sn1 = -sn1; } }
#pragma unroll
                for (int bj = 0; bj < 2; ++bj) {
                    const float rstd = W8_INV / sqrtf(ss[(ai * 4 + m) * 2 + bj] * (W8_INV * W8_INV / 64.0f) + 1e-6f);
                    f32x4 y0 = acc[ai][bj][m][0] * rstd * w0, y1 = acc[ai][bj][m][1] * rstd * w1;
                    if (rope) { f32x4 p0, p1;
#pragma unroll
                        for (int i = 0; i < 4; ++i) { p0[i] = __shfl_xor(y0[i], 32); p1[i] = __shfl_xor(y1[i], 32); }
                        y0 = y0 * cs0 + p0 * sn0; y1 = y1 * cs1 + p1 * sn1; }
                    y0 = y0 * qs; y1 = y1 * qs;
                    u32x4 w; w.x = cvt_pk_bf16(y0[0], y0[1]); w.y = cvt_pk_bf16(y0[2], y0[3]); w.z = cvt_pk_bf16(y1[0], y1[1]); w.w = cvt_pk_bf16(y1[2], y1[3]);
                    *(u32x4*)(rowp + bj * HALF) = w; }
                asm volatile("" ::: "memory"); }
    }
};
}

namespace att {
typedef unsigned short bf16_t;
using bf16x8 = __attribute__((ext_vector_type(8))) short;
using s16x4  = __attribute__((ext_vector_type(4))) short;
using f32x16 = __attribute__((ext_vector_type(16))) float;
using u32x4  = __attribute__((ext_vector_type(4))) unsigned;
constexpr int NW = 8, QBLK = 32, KVBLK = 64, LD = 3072;
constexpr float SCALE = 0.125f, C2 = 0.125f * 1.4426950408889634f;
#define KSWZ64(row, colB) ((row) * 128 + ((colB) ^ ((((row) >> 1) & 7) << 4)))
#define ASBAR() __builtin_amdgcn_sched_barrier(0)
__device__ __forceinline__ int crow(int r, int hi) { return (r & 3) + 8 * (r >> 2) + 4 * hi; }
__device__ __forceinline__ unsigned cvtpk(float lo, float hi) { unsigned r; asm volatile("v_cvt_pk_bf16_f32 %0, %1, %2" : "=v"(r) : "v"(lo), "v"(hi)); return r; }
__device__ __forceinline__ bf16x8 ld8(const bf16_t* p) { return *reinterpret_cast<const bf16x8*>(p); }
__device__ __forceinline__ void glds16(const void* gsrc, unsigned lds_dst) { unsigned keep;
  asm volatile("s_mov_b32 %0, m0\n\ts_mov_b32 m0, %2\n\ts_nop 0\n\tglobal_load_lds_dwordx4 %1, off\n\ts_mov_b32 m0, %0" : "=&s"(keep) : "v"(gsrc), "s"(lds_dst) : "memory"); }
__device__ __forceinline__ void glds16s(const void* sbase, unsigned voff, unsigned lds_dst) { unsigned keep;
  asm volatile("s_mov_b32 %0, m0\n\ts_mov_b32 m0, %3\n\ts_nop 0\n\tglobal_load_lds_dwordx4 %1, %2\n\ts_mov_b32 m0, %0" : "=&s"(keep) : "v"(voff), "s"(sbase), "s"(lds_dst) : "memory"); }

__device__ __forceinline__ void exp16(f32x16& p, float mref) {
#pragma unroll
  for (int r = 0; r < 16; ++r) p[r] = __builtin_amdgcn_exp2f(p[r]);
}
__device__ __forceinline__ void finishSM(f32x16& p0, f32x16& p1, float mref, float& l_reg, bf16x8& pa0, bf16x8& pa1, bf16x8& pa2, bf16x8& pa3) {
  exp16(p1, mref);
  float ps = 0;
#pragma unroll
  for (int r = 0; r < 16; ++r) ps += p0[r];
#pragma unroll
  for (int r = 0; r < 16; ++r) ps += p1[r];
  l_reg += ps;
#define PK4(P, BASE, OUT) do { u32x4 w = {cvtpk(P[BASE + 0], P[BASE + 1]), cvtpk(P[BASE + 2], P[BASE + 3]), cvtpk(P[BASE + 4], P[BASE + 5]), cvtpk(P[BASE + 6], P[BASE + 7])}; OUT = *reinterpret_cast<bf16x8*>(&w); } while (0)
  PK4(p0, 0, pa0); PK4(p0, 8, pa1); PK4(p1, 0, pa2); PK4(p1, 8, pa3);
#undef PK4
}
template <bool NEGM> __device__ __forceinline__ void qkt(f32x16& p0, f32x16& p1, const char* Ks, const bf16x8* qr, const f32x16& negm, int r32, int hi) {
#pragma unroll
  for (int d0 = 0; d0 < 4; ++d0) { const int cb = (d0 * 16 + hi * 8) * 2;
    const bf16x8 b0 = *reinterpret_cast<const bf16x8*>(Ks + KSWZ64(r32, cb));
    const bf16x8 b1 = *reinterpret_cast<const bf16x8*>(Ks + KSWZ64(32 + r32, cb));
    if (d0 == 0) { if constexpr (NEGM) { p0 = __builtin_amdgcn_mfma_f32_32x32x16_bf16(b0, qr[0], negm, 0, 0, 0); p1 = __builtin_amdgcn_mfma_f32_32x32x16_bf16(b1, qr[0], negm, 0, 0, 0); }
      else { p0 = __builtin_amdgcn_mfma_f32_32x32x16_bf16(b0, qr[0], f32x16{}, 0, 0, 0); p1 = __builtin_amdgcn_mfma_f32_32x32x16_bf16(b1, qr[0], f32x16{}, 0, 0, 0); } }
    else { p0 = __builtin_amdgcn_mfma_f32_32x32x16_bf16(b0, qr[d0], p0, 0, 0, 0); p1 = __builtin_amdgcn_mfma_f32_32x32x16_bf16(b1, qr[d0], p1, 0, 0, 0); } }
}
template <int NVB> __device__ __forceinline__ int v_st(int k, int c) { const int kk = k; return ((kk >> 3) * NVB + (c >> 5)) * 512 + ((kk & 7) * 32 + (c & 31)) * 2; }
__device__ __forceinline__ int v_rd_base(int lane) { return ((lane & 3) << 3) | (((lane >> 2) & 3) << 6) | (((lane >> 4) & 1) << 5) | (((lane >> 5) & 1) << 8); }
template <int NVB> constexpr int v_rd_off(int d0, int ks, int half) { return d0 * 512 + ks * (NVB * 1024) + half * (NVB * 512); }
template <int OFF> __device__ __forceinline__ s16x4 tr_read(int vb) {
  s16x4 r; asm volatile("ds_read_b64_tr_b16 %0, %1 offset:%2" : "=&v"(r) : "v"(vb), "i"(OFF) : "memory"); return r;
}
template <int NVB, int D0> __device__ __forceinline__ void v_rd(s16x4* f, int vb) {
  f[0] = tr_read<v_rd_off<NVB>(D0, 0, 0)>(vb); f[1] = tr_read<v_rd_off<NVB>(D0, 0, 1)>(vb); f[2] = tr_read<v_rd_off<NVB>(D0, 1, 0)>(vb); f[3] = tr_read<v_rd_off<NVB>(D0, 1, 1)>(vb);
  f[4] = tr_read<v_rd_off<NVB>(D0, 2, 0)>(vb); f[5] = tr_read<v_rd_off<NVB>(D0, 2, 1)>(vb); f[6] = tr_read<v_rd_off<NVB>(D0, 3, 0)>(vb); f[7] = tr_read<v_rd_off<NVB>(D0, 3, 1)>(vb);
}
__device__ __forceinline__ void pv_mm(f32x16& od, const s16x4* f, bf16x8 pa0, bf16x8 pa1, bf16x8 pa2, bf16x8 pa3) {
#define PK(L, H) (bf16x8){L[0], L[1], L[2], L[3], H[0], H[1], H[2], H[3]}
  od = __builtin_amdgcn_mfma_f32_32x32x16_bf16(pa0, PK(f[0], f[1]), od, 0, 0, 0);
  od = __builtin_amdgcn_mfma_f32_32x32x16_bf16(pa1, PK(f[2], f[3]), od, 0, 0, 0);
  od = __builtin_amdgcn_mfma_f32_32x32x16_bf16(pa2, PK(f[4], f[5]), od, 0, 0, 0);
  od = __builtin_amdgcn_mfma_f32_32x32x16_bf16(pa3, PK(f[6], f[7]), od, 0, 0, 0);
#undef PK
}
template <int LO, int N> __device__ __forceinline__ void exp_part(f32x16& p, float mref) {
#pragma unroll
  for (int r = LO; r < LO + N; ++r) p[r] = __builtin_amdgcn_exp2f(p[r]);
}
#define LGKM0() do { asm volatile("s_waitcnt lgkmcnt(0)" ::: "memory"); ASBAR(); } while (0)
template <int NVB> __device__ __forceinline__ void pv_all(f32x16* o, int vb, s16x4* fa, s16x4* fb, bf16x8 pa0, bf16x8 pa1, bf16x8 pa2, bf16x8 pa3, f32x16& c, float mref) {
  if constexpr (NVB == 4) {
    LGKM0(); v_rd<NVB, 1>(fb, vb); pv_mm(o[0], fa, pa0, pa1, pa2, pa3); exp_part<0, 4>(c, mref);
    LGKM0(); v_rd<NVB, 2>(fa, vb); pv_mm(o[1], fb, pa0, pa1, pa2, pa3); exp_part<4, 4>(c, mref);
    LGKM0(); v_rd<NVB, 3>(fb, vb); pv_mm(o[2], fa, pa0, pa1, pa2, pa3); exp_part<8, 4>(c, mref);
    LGKM0();                       pv_mm(o[3], fb, pa0, pa1, pa2, pa3); exp_part<12, 4>(c, mref);
  } else {
    LGKM0(); v_rd<NVB, 1>(fb, vb); pv_mm(o[0], fa, pa0, pa1, pa2, pa3); exp_part<0, 8>(c, mref);
    LGKM0();                       pv_mm(o[1], fb, pa0, pa1, pa2, pa3); exp_part<8, 8>(c, mref);
  }
}
template <bool SHIFT> struct DiffPol {
  static constexpr bool NEGM = false;
  const bf16_t* Kg; const bf16_t* Vg; long lat0, ctx0; float mref;
  __device__ __forceinline__ long krow(int t) const { return t < 128 ? lat0 + 64L * t : ctx0 + 64L * (t - 128); }
  __device__ __forceinline__ void mod(f32x16& p0, f32x16& p1, int, int, int, int) const {
    if constexpr (SHIFT) {
#pragma unroll
      for (int i = 0; i < 16; ++i) { p0[i] -= mref; p1[i] -= mref; } }
  }
};
struct NaPol {
  static constexpr bool NEGM = false;
  const bf16_t* Kg; const bf16_t* Vg; long lat0, ctx0; int rbase, r; const float* tab; float mref;
  __device__ __forceinline__ long krow(int t) const { if (t < 12) { int kr = rbase + t; kr = kr > 127 ? 127 : kr; return lat0 + 64L * kr; } return ctx0 + 64L * (t - 12); }
  __device__ __forceinline__ void mod(f32x16& p0, f32x16& p1, int t, int wid, int r32, int hi) const {
    if (t >= 12) {
#pragma unroll
      for (int i = 0; i < 16; ++i) { p0[i] -= mref; p1[i] -= mref; }
      return; }
    const float NEG = -INFINITY;
    const int kr = rbase + t, rq = r + (wid >> 1), c = 32 * (wid & 1) + r32;
    int r0q = rq - 4; r0q = r0q < 0 ? 0 : (r0q > 120 ? 120 : r0q);
    if (!((kr >= r0q) && (kr < r0q + 8))) {
#pragma unroll
      for (int i = 0; i < 16; ++i) { p0[i] = NEG; p1[i] = NEG; }
      return; }
    int c0 = c - 8; c0 = c0 < 0 ? 0 : (c0 > 48 ? 48 : c0);
    int d = 4 * hi - c0, off = (kr - rq + 7) * 31 + 15 - c + 4 * hi;
    asm volatile("" : "+v"(d), "+v"(off));
#pragma unroll
    for (int i = 0; i < 16; ++i) { const int ci = (i & 3) + 8 * (i >> 2);
      const bool v0 = (unsigned)(ci + d) < 16u, v1 = (unsigned)(ci + 32 + d) < 16u;
      const float b0 = tab[off + ci], b1 = tab[off + ci + 32];
      p0[i] = v0 ? p0[i] + b0 : NEG; p1[i] = v1 ? p1[i] + b1 : NEG; }
  }
};
template <int NVB> constexpr int lds_bytes() { return 3 * (64 * NVB * 64) + 3 * (64 * 128) + NW * 64 * 4; }
template <int NVB, class Pol>
__device__ __forceinline__ void attn_unit(const bf16_t* __restrict__ Qb, const Pol& pol, bf16_t* __restrict__ Ob, int ldo, int NT, float mref, char* lds) {
  constexpr int SHM_V = 64 * NVB * 64, SHM_K = 64 * 128;
  const int tid = threadIdx.x, lane = tid & 63, r32 = lane & 31, hi = lane >> 5; const int wid = __builtin_amdgcn_readfirstlane(tid >> 6);
  char* V_lds = lds; char* K_lds = lds + 3 * SHM_V;
  float* li_l = (float*)(lds + 3 * SHM_V + 3 * SHM_K) + wid * 64;
  const unsigned lds0 = (unsigned)(uintptr_t)lds;
  const int krow_ = 8 * wid + (lane >> 3), kch = (lane & 7) ^ ((krow_ >> 1) & 7);
  const unsigned koff = (unsigned)(krow_ * LD + kch * 8) * 2u;
  const unsigned voff = (unsigned)((8 * wid + ((lane >> 2) & 7)) * LD + (lane >> 5) * 32 + (lane & 3) * 8) * 2u;
  const unsigned kdst = lds0 + 3 * SHM_V + wid * 1024, vdst = lds0 + wid * (NVB == 4 ? 2048 : 1024);
#define DMA_TILE(t, b) do { const long ro_ = pol.krow(t) * LD; glds16s(pol.Kg + ro_, koff, (unsigned)__builtin_amdgcn_readfirstlane(kdst + (b) * SHM_K)); \
    glds16s(pol.Vg + ro_, voff, (unsigned)__builtin_amdgcn_readfirstlane(vdst + (b) * SHM_V)); \
    if constexpr (NVB == 4) glds16s(pol.Vg + ro_ + 64, voff, (unsigned)__builtin_amdgcn_readfirstlane(vdst + (b) * SHM_V + 1024)); } while (0)
#define WAIT_BAR() do { asm volatile("s_waitcnt vmcnt(0)" ::: "memory"); __syncthreads(); } while (0)
  DMA_TILE(0, 0); DMA_TILE(1, 1);
  float l_reg = 0; f32x16 o[NVB]; bf16x8 qr[4]; f32x16 negm;
#pragma unroll
  for (int r = 0; r < 16; ++r) negm[r] = -mref;
  if constexpr (Pol::NEGM) asm volatile("" : "+v"(negm));
#pragma unroll
  for (int d = 0; d < NVB; ++d) o[d] = f32x16{};
  const bf16_t* Qw = Qb + (long)(wid * QBLK + r32) * LD + hi * 8;
#pragma unroll
  for (int d0 = 0; d0 < 4; ++d0) qr[d0] = ld8(Qw + d0 * 16);
  const int vb0 = (int)(uintptr_t)V_lds + v_rd_base(lane);
  f32x16 pA0, pA1, pB0, pB1; bf16x8 pa0, pa1, pa2, pa3; s16x4 fa[8], fb[8];
  int bp = 0, bc = 1, bn = 2;
  WAIT_BAR();
  qkt<Pol::NEGM>(pA0, pA1, K_lds, qr, negm, r32, hi); pol.mod(pA0, pA1, 0, wid, r32, hi); exp16(pA0, mref);
#define STEP(C0, C1, P0, P1, j) do { \
    if ((j) + 1 < NT) DMA_TILE((j) + 1, bn); \
    ASBAR(); v_rd<NVB, 0>(fa, vb0 + bp * SHM_V); qkt<Pol::NEGM>(C0, C1, K_lds + bc * SHM_K, qr, negm, r32, hi); \
    finishSM(P0, P1, mref, l_reg, pa0, pa1, pa2, pa3); ASBAR(); \
    pol.mod(C0, C1, (j), wid, r32, hi); ASBAR(); \
    pv_all<NVB>(o, vb0 + bp * SHM_V, fa, fb, pa0, pa1, pa2, pa3, C0, mref); \
    WAIT_BAR(); \
    bp = bc; bc = bn; bn = (bn == 2) ? 0 : bn + 1; } while (0)
  int j = 1;
#pragma nounroll
  for (; j + 1 < NT; j += 2) { STEP(pB0, pB1, pA0, pA1, j); STEP(pA0, pA1, pB0, pB1, j + 1); }
  STEP(pB0, pB1, pA0, pA1, NT - 1);
  finishSM(pB0, pB1, mref, l_reg, pa0, pa1, pa2, pa3); ASBAR();
  v_rd<NVB, 0>(fa, vb0 + bp * SHM_V); pv_all<NVB>(o, vb0 + bp * SHM_V, fa, fb, pa0, pa1, pa2, pa3, pA0, 0.f);
  { auto rr = __builtin_amdgcn_permlane32_swap(__float_as_uint(l_reg), __float_as_uint(l_reg), false, false); l_reg = __uint_as_float(rr[0]) + __uint_as_float(rr[1]); }
  if (hi == 0) li_l[r32] = l_reg; asm volatile("s_waitcnt lgkmcnt(0)" ::: "memory");
  float rli[16];
#pragma unroll
  for (int r = 0; r < 16; ++r) rli[r] = __builtin_amdgcn_rcpf(li_l[crow(r, hi)]);
  bf16_t* Ow = Ob + (long)(wid * QBLK) * ldo;
#pragma unroll
  for (int r = 0; r < 16; ++r) { const int orow = crow(r, hi);
#pragma unroll
    for (int d0 = 0; d0 < NVB; ++d0) { const float v = o[d0][r] * rli[r]; const unsigned pk = cvtpk(v, v); Ow[(long)orow * ldo + d0 * 32 + r32] = (bf16_t)(pk & 0xffffu); } }
  __syncthreads();
#undef DMA_TILE
#undef WAIT_BAR
#undef STEP
}
}

#ifndef MK_PROBE_PHASE
#define MK_PROBE_PHASE -1
#endif
#ifndef MK_N_LAUNCHES
#define MK_N_LAUNCHES 1
#endif
constexpr int N_PHASES = 12;
constexpr int NWAVES = 8;
constexpr int DM = 1024, NB = 4, SEQ = 8192, TT = NB * SEQ, CTX = 256, TC = NB * CTX, MQ = TT + TC, NQKV = 3072;
constexpr int NE = 32, TOPK = 4, MPAD = TT * TOPK + NE * 256, MAXBLK = MPAD / 256;
constexpr float NORM_EPS = 1e-6f;
enum { I_X = 0, I_C, I_CTX, I_CCTX, I_WADA, I_BADA, I_GATTN, I_WIN, I_QND, I_KND, I_LQ1, I_LK1, I_LQ2, I_LK2, I_SUBLN, I_QNN, I_KNN, I_RPB, I_ONN, I_WOUT, I_GFFN, I_WR, I_BR, I_WGU, I_BGU, I_WD, I_BD, N_IN };

constexpr size_t MiB = 1u << 20;
constexpr size_t WS_CTL = 0, CTL_ZERO_BYTES = 64 * 1024;
constexpr size_t WS_TAB = 1 * MiB;
constexpr size_t WS_WQKV = 2 * MiB, WS_WO = 8 * MiB, WS_WGU = 10 * MiB, WS_WDN = 138 * MiB;
constexpr size_t WS_XN = 202 * MiB;
constexpr size_t WS_P = 268 * MiB;
constexpr size_t WS_OD = 499 * MiB, WS_ON = 563 * MiB, WS_MIX = 595 * MiB;
constexpr size_t WS_XG = 202 * MiB;
constexpr size_t WS_ACT = 659 * MiB;
constexpr size_t WS_Y = 202 * MiB;
constexpr size_t WS_RT = 931 * MiB;
constexpr size_t WS_END = 936 * MiB;
static_assert(WS_XN + (size_t)MQ * 2048 <= WS_P && WS_P + (size_t)MQ * 6144 <= WS_OD && WS_XG + (size_t)MPAD * 2048 <= WS_OD && WS_ACT + (size_t)MPAD * 2048 <= WS_RT, "d_ws map");
constexpr int TB_MOD = 0;
constexpr int TB_RCOS = 30720, TB_RSIN = TB_RCOS + 128 * 16, TB_CCOS = TB_RSIN + 128 * 16, TB_CSIN = TB_CCOS + 64 * 16;
constexpr int TB_LAM = TB_CSIN + 64 * 16;
constexpr int TB_NW = TB_LAM + 64;
constexpr int TB_WR = TB_NW + 256;
constexpr int TB_RC = TB_WR + 4 * 1024 * 32;
static_assert((size_t)(TB_RC + 128 + 64) * 4 <= MiB, "TAB region");
constexpr int CW_CNT = 0;
constexpr int CW_BAR = 4096;
constexpr size_t RT_E = 0, RT_G = 512 * 1024, RT_POS = 1024 * 1024, RT_SLOT = 1536 * 1024;

constexpr int RING_BYTES = 131072;
constexpr int MISC_OFF = RING_BYTES;
constexpr int LDS_BYTES = 147456;

#define GAS __attribute__((address_space(1)))
#define LAS __attribute__((address_space(3)))
typedef unsigned short bf16;
typedef unsigned v4u __attribute__((ext_vector_type(4)));
typedef unsigned v2u __attribute__((ext_vector_type(2)));
typedef float f32x4 __attribute__((ext_vector_type(4)));
typedef float f32x16 __attribute__((ext_vector_type(16)));
#define LDS_WAIT() asm volatile("s_waitcnt lgkmcnt(0)" ::: "memory")
__device__ __forceinline__ unsigned f2bf(float f) { unsigned u = __builtin_bit_cast(unsigned, f); return (u + 0x7fffu + ((u >> 16) & 1u)) >> 16; }
__device__ __forceinline__ unsigned pk2(float lo, float hi) { return f2bf(lo) | (f2bf(hi) << 16); }
__device__ __forceinline__ float bflo(unsigned w) { return __uint_as_float(w << 16); }
__device__ __forceinline__ float bfhi(unsigned w) { return __uint_as_float(w & 0xffff0000u); }
__device__ __forceinline__ float wave_sum(float v) {
#pragma unroll
    for (int o = 1; o < 64; o <<= 1) v += __shfl_xor(v, o);
    return v;
}

struct Frame {
    LAS unsigned char* lds;
    int tid, lane, wave, vcu, G;
    const float* in[N_IN]; float* out; unsigned char* ws;
};

__device__ __forceinline__ void p0_transpose_item(const float* W, int K, int N, bf16* WT, int k0, int n0, int drow0, LAS float* scr, int lane) {
#pragma unroll 8
    for (int i = 0; i < 32; ++i) { const int kk = 2 * i + (lane >> 5); scr[kk * 33 + (lane & 31)] = W[(size_t)(k0 + kk) * N + n0 + (lane & 31)]; }
    LDS_WAIT(); asm volatile("" ::: "memory");
    const int c = lane & 7;
#pragma unroll
    for (int j = 0; j < 4; ++j) { const int n = (lane >> 3) + 8 * j; const LAS float* s = scr + (8 * c) * 33 + n;
        v4u o; o.x = pk2(s[0 * 33], s[1 * 33]); o.y = pk2(s[2 * 33], s[3 * 33]); o.z = pk2(s[4 * 33], s[5 * 33]); o.w = pk2(s[6 * 33], s[7 * 33]);
        *(v4u*)(WT + (size_t)(drow0 + n) * K + k0 + 8 * c) = o; }
    LDS_WAIT(); asm volatile("" ::: "memory");
}

__device__ __forceinline__ void p0_transpose_item8(const float* W, int K, int N, unsigned char* WT, int k0, int n0, int drow0, LAS float* scr, int lane) {
#pragma unroll 8
    for (int i = 0; i < 32; ++i) { const int kk = 2 * i + (lane >> 5); scr[kk * 33 + (lane & 31)] = W[(size_t)(k0 + kk) * N + n0 + (lane & 31)]; }
    LDS_WAIT(); asm volatile("" ::: "memory");
    const int n = lane & 31, hf = lane >> 5; const LAS float* s = scr + (32 * hf) * 33 + n;
    v4u o0, o1;
#define P4(j) pg8::pk4_fp8(s[(j) * 33] * pg8::W8_SCALE, s[((j) + 1) * 33] * pg8::W8_SCALE, s[((j) + 2) * 33] * pg8::W8_SCALE, s[((j) + 3) * 33] * pg8::W8_SCALE)
    o0.x = P4(0); o0.y = P4(4); o0.z = P4(8); o0.w = P4(12); o1.x = P4(16); o1.y = P4(20); o1.z = P4(24); o1.w = P4(28);
#undef P4
    unsigned char* dst = WT + (size_t)(drow0 + n) * K + k0 + 32 * hf;
    *(v4u*)dst = o0; *(v4u*)(dst + 16) = o1;
    LDS_WAIT(); asm volatile("" ::: "memory");
}

__device__ __forceinline__ void p0_prologue(Frame& F) {
    float* tab = (float*)(F.ws + WS_TAB);
    for (int task = blockIdx.x; task < 96; task += F.G) {
        LAS float* ssilu = (LAS float*)F.lds;
        LAS float* part = ssilu + 5 * 1024;
        for (int i = F.tid; i < 5 * 1024; i += 512) { const int r = i >> 10, k = i & 1023; const float v = (r < 4) ? F.in[I_C][r * 1024 + k] : F.in[I_CCTX][k]; ssilu[i] = v / (1.0f + __expf(-v)); }
        __syncthreads();
        const int col = task * 64 + F.lane; const float* w = F.in[I_WADA] + col; float a0 = 0, a1 = 0, a2 = 0, a3 = 0, a4 = 0;
        const int kb = F.wave * 128;
#pragma unroll 8
        for (int k = kb; k < kb + 128; ++k) { const float wv = w[(size_t)k * 6144]; a0 += ssilu[k] * wv; a1 += ssilu[1024 + k] * wv; a2 += ssilu[2048 + k] * wv; a3 += ssilu[3072 + k] * wv; a4 += ssilu[4096 + k] * wv; }
        part[(F.wave * 5 + 0) * 64 + F.lane] = a0; part[(F.wave * 5 + 1) * 64 + F.lane] = a1; part[(F.wave * 5 + 2) * 64 + F.lane] = a2; part[(F.wave * 5 + 3) * 64 + F.lane] = a3; part[(F.wave * 5 + 4) * 64 + F.lane] = a4;
        __syncthreads();
        if (F.tid < 320) { const int r = F.tid >> 6, cl = F.tid & 63; float s = 0; for (int wv = 0; wv < 8; ++wv) s += part[(wv * 5 + r) * 64 + cl]; const int j = task * 64 + cl; tab[TB_MOD + r * 6144 + j] = s + F.in[I_BADA][j]; }
        __syncthreads();
    }
    if ((int)blockIdx.x == F.G - 1) {
        for (int i = F.tid; i < 192 * 16; i += 512) { const int p = i >> 4, f = i & 15; const float inv = 1.0f / powf(10000.0f, (float)f / 16.0f); const int pos = p < 128 ? p : p - 128; const float ang = (float)pos * inv;
            const float cv = cosf(ang), sv = sinf(ang);
            if (p < 128) { tab[TB_RCOS + pos * 16 + f] = cv; tab[TB_RSIN + pos * 16 + f] = sv; } else { tab[TB_CCOS + pos * 16 + f] = cv; tab[TB_CSIN + pos * 16 + f] = sv; } }
        if (F.wave == 0) tab[TB_NW + F.lane] = F.in[I_QND][F.lane];
        if (F.wave == 1) tab[TB_NW + 64 + F.lane] = F.in[I_KND][F.lane];
        if (F.wave == 2) tab[TB_NW + 128 + F.lane] = F.in[I_QNN][F.lane];
        if (F.wave == 3) tab[TB_NW + 192 + F.lane] = F.in[I_KNN][F.lane];
        if (F.wave == 0) { const float s1 = wave_sum(F.in[I_LQ1][F.lane] * F.in[I_LK1][F.lane]), s2 = wave_sum(F.in[I_LQ2][F.lane] * F.in[I_LK2][F.lane]);
            if (F.lane == 0) tab[TB_LAM] = expf(s1) - expf(s2) + 0.2f;
            float a = fabsf(F.in[I_QND][F.lane]), bq = fabsf(F.in[I_KND][F.lane]), c = fabsf(F.in[I_QNN][F.lane]), d = fabsf(F.in[I_KNN][F.lane]); float rm = -1e30f;
            for (int i = F.lane; i < 8 * 465; i += 64) rm = fmaxf(rm, F.in[I_RPB][i]);
#pragma unroll
            for (int o = 1; o < 64; o <<= 1) { a = fmaxf(a, __shfl_xor(a, o)); bq = fmaxf(bq, __shfl_xor(bq, o)); c = fmaxf(c, __shfl_xor(c, o)); d = fmaxf(d, __shfl_xor(d, o)); rm = fmaxf(rm, __shfl_xor(rm, o)); }
            if (F.lane == 0) { tab[TB_LAM + 1] = att::C2 * 64.0f * a * bq * 1.02f + 0.05f; tab[TB_LAM + 2] = att::C2 * 64.0f * c * d * 1.02f + 0.05f + fmaxf(rm, 0.f) * 1.4426950408889634f; } }
    }
    LAS float* scr = (LAS float*)(F.lds + 32768 + F.wave * 8704);
    const int gw = F.vcu * NWAVES + F.wave, NGW = F.G * NWAVES;
    constexpr int I_IN = 16 * 96, I_OUT = 16 * 32, I_GU = 16 * 64, I_DN = 16 * 32;
    constexpr int NITEMS = I_IN + I_OUT + NE * (I_GU + I_DN);
    bf16* wqkv = (bf16*)(F.ws + WS_WQKV); bf16* wo = (bf16*)(F.ws + WS_WO); unsigned char* wgu = F.ws + WS_WGU; unsigned char* wdn = F.ws + WS_WDN;
    for (int it = gw; it < NITEMS; it += NGW) {
        int r = it;
        if (r < I_IN) { const int kb = r / 96, nb = r % 96; p0_transpose_item8(F.in[I_WIN], 1024, 3072, (unsigned char*)wqkv, 64 * kb, 32 * nb, 32 * nb, scr, F.lane); continue; } r -= I_IN;
        if (r < I_OUT) { const int kb = r / 32, nb = r % 32; p0_transpose_item(F.in[I_WOUT], 1024, 1024, wo, 64 * kb, 32 * nb, 32 * nb, scr, F.lane); continue; } r -= I_OUT;
        if (r < NE * I_GU) { const int e = r / I_GU, q = r % I_GU, kb = q / 64, nb = q % 64, n0 = 32 * nb;
            const int drow = (n0 < 1024) ? ((n0 >> 7) * 256 + (n0 & 127)) : (((n0 - 1024) >> 7) * 256 + 128 + ((n0 - 1024) & 127));
            p0_transpose_item8(F.in[I_WGU] + (size_t)e * 1024 * 2048, 1024, 2048, wgu + (size_t)e * 2048 * 1024, 64 * kb, n0, drow, scr, F.lane); continue; } r -= NE * I_GU;
        { const int e = r / I_DN, q = r % I_DN, kb = q / 32, nb = q % 32;
            p0_transpose_item8(F.in[I_WD] + (size_t)e * 1024 * 1024, 1024, 1024, wdn + (size_t)e * 1024 * 1024, 64 * kb, 32 * nb, 32 * nb, scr, F.lane); }
    }
}

__device__ __forceinline__ void p1_norm(Frame& F) {
    const float* tab = (const float*)(F.ws + WS_TAB); unsigned char* XN = F.ws + WS_XN;
    const int gw = F.vcu * NWAVES + F.wave, NGW = F.G * NWAVES;
    const f32x4* gat = (const f32x4*)F.in[I_GATTN] + F.lane;
    for (int m = gw; m < MQ; m += NGW) {
        const int b = m < TT ? (m >> 13) : 4;
        const float* xrow = m < TT ? F.in[I_X] + (size_t)m * DM : F.in[I_CTX] + (size_t)(m - TT) * DM;
        const f32x4* xr = (const f32x4*)xrow + F.lane;
        const f32x4* sh = (const f32x4*)(tab + TB_MOD + b * 6144) + F.lane; const f32x4* sc = (const f32x4*)(tab + TB_MOD + b * 6144 + 1024) + F.lane;
        f32x4 v[4]; float s = 0.f;
#pragma unroll
        for (int j = 0; j < 4; ++j) { v[j] = xr[64 * j]; s += (v[j].x * v[j].x + v[j].y * v[j].y) + (v[j].z * v[j].z + v[j].w * v[j].w); }
        const float rstd = 1.0f / sqrtf(wave_sum(s) * (1.f / DM) + NORM_EPS);
        unsigned* o4 = (unsigned*)(XN + (size_t)m * DM) + F.lane;
#pragma unroll
        for (int j = 0; j < 4; ++j) { const f32x4 g = gat[64 * j], a = sc[64 * j], c = sh[64 * j];
            const f32x4 h = (v[j] * rstd) * g * (a + 1.0f) + c;
            o4[64 * j] = pg8::pk4_fp8(h.x, h.y, h.z, h.w); }
    }
    float* tw = (float*)(F.ws + WS_TAB);
    for (int i = (int)blockIdx.x * 512 + F.tid; i < 4 * 1024 * 32; i += F.G * 512) { const int b = i >> 15, k = (i >> 5) & 1023;
        tw[TB_WR + i] = F.in[I_GFFN][k] * (1.0f + tab[TB_MOD + b * 6144 + 4 * 1024 + k]) * F.in[I_WR][i & 32767]; }
    for (int t = gw; t < 128; t += NGW) { const int b = t >> 5, e = t & 31; float s = 0.f;
        for (int k = F.lane; k < 1024; k += 64) s += tab[TB_MOD + b * 6144 + 3 * 1024 + k] * F.in[I_WR][k * 32 + e];
        s = wave_sum(s); if (F.lane == 0) tw[TB_RC + t] = s + F.in[I_BR][e]; }
}

__device__ __forceinline__ void p3_qknorm(Frame& F) {
    const float* tab = (const float*)(F.ws + WS_TAB); bf16* P = (bf16*)(F.ws + WS_P);
    const int gw = F.vcu * NWAVES + F.wave, NGW = F.G * NWAVES;
    const int j = F.lane & 7;
    for (int task = gw; task < MQ * 4; task += NGW) {
        const int row = task >> 2, g = task & 3;
        const int colb = (g == 0) ? 0 : (g == 1) ? 512 : (g == 2) ? 1536 : 2048;
        const float* nw = ((g == 0) ? F.in[I_QND] : (g == 1) ? F.in[I_KND] : (g == 2) ? F.in[I_QNN] : F.in[I_KNN]) + 8 * j;
        bf16* p = P + (size_t)row * NQKV + colb + F.lane * 8;
        const v4u w = *(const v4u*)p;
        float v[8] = {bflo(w.x), bfhi(w.x), bflo(w.y), bfhi(w.y), bflo(w.z), bfhi(w.z), bflo(w.w), bfhi(w.w)};
        float ss = 0.f;
#pragma unroll
        for (int i = 0; i < 8; ++i) ss += v[i] * v[i];
        ss += __shfl_xor(ss, 1); ss += __shfl_xor(ss, 2); ss += __shfl_xor(ss, 4);
        const float rstd = 1.0f / sqrtf(ss * (1.f / 64.f) + NORM_EPS);
        const f32x4 n0 = *(const f32x4*)nw, n1 = *(const f32x4*)(nw + 4);
        v[0] *= rstd * n0.x; v[1] *= rstd * n0.y; v[2] *= rstd * n0.z; v[3] *= rstd * n0.w; v[4] *= rstd * n1.x; v[5] *= rstd * n1.y; v[6] *= rstd * n1.z; v[7] *= rstd * n1.w;
        if (g < 2 && row < TT) {
            const int s = row & (SEQ - 1), prow = s >> 6, pcol = s & 63, half = j >> 2, isx2 = (j >> 1) & 1;
            const float* ct = tab + (half ? TB_CCOS + pcol * 16 : TB_RCOS + prow * 16) + 8 * (j & 1);
            const float* st = tab + (half ? TB_CSIN + pcol * 16 : TB_RSIN + prow * 16) + 8 * (j & 1);
            const f32x4 c0 = *(const f32x4*)ct, c1 = *(const f32x4*)(ct + 4), s0 = *(const f32x4*)st, s1 = *(const f32x4*)(st + 4);
            const float cc[8] = {c0.x, c0.y, c0.z, c0.w, c1.x, c1.y, c1.z, c1.w}, sn[8] = {s0.x, s0.y, s0.z, s0.w, s1.x, s1.y, s1.z, s1.w};
#pragma unroll
            for (int i = 0; i < 8; ++i) { const float pr = __shfl_xor(v[i], 2); v[i] = isx2 ? (v[i] * cc[i] + pr * sn[i]) : (v[i] * cc[i] - pr * sn[i]); }
        }
        if (g == 0 || g == 2) {
#pragma unroll
            for (int i = 0; i < 8; ++i) v[i] *= att::C2;
        }
        v4u o; o.x = pk2(v[0], v[1]); o.y = pk2(v[2], v[3]); o.z = pk2(v[4], v[5]); o.w = pk2(v[6], v[7]);
        *(v4u*)p = o;
    }
}

__device__ __forceinline__ void p4_attention(Frame& F, char* lds) {
    const bf16* P = (const bf16*)(F.ws + WS_P); bf16* OD = (bf16*)(F.ws + WS_OD); bf16* ON = (bf16*)(F.ws + WS_ON);
    const float* tab = (const float*)(F.ws + WS_TAB); const float mref_d = tab[TB_LAM + 1], mref_n = tab[TB_LAM + 2];
#ifndef MK_NO_DIFF
#define DIFF_UNITS(SH) for (int unit = F.vcu; unit < 1024; unit += F.G) { \
        const int bhm = unit >> 5, qb = unit & 31, b = bhm >> 3, h = (bhm >> 1) & 3, m = bhm & 1; \
        att::DiffPol<SH> pol; pol.Kg = P + 512 + h * 128 + m * 64; pol.Vg = P + 1024 + h * 128; pol.lat0 = (long)b * SEQ; pol.ctx0 = (long)TT + b * CTX; pol.mref = mref_d; \
        att::attn_unit<4, att::DiffPol<SH> >(P + ((size_t)b * SEQ + qb * 256) * NQKV + h * 128 + m * 64, pol, OD + ((size_t)b * SEQ + qb * 256) * 1024 + h * 256 + m * 128, 1024, 132, mref_d, lds); }
    if (mref_d <= 100.0f) { DIFF_UNITS(false) } else { DIFF_UNITS(true) }
#undef DIFF_UNITS
#endif
#ifndef MK_NO_NA
    float* tabl = (float*)(lds + att::lds_bytes<4>());
    for (int unit = F.vcu; unit < 1024; unit += F.G) {
        const int bh = unit >> 5, rb = unit & 31, b = bh >> 3, hn = bh & 7, r = rb * 4;
        for (int i = F.tid; i < 15 * 31; i += 512) tabl[i] = F.in[I_RPB][hn * 465 + i] * 1.4426950408889634f - mref_n;
        att::NaPol pol; pol.Kg = P + 2048 + hn * 64; pol.Vg = P + 2560 + hn * 64; pol.lat0 = (long)b * SEQ; pol.ctx0 = (long)TT + b * CTX;
        pol.mref = mref_n; pol.r = r; pol.rbase = (r - 4) < 0 ? 0 : ((r - 4) > 120 ? 120 : (r - 4)); pol.tab = tabl;
        att::attn_unit<2, att::NaPol>(P + ((size_t)b * SEQ + r * 64) * NQKV + 1536 + hn * 64, pol, ON + ((size_t)b * SEQ + r * 64) * 512 + hn * 64, 512, 16, mref_n, lds);
    }
#endif
}

__device__ __forceinline__ void p5_mix(Frame& F) {
    const float* tab = (const float*)(F.ws + WS_TAB); const bf16* OD = (const bf16*)(F.ws + WS_OD); const bf16* ON = (const bf16*)(F.ws + WS_ON); bf16* MX = (bf16*)(F.ws + WS_MIX);
    const int gw = F.vcu * NWAVES + F.wave, NGW = F.G * NWAVES;
    const float lam = tab[TB_LAM];
    const int h = F.lane >> 4, e0 = (F.lane & 15) * 8;
    const f32x4 sl0 = *(const f32x4*)(F.in[I_SUBLN] + e0), sl1 = *(const f32x4*)(F.in[I_SUBLN] + e0 + 4);
    const f32x4 on0 = *(const f32x4*)(F.in[I_ONN] + F.lane * 8), on1 = *(const f32x4*)(F.in[I_ONN] + F.lane * 8 + 4);
    for (int t = gw; t < TT; t += NGW) {
        const v4u a = *(const v4u*)(OD + (size_t)t * 1024 + h * 256 + e0), c = *(const v4u*)(OD + (size_t)t * 1024 + h * 256 + 128 + e0);
        const v4u n = *(const v4u*)(ON + (size_t)t * 512 + F.lane * 8);
        float d[8] = {bflo(a.x) - lam * bflo(c.x), bfhi(a.x) - lam * bfhi(c.x), bflo(a.y) - lam * bflo(c.y), bfhi(a.y) - lam * bfhi(c.y),
                      bflo(a.z) - lam * bflo(c.z), bfhi(a.z) - lam * bfhi(c.z), bflo(a.w) - lam * bflo(c.w), bfhi(a.w) - lam * bfhi(c.w)};
        float ss = 0.f;
#pragma unroll
        for (int i = 0; i < 8; ++i) ss += d[i] * d[i];
        ss += __shfl_xor(ss, 1); ss += __shfl_xor(ss, 2); ss += __shfl_xor(ss, 4); ss += __shfl_xor(ss, 8);
        const float rs = 0.8f / sqrtf(ss * (1.f / 128.f) + NORM_EPS);
        v4u o; o.x = pk2(d[0] * rs * sl0.x, d[1] * rs * sl0.y); o.y = pk2(d[2] * rs * sl0.z, d[3] * rs * sl0.w); o.z = pk2(d[4] * rs * sl1.x, d[5] * rs * sl1.y); o.w = pk2(d[6] * rs * sl1.z, d[7] * rs * sl1.w);
        *(v4u*)(MX + (size_t)t * 1024 + h * 128 + e0) = o;
        float q[8] = {bflo(n.x), bfhi(n.x), bflo(n.y), bfhi(n.y), bflo(n.z), bfhi(n.z), bflo(n.w), bfhi(n.w)};
        float s2 = 0.f;
#pragma unroll
        for (int i = 0; i < 8; ++i) s2 += q[i] * q[i];
        s2 += __shfl_xor(s2, 1); s2 += __shfl_xor(s2, 2); s2 += __shfl_xor(s2, 4);
        const float r2 = 1.0f / sqrtf(s2 * (1.f / 64.f) + NORM_EPS);
        v4u o2; o2.x = pk2(q[0] * r2 * on0.x, q[1] * r2 * on0.y); o2.y = pk2(q[2] * r2 * on0.z, q[3] * r2 * on0.w); o2.z = pk2(q[4] * r2 * on1.x, q[5] * r2 * on1.y); o2.w = pk2(q[6] * r2 * on1.z, q[7] * r2 * on1.w);
        *(v4u*)(MX + (size_t)t * 1024 + 512 + F.lane * 8) = o2;
    }
}

__device__ __forceinline__ void p7_router(Frame& F) {
    const float* tab = (const float*)(F.ws + WS_TAB); unsigned* cnt = (unsigned*)(F.ws + WS_CTL) + CW_CNT;
    int* rt_e = (int*)(F.ws + WS_RT + RT_E); float* rt_g = (float*)(F.ws + WS_RT + RT_G); int* rt_pos = (int*)(F.ws + WS_RT + RT_POS);
    LAS unsigned* cntl = (LAS unsigned*)(F.lds + MISC_OFF); LAS unsigned* basel = cntl + 32;
    const int j = F.lane & 31, kh = F.lane >> 5;
    for (int tile = F.vcu; tile < TT / 128; tile += F.G) {
        if (F.tid < 32) cntl[F.tid] = 0u;
        __syncthreads();
        int te[4] = {0, 0, 0, 0}; float tg[4] = {0, 0, 0, 0}; unsigned lp[4] = {0, 0, 0, 0}; const int t = tile * 128 + 32 * F.wave + j;
        if (F.wave < 4) {
            const int b = t >> 13;
            const float* xr = F.out + (size_t)t * DM + 4 * kh;
            const float* wp = tab + TB_WR + (size_t)b * 32768 + (4 * kh) * 32 + j;
            f32x16 acc = f32x16{}; float ss = 0.f;
#pragma unroll 4
            for (int u = 0; u < 128; ++u) {
                const f32x4 xv = *(const f32x4*)(xr + 8 * u);
                const float w0 = wp[(8 * u + 0) * 32], w1 = wp[(8 * u + 1) * 32], w2 = wp[(8 * u + 2) * 32], w3 = wp[(8 * u + 3) * 32];
                ss += (xv.x * xv.x + xv.y * xv.y) + (xv.z * xv.z + xv.w * xv.w);
                acc = __builtin_amdgcn_mfma_f32_32x32x2f32(w0, xv.x, acc, 0, 0, 0);
                acc = __builtin_amdgcn_mfma_f32_32x32x2f32(w1, xv.y, acc, 0, 0, 0);
                acc = __builtin_amdgcn_mfma_f32_32x32x2f32(w2, xv.z, acc, 0, 0, 0);
                acc = __builtin_amdgcn_mfma_f32_32x32x2f32(w3, xv.w, acc, 0, 0, 0);
            }
            ss += __shfl_xor(ss, 32);
            const float rstd = 1.0f / sqrtf(ss * (1.f / DM) + NORM_EPS);
            float v[16];
#pragma unroll
            for (int r = 0; r < 16; ++r) v[r] = acc[r] * rstd + tab[TB_RC + b * 32 + att::crow(r, kh)];
            float cv[8]; int ce[8];
#pragma unroll
            for (int k = 0; k < 4; ++k) { float best = -INFINITY; int bi = 0;
#pragma unroll
                for (int r = 0; r < 16; ++r) if (v[r] > best) { best = v[r]; bi = r; }
#pragma unroll
                for (int r = 0; r < 16; ++r) if (r == bi) v[r] = -INFINITY;
                cv[k] = best; ce[k] = att::crow(bi, kh); }
#pragma unroll
            for (int k = 0; k < 4; ++k) { cv[4 + k] = __shfl_xor(cv[k], 32); ce[4 + k] = __shfl_xor(ce[k], 32); }
            float tv[4];
#pragma unroll
            for (int k = 0; k < 4; ++k) { float best = -INFINITY; int be = 1 << 30, bi = 0;
#pragma unroll
                for (int q = 0; q < 8; ++q) if (cv[q] > best || (cv[q] == best && ce[q] < be)) { best = cv[q]; be = ce[q]; bi = q; }
#pragma unroll
                for (int q = 0; q < 8; ++q) if (q == bi) cv[q] = -INFINITY;
                tv[k] = best; te[k] = be; }
            const float e1 = __expf(tv[1] - tv[0]), e2 = __expf(tv[2] - tv[0]), e3 = __expf(tv[3] - tv[0]); const float inv = 1.0f / (1.0f + e1 + e2 + e3);
            tg[0] = inv; tg[1] = e1 * inv; tg[2] = e2 * inv; tg[3] = e3 * inv;
            if (kh == 0) {
#pragma unroll
                for (int k = 0; k < 4; ++k) lp[k] = __hip_atomic_fetch_add(cntl + te[k], 1u, __ATOMIC_RELAXED, __HIP_MEMORY_SCOPE_WORKGROUP);
            }
        }
        __syncthreads();
        if (F.tid < 32) { const unsigned c = cntl[F.tid]; basel[F.tid] = c ? atomicAdd(cnt + F.tid, c) : 0u; }
        __syncthreads();
        if (F.wave < 4 && kh == 0) {
#pragma unroll
            for (int k = 0; k < 4; ++k) { rt_e[t * 4 + k] = te[k]; rt_g[t * 4 + k] = tg[k]; rt_pos[t * 4 + k] = (int)(basel[te[k]] + lp[k]); }
        }
        __syncthreads();
    }
}

__device__ __forceinline__ int pad_starts(const unsigned* cnt, int lane) {
    const int c = lane < 32 ? (int)__hip_atomic_load(cnt + lane, __ATOMIC_RELAXED, __HIP_MEMORY_SCOPE_AGENT) : 0;
    int p = (c + 255) & ~255, incl = p;
#pragma unroll
    for (int o = 1; o < 64; o <<= 1) { const int n = __shfl_up(incl, o); if (lane >= o) incl += n; }
    return incl - p;
}

__device__ __forceinline__ void p8_scatter(Frame& F) {
    const float* tab = (const float*)(F.ws + WS_TAB); const unsigned* cnt = (const unsigned*)(F.ws + WS_CTL) + CW_CNT;
    const int* rt_e = (const int*)(F.ws + WS_RT + RT_E); const int* rt_pos = (const int*)(F.ws + WS_RT + RT_POS); int* rt_slot = (int*)(F.ws + WS_RT + RT_SLOT);
    unsigned char* XG = F.ws + WS_XG;
    const int gw = F.vcu * NWAVES + F.wave, NGW = F.G * NWAVES;
    const int pst = pad_starts(cnt, F.lane);
    const f32x4* gf = (const f32x4*)F.in[I_GFFN] + F.lane;
    for (int t = gw; t < TT; t += NGW) {
        const int b = t >> 13;
        const f32x4* xr = (const f32x4*)(F.out + (size_t)t * DM) + F.lane;
        const f32x4* sh = (const f32x4*)(tab + TB_MOD + b * 6144 + 3 * 1024) + F.lane; const f32x4* sc = (const f32x4*)(tab + TB_MOD + b * 6144 + 4 * 1024) + F.lane;
        f32x4 v[4]; float s = 0.f;
#pragma unroll
        for (int jj = 0; jj < 4; ++jj) { v[jj] = xr[64 * jj]; s += (v[jj].x * v[jj].x + v[jj].y * v[jj].y) + (v[jj].z * v[jj].z + v[jj].w * v[jj].w); }
        const float rstd = 1.0f / sqrtf(wave_sum(s) * (1.f / DM) + NORM_EPS);
        unsigned pk[4];
#pragma unroll
        for (int jj = 0; jj < 4; ++jj) { const f32x4 g = gf[64 * jj], a = sc[64 * jj], c = sh[64 * jj]; const f32x4 h = (v[jj] * rstd) * g * (a + 1.0f) + c;
            pk[jj] = pg8::pk4_fp8(h.x, h.y, h.z, h.w); }
        const int my_e = rt_e[t * 4 + (F.lane & 3)], my_pos = rt_pos[t * 4 + (F.lane & 3)];
#pragma unroll
        for (int k = 0; k < 4; ++k) { const int e = __shfl(my_e, k), pos = __shfl(my_pos, k); const int slot = __shfl(pst, e) + pos;
            unsigned* o4 = (unsigned*)(XG + (size_t)slot * DM) + F.lane;
#pragma unroll
            for (int jj = 0; jj < 4; ++jj) o4[64 * jj] = pk[jj];
            if (F.lane == 0) rt_slot[t * 4 + k] = slot; }
    }
}

__device__ __forceinline__ int moe_block_table(Frame& F, LAS int* bexp) {
    const unsigned* cnt = (const unsigned*)(F.ws + WS_CTL) + CW_CNT;
    const int pst = pad_starts(cnt, F.lane);
    const int total = __shfl(pst, 32) >> 8;
    if (F.wave == 0) {
        const int nxt = __shfl_down(pst, 1);
        if (F.lane < 32) for (int bl = pst >> 8; bl < (nxt >> 8); ++bl) bexp[bl] = F.lane;
    }
    __syncthreads();
    return __builtin_amdgcn_readfirstlane(total);
}

__device__ __forceinline__ void p11_combine(Frame& F) {
    const float* tab = (const float*)(F.ws + WS_TAB); const bf16* Y = (const bf16*)(F.ws + WS_Y);
    const float* rt_g = (const float*)(F.ws + WS_RT + RT_G); const int* rt_slot = (const int*)(F.ws + WS_RT + RT_SLOT);
    const int gw = F.vcu * NWAVES + F.wave, NGW = F.G * NWAVES;
    for (int t = gw; t < TT; t += NGW) {
        const int b = t >> 13;
        f32x4* xr = (f32x4*)(F.out + (size_t)t * DM) + F.lane;
        const f32x4* g2 = (const f32x4*)(tab + TB_MOD + b * 6144 + 5 * 1024) + F.lane;
        f32x4 acc[4];
#pragma unroll
        for (int jj = 0; jj < 4; ++jj) acc[jj] = (f32x4){0.f, 0.f, 0.f, 0.f};
        const int my_slot = rt_slot[t * 4 + (F.lane & 3)]; const float my_g = rt_g[t * 4 + (F.lane & 3)];
#pragma unroll
        for (int k = 0; k < 4; ++k) { const int slot = __shfl(my_slot, k); const float g = __shfl(my_g, k);
            const v2u* yr = (const v2u*)(Y + (size_t)slot * DM) + F.lane;
#pragma unroll
            for (int jj = 0; jj < 4; ++jj) { const v2u w = yr[64 * jj]; acc[jj] += (f32x4){bflo(w.x), bfhi(w.x), bflo(w.y), bfhi(w.y)} * g; } }
#pragma unroll
        for (int jj = 0; jj < 4; ++jj) xr[64 * jj] = xr[64 * jj] + g2[64 * jj] * acc[jj];
#ifdef MK_DBG_ATT
        if (t == 0 && F.lane == 0) { const float* dbg = tab + TB_RC + 128; F.out[0] += 8.0f + 120.0f * (dbg[0] / dbg[1]); }
#endif
    }
}

#define XB_TMO      128
#define XB_XCNT(j)  (256  + 64 * (j))
#define XB_XSUB(j)  (1280 + 64 * (j))
#define XB_XGEN(j)  (2304 + 64 * (j))
#define XB_TOP      3328
#define XB_TOPGEN   3392
#define XCD_BAR_WORDS 3456
#define XB_SPIN_CAP (1u << 18)

__device__ __forceinline__ unsigned xb_ld(unsigned* p)              { return __hip_atomic_load(p, __ATOMIC_RELAXED, __HIP_MEMORY_SCOPE_AGENT); }
__device__ __forceinline__ unsigned xb_add(unsigned* p, unsigned v) { return __hip_atomic_fetch_add(p, v, __ATOMIC_RELAXED, __HIP_MEMORY_SCOPE_AGENT); }
__device__ __forceinline__ unsigned xb_xcc_id() { return (unsigned)__builtin_amdgcn_s_getreg((3 << 11) | 20) & 0xFu; }
#define XB_SPIN(cond, bar) do { unsigned _sp = 0; while (cond) { __builtin_amdgcn_s_sleep(1); \
    if ((++_sp & 255u) == 0u) { if (xb_ld(&(bar)[XB_TMO])) break; if (_sp > XB_SPIN_CAP) { atomicAdd(&(bar)[XB_TMO], 1u); break; } } } } while (0)

struct XcdBarrier {
    unsigned* bar; unsigned x;
    volatile LAS unsigned* st;
};

__device__ __forceinline__ XcdBarrier xcd_barrier_post(unsigned* bar, volatile LAS unsigned* st) {
    XcdBarrier b; b.bar = bar; b.x = xb_xcc_id(); b.st = st;
    if (threadIdx.x == 0) (void)xb_add(&bar[XB_XCNT(b.x)], 1u);
    return b;
}
__device__ __forceinline__ void xcd_barrier_complete(unsigned* bar, unsigned x, unsigned& nloc, unsigned& nx) {
    const unsigned G = gridDim.x * gridDim.y * gridDim.z;
    unsigned sum, cnt, mine, sp = 0u;
    for (;;) {
        sum = 0u; cnt = 0u; mine = 0u;
#pragma unroll
        for (unsigned j = 0; j < 16; ++j) { const unsigned c = xb_ld(&bar[XB_XCNT(j)]); sum += c; cnt += (c > 0u) ? 1u : 0u; mine = (j == x) ? c : mine; }
        if (sum == G) break;
        __builtin_amdgcn_s_sleep(1);
        if ((++sp & 255u) == 0u) { if (xb_ld(&bar[XB_TMO])) break; if (sp > XB_SPIN_CAP) { atomicAdd(&bar[XB_TMO], 1u); break; } }
    }
    nloc = mine > 0u ? mine : 1u; nx = cnt > 0u ? cnt : 1u;
}

__device__ __forceinline__ void xcd_barrier(const XcdBarrier& b) {
    asm volatile("s_waitcnt vmcnt(0)" ::: "memory");
    __syncthreads();
    if (threadIdx.x == 0) {
        unsigned* bar = b.bar;
        __builtin_amdgcn_s_waitcnt(0);
        unsigned nloc = b.st[0], nx = b.st[1];
        if (nloc == 0u) { xcd_barrier_complete(bar, b.x, nloc, nx); b.st[0] = nloc; b.st[1] = nx; }
        const unsigned old = xb_add(&bar[XB_XSUB(b.x)], 1u);
        const unsigned gen = old / nloc;
        if (old + 1u == (gen + 1u) * nloc) {
            __builtin_amdgcn_fence(__ATOMIC_RELEASE, "agent");
            asm volatile("s_waitcnt vmcnt(0)" ::: "memory");
            const unsigned og = xb_add(&bar[XB_TOP], 1u);
            const unsigned tg = og / nx;
            if (og + 1u == (tg + 1u) * nx) xb_add(&bar[XB_TOPGEN], 1u);
            else XB_SPIN(xb_ld(&bar[XB_TOPGEN]) == tg, bar);
            __builtin_amdgcn_fence(__ATOMIC_ACQUIRE, "agent");
            xb_add(&bar[XB_XGEN(b.x)], 1u);
            asm volatile("s_waitcnt vmcnt(0)" ::: "memory");
        } else {
            XB_SPIN(xb_ld(&bar[XB_XGEN(b.x)]) == gen, bar);
            __builtin_amdgcn_fence(__ATOMIC_ACQUIRE, "agent");
            asm volatile("s_waitcnt vmcnt(0)" ::: "memory");
        }
    }
    __syncthreads();
}

struct Args { const float* in[N_IN]; float* out; unsigned char* ws; int ph_lo, ph_hi, li, pad; };
__global__ void __launch_bounds__(NWAVES * 64, 2) mk_fwd(Args args) {
    extern __shared__ __attribute__((aligned(16))) unsigned char lds[];
    Frame F;
    F.lds = (LAS unsigned char*)lds;
    F.tid = threadIdx.x; F.lane = F.tid & 63; F.wave = __builtin_amdgcn_readfirstlane(F.tid >> 6);
    F.G = gridDim.x; { const int bx = blockIdx.x; F.vcu = (F.G % 8 == 0) ? (bx % 8) * (F.G / 8) + bx / 8 : bx; }
#pragma unroll
    for (int i = 0; i < N_IN; ++i) F.in[i] = args.in[i];
    F.out = args.out; F.ws = args.ws;
    const int lo = args.ph_lo, hi = args.ph_hi;
    volatile LAS unsigned* bst = (volatile LAS unsigned*)(F.lds + MISC_OFF + 4096);
    if (F.tid < 2) bst[F.tid] = 0u;
    __syncthreads();
    XcdBarrier bar; bar.bar = (unsigned*)(F.ws + WS_CTL) + CW_BAR + args.li * XCD_BAR_WORDS; bar.x = 0; bar.st = nullptr;
    if (hi - lo > 1) bar = xcd_barrier_post((unsigned*)(F.ws + WS_CTL) + CW_BAR + args.li * XCD_BAR_WORDS, bst);
#ifndef MK_PHASE_MASK
#define MK_PHASE_MASK 0xFFF
#endif
#define IN(k) (((MK_PHASE_MASK >> (k)) & 1) && lo <= (k) && (k) < hi)
    if (args.pad != 0) cg::this_grid().sync();
#define SEAM(k) do { if (IN(k) && IN((k) + 1)) { xcd_barrier(bar); } } while (0)
    if (IN(0)) { p0_prologue(F); } SEAM(0);
    if (IN(1)) { p1_norm(F); } SEAM(1);
    if (IN(2)) {
        pg8::Gemm g{(const bf16*)(F.ws + WS_XN), (const bf16*)(F.ws + WS_WQKV), MQ, NQKV, DM, 0};
        pg8::StaticOrder S; S.init(MQ, NQKV, F.G, (int)blockIdx.x);
        typedef pg8::EpiQKV<TB_NW, TB_RCOS, TB_RSIN, TB_CCOS, TB_CSIN> EpiQ;
        EpiQ E{(bf16*)(F.ws + WS_P), (const float*)(F.ws + WS_TAB), (LAS float*)(F.lds + MISC_OFF + 5120), att::C2};
        pg8::gemm_phase<EpiQ, pg8::StaticOrder, true, true, 1>(F.lds, g, S, E);
    } SEAM(2);
#ifdef MK_SEPARATE_QKNORM
    if (IN(3)) { p3_qknorm(F); } SEAM(3);
#endif
    if (IN(4)) { p4_attention(F, (char*)lds); } SEAM(4);
    if (IN(5)) { p5_mix(F); } SEAM(5);
    if (IN(6)) {
        pg8::Gemm g{(const bf16*)(F.ws + WS_MIX), (const bf16*)(F.ws + WS_WO), TT, DM, DM, 0};
        pg8::StaticOrder S; S.init(TT, DM, F.G, (int)blockIdx.x);
        pg8::EpiOut E{F.in[I_X], F.out, (const float*)(F.ws + WS_TAB) + TB_MOD};
        pg8::gemm_phase<pg8::EpiOut, pg8::StaticOrder, true, true>(F.lds, g, S, E);
    } SEAM(6);
    if (IN(7)) { p7_router(F); } SEAM(7);
    if (IN(8)) { p8_scatter(F); } SEAM(8);
    if (IN(9)) {
        LAS int* bexp = (LAS int*)(F.lds + MISC_OFF + 1024);
        const int nblk = moe_block_table(F, bexp);
        pg8::Gemm g{(const bf16*)(F.ws + WS_XG), (const bf16*)(F.ws + WS_WGU), MPAD, 2048, DM, (size_t)2048 * 1024};
        pg8::MoeOrder S; S.init(nblk, 8, F.G, (int)blockIdx.x, bexp);
        pg8::EpiSwiGLU E{F.ws + WS_ACT, F.in[I_BGU]};
        pg8::gemm_phase<pg8::EpiSwiGLU, pg8::MoeOrder, true, true, 1>(F.lds, g, S, E);
    } SEAM(9);
    if (IN(10)) {
        LAS int* bexp = (LAS int*)(F.lds + MISC_OFF + 1024);
        const int nblk = moe_block_table(F, bexp);
        pg8::Gemm g{(const bf16*)(F.ws + WS_ACT), (const bf16*)(F.ws + WS_WDN), MPAD, 1024, DM, (size_t)1024 * 1024};
        pg8::MoeOrder S; S.init(nblk, 4, F.G, (int)blockIdx.x, bexp);
        pg8::EpiDown E{(bf16*)(F.ws + WS_Y), F.in[I_BD]};
        pg8::gemm_phase<pg8::EpiDown, pg8::MoeOrder, true, true, 1>(F.lds, g, S, E);
    } SEAM(10);
    if (IN(11)) { p11_combine(F); }
#undef IN
#undef SEAM
}

extern "C" void kernel_launch(void* const* d_in, const int* in_sizes, int n_in, void* d_out, int out_size, void* d_ws, size_t ws_size, hipStream_t stream) {
    static int grid = 0;
    if (grid == 0) {
        if (n_in != N_IN || in_sizes[0] != TT * DM || out_size != TT * DM || ws_size < WS_END) { fprintf(stderr, "kernel_launch: unexpected shapes (n_in %d, in0 %d, out %d, ws %zu)\n", n_in, n_in > 0 ? in_sizes[0] : -1, out_size, ws_size); grid = -1; return; }
        int dev = 0, cus = 0, per_cu = 0;
        if (hipGetDevice(&dev) != hipSuccess || hipDeviceGetAttribute(&cus, hipDeviceAttributeMultiprocessorCount, dev) != hipSuccess) { grid = -1; return; }
        if (hipFuncSetAttribute((const void*)mk_fwd, hipFuncAttributeMaxDynamicSharedMemorySize, LDS_BYTES) != hipSuccess) { fprintf(stderr, "kernel_launch: hipFuncSetAttribute failed\n"); grid = -1; return; }
        if (hipOccupancyMaxActiveBlocksPerMultiprocessor(&per_cu, (const void*)mk_fwd, NWAVES * 64, LDS_BYTES) != hipSuccess || per_cu < 1) { fprintf(stderr, "kernel_launch: occupancy query reports %d\n", per_cu); (void)hipGetLastError(); per_cu = 1; }
        grid = cus;
    }
    if (grid < 0) return;
    (void)hipMemsetAsync((char*)d_ws + WS_CTL, 0, CTL_ZERO_BYTES, stream);
    Args a{};
    for (int i = 0; i < N_IN; ++i) a.in[i] = (const float*)d_in[i];
    a.out = (float*)d_out; a.ws = (unsigned char*)d_ws;
    int lo_[3] = {0, 0, 0}, hi_[3] = {N_PHASES, 0, 0}, nl = 1;
    if (MK_PROBE_PHASE >= 0) { nl = 0; lo_[nl] = 0; hi_[nl] = MK_PROBE_PHASE + 1; ++nl; lo_[nl] = MK_PROBE_PHASE; hi_[nl] = MK_PROBE_PHASE + 1; ++nl; if (MK_PROBE_PHASE + 1 < N_PHASES) { lo_[nl] = MK_PROBE_PHASE + 1; hi_[nl] = N_PHASES; ++nl; } }
    for (int li = 0; li < nl; ++li) {
        a.ph_lo = lo_[li]; a.ph_hi = hi_[li]; a.li = li;
        void* params[] = {&a};
        const hipError_t e = hipLaunchCooperativeKernel((const void*)mk_fwd, dim3(grid), dim3(NWAVES * 64), params, LDS_BYTES, stream);
        if (e != hipSuccess) fprintf(stderr, "kernel_launch: cooperative launch failed: %s (grid %d)\n", hipGetErrorString(e), grid);
    }
}
```

```cpp
#include <hip/hip_runtime.h>
#include <hip/hip_cooperative_groups.h>
#include <cstdio>
#include <cstdint>
namespace cg = cooperative_groups;
namespace pg8 {
#define PG8_LAS __attribute__((address_space(3)))
typedef unsigned short bf16_t;
typedef short bf16x8 __attribute__((ext_vector_type(8)));
typedef float f32x4 __attribute__((ext_vector_type(4)));
typedef unsigned u32x4 __attribute__((ext_vector_type(4)));
constexpr int BM = 256, BK = 64, HALF = 128, HTB = HALF * BK * 2  , STAGE_BYTES = 8 * HTB, NXCD = 8, WGM = 8;

__host__ __device__ __forceinline__ int lds_byte(int r, int c) { const int st = (r >> 4) * 2 + (c >> 5), rr = r & 15, cc = c & 31, ob = rr * 64 + cc * 2; return st * 1024 + (ob ^ (((ob >> 9) & 1) << 5)); }
__host__ __device__ __forceinline__ void stage_rc(int b, int& R, int& C) { const int st = b / 1024, sb = b % 1024, swz = sb ^ (((sb >> 9) & 1) << 5); R = (st >> 1) * 16 + swz / 64; C = (st & 1) * 32 + (swz % 64) / 2; }
__host__ __device__ __forceinline__ int perm32(int rho) { const int n = rho >> 4, i = rho & 15; return 8 * (i >> 2) + 4 * n + (i & 3); }

__device__ __forceinline__ void dma16(const void* gptr, PG8_LAS void* ldst) {
    asm volatile("s_mov_b32 m0, %1\n\ts_nop 0\n\tglobal_load_lds_dwordx4 %0, off" :: "v"(gptr), "s"((unsigned)(size_t)ldst) : "memory"); }
struct Unit { int pm, pn, e; };
struct Gemm { const bf16_t* A; const bf16_t* Bt; int M, N, K; size_t estride; const unsigned* atab = nullptr; PG8_LAS unsigned* tkl = nullptr; };

struct StaticOrder {
    int nM, nN, nwg, G, c;
    __host__ __device__ void init(int M, int N, int G_, int c_) { nM = M / BM; nN = N / BM; nwg = nM * nN; G = G_; c = c_; }
    __host__ __device__ bool next(int i, Unit& u) const {
        const long L = (long)i * G + c; if (L >= nwg) return false;
        int wgid = (int)L; { const int q = nwg / NXCD, r = nwg % NXCD, xcd = wgid % NXCD, off = wgid / NXCD; wgid = (xcd < r ? xcd * (q + 1) : r * (q + 1) + (xcd - r) * q) + off; }
        const int nig = WGM * nN, gid = wgid / nig, fm = gid * WGM, gsz = (nM - fm) < WGM ? (nM - fm) : WGM;
        u.pm = fm + ((wgid % nig) % gsz); u.pn = (wgid % nig) / gsz; u.e = 0; return true;
    }
    __device__ __forceinline__ void a_ready(const Unit&) const {}
    __device__ __forceinline__ void done(const Unit&) const {}
};

__device__ __forceinline__ unsigned cvt_pk_bf16(float lo, float hi) { unsigned r; asm volatile("v_cvt_pk_bf16_f32 %0, %1, %2" : "=v"(r) : "v"(lo), "v"(hi)); return r; }
typedef float f32x2 __attribute__((ext_vector_type(2)));
__device__ __forceinline__ f32x2 gelu_pk(f32x2 v) {
    const f32x2 av = __builtin_elementwise_abs(v), d = av * 0.2316418882f + 1.0f;
    f32x2 t; t.x = __builtin_amdgcn_rcpf(d.x); t.y = __builtin_amdgcn_rcpf(d.y);
    f32x2 q = t * 0.5307027145f + (-0.7265760135f); q = q * t + 0.7107068705f; q = q * t + (-0.142248368f); q = q * t + 0.127414796f; q = q * t;
    const f32x2 s = (v * v) * (-0.72134752044f);
    f32x2 e; e.x = __builtin_amdgcn_exp2f(s.x); e.y = __builtin_amdgcn_exp2f(s.y);
    const f32x2 m = v * (q * e), r = v - m;
    f32x2 o; o.x = v.x < 0.f ? m.x : r.x; o.y = v.y < 0.f ? m.y : r.y; return o;
}

template <int ACT  > struct EpiBf16 {
    static constexpr bool PERM = true, AFTER_DRAIN = false; static_assert(ACT == 0 || ACT == 1, "EpiBf16: ACT is 0 (none) or 1 (gelu_pk)");
    __device__ __forceinline__ void prefetch(const Unit&, int, int, int) const {}
    bf16_t* O; int ldc; const float* bias; int split_cols; size_t split_stride; float scale0;
    __device__ __forceinline__ void operator()(const f32x4 (&acc)[2][2][4][2], const Unit& u, int wr, int wc, int fr, int fq, int = 0) const {
        const int row0 = u.pm * BM + wr * 64 + fr; int colt = u.pn * BM; bf16_t* base = O;
        float sc = 1.f; if (split_cols) { const int t = colt / split_cols; base += (size_t)t * split_stride; colt -= t * split_cols; if (t == 0) sc = scale0; }
        const int col0 = colt + wc * 32 + 8 * fq, bcol0 = u.pn * BM + wc * 32 + 8 * fq;
        f32x4 bv[2][2];
#pragma unroll
        for (int bj = 0; bj < 2; ++bj)
#pragma unroll
            for (int n = 0; n < 2; ++n) bv[bj][n] = bias ? *(const f32x4*)(bias + bcol0 + bj * HALF + 4 * n) : (f32x4){0.f, 0.f, 0.f, 0.f};
#pragma unroll
        for (int ai = 0; ai < 2; ++ai)
#pragma unroll
            for (int m = 0; m < 4; ++m) { bf16_t* rowp = base + (size_t)(row0 + ai * HALF + m * 16) * ldc + col0;
#pragma unroll
                for (int bj = 0; bj < 2; ++bj) { f32x4 v0 = acc[ai][bj][m][0] + bv[bj][0], v1 = acc[ai][bj][m][1] + bv[bj][1];
                    if (ACT == 1) { f32x2 a = gelu_pk((f32x2){v0[0], v0[1]}), b = gelu_pk((f32x2){v0[2], v0[3]}), c = gelu_pk((f32x2){v1[0], v1[1]}), d = gelu_pk((f32x2){v1[2], v1[3]});
                        v0 = (f32x4){a.x, a.y, b.x, b.y}; v1 = (f32x4){c.x, c.y, d.x, d.y}; }
                    v0 = v0 * sc; v1 = v1 * sc; u32x4 w; w.x = cvt_pk_bf16(v0[0], v0[1]); w.y = cvt_pk_bf16(v0[2], v0[3]); w.z = cvt_pk_bf16(v1[0], v1[1]); w.w = cvt_pk_bf16(v1[2], v1[3]);
                    *(u32x4*)(rowp + bj * HALF) = w; } }
    }
};

typedef int i32x4 __attribute__((ext_vector_type(4)));
typedef int i32x8 __attribute__((ext_vector_type(8)));
__device__ __forceinline__ i32x8 cat8(bf16x8 lo, bf16x8 hi) { const i32x4 a = __builtin_bit_cast(i32x4, lo), b = __builtin_bit_cast(i32x4, hi); return __builtin_shufflevector(a, b, 0, 1, 2, 3, 4, 5, 6, 7); }
template <class Epi, class Sched, bool ALIGN_EPI = false, bool SP2 = false, int ESZ = 2, bool AGATHER = false>
__device__ __forceinline__ void gemm_phase(PG8_LAS unsigned char* lds, const Gemm g, const Sched& S, const Epi& E) {
    const int tid = threadIdx.x, wid = __builtin_amdgcn_readfirstlane(tid >> 6), lane = tid & 63, wr = wid >> 2, wc = wid & 3, fr = lane & 15, fq = lane >> 4;
    const int K = g.K, nt = K * ESZ / (BK * 2);
    unsigned voffA[2], voffB[2];
#pragma unroll
    for (int i = 0; i < 2; ++i) { int R, C; stage_rc(tid * 16 + i * 8192, R, C); const int Rb = Epi::PERM ? ((R & ~31) + perm32(R & 31)) : R;
        voffA[i] = (unsigned)(R * K * ESZ + C * 2); voffB[i] = (unsigned)(Rb * K * ESZ + C * 2); }
    static_assert(!AGATHER || SP2, "AGATHER is written for the SP2 schedule");
    int gR0 = 0, gC2 = 0; { int R, C; stage_rc(tid * 16, R, C); gR0 = R; gC2 = C * 2; }
    unsigned offA[2][2] = {{0u, 0u}, {0u, 0u}};
#define PG8_TKLOAD(par, h) do { int r0_ = gR0; asm volatile("" : "+v"(r0_));   \
        const PG8_LAS unsigned* tp_ = g.tkl + (par) * 256 + (h) * 128 + r0_; offA[h][0] = tp_[0] + (unsigned)gC2; offA[h][1] = tp_[64] + (unsigned)gC2; } while (0)
    const size_t kstep = (size_t)(BK * 2);
    const size_t hstep = (size_t)HALF * K * ESZ;
    const size_t tstep = 2 * hstep;
    const unsigned ldsw = (unsigned)wid * 1024u;
    const unsigned ldsb = (unsigned)__builtin_amdgcn_readfirstlane((int)((unsigned)(size_t)lds + ldsw));
    const int aoff = lds_byte(wr * 64 + fr, fq * 8), boff = lds_byte(wc * 32 + fr, fq * 8);
#define PG8_SA(b, h) (((b) * 2 + (h)) * HTB)
#define PG8_SB(b, h) ((4 + (b) * 2 + (h)) * HTB)
#define PG8_STAGE(bufoff, gbase, voff) do { _Pragma("unroll") for (int _i = 0; _i < 2; ++_i) \
        asm volatile("s_mov_b32 m0, %2\n\ts_nop 0\n\tglobal_load_lds_dwordx4 %0, %1" :: "v"((voff)[_i]), "s"((const char*)(gbase)), "s"((unsigned)ldsb + (unsigned)((bufoff) + _i * 8192)) : "memory"); } while (0)
#define PG8_STAGEA(bufoff, gbase, H) do { if constexpr (AGATHER) PG8_STAGE(bufoff, gbase, offA[H]); else PG8_STAGE(bufoff, (gbase) + (H) * hstep, voffA); } while (0)
#define PG8_LDA(dst, b, h) do { _Pragma("unroll") for (int m = 0; m < 4; ++m) _Pragma("unroll") for (int k = 0; k < 2; ++k) dst[m][k] = *(const PG8_LAS bf16x8*)(lds + PG8_SA(b, h) + aoff + m * 2048 + k * 1024); } while (0)
#define PG8_LDB(dst, b, h) do { _Pragma("unroll") for (int n = 0; n < 2; ++n) _Pragma("unroll") for (int k = 0; k < 2; ++k) dst[n][k] = *(const PG8_LAS bf16x8*)(lds + PG8_SB(b, h) + boff + n * 2048 + k * 1024); } while (0)
#define PG8_MMA(ai, bj, At, Bt) do { __builtin_amdgcn_s_setprio(1); _Pragma("unroll") for (int m = 0; m < 4; ++m) _Pragma("unroll") for (int n = 0; n < 2; ++n) { \
        if constexpr (ESZ == 2) { _Pragma("unroll") for (int k = 0; k < 2; ++k) acc[ai][bj][m][n] = __builtin_amdgcn_mfma_f32_16x16x32_bf16(Bt[n][k], At[m][k], acc[ai][bj][m][n], 0, 0, 0); } \
        else { acc[ai][bj][m][n] = __builtin_amdgcn_mfma_scale_f32_16x16x128_f8f6f4(cat8(Bt[n][0], Bt[n][1]), cat8(At[m][0], At[m][1]), acc[ai][bj][m][n], 0, 0, 0, 0x7f7f7f7f, 0, 0x7f7f7f7f); } } \
        if constexpr (ESZ == 1) {   \
            _Pragma("unroll") for (int m = 0; m < 4; ++m) asm volatile("" : "+v"(acc[ai][bj][m][0]), "+v"(acc[ai][bj][m][1])); } \
        __builtin_amdgcn_s_setprio(0); } while (0)
#define PG8_WAIT_V(n) asm volatile("s_waitcnt vmcnt(" #n ")" ::: "memory")
#define PG8_WAIT_L(n) asm volatile("s_waitcnt lgkmcnt(" #n ")" ::: "memory")
#define PG8_BAR __builtin_amdgcn_s_barrier()
#define PG8_SCHED __builtin_amdgcn_sched_barrier(0)
    Unit cur, nxt; int ui = 0;
    if (!S.next(0, cur)) return;
    f32x4 acc[2][2][4][2];
#pragma unroll
    for (int a = 0; a < 2; ++a)
#pragma unroll
        for (int b = 0; b < 2; ++b)
#pragma unroll
            for (int m = 0; m < 4; ++m)
#pragma unroll
                for (int n = 0; n < 2; ++n) acc[a][b][m][n] = (f32x4){0.f, 0.f, 0.f, 0.f};
    bf16x8 At[4][2], B0[2][2], B1[2][2];
    const char* cA = (const char*)g.A + (AGATHER ? (size_t)0 : (size_t)cur.pm * tstep); const char* cB = (const char*)g.Bt + (size_t)cur.e * g.estride + (size_t)cur.pn * tstep;
    S.a_ready(cur);
    E.prefetch(cur, ui, wid, lane);
    if constexpr (AGATHER) {
        if (wid == 1) dma16(g.atab + (size_t)cur.pm * 256 + lane * 4, g.tkl);
        asm volatile("s_waitcnt vmcnt(0)" ::: "memory"); __builtin_amdgcn_s_barrier(); asm volatile("" ::: "memory");
        PG8_TKLOAD(0, 0); PG8_TKLOAD(0, 1);
    }
    if constexpr (SP2) {
        PG8_STAGE(PG8_SB(0, 0), cB, voffB); PG8_STAGE(PG8_SB(0, 1), cB + hstep, voffB); PG8_STAGEA(PG8_SA(0, 0), cA, 0); PG8_STAGEA(PG8_SA(0, 1), cA, 1);
        if (wr == 1) PG8_BAR;
        PG8_WAIT_V(2); PG8_BAR;
        PG8_STAGE(PG8_SB(1, 0), cB + kstep, voffB); PG8_STAGEA(PG8_SA(1, 0), cA + kstep, 0); PG8_STAGE(PG8_SB(1, 1), cB + hstep + kstep, voffB);
        PG8_WAIT_V(6); PG8_BAR;
    } else {
        PG8_STAGE(PG8_SB(0, 0), cB, voffB); PG8_STAGEA(PG8_SA(0, 0), cA, 0); PG8_STAGE(PG8_SB(0, 1), cB + hstep, voffB); PG8_STAGEA(PG8_SA(0, 1), cA, 1);
        if (wr == 1) PG8_BAR;
        PG8_WAIT_V(4); PG8_BAR;
        PG8_STAGE(PG8_SB(1, 0), cB + kstep, voffB); PG8_STAGEA(PG8_SA(1, 0), cA + kstep, 0); PG8_STAGE(PG8_SB(1, 1), cB + hstep + kstep, voffB);
        PG8_WAIT_V(6); PG8_BAR;
    }
    for (;;) {
        const bool has_next = S.next(ui + 1, nxt);
        if constexpr (AGATHER) { if (has_next && wid == 1) { int l_ = lane; asm volatile("" : "+v"(l_)); dma16(g.atab + (size_t)nxt.pm * 256 + l_ * 4, g.tkl + ((ui + 1) & 1) * 256); } }
        const char* nA = (has_next && !AGATHER) ? (const char*)g.A + (size_t)nxt.pm * tstep : cA; const char* nB = has_next ? (const char*)g.Bt + (size_t)nxt.e * g.estride + (size_t)nxt.pn * tstep : cB;
        for (int t = 0; t < nt; t += 2) {
            const bool last = (t == nt - 2);
            const char* a1 = cA + (size_t)(t + 1) * kstep;
            const char* a2 = last ? nA : cA + (size_t)(t + 2) * kstep; const char* b2 = last ? nB : cB + (size_t)(t + 2) * kstep;
            const char* a3 = a2 + kstep; const char* b3 = b2 + kstep;
            if (last && has_next) S.a_ready(nxt);
            if constexpr (AGATHER) { if (last && has_next) PG8_TKLOAD((ui + 1) & 1, 0); }
            if constexpr (SP2) {
            PG8_LDB(B0, 0, 0); PG8_LDB(B1, 0, 1); PG8_SCHED; PG8_LDA(At, 0, 0); PG8_STAGEA(PG8_SA(1, 1), a1, 1);
            if constexpr (AGATHER) { if (last && has_next) PG8_TKLOAD((ui + 1) & 1, 1); }
            PG8_WAIT_V(8); PG8_WAIT_L(0); PG8_BAR; PG8_MMA(0, 0, At, B0); PG8_MMA(0, 1, At, B1); PG8_BAR; PG8_SCHED;
            PG8_LDA(At, 0, 1); PG8_STAGE(PG8_SB(0, 0), b2, voffB); PG8_STAGE(PG8_SB(0, 1), b2 + hstep, voffB); PG8_STAGEA(PG8_SA(0, 0), a2, 0);
            PG8_WAIT_V(8); PG8_WAIT_L(0); PG8_BAR; PG8_MMA(1, 0, At, B0); PG8_MMA(1, 1, At, B1); PG8_BAR; PG8_SCHED;
            PG8_LDB(B0, 1, 0); PG8_LDB(B1, 1, 1); PG8_SCHED; PG8_LDA(At, 1, 0); PG8_STAGEA(PG8_SA(0, 1), a2, 1);
            PG8_WAIT_V(8); PG8_WAIT_L(0); PG8_BAR; PG8_MMA(0, 0, At, B0); PG8_MMA(0, 1, At, B1); PG8_BAR; PG8_SCHED;
            PG8_LDA(At, 1, 1); PG8_STAGE(PG8_SB(1, 0), b3, voffB); PG8_STAGE(PG8_SB(1, 1), b3 + hstep, voffB); PG8_STAGEA(PG8_SA(1, 0), a3, 0);
            PG8_WAIT_V(8); PG8_WAIT_L(0); PG8_BAR; PG8_MMA(1, 0, At, B0); PG8_MMA(1, 1, At, B1); PG8_BAR; PG8_SCHED;
            } else {
            PG8_LDB(B0, 0, 0); PG8_SCHED; PG8_LDA(At, 0, 0); PG8_STAGEA(PG8_SA(1, 1), a1, 1);
            PG8_WAIT_L(8); PG8_BAR; PG8_WAIT_L(0); PG8_MMA(0, 0, At, B0); PG8_BAR; PG8_SCHED;
            PG8_LDB(B1, 0, 1); PG8_STAGE(PG8_SB(0, 0), b2, voffB);
            PG8_BAR; PG8_WAIT_L(0); PG8_MMA(0, 1, At, B1); PG8_BAR;
            PG8_LDA(At, 0, 1); PG8_STAGEA(PG8_SA(0, 0), a2, 0);
            PG8_BAR; PG8_WAIT_L(0); PG8_MMA(1, 0, At, B0); PG8_BAR; PG8_SCHED;
            PG8_STAGE(PG8_SB(0, 1), b2 + hstep, voffB);
            PG8_WAIT_V(6); PG8_BAR; PG8_MMA(1, 1, At, B1); PG8_BAR;
            PG8_LDB(B0, 1, 0); PG8_SCHED; PG8_LDA(At, 1, 0); PG8_STAGEA(PG8_SA(0, 1), a2, 1);
            PG8_WAIT_L(8); PG8_BAR; PG8_WAIT_L(0); PG8_MMA(0, 0, At, B0); PG8_BAR; PG8_SCHED;
            PG8_LDB(B1, 1, 1); PG8_STAGE(PG8_SB(1, 0), b3, voffB);
            PG8_BAR; PG8_WAIT_L(0); PG8_MMA(0, 1, At, B1); PG8_BAR;
            PG8_LDA(At, 1, 1); PG8_STAGEA(PG8_SA(1, 0), a3, 0);
            PG8_BAR; PG8_WAIT_L(0); PG8_MMA(1, 0, At, B0); PG8_BAR; PG8_SCHED;
            PG8_STAGE(PG8_SB(1, 1), b3 + hstep, voffB);
            PG8_WAIT_V(6); PG8_BAR; PG8_MMA(1, 1, At, B1); PG8_BAR;
            }
        }
        if constexpr (ALIGN_EPI) { if (wr == 0) PG8_BAR; }
        if constexpr (!Epi::AFTER_DRAIN) { E(acc, cur, wr, wc, fr, fq, ui); S.done(cur); }
        if (!has_next) break;
#pragma unroll
        for (int a = 0; a < 2; ++a)
#pragma unroll
            for (int b = 0; b < 2; ++b)
#pragma unroll
                for (int m = 0; m < 4; ++m)
#pragma unroll
                    for (int n = 0; n < 2; ++n) acc[a][b][m][n] = (f32x4){0.f, 0.f, 0.f, 0.f};
        cur = nxt; cA = nA; cB = nB; ++ui;
        E.prefetch(cur, ui, wid, lane);
        if constexpr (ALIGN_EPI) { if (wr == 1) PG8_BAR; }
    }
    PG8_WAIT_V(0);
    if constexpr (!ALIGN_EPI) { if (wr == 0) PG8_BAR; }
    PG8_BAR;
    if constexpr (Epi::AFTER_DRAIN) { E.fused(acc, cur, wr, wc, fr, fq, lds, wid, lane); S.done(cur); }
#undef PG8_STAGEA
#undef PG8_TKLOAD
#undef PG8_SA
#undef PG8_SB
#undef PG8_STAGE
#undef PG8_LDA
#undef PG8_LDB
#undef PG8_MMA
#undef PG8_WAIT_V
#undef PG8_WAIT_L
#undef PG8_BAR
#undef PG8_SCHED
}
}

namespace pg8 {
struct MoeOrder {
    int nM, nN, nwg, G, c; const PG8_LAS int* bexp;
    __device__ __forceinline__ void init(int nM_, int nN_, int G_, int c_, const PG8_LAS int* bexp_) { nM = nM_; nN = nN_; nwg = nM_ * nN_; G = G_; c = c_; bexp = bexp_; }
    __device__ __forceinline__ bool next(int i, Unit& u) const {
        const long L = (long)i * G + c; if (L >= nwg) return false;
        int wgid = (int)L; { const int q = nwg / NXCD, r = nwg % NXCD, xcd = wgid % NXCD, off = wgid / NXCD; wgid = (xcd < r ? xcd * (q + 1) : r * (q + 1) + (xcd - r) * q) + off; }
        const int nig = WGM * nN, gid = wgid / nig, fm = gid * WGM, gsz = (nM - fm) < WGM ? (nM - fm) : WGM;
        u.pm = fm + ((wgid % nig) % gsz); u.pn = (wgid % nig) / gsz; u.e = __builtin_amdgcn_readfirstlane(bexp[u.pm]); return true;
    }
    __device__ __forceinline__ void a_ready(const Unit&) const {}
    __device__ __forceinline__ void done(const Unit&) const {}
};
struct EpiOut {
    static constexpr bool PERM = true, AFTER_DRAIN = false;
    const float* x; bf16_t* x1; const float* mod;
    __device__ __forceinline__ void prefetch(const Unit&, int, int, int) const {}
    __device__ __forceinline__ void operator()(const f32x4 (&acc)[2][2][4][2], const Unit& u, int wr, int wc, int fr, int fq, int = 0) const {
        const int row0 = u.pm * BM + wr * 64 + fr, col0 = u.pn * BM + wc * 32 + 8 * fq;
        const float* g = mod + (size_t)(u.pm >> 5) * 6144 + 2 * 1024;
        f32x4 gv[2][2];
#pragma unroll
        for (int bj = 0; bj < 2; ++bj)
#pragma unroll
            for (int n = 0; n < 2; ++n) gv[bj][n] = *(const f32x4*)(g + col0 + bj * HALF + 4 * n) * (1.0f / 32.0f);
#pragma unroll
        for (int ai = 0; ai < 2; ++ai) { f32x4 xa[4][2], xb[4][2];
#pragma unroll
            for (int m = 0; m < 4; ++m) { const size_t off = (size_t)(row0 + ai * HALF + m * 16) * 1024 + col0;
#pragma unroll
                for (int bj = 0; bj < 2; ++bj) { xa[m][bj] = *(const f32x4*)(x + off + bj * HALF); xb[m][bj] = *(const f32x4*)(x + off + bj * HALF + 4); } }
#pragma unroll
            for (int m = 0; m < 4; ++m) { const size_t off = (size_t)(row0 + ai * HALF + m * 16) * 1024 + col0;
#pragma unroll
                for (int bj = 0; bj < 2; ++bj) {
                    const f32x4 v0 = xa[m][bj] + gv[bj][0] * acc[ai][bj][m][0], v1 = xb[m][bj] + gv[bj][1] * acc[ai][bj][m][1];
                    u32x4 w; w.x = cvt_pk_bf16(v0[0], v0[1]); w.y = cvt_pk_bf16(v0[2], v0[3]); w.z = cvt_pk_bf16(v1[0], v1[1]); w.w = cvt_pk_bf16(v1[2], v1[3]);
                    *(u32x4*)(x1 + off + bj * HALF) = w; } } }
    }
};
__device__ __forceinline__ float swiglu1(float g, float l) {
    const float glu = fminf(g, 7.0f), lin = fminf(fmaxf(l, -7.0f), 7.0f);
    const float sg = __builtin_amdgcn_rcpf(1.0f + __builtin_amdgcn_exp2f(glu * (-1.702f * 1.4426950408889634f)));
    return glu * sg * (lin + 1.0f);
}
typedef float f32x2s __attribute__((ext_vector_type(2)));
__device__ __forceinline__ f32x2s swiglu2(f32x2s g, f32x2s l) {
    f32x2s glu, lin; glu.x = fminf(g.x, 7.0f); glu.y = fminf(g.y, 7.0f); lin.x = __builtin_amdgcn_fmed3f(l.x, -7.0f, 7.0f); lin.y = __builtin_amdgcn_fmed3f(l.y, -7.0f, 7.0f);
    const f32x2s a = glu * (-1.702f * 1.4426950408889634f);
    f32x2s ex; ex.x = __builtin_amdgcn_exp2f(a.x); ex.y = __builtin_amdgcn_exp2f(a.y);
    const f32x2s d = ex + 1.0f;
    f32x2s sg; sg.x = __builtin_amdgcn_rcpf(d.x); sg.y = __builtin_amdgcn_rcpf(d.y);
    const f32x2s t = glu * sg;
    return t * lin + t;
}
__device__ __forceinline__ float sat8(float v) { return __builtin_amdgcn_fmed3f(v, -448.0f, 448.0f); }
__device__ __forceinline__ unsigned pk4_fp8(float a, float b, float c, float d) { int w = 0; w = __builtin_amdgcn_cvt_pk_fp8_f32(a, b, w, false); w = __builtin_amdgcn_cvt_pk_fp8_f32(c, d, w, true); return (unsigned)w; }
constexpr float W8_SCALE = 32.0f, W8_INV = 1.0f / 32.0f;
struct EpiSwiGLU {
    static constexpr bool PERM = true, AFTER_DRAIN = false;
    unsigned char* act; const float* bgu;
    PG8_LAS float* bls;
    __device__ __forceinline__ void prefetch(const Unit& u, int ui, int wid, int lane) const {
        if (wid == 0) { asm volatile("" : "+v"(lane)); const float* src = bgu + (size_t)u.e * 2048 + (lane < 32 ? 0 : 1024 - 128) + u.pn * 128 + lane * 4;
            dma16(src, bls + (ui & 1) * 256); }
    }
    __device__ __forceinline__ void operator()(const f32x4 (&acc)[2][2][4][2], const Unit& u, int wr, int wc, int fr, int fq, int ui) const {
        const int row0 = u.pm * BM + wr * 64 + fr, cg = u.pn * 128 + wc * 32 + 8 * fq;
        const PG8_LAS float* bb = bls + (ui & 1) * 256 + wc * 32 + 8 * fq;
        f32x4 bg[2], bl[2];
#pragma unroll
        for (int n = 0; n < 2; ++n) { bg[n] = *(const PG8_LAS f32x4*)(bb + 4 * n); bl[n] = *(const PG8_LAS f32x4*)(bb + 128 + 4 * n); }
#pragma unroll
        for (int ai = 0; ai < 2; ++ai)
#pragma unroll
            for (int m = 0; m < 4; ++m) { unsigned char* rowp = act + (size_t)(row0 + ai * HALF + m * 16) * 1024 + cg;
                const f32x4 g0 = acc[ai][0][m][0] * W8_INV + bg[0], g1 = acc[ai][0][m][1] * W8_INV + bg[1], l0 = acc[ai][1][m][0] * W8_INV + bl[0], l1 = acc[ai][1][m][1] * W8_INV + bl[1];
                typedef unsigned u32x2 __attribute__((ext_vector_type(2)));
                const f32x2s s0 = swiglu2((f32x2s){g0[0], g0[1]}, (f32x2s){l0[0], l0[1]}), s1 = swiglu2((f32x2s){g0[2], g0[3]}, (f32x2s){l0[2], l0[3]});
                const f32x2s s2 = swiglu2((f32x2s){g1[0], g1[1]}, (f32x2s){l1[0], l1[1]}), s3 = swiglu2((f32x2s){g1[2], g1[3]}, (f32x2s){l1[2], l1[3]});
                u32x2 w; w.x = pk4_fp8(s0.x, s0.y, s1.x, s1.y); w.y = pk4_fp8(s2.x, s2.y, s3.x, s3.y);
                *(u32x2*)rowp = w; }
    }
};
struct EpiDown {
    static constexpr bool PERM = true, AFTER_DRAIN = false;
    unsigned char* y; const float* bd;
    PG8_LAS float* bls;
    __device__ __forceinline__ void prefetch(const Unit& u, int ui, int wid, int lane) const {
        if (wid == 0) { const float* src = bd + (size_t)u.e * 1024 + u.pn * BM + lane * 4;
            dma16(src, bls + (ui & 1) * 256); }
    }
    __device__ __forceinline__ void operator()(const f32x4 (&acc)[2][2][4][2], const Unit& u, int wr, int wc, int fr, int fq, int ui) const {
        const int row0 = u.pm * BM + wr * 64 + fr, col0 = u.pn * BM + wc * 32 + 8 * fq;
        const PG8_LAS float* bb = bls + (ui & 1) * 256 + wc * 32 + 8 * fq;
        f32x4 bv[2][2];
#pragma unroll
        for (int bj = 0; bj < 2; ++bj)
#pragma unroll
            for (int n = 0; n < 2; ++n) bv[bj][n] = *(const PG8_LAS f32x4*)(bb + bj * HALF + 4 * n);
#pragma unroll
        for (int ai = 0; ai < 2; ++ai)
#pragma unroll
            for (int m = 0; m < 4; ++m) { unsigned char* rowp = y + (size_t)(row0 + ai * HALF + m * 16) * 1024 + col0;
#pragma unroll
                for (int bj = 0; bj < 2; ++bj) { const f32x4 v0 = acc[ai][bj][m][0] * W8_INV + bv[bj][0], v1 = acc[ai][bj][m][1] * W8_INV + bv[bj][1];
                    typedef unsigned u32x2 __attribute__((ext_vector_type(2)));
                    u32x2 w; w.x = pk4_fp8(sat8(v0[0]), sat8(v0[1]), sat8(v0[2]), sat8(v0[3])); w.y = pk4_fp8(sat8(v1[0]), sat8(v1[1]), sat8(v1[2]), sat8(v1[3]));
                    *(u32x2*)(rowp + bj * HALF) = w; } }
    }
};

template <int NWOFF, int RCOS, int RSIN, int CCOS, int CSIN> struct EpiQKV {
    static constexpr bool PERM = true, AFTER_DRAIN = false;
    bf16_t* P; const float* tab;
    PG8_LAS float* xch;
    __device__ __forceinline__ void prefetch(const Unit&, int, int, int) const {}
    float qscale;
    __device__ __forceinline__ void operator()(const f32x4 (&acc)[2][2][4][2], const Unit& u, int wr, int wc, int fr, int fq, int = 0) const {
        const int type = u.pn >> 1, row0 = u.pm * BM + wr * 64 + fr, col0 = u.pn * BM + wc * 32 + 8 * fq;
        if (type == 2 || type == 5) {
#pragma unroll
            for (int ai = 0; ai < 2; ++ai)
#pragma unroll
                for (int m = 0; m < 4; ++m) { bf16_t* rowp = P + (size_t)(row0 + ai * HALF + m * 16) * 3072 + col0;
#pragma unroll
                    for (int bj = 0; bj < 2; ++bj) { const f32x4 v0 = acc[ai][bj][m][0] * W8_INV, v1 = acc[ai][bj][m][1] * W8_INV;
                        u32x4 w; w.x = cvt_pk_bf16(v0[0], v0[1]); w.y = cvt_pk_bf16(v0[2], v0[3]); w.z = cvt_pk_bf16(v1[0], v1[1]); w.w = cvt_pk_bf16(v1[2], v1[3]);
                        *(u32x4*)(rowp + bj * HALF) = w; } }
            return;
        }
        const int wid = wr * 4 + wc;
        float ss[16];
#pragma unroll
        for (int ai = 0; ai < 2; ++ai)
#pragma unroll
            for (int m = 0; m < 4; ++m)
#pragma unroll
                for (int bj = 0; bj < 2; ++bj) { const f32x4 a = acc[ai][bj][m][0], b = acc[ai][bj][m][1];
                    float s = (a[0] * a[0] + a[1] * a[1]) + (a[2] * a[2] + a[3] * a[3]) + (b[0] * b[0] + b[1] * b[1]) + (b[2] * b[2] + b[3] * b[3]);
                    s += __shfl_xor(s, 16); s += __shfl_xor(s, 32); ss[(ai * 4 + m) * 2 + bj] = s; }
        int xo_ = wid * 256 + fr; asm volatile("" : "+v"(xo_));
        PG8_LAS float* xw_ = xch + xo_; const PG8_LAS float* xr_ = xch + (xo_ ^ 256);
        if (fq == 0) {
#pragma unroll
            for (int i = 0; i < 16; ++i) xw_[i * 16] = ss[i]; }
        asm volatile("s_waitcnt lgkmcnt(0)" ::: "memory"); __builtin_amdgcn_s_barrier(); asm volatile("" ::: "memory");
#pragma unroll
        for (int i = 0; i < 16; ++i) ss[i] += xr_[i * 16];
        const int d0 = 32 * (wc & 1) + 8 * fq;
        const float* nwp = tab + NWOFF + (type - (type > 2 ? 1 : 0)) * 64 + d0;
        const f32x4 w0 = *(const f32x4*)nwp, w1 = *(const f32x4*)(nwp + 4);
        const float qs = (type == 0 || type == 3) ? qscale : 1.0f;
        const bool rope = (type < 2) && (u.pm < 128);
        const int half = wc & 1, f0 = 8 * (fq & 1); const bool isx2 = fq >= 2;
#pragma unroll
        for (int ai = 0; ai < 2; ++ai)
#pragma unroll
            for (int m = 0; m < 4; ++m) { const int row = row0 + ai * HALF + m * 16; bf16_t* rowp = P + (size_t)row * 3072 + col0;
                f32x4 cs0 = {1.f, 1.f, 1.f, 1.f}, cs1 = cs0, sn0 = {0.f, 0.f, 0.f, 0.f}, sn1 = sn0;
                if (rope) { const int s = row & 8191, pp = half ? (s & 63) : (s >> 6); const float* ct = tab + RCOS + half * (CCOS - RCOS) + pp * 16 + f0; const float* st = tab + RSIN + half * (CSIN - RSIN) + pp * 16 + f0;
                    cs0 = *(const f32x4*)ct; cs1 = *(const f32x4*)(ct + 4); sn0 = *(const f32x4*)st; sn1 = *(const f32x4*)(st + 4); if (!isx2) { sn0 = -sn0; sn1 = -sn1; } }
#pragma unroll
                for (int bj = 0; bj < 2; ++bj) {
                    const float rstd = (W8_INV * qs) * __builtin_amdgcn_rsqf(ss[(ai * 4 + m) * 2 + bj] * (W8_INV * W8_INV / 64.0f) + 1e-6f);
                    f32x4 y0 = acc[ai][bj][m][0] * rstd * w0, y1 = acc[ai][bj][m][1] * rstd * w1;
                    if (rope) { f32x4 p0, p1;
#pragma unroll
                        for (int i = 0; i < 4; ++i) { p0[i] = __shfl_xor(y0[i], 32); p1[i] = __shfl_xor(y1[i], 32); }
                        y0 = y0 * cs0 + p0 * sn0; y1 = y1 * cs1 + p1 * sn1; }
                    u32x4 w; w.x = cvt_pk_bf16(y0[0], y0[1]); w.y = cvt_pk_bf16(y0[2], y0[3]); w.z = cvt_pk_bf16(y1[0], y1[1]); w.w = cvt_pk_bf16(y1[2], y1[3]);
                    *(u32x4*)(rowp + bj * HALF) = w; }
                asm volatile("" ::: "memory"); }
    }
};
}

namespace att {
typedef unsigned short bf16_t;
using bf16x8 = __attribute__((ext_vector_type(8))) short;
using s16x4  = __attribute__((ext_vector_type(4))) short;
using f32x16 = __attribute__((ext_vector_type(16))) float;
using u32x4  = __attribute__((ext_vector_type(4))) unsigned;
constexpr int NW = 8, QBLK = 32, KVBLK = 64, LD = 3072;
constexpr float SCALE = 0.125f, C2 = 0.125f * 1.4426950408889634f;
#define KSWZ64(row, colB) ((row) * 128 + ((colB) ^ ((((row) >> 1) & 7) << 4)))
#define ASBAR() __builtin_amdgcn_sched_barrier(0)
__device__ __forceinline__ unsigned pk4f8(float a, float b, float c, float d) { int w = 0; w = __builtin_amdgcn_cvt_pk_fp8_f32(a, b, w, false); w = __builtin_amdgcn_cvt_pk_fp8_f32(c, d, w, true); return (unsigned)w; }
__device__ __forceinline__ int crow(int r, int hi) { return (r & 3) + 8 * (r >> 2) + 4 * hi; }
__device__ __forceinline__ unsigned cvtpk(float lo, float hi) { unsigned r; asm volatile("v_cvt_pk_bf16_f32 %0, %1, %2" : "=v"(r) : "v"(lo), "v"(hi)); return r; }
__device__ __forceinline__ bf16x8 ld8(const bf16_t* p) { return *reinterpret_cast<const bf16x8*>(p); }
__device__ __forceinline__ void glds16(const void* gsrc, unsigned lds_dst) { unsigned keep;
  asm volatile("s_mov_b32 %0, m0\n\ts_mov_b32 m0, %2\n\ts_nop 0\n\tglobal_load_lds_dwordx4 %1, off\n\ts_mov_b32 m0, %0" : "=&s"(keep) : "v"(gsrc), "s"(lds_dst) : "memory"); }
__device__ __forceinline__ void glds16s(const void* sbase, unsigned voff, unsigned lds_dst) { unsigned keep;
  asm volatile("s_mov_b32 %0, m0\n\ts_mov_b32 m0, %3\n\ts_nop 0\n\tglobal_load_lds_dwordx4 %1, %2\n\ts_mov_b32 m0, %0" : "=&s"(keep) : "v"(voff), "s"(sbase), "s"(lds_dst) : "memory"); }

template <int NVB> __device__ __forceinline__ void dma_kv(const void* kbase, const void* vbase, unsigned koff, unsigned voff, unsigned kd, unsigned vd) {
  if constexpr (NVB == 4)
    asm volatile("s_mov_b32 m0, %4\n\ts_nop 0\n\tglobal_load_lds_dwordx4 %0, %2\n\ts_mov_b32 m0, %5\n\ts_nop 0\n\tglobal_load_lds_dwordx4 %1, %3\n\ts_mov_b32 m0, %6\n\ts_nop 0\n\tglobal_load_lds_dwordx4 %1, %3 offset:128"
                 :: "v"(koff), "v"(voff), "s"(kbase), "s"(vbase), "s"(kd), "s"(vd), "s"(vd + 896u) : "memory");
  else
    asm volatile("s_mov_b32 m0, %4\n\ts_nop 0\n\tglobal_load_lds_dwordx4 %0, %2\n\ts_mov_b32 m0, %5\n\ts_nop 0\n\tglobal_load_lds_dwordx4 %1, %3"
                 :: "v"(koff), "v"(voff), "s"(kbase), "s"(vbase), "s"(kd), "s"(vd) : "memory");
}
__device__ __forceinline__ void exp16(f32x16& p, float mref) {
#pragma unroll
  for (int r = 0; r < 16; ++r) p[r] = __builtin_amdgcn_exp2f(p[r]);
}
__device__ __forceinline__ void finishSM(f32x16& p0, f32x16& p1, float mref, float& l_reg, bf16x8& pa0, bf16x8& pa1, bf16x8& pa2, bf16x8& pa3) {
  exp16(p1, mref);
  float ps = 0;
#pragma unroll
  for (int r = 0; r < 16; ++r) ps += p0[r];
#pragma unroll
  for (int r = 0; r < 16; ++r) ps += p1[r];
  l_reg += ps;
#define PK4(P, BASE, OUT) do { u32x4 w = {cvtpk(P[BASE + 0], P[BASE + 1]), cvtpk(P[BASE + 2], P[BASE + 3]), cvtpk(P[BASE + 4], P[BASE + 5]), cvtpk(P[BASE + 6], P[BASE + 7])}; OUT = *reinterpret_cast<bf16x8*>(&w); } while (0)
  PK4(p0, 0, pa0); PK4(p0, 8, pa1); PK4(p1, 0, pa2); PK4(p1, 8, pa3);
#undef PK4
}
template <bool NEGM> __device__ __forceinline__ void qkt(f32x16& p0, f32x16& p1, const char* Ks, const bf16x8* qr, const f32x16& negm, int r32, int hi) {
#pragma unroll
  for (int d0 = 0; d0 < 4; ++d0) { const int cb = (d0 * 16 + hi * 8) * 2;
    const bf16x8 b0 = *reinterpret_cast<const bf16x8*>(Ks + KSWZ64(r32, cb));
    const bf16x8 b1 = *reinterpret_cast<const bf16x8*>(Ks + KSWZ64(32 + r32, cb));
    if (d0 == 0) { if constexpr (NEGM) { p0 = __builtin_amdgcn_mfma_f32_32x32x16_bf16(b0, qr[0], negm, 0, 0, 0); p1 = __builtin_amdgcn_mfma_f32_32x32x16_bf16(b1, qr[0], negm, 0, 0, 0); }
      else { p0 = __builtin_amdgcn_mfma_f32_32x32x16_bf16(b0, qr[0], f32x16{}, 0, 0, 0); p1 = __builtin_amdgcn_mfma_f32_32x32x16_bf16(b1, qr[0], f32x16{}, 0, 0, 0); } }
    else { p0 = __builtin_amdgcn_mfma_f32_32x32x16_bf16(b0, qr[d0], p0, 0, 0, 0); p1 = __builtin_amdgcn_mfma_f32_32x32x16_bf16(b1, qr[d0], p1, 0, 0, 0); } }
}
template <int NVB> __device__ __forceinline__ int v_st(int k, int c) { const int kk = k; return ((kk >> 3) * NVB + (c >> 5)) * 512 + ((kk & 7) * 32 + (c & 31)) * 2; }
__device__ __forceinline__ int v_rd_base(int lane) { return ((lane & 3) << 3) | (((lane >> 2) & 3) << 6) | (((lane >> 4) & 1) << 5) | (((lane >> 5) & 1) << 8); }
template <int NVB> constexpr int v_rd_off(int d0, int ks, int half) { return d0 * 512 + ks * (NVB * 1024) + half * (NVB * 512); }
template <int OFF> __device__ __forceinline__ s16x4 tr_read(int vb) {
  s16x4 r; asm volatile("ds_read_b64_tr_b16 %0, %1 offset:%2" : "=&v"(r) : "v"(vb), "i"(OFF) : "memory"); return r;
}
template <int NVB, int D0> __device__ __forceinline__ void v_rd(s16x4* f, int vb) {
  f[0] = tr_read<v_rd_off<NVB>(D0, 0, 0)>(vb); f[1] = tr_read<v_rd_off<NVB>(D0, 0, 1)>(vb); f[2] = tr_read<v_rd_off<NVB>(D0, 1, 0)>(vb); f[3] = tr_read<v_rd_off<NVB>(D0, 1, 1)>(vb);
  f[4] = tr_read<v_rd_off<NVB>(D0, 2, 0)>(vb); f[5] = tr_read<v_rd_off<NVB>(D0, 2, 1)>(vb); f[6] = tr_read<v_rd_off<NVB>(D0, 3, 0)>(vb); f[7] = tr_read<v_rd_off<NVB>(D0, 3, 1)>(vb);
}
__device__ __forceinline__ void pv_mm(f32x16& od, const s16x4* f, bf16x8 pa0, bf16x8 pa1, bf16x8 pa2, bf16x8 pa3) {
#define PK(L, H) (bf16x8){L[0], L[1], L[2], L[3], H[0], H[1], H[2], H[3]}
  od = __builtin_amdgcn_mfma_f32_32x32x16_bf16(pa0, PK(f[0], f[1]), od, 0, 0, 0);
  od = __builtin_amdgcn_mfma_f32_32x32x16_bf16(pa1, PK(f[2], f[3]), od, 0, 0, 0);
  od = __builtin_amdgcn_mfma_f32_32x32x16_bf16(pa2, PK(f[4], f[5]), od, 0, 0, 0);
  od = __builtin_amdgcn_mfma_f32_32x32x16_bf16(pa3, PK(f[6], f[7]), od, 0, 0, 0);
#undef PK
}
template <int LO, int N> __device__ __forceinline__ void exp_part(f32x16& p, float mref) {
#pragma unroll
  for (int r = LO; r < LO + N; ++r) p[r] = __builtin_amdgcn_exp2f(p[r]);
}
#define LGKM0() do { asm volatile("s_waitcnt lgkmcnt(0)" ::: "memory"); ASBAR(); } while (0)
template <int NVB> __device__ __forceinline__ void pv_all(f32x16* o, int vb, s16x4* fa, s16x4* fb, bf16x8 pa0, bf16x8 pa1, bf16x8 pa2, bf16x8 pa3, f32x16& c, float mref) {
  if constexpr (NVB == 4) {
    LGKM0(); v_rd<NVB, 1>(fb, vb); pv_mm(o[0], fa, pa0, pa1, pa2, pa3); exp_part<0, 4>(c, mref);
    LGKM0(); v_rd<NVB, 2>(fa, vb); pv_mm(o[1], fb, pa0, pa1, pa2, pa3); exp_part<4, 4>(c, mref);
    LGKM0(); v_rd<NVB, 3>(fb, vb); pv_mm(o[2], fa, pa0, pa1, pa2, pa3); exp_part<8, 4>(c, mref);
    LGKM0();                       pv_mm(o[3], fb, pa0, pa1, pa2, pa3); exp_part<12, 4>(c, mref);
  } else {
    LGKM0(); v_rd<NVB, 1>(fb, vb); pv_mm(o[0], fa, pa0, pa1, pa2, pa3); exp_part<0, 8>(c, mref);
    LGKM0();                       pv_mm(o[1], fb, pa0, pa1, pa2, pa3); exp_part<8, 8>(c, mref);
  }
}
template <bool SHIFT> struct DiffPol {
  static constexpr bool NEGM = false;
  const bf16_t* Kg; const bf16_t* Vg; long lat0, ctx0; float mref;
  __device__ __forceinline__ int krow(int t) const { return t < 128 ? (int)lat0 + 64 * t : (int)ctx0 + 64 * (t - 128); }
  static constexpr bool INCR = true;
  __device__ __forceinline__ long delta(int t) const { return t == 127 ? ((long)ctx0 - (long)lat0 - 64L * 127) * LD : 64L * LD; }
  __device__ __forceinline__ void mod(f32x16& p0, f32x16& p1, int, int, int, int) const {
    if constexpr (SHIFT) {
#pragma unroll
      for (int i = 0; i < 16; ++i) { p0[i] -= mref; p1[i] -= mref; } }
  }
};
template <int PAR> struct NaPol {
  static constexpr bool NEGM = false;
  const bf16_t* Kg; const bf16_t* Vg; long lat0, ctx0; int rbase, r; const float* tab; float mref;
  static constexpr bool INCR = false;
  __device__ __forceinline__ long delta(int) const { return 0; }
  __device__ __forceinline__ int krow(int t) const { if (t < 11) { int kr = rbase + t; kr = kr > 127 ? 127 : kr; return (int)lat0 + 64 * kr; } return (int)ctx0 + 64 * (t - 11); }
  __device__ __forceinline__ void mod(f32x16& p0, f32x16& p1, int t, int wid, int r32, int hi) const {
    if (t >= 11) {
#pragma unroll
      for (int i = 0; i < 16; ++i) { p0[i] -= mref; p1[i] -= mref; }
      return; }
    const float NEG = -INFINITY;
    const int kr = rbase + t, rq = r + (wid >> 1), c = 32 * (wid & 1) + r32;
    int r0q = rq - 4; r0q = r0q < 0 ? 0 : (r0q > 120 ? 120 : r0q);
    if (!((kr >= r0q) && (kr < r0q + 8))) {
#pragma unroll
      for (int i = 0; i < 16; ++i) { p0[i] = NEG; p1[i] = NEG; }
      return; }
    int c0 = c - 8; c0 = c0 < 0 ? 0 : (c0 > 48 ? 48 : c0);
    int d = 4 * hi - c0, off = (kr - rq + 7) * 31 + 15 - c + 4 * hi;
    asm volatile("" : "+v"(d), "+v"(off));
#pragma unroll
    for (int i = 0; i < 16; ++i) { const int ci = (i & 3) + 8 * (i >> 2);
      if (PAR == 1 && i < 12) p0[i] = NEG; else { const bool v0 = (unsigned)(ci + d) < 16u; p0[i] += tab[v0 ? off + ci : 15 * 31]; }
      if (PAR == 0 && i >= 4) p1[i] = NEG; else { const bool v1 = (unsigned)(ci + 32 + d) < 16u; p1[i] += tab[v1 ? off + ci + 32 : 15 * 31]; } }
  }
};
template <int NVB> constexpr int lds_bytes() { return 3 * (64 * NVB * 64) + 3 * (64 * 128) + NW * 64 * 4; }
constexpr int STAGE_OFF = 77824;
template <int NVB, class Pol, int MODE, int VKB>
__device__ __forceinline__ void attn_unit(const bf16_t* __restrict__ Qb, const Pol& pol, bf16_t* __restrict__ Ob, int ldo, int NT, float mref, char* lds, float lam = 0.f, const float* wn = nullptr) {
  constexpr int SHM_V = 64 * NVB * 64, SHM_K = 64 * 128;
  const int tid = threadIdx.x, lane = tid & 63, r32 = lane & 31, hi = lane >> 5; const int wid = __builtin_amdgcn_readfirstlane(tid >> 6);
  char* V_lds = lds; char* K_lds = lds + 3 * SHM_V;
  float* li_l = (float*)(lds + 3 * SHM_V + 3 * SHM_K) + wid * 64;
  const unsigned lds0 = (unsigned)(uintptr_t)lds;
  const int krow_ = 8 * wid + (lane >> 3), kch = (lane & 7) ^ ((krow_ >> 1) & 7);
  const unsigned koff = (unsigned)(krow_ * LD + kch * 8) * 2u;
  const unsigned voff = (unsigned)((8 * wid + ((lane >> 2) & 7)) * LD + (lane >> 5) * 32 + (lane & 3) * 8) * 2u;
  const unsigned kdst = lds0 + 3 * SHM_V + wid * 1024, vdst = lds0 + wid * (NVB == 4 ? 2048 : 1024);
  const bf16_t* kq = pol.Kg + (unsigned)(int)pol.krow(0) * (unsigned)LD;
#define DMA_TILE(t, b) do { const bf16_t* kp_; if constexpr (Pol::INCR) { kp_ = kq; kq += pol.delta(t); } else kp_ = pol.Kg + (unsigned)(int)pol.krow(t) * (unsigned)LD;        \
    dma_kv<NVB>(kp_, kp_ + VKB / 2, koff, voff, (unsigned)__builtin_amdgcn_readfirstlane(kdst + (b) * SHM_K), (unsigned)__builtin_amdgcn_readfirstlane(vdst + (b) * SHM_V)); } while (0)
#define WAIT_BAR() do { asm volatile("s_waitcnt vmcnt(0)" ::: "memory"); __syncthreads(); } while (0)
  DMA_TILE(0, 0); DMA_TILE(1, 1);
  float l_reg = 0; f32x16 o[NVB]; bf16x8 qr[4]; f32x16 negm;
#pragma unroll
  for (int r = 0; r < 16; ++r) negm[r] = -mref;
  if constexpr (Pol::NEGM) asm volatile("" : "+v"(negm));
#pragma unroll
  for (int d = 0; d < NVB; ++d) o[d] = f32x16{};
  const bf16_t* Qw = Qb + (long)(wid * QBLK + r32) * LD + hi * 8;
#pragma unroll
  for (int d0 = 0; d0 < 4; ++d0) qr[d0] = ld8(Qw + d0 * 16);
  const int vb0 = (int)(uintptr_t)V_lds + v_rd_base(lane);
  f32x16 pA0, pA1, pB0, pB1; bf16x8 pa0, pa1, pa2, pa3; s16x4 fa[8], fb[8];
  int bp = 0, bc = 1, bn = 2;
  WAIT_BAR();
  qkt<Pol::NEGM>(pA0, pA1, K_lds, qr, negm, r32, hi); pol.mod(pA0, pA1, 0, wid, r32, hi); exp16(pA0, mref);
#define STEP(C0, C1, P0, P1, j) do { \
    if ((j) + 1 < NT) DMA_TILE((j) + 1, bn); \
    ASBAR(); v_rd<NVB, 0>(fa, vb0 + bp * SHM_V); qkt<Pol::NEGM>(C0, C1, K_lds + bc * SHM_K, qr, negm, r32, hi); \
    finishSM(P0, P1, mref, l_reg, pa0, pa1, pa2, pa3); ASBAR(); \
    pol.mod(C0, C1, (j), wid, r32, hi); ASBAR(); \
    pv_all<NVB>(o, vb0 + bp * SHM_V, fa, fb, pa0, pa1, pa2, pa3, C0, mref); \
    WAIT_BAR(); \
    bp = bc; bc = bn; bn = (bn == 2) ? 0 : bn + 1; } while (0)
  int j = 1;
#pragma nounroll
  for (; j + 1 < NT; j += 2) { STEP(pB0, pB1, pA0, pA1, j); STEP(pA0, pA1, pB0, pB1, j + 1); }
  if (NT & 1) {
    finishSM(pA0, pA1, mref, l_reg, pa0, pa1, pa2, pa3); ASBAR();
    v_rd<NVB, 0>(fa, vb0 + bp * SHM_V); pv_all<NVB>(o, vb0 + bp * SHM_V, fa, fb, pa0, pa1, pa2, pa3, pB0, 0.f);
  } else {
    STEP(pB0, pB1, pA0, pA1, NT - 1);
    finishSM(pB0, pB1, mref, l_reg, pa0, pa1, pa2, pa3); ASBAR();
    v_rd<NVB, 0>(fa, vb0 + bp * SHM_V); pv_all<NVB>(o, vb0 + bp * SHM_V, fa, fb, pa0, pa1, pa2, pa3, pA0, 0.f);
  }
  { auto rr = __builtin_amdgcn_permlane32_swap(__float_as_uint(l_reg), __float_as_uint(l_reg), false, false); l_reg = __uint_as_float(rr[0]) + __uint_as_float(rr[1]); }
  if (hi == 0) li_l[r32] = l_reg; asm volatile("s_waitcnt lgkmcnt(0)" ::: "memory");
  bf16_t* stg = (bf16_t*)(lds + STAGE_OFF) + wid * (32 * 32 * NVB);
  bf16_t* Ow = Ob + (long)(wid * QBLK) * ldo;
  if constexpr (MODE == 0) {
#pragma unroll
    for (int r = 0; r < 16; ++r) { const int orow = crow(r, hi); const float rl = __builtin_amdgcn_rcpf(li_l[orow]);
#pragma unroll
      for (int d0 = 0; d0 < NVB; ++d0) { const float v = o[d0][r] * rl; const unsigned pk = cvtpk(v, v); stg[orow * (32 * NVB) + d0 * 32 + r32] = (bf16_t)(pk & 0xffffu); } }
  } else {
    float ss[16];
#pragma unroll
    for (int r = 0; r < 16; ++r) { const int orow = crow(r, hi); float a = 0.f; const float rl = __builtin_amdgcn_rcpf(li_l[orow]);
#pragma unroll
      for (int d0 = 0; d0 < NVB; ++d0) { float v = o[d0][r] * rl;
        if constexpr (MODE == 1) { const float o1 = __uint_as_float(((unsigned)stg[orow * (32 * NVB) + d0 * 32 + r32]) << 16); v = o1 - lam * v; }
        o[d0][r] = v; a += v * v; }
      ss[r] = a; }
#pragma unroll
    for (int sft = 1; sft < 32; sft <<= 1) {
#pragma unroll
      for (int r = 0; r < 16; ++r) ss[r] += __shfl_xor(ss[r], sft); }
    float wv[NVB];
#pragma unroll
    for (int d0 = 0; d0 < NVB; ++d0) wv[d0] = wn[d0 * 32 + r32];
#pragma unroll
    for (int r = 0; r < 16; ++r) { const int orow = crow(r, hi);
      const float rs = (MODE == 1 ? 0.8f : 1.0f) / sqrtf(ss[r] * (1.0f / (32 * NVB)) + 1e-6f);
#pragma unroll
      for (int d0 = 0; d0 < NVB; ++d0) { const float v = o[d0][r] * rs * wv[d0]; const unsigned pk = cvtpk(v, v); stg[orow * (32 * NVB) + d0 * 32 + r32] = (bf16_t)(pk & 0xffffu); } }
    asm volatile("s_waitcnt lgkmcnt(0)" ::: "memory");
    constexpr int CH = 2 * NVB;
#pragma unroll
    for (int i = 0; i < (32 * CH) / 64; ++i) { const int idx = i * 64 + lane, row = idx / CH, ch = idx % CH;
      const u32x4 a = *(const u32x4*)(stg + row * (32 * NVB) + ch * 16), b = *(const u32x4*)(stg + row * (32 * NVB) + ch * 16 + 8);
#define F8P(w0, w1) pk4f8(__uint_as_float((w0) << 16), __uint_as_float((w0) & 0xffff0000u), __uint_as_float((w1) << 16), __uint_as_float((w1) & 0xffff0000u))
      u32x4 v; v.x = F8P(a.x, a.y); v.y = F8P(a.z, a.w); v.z = F8P(b.x, b.y); v.w = F8P(b.z, b.w);
#undef F8P
      *(u32x4*)((unsigned char*)Ob + (long)(wid * QBLK + row) * ldo + ch * 16) = v; }
  }
  __syncthreads();
#undef DMA_TILE
#undef WAIT_BAR
#undef STEP
}
}

#ifndef MK_PROBE_PHASE
#define MK_PROBE_PHASE -1
#endif
#ifndef MK_N_LAUNCHES
#define MK_N_LAUNCHES 1
#endif
constexpr int N_PHASES = 12;
constexpr int NWAVES = 8;
constexpr int DM = 1024, NB = 4, SEQ = 8192, TT = NB * SEQ, CTX = 256, TC = NB * CTX, MQ = TT + TC, NQKV = 3072;
constexpr int NE = 32, TOPK = 4, MPAD = TT * TOPK + NE * 256, MAXBLK = MPAD / 256;
constexpr float NORM_EPS = 1e-6f;
enum { I_X = 0, I_C, I_CTX, I_CCTX, I_WADA, I_BADA, I_GATTN, I_WIN, I_QND, I_KND, I_LQ1, I_LK1, I_LQ2, I_LK2, I_SUBLN, I_QNN, I_KNN, I_RPB, I_ONN, I_WOUT, I_GFFN, I_WR, I_BR, I_WGU, I_BGU, I_WD, I_BD, N_IN };

constexpr size_t MiB = 1u << 20;
constexpr size_t WS_CTL = 0, CTL_ZERO_BYTES = 64 * 1024;
constexpr size_t WS_TAB = 1 * MiB;
constexpr size_t WS_WR3 = 128 * 1024;
constexpr size_t WS_WQKV = 2 * MiB, WS_WO = 8 * MiB, WS_WGU = 10 * MiB, WS_WDN = 138 * MiB;
constexpr size_t WS_XN = 202 * MiB;
constexpr size_t WS_P = 268 * MiB;
constexpr size_t WS_OD = 499 * MiB, WS_ON = 563 * MiB, WS_MIX = 595 * MiB;
constexpr size_t WS_X1 = 499 * MiB;
constexpr size_t WS_XG = 202 * MiB;
constexpr size_t WS_ACT = 659 * MiB;
constexpr size_t WS_Y = 202 * MiB;
constexpr size_t WS_RT = 931 * MiB;
constexpr size_t WS_END = 936 * MiB;
static_assert(WS_XN + (size_t)MQ * 2048 <= WS_P && WS_P + (size_t)MQ * 6144 <= WS_OD && WS_XG + (size_t)MPAD * 2048 <= WS_OD && WS_ACT + (size_t)MPAD * 2048 <= WS_RT, "d_ws map");
constexpr int TB_MOD = 0;
constexpr int TB_RCOS = 30720, TB_RSIN = TB_RCOS + 128 * 16, TB_CCOS = TB_RSIN + 128 * 16, TB_CSIN = TB_CCOS + 64 * 16;
constexpr int TB_LAM = TB_CSIN + 64 * 16;
constexpr int TB_NW = TB_LAM + 64;
constexpr int TB_WR = TB_NW + 256;
constexpr int TB_RC = TB_WR + 4 * 1024 * 32;
static_assert((size_t)(TB_RC + 128 + 64) * 4 <= MiB, "TAB region");
constexpr int CW_CNT = 0;
constexpr int CW_RC = 64;
constexpr int CW_BAR = 4096;
constexpr size_t RT_E = 0, RT_G = 512 * 1024, RT_POS = 1024 * 1024, RT_SLOT = 1536 * 1024;
constexpr size_t RT_TOK = 2048 * 1024;

constexpr int RING_BYTES = 131072;
constexpr int MISC_OFF = RING_BYTES;
constexpr int LDS_BYTES = 147456;

#define GAS __attribute__((address_space(1)))
#define LAS __attribute__((address_space(3)))
typedef unsigned short bf16;
typedef unsigned v4u __attribute__((ext_vector_type(4)));
typedef unsigned v2u __attribute__((ext_vector_type(2)));
typedef float f32x4 __attribute__((ext_vector_type(4)));
typedef float f32x16 __attribute__((ext_vector_type(16)));
#define LDS_WAIT() asm volatile("s_waitcnt lgkmcnt(0)" ::: "memory")
__device__ __forceinline__ unsigned f2bf(float f) { unsigned u = __builtin_bit_cast(unsigned, f); return (u + 0x7fffu + ((u >> 16) & 1u)) >> 16; }
__device__ __forceinline__ unsigned pk2(float lo, float hi) { return f2bf(lo) | (f2bf(hi) << 16); }
__device__ __forceinline__ float bflo(unsigned w) { return __uint_as_float(w << 16); }
__device__ __forceinline__ float bfhi(unsigned w) { return __uint_as_float(w & 0xffff0000u); }
__device__ __forceinline__ float wave_sum(float v) {
#pragma unroll
    for (int o = 1; o < 64; o <<= 1) v += __shfl_xor(v, o);
    return v;
}

#define FTID ((int)threadIdx.x)
#define FLANE ((int)(threadIdx.x & 63u))
struct Frame {
    LAS unsigned char* lds;
    int wave, vcu, G;
    const float* in[N_IN]; float* out; unsigned char* ws;
};

__device__ __forceinline__ void p0_transpose_item(const float* W, int K, int N, bf16* WT, int k0, int n0, int drow0, LAS float* scr, int lane) {
    float st_[32];
#pragma unroll
    for (int i = 0; i < 32; ++i) st_[i] = __builtin_nontemporal_load(&W[(size_t)(k0 + 2 * i + (lane >> 5)) * N + n0 + (lane & 31)]);
#pragma unroll
    for (int i = 0; i < 32; ++i) scr[(2 * i + (lane >> 5)) * 33 + (lane & 31)] = st_[i];
    LDS_WAIT(); asm volatile("" ::: "memory");
    const int c = lane & 7;
#pragma unroll
    for (int j = 0; j < 4; ++j) { const int n = (lane >> 3) + 8 * j; const LAS float* s = scr + (8 * c) * 33 + n;
        v4u o; o.x = pk2(s[0 * 33], s[1 * 33]); o.y = pk2(s[2 * 33], s[3 * 33]); o.z = pk2(s[4 * 33], s[5 * 33]); o.w = pk2(s[6 * 33], s[7 * 33]);
        *(v4u*)(WT + (size_t)(drow0 + n) * K + k0 + 8 * c) = o; }
    LDS_WAIT(); asm volatile("" ::: "memory");
}

__device__ __forceinline__ void p0_transpose_item8(const float* W, int K, int N, unsigned char* WT, int k0, int n0, int drow0, LAS float* scr, int lane) {
    float st_[32];
#pragma unroll
    for (int i = 0; i < 32; ++i) st_[i] = __builtin_nontemporal_load(&W[(size_t)(k0 + 2 * i + (lane >> 5)) * N + n0 + (lane & 31)]);
#pragma unroll
    for (int i = 0; i < 32; ++i) scr[(2 * i + (lane >> 5)) * 33 + (lane & 31)] = st_[i];
    LDS_WAIT(); asm volatile("" ::: "memory");
    const int n = lane & 31, hf = lane >> 5; const LAS float* s = scr + (32 * hf) * 33 + n;
    v4u o0, o1;
#define P4(j) pg8::pk4_fp8(s[(j) * 33] * pg8::W8_SCALE, s[((j) + 1) * 33] * pg8::W8_SCALE, s[((j) + 2) * 33] * pg8::W8_SCALE, s[((j) + 3) * 33] * pg8::W8_SCALE)
    o0.x = P4(0); o0.y = P4(4); o0.z = P4(8); o0.w = P4(12); o1.x = P4(16); o1.y = P4(20); o1.z = P4(24); o1.w = P4(28);
#undef P4
    unsigned char* dst = WT + (size_t)(drow0 + n) * K + k0 + 32 * hf;
    *(v4u*)dst = o0; *(v4u*)(dst + 16) = o1;
    LDS_WAIT(); asm volatile("" ::: "memory");
}

constexpr int P0_I_IN = 16 * 96, P0_I_GU = 16 * 64, P0_I_DN = 16 * 32, P0_I_OUT = 16 * 32;
constexpr int P0_N8 = P0_I_IN + NE * (P0_I_GU + P0_I_DN);
constexpr int P0_QUOTA = 3;
__device__ __forceinline__ int p0_deferred(int G) { const int rem = (MQ / 256 * (NQKV / 256)) % G; return rem == 0 ? 0 : (G - rem) * NWAVES * P0_QUOTA; }
__device__ __forceinline__ void p0_convert(Frame& F, int first, int stride, int begin, int end) {
    constexpr int I_IN = P0_I_IN, I_GU = P0_I_GU, I_DN = P0_I_DN;
    LAS float* scr = (LAS float*)(F.lds + 32768 + F.wave * 8704);
#define P0_DECODE(it_, W_, N_, k0_, n0_, dr_, D_) do { int r_ = (it_); \
        if (r_ < I_IN) { W_ = F.in[I_WIN]; N_ = 3072; k0_ = 64 * (r_ / 96); n0_ = 32 * (r_ % 96); dr_ = n0_; D_ = F.ws + WS_WQKV; } \
        else if ((r_ -= I_IN) < NE * I_GU) { const int e_ = r_ / I_GU, q_ = r_ % I_GU; W_ = F.in[I_WGU] + (size_t)e_ * 1024 * 2048; N_ = 2048; k0_ = 64 * (q_ / 64); n0_ = 32 * (q_ % 64); \
            dr_ = (n0_ < 1024) ? ((n0_ >> 7) * 256 + (n0_ & 127)) : (((n0_ - 1024) >> 7) * 256 + 128 + ((n0_ - 1024) & 127)); D_ = F.ws + WS_WGU + (size_t)e_ * 2048 * 1024; } \
        else { r_ -= NE * I_GU; const int e_ = r_ / I_DN, q_ = r_ % I_DN; W_ = F.in[I_WD] + (size_t)e_ * 1024 * 1024; N_ = 1024; k0_ = 64 * (q_ / 32); n0_ = 32 * (q_ % 32); dr_ = n0_; D_ = F.ws + WS_WDN + (size_t)e_ * 1024 * 1024; } } while (0)
#define P0_LOAD(R_, W_, N_, k0_, n0_) do { _Pragma("unroll") for (int i = 0; i < 32; ++i) R_[i] = __builtin_nontemporal_load(&W_[(size_t)(k0_ + 2 * i + (FLANE >> 5)) * N_ + n0_ + (FLANE & 31)]); } while (0)
#define P0_STORE8(R_, D_, dr_, k0_) do { _Pragma("unroll") for (int i = 0; i < 32; ++i) scr[(2 * i + (FLANE >> 5)) * 33 + (FLANE & 31)] = R_[i]; \
        LDS_WAIT(); asm volatile("" ::: "memory"); \
        { const int n_ = FLANE & 31, hf_ = FLANE >> 5; const LAS float* s = scr + (32 * hf_) * 33 + n_; v4u o0, o1; \
          o0.x = P4(0); o0.y = P4(4); o0.z = P4(8); o0.w = P4(12); o1.x = P4(16); o1.y = P4(20); o1.z = P4(24); o1.w = P4(28); \
          unsigned char* dst_ = D_ + (size_t)(dr_ + n_) * 1024 + k0_ + 32 * hf_; *(v4u*)dst_ = o0; *(v4u*)(dst_ + 16) = o1; } \
        LDS_WAIT(); asm volatile("" ::: "memory"); } while (0)
#define P4(j) pg8::pk4_fp8(s[(j) * 33] * pg8::W8_SCALE, s[((j) + 1) * 33] * pg8::W8_SCALE, s[((j) + 2) * 33] * pg8::W8_SCALE, s[((j) + 3) * 33] * pg8::W8_SCALE)
    {
        float ra[32], rb[32]; const float *Wa, *Wb; unsigned char *Da, *Db; int Na, ka, na, da, Nb, kb2, nb2, db;
        int it = begin + first;
        if (it < end) { P0_DECODE(it, Wa, Na, ka, na, da, Da); P0_LOAD(ra, Wa, Na, ka, na); }
        while (it < end) {
            const int it2 = it + stride;
            if (it2 < end) { P0_DECODE(it2, Wb, Nb, kb2, nb2, db, Db); P0_LOAD(rb, Wb, Nb, kb2, nb2); }
            P0_STORE8(ra, Da, da, ka);
            if (it2 >= end) break;
            const int it3 = it2 + stride;
            if (it3 < end) { P0_DECODE(it3, Wa, Na, ka, na, da, Da); P0_LOAD(ra, Wa, Na, ka, na); }
            P0_STORE8(rb, Db, db, kb2);
            it = it3;
        }
    }
#undef P4
#undef P0_DECODE
#undef P0_LOAD
#undef P0_STORE8
}

__device__ __forceinline__ void p0_prologue(Frame& F) {
    float* tab = (float*)(F.ws + WS_TAB);
    for (int task = blockIdx.x; task < 96; task += F.G) {
        LAS float* ssilu = (LAS float*)F.lds;
        LAS float* part = ssilu + 5 * 1024;
#pragma unroll
        for (int j = 0; j < 10; ++j) { const int i = FTID + 512 * j, r = i >> 10, k = i & 1023; const float v = (r < 4) ? F.in[I_C][r * 1024 + k] : F.in[I_CCTX][k]; ssilu[i] = v / (1.0f + __expf(-v)); }
        __syncthreads();
        const int kk = FLANE >> 4, c4 = FLANE & 15, kb = F.wave * 128;
        const f32x4* w = (const f32x4*)(F.in[I_WADA] + task * 64);
        f32x4 a0 = {0.f, 0.f, 0.f, 0.f}, a1 = a0, a2 = a0, a3 = a0, a4 = a0;
#pragma unroll 1
        for (int h = 0; h < 2; ++h) {
            f32x4 wv[16]; int ro = (kb + 64 * h + kk) * 1536 + c4; asm volatile("" : "+v"(ro));
#pragma unroll
            for (int i = 0; i < 16; ++i) wv[i] = __builtin_nontemporal_load(w + (ro + i * 4 * 1536));
#pragma unroll
            for (int i = 0; i < 16; ++i) { const int k = kb + 64 * h + 4 * i + kk; a0 += wv[i] * ssilu[k]; a1 += wv[i] * ssilu[1024 + k]; a2 += wv[i] * ssilu[2048 + k]; a3 += wv[i] * ssilu[3072 + k]; a4 += wv[i] * ssilu[4096 + k];
                if ((i & 3) == 3) asm volatile("" ::: "memory"); }
        }
#define P0_RED(a_, r_) do { _Pragma("unroll") for (int q = 0; q < 4; ++q) { float t_ = a_[q]; t_ += __shfl_xor(t_, 16); t_ += __shfl_xor(t_, 32); if (kk == 0) part[(F.wave * 5 + r_) * 64 + 4 * c4 + q] = t_; } } while (0)
        P0_RED(a0, 0); P0_RED(a1, 1); P0_RED(a2, 2); P0_RED(a3, 3); P0_RED(a4, 4);
#undef P0_RED
        __syncthreads();
        if (FTID < 320) { const int r = FTID >> 6, cl = FTID & 63; float s = 0; for (int wv = 0; wv < 8; ++wv) s += part[(wv * 5 + r) * 64 + cl]; const int j = task * 64 + cl; tab[TB_MOD + r * 6144 + j] = s + F.in[I_BADA][j]; }
        __syncthreads();
    }
    if ((int)blockIdx.x == F.G - 1) {
        for (int i = FTID; i < 192 * 16; i += 512) { const int p = i >> 4, f = i & 15; const float inv = 1.0f / powf(10000.0f, (float)f / 16.0f); const int pos = p < 128 ? p : p - 128; const float ang = (float)pos * inv;
            const float cv = cosf(ang), sv = sinf(ang);
            if (p < 128) { tab[TB_RCOS + pos * 16 + f] = cv; tab[TB_RSIN + pos * 16 + f] = sv; } else { tab[TB_CCOS + pos * 16 + f] = cv; tab[TB_CSIN + pos * 16 + f] = sv; } }
        LAS float* rmx = (LAS float*)(F.lds + 31744);
        { float rm = -1e30f;
#pragma unroll
          for (int j = 0; j < 8; ++j) { const int i = FTID + 512 * j; if (i < 8 * 465) rm = fmaxf(rm, F.in[I_RPB][i]); }
#pragma unroll
          for (int o = 1; o < 64; o <<= 1) rm = fmaxf(rm, __shfl_xor(rm, o));
          if (FLANE == 0) rmx[F.wave] = rm; }
        __syncthreads();
        if (F.wave == 0) tab[TB_NW + FLANE] = F.in[I_QND][FLANE];
        if (F.wave == 1) tab[TB_NW + 64 + FLANE] = F.in[I_KND][FLANE];
        if (F.wave == 2) tab[TB_NW + 128 + FLANE] = F.in[I_QNN][FLANE];
        if (F.wave == 3) tab[TB_NW + 192 + FLANE] = F.in[I_KNN][FLANE];
        if (F.wave == 0) { const float s1 = wave_sum(F.in[I_LQ1][FLANE] * F.in[I_LK1][FLANE]), s2 = wave_sum(F.in[I_LQ2][FLANE] * F.in[I_LK2][FLANE]);
            if (FLANE == 0) tab[TB_LAM] = expf(s1) - expf(s2) + 0.2f;
            float a = fabsf(F.in[I_QND][FLANE]), bq = fabsf(F.in[I_KND][FLANE]), c = fabsf(F.in[I_QNN][FLANE]), d = fabsf(F.in[I_KNN][FLANE]); float rm = rmx[FLANE & 7];
#pragma unroll
            for (int o = 1; o < 64; o <<= 1) { a = fmaxf(a, __shfl_xor(a, o)); bq = fmaxf(bq, __shfl_xor(bq, o)); c = fmaxf(c, __shfl_xor(c, o)); d = fmaxf(d, __shfl_xor(d, o)); rm = fmaxf(rm, __shfl_xor(rm, o)); }
            if (FLANE == 0) { tab[TB_LAM + 1] = att::C2 * 64.0f * a * bq * 1.02f + 0.05f; tab[TB_LAM + 2] = att::C2 * 64.0f * c * d * 1.02f + 0.05f + fmaxf(rm, 0.f) * 1.4426950408889634f; } }
    }
    LAS float* scr = (LAS float*)(F.lds + 32768 + F.wave * 8704);
    const int gw = F.vcu * NWAVES + F.wave, NGW = F.G * NWAVES;
    constexpr int I_OUT = P0_I_OUT; const int N8 = P0_N8 - p0_deferred(F.G);
    p0_convert(F, gw, NGW, 0, N8);
    for (int it = (gw - N8 % NGW + NGW) % NGW; it < I_OUT; it += NGW) { const int kb = it / 32, nb = it % 32; p0_transpose_item8(F.in[I_WOUT], 1024, 1024, F.ws + WS_WO, 64 * kb, 32 * nb, 32 * nb, scr, FLANE); }
}

__device__ __forceinline__ void p1_norm(Frame& F) {
    const float* tab = (const float*)(F.ws + WS_TAB); unsigned char* XN = F.ws + WS_XN;
    const int gw = F.vcu * NWAVES + F.wave, NGW = F.G * NWAVES;
    LAS float* mA = (LAS float*)F.lds; LAS float* mC = mA + 5 * 1024;
#pragma unroll
    for (int q = 0; q < 10; ++q) { const int i = FTID + 512 * q, b = i >> 10, k = i & 1023; mA[i] = F.in[I_GATTN][k] * (1.0f + tab[TB_MOD + b * 6144 + 1024 + k]); mC[i] = tab[TB_MOD + b * 6144 + k]; }
    __syncthreads();
    constexpr int RB = 4;
    for (int m0 = gw; m0 < MQ; m0 += RB * NGW) {
        f32x4 v[RB][4]; float s[RB];
#pragma unroll
        for (int r = 0; r < RB; ++r) { const int m = m0 + r * NGW; s[r] = 0.f;
            if (m < MQ) { const float* xrow = m < TT ? F.in[I_X] + (size_t)m * DM : F.in[I_CTX] + (size_t)(m - TT) * DM; const f32x4* xr = (const f32x4*)xrow + FLANE;
#pragma unroll
                for (int j = 0; j < 4; ++j) v[r][j] = __builtin_nontemporal_load(xr + 64 * j); }
            else {
#pragma unroll
                for (int j = 0; j < 4; ++j) v[r][j] = (f32x4){0.f, 0.f, 0.f, 0.f}; } }
#pragma unroll
        for (int r = 0; r < RB; ++r) {
#pragma unroll
            for (int j = 0; j < 4; ++j) s[r] += (v[r][j].x * v[r][j].x + v[r][j].y * v[r][j].y) + (v[r][j].z * v[r][j].z + v[r][j].w * v[r][j].w); }
#pragma unroll
        for (int o = 1; o < 64; o <<= 1) {
#pragma unroll
            for (int r = 0; r < RB; ++r) s[r] += __shfl_xor(s[r], o); }
#pragma unroll
        for (int r = 0; r < RB; ++r) { const int m = m0 + r * NGW; if (m >= MQ) break;
            const int b = m < TT ? (m >> 13) : 4; const float rstd = 1.0f / sqrtf(s[r] * (1.f / DM) + NORM_EPS);
            const LAS f32x4* sa = (const LAS f32x4*)(mA + b * 1024) + FLANE; const LAS f32x4* sh = (const LAS f32x4*)(mC + b * 1024) + FLANE;
            unsigned* o4 = (unsigned*)(XN + (size_t)m * DM) + FLANE;
#pragma unroll
            for (int j = 0; j < 4; ++j) { const f32x4 a = sa[64 * j], c = sh[64 * j];
                const f32x4 h = (v[r][j] * rstd) * a + c;
                o4[64 * j] = pg8::pk4_fp8(pg8::sat8(h.x), pg8::sat8(h.y), pg8::sat8(h.z), pg8::sat8(h.w)); } }
    }
    float* tw = (float*)(F.ws + WS_TAB);
    bf16* w3 = (bf16*)(F.ws + WS_WR3);
    for (int i = (int)blockIdx.x * 512 + FTID; i < 4 * 1024 * 32; i += F.G * 512) { const int b = i >> 15, k = (i >> 5) & 1023, e = i & 31;
        const float w = F.in[I_GFFN][k] * (1.0f + tab[TB_MOD + b * 6144 + 4 * 1024 + k]) * F.in[I_WR][i & 32767];
        const unsigned h0 = pk2(w, w) & 0xffffu; const float r1 = w - __uint_as_float(h0 << 16);
        const unsigned h1 = pk2(r1, r1) & 0xffffu; const float r2 = r1 - __uint_as_float(h1 << 16);
        const unsigned h2 = pk2(r2, r2) & 0xffffu;
        const size_t o = ((size_t)((b * 2 + (k >> 9)) * 3) * 32 + ((k & 511) >> 4)) * 512 + (e + 32 * ((k >> 3) & 1)) * 8 + (k & 7);
        w3[o] = (bf16)h0; w3[o + 32 * 512] = (bf16)h1; w3[o + 2 * 32 * 512] = (bf16)h2; }
    if (F.wave == 0) for (int t = F.vcu; t < 128; t += F.G) { const int b = t >> 5, e = t & 31; float s = 0.f;
#pragma unroll
        for (int q = 0; q < 16; ++q) { const int k = FLANE + 64 * q; s += tab[TB_MOD + b * 6144 + 3 * 1024 + k] * F.in[I_WR][k * 32 + e]; }
        s = wave_sum(s); if (FLANE == 0) tw[TB_RC + t] = s + F.in[I_BR][e]; }
}

__device__ __forceinline__ void p3_qknorm(Frame& F) {
    const float* tab = (const float*)(F.ws + WS_TAB); bf16* P = (bf16*)(F.ws + WS_P);
    const int gw = F.vcu * NWAVES + F.wave, NGW = F.G * NWAVES;
    const int j = FLANE & 7;
    for (int task = gw; task < MQ * 4; task += NGW) {
        const int row = task >> 2, g = task & 3;
        const int colb = (g == 0) ? 0 : (g == 1) ? 512 : (g == 2) ? 1536 : 2048;
        const float* nw = ((g == 0) ? F.in[I_QND] : (g == 1) ? F.in[I_KND] : (g == 2) ? F.in[I_QNN] : F.in[I_KNN]) + 8 * j;
        bf16* p = P + (size_t)row * NQKV + colb + FLANE * 8;
        const v4u w = *(const v4u*)p;
        float v[8] = {bflo(w.x), bfhi(w.x), bflo(w.y), bfhi(w.y), bflo(w.z), bfhi(w.z), bflo(w.w), bfhi(w.w)};
        float ss = 0.f;
#pragma unroll
        for (int i = 0; i < 8; ++i) ss += v[i] * v[i];
        ss += __shfl_xor(ss, 1); ss += __shfl_xor(ss, 2); ss += __shfl_xor(ss, 4);
        const float rstd = 1.0f / sqrtf(ss * (1.f / 64.f) + NORM_EPS);
        const f32x4 n0 = *(const f32x4*)nw, n1 = *(const f32x4*)(nw + 4);
        v[0] *= rstd * n0.x; v[1] *= rstd * n0.y; v[2] *= rstd * n0.z; v[3] *= rstd * n0.w; v[4] *= rstd * n1.x; v[5] *= rstd * n1.y; v[6] *= rstd * n1.z; v[7] *= rstd * n1.w;
        if (g < 2 && row < TT) {
            const int s = row & (SEQ - 1), prow = s >> 6, pcol = s & 63, half = j >> 2, isx2 = (j >> 1) & 1;
            const float* ct = tab + (half ? TB_CCOS + pcol * 16 : TB_RCOS + prow * 16) + 8 * (j & 1);
            const float* st = tab + (half ? TB_CSIN + pcol * 16 : TB_RSIN + prow * 16) + 8 * (j & 1);
            const f32x4 c0 = *(const f32x4*)ct, c1 = *(const f32x4*)(ct + 4), s0 = *(const f32x4*)st, s1 = *(const f32x4*)(st + 4);
            const float cc[8] = {c0.x, c0.y, c0.z, c0.w, c1.x, c1.y, c1.z, c1.w}, sn[8] = {s0.x, s0.y, s0.z, s0.w, s1.x, s1.y, s1.z, s1.w};
#pragma unroll
            for (int i = 0; i < 8; ++i) { const float pr = __shfl_xor(v[i], 2); v[i] = isx2 ? (v[i] * cc[i] + pr * sn[i]) : (v[i] * cc[i] - pr * sn[i]); }
        }
        if (g == 0 || g == 2) {
#pragma unroll
            for (int i = 0; i < 8; ++i) v[i] *= att::C2;
        }
        v4u o; o.x = pk2(v[0], v[1]); o.y = pk2(v[2], v[3]); o.z = pk2(v[4], v[5]); o.w = pk2(v[6], v[7]);
        *(v4u*)p = o;
    }
}

__device__ __forceinline__ void p4_attention(Frame& F, char* lds) {
    const bf16* P = (const bf16*)(F.ws + WS_P); bf16* OD = (bf16*)(F.ws + WS_OD); bf16* MX = (bf16*)(F.ws + WS_MIX);
    const float* tab = (const float*)(F.ws + WS_TAB); const float mref_d = tab[TB_LAM + 1], mref_n = tab[TB_LAM + 2], lam = tab[TB_LAM];
#ifndef MK_NO_DIFF
#define DIFF_UNITS(SH) for (int su = F.vcu; su < 512; su += F.G) { \
        const int bh = su >> 5, qb = su & 31, b = bh >> 2, h = bh & 3; const size_t row0 = (size_t)b * SEQ + qb * 256; \
        att::DiffPol<SH> pol; pol.Vg = P + 1024 + h * 128; pol.lat0 = (long)b * SEQ; pol.ctx0 = (long)TT + b * CTX; pol.mref = mref_d; \
        pol.Kg = P + 512 + h * 128; \
        att::attn_unit<4, att::DiffPol<SH>, 0, 1024>(P + row0 * NQKV + h * 128, pol, MX, 1024, 132, mref_d, lds); \
        pol.Kg = P + 512 + h * 128 + 64; \
        att::attn_unit<4, att::DiffPol<SH>, 1, 896>(P + row0 * NQKV + h * 128 + 64, pol, (bf16*)((unsigned char*)MX + row0 * 1024 + h * 128), 1024, 132, mref_d, lds, lam, F.in[I_SUBLN]); }
    if (mref_d <= 100.0f) { DIFF_UNITS(false) } else { DIFF_UNITS(true) }
#undef DIFF_UNITS
#endif
#ifdef MK_DBG_PHASE
    if (blockIdx.x == 0 && FTID == 0) ((unsigned*)((float*)(F.ws + WS_TAB) + TB_RC + 128))[23] = (unsigned)__builtin_amdgcn_s_memrealtime();
#endif
#ifndef MK_NO_NA
    float* tabl = (float*)(lds + att::lds_bytes<4>());
    for (int unit = F.vcu; unit < 1024; unit += F.G) {
        const int bh = unit >> 5, rb = unit & 31, b = bh >> 3, hn = bh & 7, r = rb * 4;
        int i0 = FTID; asm volatile("" : "+v"(i0));
        for (int i = i0; i < 15 * 31 + 1; i += 512) tabl[i] = i < 15 * 31 ? F.in[I_RPB][hn * 465 + i] * 1.4426950408889634f - mref_n : -INFINITY;
#define NA_UNIT(PAR) do { att::NaPol<PAR> pol; pol.Kg = P + 2048 + hn * 64; pol.Vg = P + 2560 + hn * 64; pol.lat0 = (long)b * SEQ; pol.ctx0 = (long)TT + b * CTX; \
        pol.mref = mref_n; pol.r = r; pol.rbase = (r - 4) < 0 ? 0 : ((r - 4) > 120 ? 120 : (r - 4)); pol.tab = tabl; \
        att::attn_unit<2, att::NaPol<PAR>, 2, 1024>(P + ((size_t)b * SEQ + r * 64) * NQKV + 1536 + hn * 64, pol, (bf16*)((unsigned char*)MX + ((size_t)b * SEQ + r * 64) * 1024 + 512 + hn * 64), 1024, 15, mref_n, lds, 0.f, F.in[I_ONN] + hn * 64); } while (0)
        if (F.wave & 1) NA_UNIT(1); else NA_UNIT(0);
#undef NA_UNIT
    }
#endif
}

__device__ __forceinline__ void p5_mix(Frame& F) {
    const float* tab = (const float*)(F.ws + WS_TAB); const bf16* OD = (const bf16*)(F.ws + WS_OD); const bf16* ON = (const bf16*)(F.ws + WS_ON); bf16* MX = (bf16*)(F.ws + WS_MIX);
    const int gw = F.vcu * NWAVES + F.wave, NGW = F.G * NWAVES;
    const float lam = tab[TB_LAM];
    const int h = FLANE >> 4, e0 = (FLANE & 15) * 8;
    const f32x4 sl0 = *(const f32x4*)(F.in[I_SUBLN] + e0), sl1 = *(const f32x4*)(F.in[I_SUBLN] + e0 + 4);
    const f32x4 on0 = *(const f32x4*)(F.in[I_ONN] + FLANE * 8), on1 = *(const f32x4*)(F.in[I_ONN] + FLANE * 8 + 4);
    for (int t = gw; t < TT; t += NGW) {
        const v4u a = *(const v4u*)(OD + (size_t)t * 1024 + h * 256 + e0), c = *(const v4u*)(OD + (size_t)t * 1024 + h * 256 + 128 + e0);
        const v4u n = *(const v4u*)(ON + (size_t)t * 512 + FLANE * 8);
        float d[8] = {bflo(a.x) - lam * bflo(c.x), bfhi(a.x) - lam * bfhi(c.x), bflo(a.y) - lam * bflo(c.y), bfhi(a.y) - lam * bfhi(c.y),
                      bflo(a.z) - lam * bflo(c.z), bfhi(a.z) - lam * bfhi(c.z), bflo(a.w) - lam * bflo(c.w), bfhi(a.w) - lam * bfhi(c.w)};
        float ss = 0.f;
#pragma unroll
        for (int i = 0; i < 8; ++i) ss += d[i] * d[i];
        ss += __shfl_xor(ss, 1); ss += __shfl_xor(ss, 2); ss += __shfl_xor(ss, 4); ss += __shfl_xor(ss, 8);
        const float rs = 0.8f / sqrtf(ss * (1.f / 128.f) + NORM_EPS);
        v4u o; o.x = pk2(d[0] * rs * sl0.x, d[1] * rs * sl0.y); o.y = pk2(d[2] * rs * sl0.z, d[3] * rs * sl0.w); o.z = pk2(d[4] * rs * sl1.x, d[5] * rs * sl1.y); o.w = pk2(d[6] * rs * sl1.z, d[7] * rs * sl1.w);
        *(v4u*)(MX + (size_t)t * 1024 + h * 128 + e0) = o;
        float q[8] = {bflo(n.x), bfhi(n.x), bflo(n.y), bfhi(n.y), bflo(n.z), bfhi(n.z), bflo(n.w), bfhi(n.w)};
        float s2 = 0.f;
#pragma unroll
        for (int i = 0; i < 8; ++i) s2 += q[i] * q[i];
        s2 += __shfl_xor(s2, 1); s2 += __shfl_xor(s2, 2); s2 += __shfl_xor(s2, 4);
        const float r2 = 1.0f / sqrtf(s2 * (1.f / 64.f) + NORM_EPS);
        v4u o2; o2.x = pk2(q[0] * r2 * on0.x, q[1] * r2 * on0.y); o2.y = pk2(q[2] * r2 * on0.z, q[3] * r2 * on0.w); o2.z = pk2(q[4] * r2 * on1.x, q[5] * r2 * on1.y); o2.w = pk2(q[6] * r2 * on1.z, q[7] * r2 * on1.w);
        *(v4u*)(MX + (size_t)t * 1024 + 512 + FLANE * 8) = o2;
    }
}

__device__ __forceinline__ void p7_router(Frame& F) {
    const float* tab = (const float*)(F.ws + WS_TAB); unsigned* cnt = (unsigned*)(F.ws + WS_CTL) + CW_CNT;
    int* rt_e = (int*)(F.ws + WS_RT + RT_E); float* rt_g = (float*)(F.ws + WS_RT + RT_G); int* rt_pos = (int*)(F.ws + WS_RT + RT_POS);
    LAS unsigned* cntl = (LAS unsigned*)(F.lds + MISC_OFF); LAS unsigned* basel = cntl + 32; LAS float* rstdl = (LAS float*)(F.lds + MISC_OFF + 512);
    const int j = FLANE & 31, kh = FLANE >> 5;
    for (int tile = F.vcu; tile < TT / 128; tile += F.G) {
        if (FTID < 32) cntl[FTID] = 0u;
        __syncthreads();
        int te[4] = {0, 0, 0, 0}; float tg[4] = {0, 0, 0, 0}; unsigned lp[4] = {0, 0, 0, 0}; const int t = tile * 128 + 32 * F.wave + j;
        f32x16 acc = f32x16{}, accs = f32x16{}; float ss = 0.f;
        const int bt = (tile * 128) >> 13;
#pragma unroll 1
        for (int half = 0; half < 2; ++half) {
            if (half) __syncthreads();
            { const f32x4* g4 = (const f32x4*)(F.ws + WS_WR3 + (size_t)(bt * 2 + half) * 98304) + FTID; LAS f32x4* l4 = (LAS f32x4*)F.lds + FTID;
#pragma unroll
                for (int i = 0; i < 12; ++i) l4[512 * i] = g4[512 * i]; }
            __syncthreads();
            if (F.wave < 4) {
                const bf16* xr = (const bf16*)(F.ws + WS_X1) + (size_t)t * DM + half * 512 + 8 * kh;
                const LAS unsigned char* wp = F.lds + FLANE * 16;
#pragma unroll 16
                for (int s = 0; s < 32; ++s) {
                    const att::bf16x8 xv = *(const att::bf16x8*)(xr + 16 * s);
                    const att::bf16x8 a0 = *(const LAS att::bf16x8*)(wp + s * 1024), a1 = *(const LAS att::bf16x8*)(wp + (32 + s) * 1024), a2 = *(const LAS att::bf16x8*)(wp + (64 + s) * 1024);
                    acc = __builtin_amdgcn_mfma_f32_32x32x16_bf16(a0, xv, acc, 0, 0, 0);
                    acc = __builtin_amdgcn_mfma_f32_32x32x16_bf16(a1, xv, acc, 0, 0, 0);
                    acc = __builtin_amdgcn_mfma_f32_32x32x16_bf16(a2, xv, acc, 0, 0, 0);
                    accs = __builtin_amdgcn_mfma_f32_32x32x16_bf16(xv, xv, accs, 0, 0, 0);
                }
            }
        }
        if (F.wave < 4) {
#pragma unroll
            for (int r = 0; r < 16; ++r) ss += (att::crow(r, kh) == j) ? accs[r] : 0.f;
        }
        __syncthreads();
        if (F.wave < 4) {
            const int b = t >> 13;
            ss += __shfl_xor(ss, 32);
            const float rstd = 1.0f / sqrtf(ss * (1.f / DM) + NORM_EPS);
            if (kh == 0) rstdl[32 * F.wave + j] = rstd;
            float v[16];
#pragma unroll
            for (int r = 0; r < 16; ++r) v[r] = acc[r] * rstd + tab[TB_RC + b * 32 + att::crow(r, kh)];
            float cv[8]; int ce[8];
#pragma unroll
            for (int k = 0; k < 4; ++k) { float best = -INFINITY; int bi = 0;
#pragma unroll
                for (int r = 0; r < 16; ++r) if (v[r] > best) { best = v[r]; bi = r; }
#pragma unroll
                for (int r = 0; r < 16; ++r) if (r == bi) v[r] = -INFINITY;
                cv[k] = best; ce[k] = att::crow(bi, kh); }
#pragma unroll
            for (int k = 0; k < 4; ++k) { cv[4 + k] = __shfl_xor(cv[k], 32); ce[4 + k] = __shfl_xor(ce[k], 32); }
            float tv[4];
#pragma unroll
            for (int k = 0; k < 4; ++k) { float best = -INFINITY; int be = 1 << 30, bi = 0;
#pragma unroll
                for (int q = 0; q < 8; ++q) if (cv[q] > best || (cv[q] == best && ce[q] < be)) { best = cv[q]; be = ce[q]; bi = q; }
#pragma unroll
                for (int q = 0; q < 8; ++q) if (q == bi) cv[q] = -INFINITY;
                tv[k] = best; te[k] = be; }
            const float e1 = __expf(tv[1] - tv[0]), e2 = __expf(tv[2] - tv[0]), e3 = __expf(tv[3] - tv[0]); const float inv = 1.0f / (1.0f + e1 + e2 + e3);
            tg[0] = inv; tg[1] = e1 * inv; tg[2] = e2 * inv; tg[3] = e3 * inv;
            if (kh == 0) {
#pragma unroll
                for (int k = 0; k < 4; ++k) lp[k] = __hip_atomic_fetch_add(cntl + te[k], 1u, __ATOMIC_RELAXED, __HIP_MEMORY_SCOPE_WORKGROUP);
            }
        }
        __syncthreads();
        if (FTID < 32) { const unsigned c = cntl[FTID]; basel[FTID] = c ? atomicAdd(cnt + FTID, c) : 0u; }
        __syncthreads();
        if (F.wave < 4 && kh == 0) {
#pragma unroll
            for (int k = 0; k < 4; ++k) { rt_e[t * 4 + k] = te[k]; rt_g[t * 4 + k] = tg[k]; rt_pos[t * 4 + k] = (int)(basel[te[k]] + lp[k]); }
        }
        { const int c0 = 16 * FLANE; f32x4 mA4[4], mC4[4];
#pragma unroll
          for (int q = 0; q < 4; ++q) { const f32x4 g = *(const f32x4*)(F.in[I_GFFN] + c0 + 4 * q), sc = *(const f32x4*)(tab + TB_MOD + bt * 6144 + 4 * 1024 + c0 + 4 * q);
              mA4[q] = g * (sc + 1.0f); mC4[q] = *(const f32x4*)(tab + TB_MOD + bt * 6144 + 3 * 1024 + c0 + 4 * q); }
          unsigned char* H2 = F.ws + WS_XG;
#pragma unroll 8
          for (int r = 0; r < 16; ++r) { const int tl = 16 * F.wave + r; const int tt = tile * 128 + tl; const float rs = rstdl[tl];
              const v4u* xr = (const v4u*)((const bf16*)(F.ws + WS_X1) + (size_t)tt * DM) + 2 * FLANE; const v4u x0 = xr[0], x1v = xr[1];
              const unsigned xw[8] = {x0.x, x0.y, x0.z, x0.w, x1v.x, x1v.y, x1v.z, x1v.w}; v4u o; unsigned ow[4];
#pragma unroll
              for (int q = 0; q < 4; ++q) { const f32x4 xv = {bflo(xw[2 * q]), bfhi(xw[2 * q]), bflo(xw[2 * q + 1]), bfhi(xw[2 * q + 1])}; const f32x4 h = (xv * rs) * mA4[q] + mC4[q];
                  ow[q] = pg8::pk4_fp8(pg8::sat8(h.x), pg8::sat8(h.y), pg8::sat8(h.z), pg8::sat8(h.w)); }
              o.x = ow[0]; o.y = ow[1]; o.z = ow[2]; o.w = ow[3];
              *(v4u*)(H2 + (size_t)tt * DM + c0) = o; } }
        __syncthreads();
    }
}

__device__ __forceinline__ int pad_starts(const unsigned* cnt, int lane) {
    const int c = lane < 32 ? (int)__hip_atomic_load(cnt + lane, __ATOMIC_RELAXED, __HIP_MEMORY_SCOPE_AGENT) : 0;
    int p = (c + 255) & ~255, incl = p;
#pragma unroll
    for (int o = 1; o < 64; o <<= 1) { const int n = __shfl_up(incl, o); if (lane >= o) incl += n; }
    return incl - p;
}

__device__ __forceinline__ void p8_scatter(Frame& F) {
    const unsigned* cnt = (const unsigned*)(F.ws + WS_CTL) + CW_CNT;
    const int* rt_e = (const int*)(F.ws + WS_RT + RT_E); const int* rt_pos = (const int*)(F.ws + WS_RT + RT_POS); int* rt_slot = (int*)(F.ws + WS_RT + RT_SLOT);
    unsigned* rt_tok = (unsigned*)(F.ws + WS_RT + RT_TOK);
    const int gw = F.vcu * NWAVES + F.wave, NGW = F.G * NWAVES;
    const int pst = pad_starts(cnt, FLANE);
    LAS int* pstl = (LAS int*)(F.lds + MISC_OFF);
    if (F.wave == 0 && FLANE < 33) pstl[FLANE] = pst;
    __syncthreads();
    for (int i = (int)blockIdx.x * 512 + FTID; i < TT * TOPK; i += F.G * 512) { const int slot = pstl[rt_e[i]] + rt_pos[i]; rt_slot[i] = slot; rt_tok[slot] = (unsigned)(i >> 2) * (unsigned)DM; }
    for (int e = gw; e < NE; e += NGW) { const int c = (int)__hip_atomic_load(cnt + e, __ATOMIC_RELAXED, __HIP_MEMORY_SCOPE_AGENT), s0 = __shfl(pst, e) + c, s1 = __shfl(pst, e + 1);
        for (int i = s0 + FLANE; i < s1; i += 64) rt_tok[i] = 0u; }
}

__device__ __forceinline__ int moe_block_table(Frame& F, LAS int* bexp) {
    const unsigned* cnt = (const unsigned*)(F.ws + WS_CTL) + CW_CNT;
    const int pst = pad_starts(cnt, FLANE);
    const int total = __shfl(pst, 32) >> 8;
    if (F.wave == 0) {
        const int nxt = __shfl_down(pst, 1);
        if (FLANE < 32) for (int bl = pst >> 8; bl < (nxt >> 8); ++bl) bexp[bl] = FLANE;
    }
    __syncthreads();
    return __builtin_amdgcn_readfirstlane(total);
}

__device__ __forceinline__ void p11_combine(Frame& F) {
    const float* tab = (const float*)(F.ws + WS_TAB); const unsigned char* Y = F.ws + WS_Y;
    const float* rt_g = (const float*)(F.ws + WS_RT + RT_G); const int* rt_slot = (const int*)(F.ws + WS_RT + RT_SLOT);
    const int gw = F.vcu * NWAVES + F.wave, NGW = F.G * NWAVES;
    constexpr int RB = 2;
    for (int t0 = gw; t0 < TT; t0 += RB * NGW) {
        int my_slot[RB]; float my_g[RB];
#pragma unroll
        for (int r = 0; r < RB; ++r) { const int t = t0 + r * NGW; const int tt = t < TT ? t : 0; my_slot[r] = rt_slot[tt * 4 + (FLANE & 3)]; my_g[r] = rt_g[tt * 4 + (FLANE & 3)]; }
        unsigned yw[RB][4][4]; v2u xw[RB][4];
#pragma unroll
        for (int r = 0; r < RB; ++r) { const int t = t0 + r * NGW; const int tt = t < TT ? t : 0;
            const v2u* xr = (const v2u*)((const bf16*)(F.ws + WS_X1) + (size_t)tt * DM) + FLANE;
#pragma unroll
            for (int jj = 0; jj < 4; ++jj) xw[r][jj] = xr[64 * jj];
#pragma unroll
            for (int k = 0; k < 4; ++k) { const int slot = __shfl(my_slot[r], k); const unsigned* yr = (const unsigned*)(Y + (size_t)slot * DM) + FLANE;
#pragma unroll
                for (int jj = 0; jj < 4; ++jj) yw[r][k][jj] = __builtin_nontemporal_load(yr + 64 * jj); } }
#pragma unroll
        for (int r = 0; r < RB; ++r) { const int t = t0 + r * NGW; if (t >= TT) break;
            const int b = t >> 13; f32x4* xo = (f32x4*)(F.out + (size_t)t * DM) + FLANE;
            const f32x4* g2 = (const f32x4*)(tab + TB_MOD + b * 6144 + 5 * 1024) + FLANE;
#pragma unroll
            for (int jj = 0; jj < 4; ++jj) { f32x4 acc = (f32x4){0.f, 0.f, 0.f, 0.f};
#pragma unroll
                for (int k = 0; k < 4; ++k) { const float g = __shfl(my_g[r], k); const int w = (int)yw[r][k][jj];
                    acc += (f32x4){__builtin_amdgcn_cvt_f32_fp8(w, 0), __builtin_amdgcn_cvt_f32_fp8(w, 1), __builtin_amdgcn_cvt_f32_fp8(w, 2), __builtin_amdgcn_cvt_f32_fp8(w, 3)} * g; }
                const v2u x2 = xw[r][jj];
                __builtin_nontemporal_store((f32x4){bflo(x2.x), bfhi(x2.x), bflo(x2.y), bfhi(x2.y)} + g2[64 * jj] * acc, xo + 64 * jj); }
#ifdef MK_DBG_PHASE
            __builtin_amdgcn_s_waitcnt(0); if (t == 0 && FLANE == 0) { const unsigned* ts_ = (const unsigned*)(tab + TB_RC + 128); F.out[0] += 8.0f + (float)(ts_[MK_DBG_B] - ts_[MK_DBG_A]) * (0.01f / (MK_DBG_DIV)); }
#endif
        }
    }
}

#define XB_TMO      128
#define XB_XCNT(j)  (256  + 64 * (j))
#define XB_XSUB(j)  (1280 + 64 * (j))
#define XB_XGEN(j)  (2304 + 64 * (j))
#define XB_TOP      3328
#define XB_TOPGEN   3392
#define XCD_BAR_WORDS 3456
#define XB_SPIN_CAP (1u << 18)

__device__ __forceinline__ unsigned xb_ld(unsigned* p)              { return __hip_atomic_load(p, __ATOMIC_RELAXED, __HIP_MEMORY_SCOPE_AGENT); }
__device__ __forceinline__ unsigned xb_add(unsigned* p, unsigned v) { return __hip_atomic_fetch_add(p, v, __ATOMIC_RELAXED, __HIP_MEMORY_SCOPE_AGENT); }
__device__ __forceinline__ unsigned xb_xcc_id() { return (unsigned)__builtin_amdgcn_s_getreg((3 << 11) | 20) & 0xFu; }
#define XB_SPIN(cond, bar) do { unsigned _sp = 0; while (cond) { __builtin_amdgcn_s_sleep(1); \
    if ((++_sp & 255u) == 0u) { if (xb_ld(&(bar)[XB_TMO])) break; if (_sp > XB_SPIN_CAP) { atomicAdd(&(bar)[XB_TMO], 1u); break; } } } } while (0)

struct XcdBarrier {
    unsigned* bar; unsigned x;
    volatile LAS unsigned* st;
};

__device__ __forceinline__ XcdBarrier xcd_barrier_post(unsigned* bar, volatile LAS unsigned* st) {
    XcdBarrier b; b.bar = bar; b.x = xb_xcc_id(); b.st = st;
    if (threadIdx.x == 0) (void)xb_add(&bar[XB_XCNT(b.x)], 1u);
    return b;
}
__device__ __forceinline__ void xcd_barrier_complete(unsigned* bar, unsigned x, unsigned& nloc, unsigned& nx) {
    const unsigned G = gridDim.x * gridDim.y * gridDim.z;
    unsigned sum, cnt, mine, sp = 0u;
    for (;;) {
        sum = 0u; cnt = 0u; mine = 0u;
#pragma unroll
        for (unsigned j = 0; j < 16; ++j) { const unsigned c = xb_ld(&bar[XB_XCNT(j)]); sum += c; cnt += (c > 0u) ? 1u : 0u; mine = (j == x) ? c : mine; }
        if (sum == G) break;
        __builtin_amdgcn_s_sleep(1);
        if ((++sp & 255u) == 0u) { if (xb_ld(&bar[XB_TMO])) break; if (sp > XB_SPIN_CAP) { atomicAdd(&bar[XB_TMO], 1u); break; } }
    }
    nloc = mine > 0u ? mine : 1u; nx = cnt > 0u ? cnt : 1u;
}

__device__ __forceinline__ void xcd_barrier(const XcdBarrier& b) {
    asm volatile("s_waitcnt vmcnt(0)" ::: "memory");
    __syncthreads();
    if (threadIdx.x == 0) {
        unsigned* bar = b.bar;
        __builtin_amdgcn_s_waitcnt(0);
        unsigned nloc = b.st[0], nx = b.st[1];
        if (nloc == 0u) { xcd_barrier_complete(bar, b.x, nloc, nx); b.st[0] = nloc; b.st[1] = nx; }
        const unsigned old = xb_add(&bar[XB_XSUB(b.x)], 1u);
        const unsigned gen = old / nloc;
        if (old + 1u == (gen + 1u) * nloc) {
            __builtin_amdgcn_fence(__ATOMIC_RELEASE, "agent");
            asm volatile("s_waitcnt vmcnt(0)" ::: "memory");
            const unsigned og = xb_add(&bar[XB_TOP], 1u);
            const unsigned tg = og / nx;
            if (og + 1u == (tg + 1u) * nx) xb_add(&bar[XB_TOPGEN], 1u);
            else XB_SPIN(xb_ld(&bar[XB_TOPGEN]) == tg, bar);
            __builtin_amdgcn_fence(__ATOMIC_ACQUIRE, "agent");
            xb_add(&bar[XB_XGEN(b.x)], 1u);
            asm volatile("s_waitcnt vmcnt(0)" ::: "memory");
        } else {
            XB_SPIN(xb_ld(&bar[XB_XGEN(b.x)]) == gen, bar);
            __builtin_amdgcn_fence(__ATOMIC_ACQUIRE, "agent");
            asm volatile("s_waitcnt vmcnt(0)" ::: "memory");
        }
    }
    __syncthreads();
}

struct Args { const float* in[N_IN]; float* out; unsigned char* ws; int ph_lo, ph_hi, li, pad; };
__global__ void __launch_bounds__(NWAVES * 64, 2) mk_fwd(Args args) {
    extern __shared__ __attribute__((aligned(16))) unsigned char lds[];
    Frame F;
    F.lds = (LAS unsigned char*)lds;
    F.wave = __builtin_amdgcn_readfirstlane((int)threadIdx.x >> 6);
    F.G = gridDim.x; { const int bx = blockIdx.x; F.vcu = (F.G % 8 == 0) ? (bx % 8) * (F.G / 8) + bx / 8 : bx; }
#pragma unroll
    for (int i = 0; i < N_IN; ++i) F.in[i] = args.in[i];
    F.out = args.out; F.ws = args.ws;
    const int lo = args.ph_lo, hi = args.ph_hi;
    volatile LAS unsigned* bst = (volatile LAS unsigned*)(F.lds + LDS_BYTES - 16);
    if (FTID < 2) bst[FTID] = 0u;
    __syncthreads();
    XcdBarrier bar; bar.bar = (unsigned*)(F.ws + WS_CTL) + CW_BAR + args.li * XCD_BAR_WORDS; bar.x = 0; bar.st = nullptr;
    if (hi - lo > 1) bar = xcd_barrier_post((unsigned*)(F.ws + WS_CTL) + CW_BAR + args.li * XCD_BAR_WORDS, bst);
#ifndef MK_PHASE_MASK
#define MK_PHASE_MASK 0xFFF
#endif
#define IN(k) (((MK_PHASE_MASK >> (k)) & 1) && lo <= (k) && (k) < hi)
    if (args.pad != 0) cg::this_grid().sync();
#ifdef MK_DBG_PHASE
    unsigned* tsb = (unsigned*)((float*)(F.ws + WS_TAB) + TB_RC + 128);
#define STAMP(k) do { if (blockIdx.x == 0 && FTID == 0) tsb[(k)] = (unsigned)__builtin_amdgcn_s_memrealtime(); } while (0)
    STAMP(0);
#else
#define STAMP(k) do {} while (0)
#endif
#define SEAM(k) do { if (IN(k) && IN((k) + 1)) { xcd_barrier(bar); } STAMP((k) + 1); } while (0)
    if (IN(0)) { p0_prologue(F); STAMP(12); } SEAM(0);
    if (IN(1)) { p1_norm(F); STAMP(19); } SEAM(1);
    if (IN(2)) {
        pg8::Gemm g{(const bf16*)(F.ws + WS_XN), (const bf16*)(F.ws + WS_WQKV), MQ, NQKV, DM, 0};
        pg8::StaticOrder S; S.init(MQ, NQKV, F.G, (int)blockIdx.x);
        typedef pg8::EpiQKV<TB_NW, TB_RCOS, TB_RSIN, TB_CCOS, TB_CSIN> EpiQ;
        EpiQ E{(bf16*)(F.ws + WS_P), (const float*)(F.ws + WS_TAB), (LAS float*)(F.lds + MISC_OFF + 5120), att::C2};
        pg8::gemm_phase<EpiQ, pg8::StaticOrder, true, true, 1>(F.lds, g, S, E); STAMP(16);
        { const int nd = p0_deferred(F.G), rem = (MQ / 256 * (NQKV / 256)) % F.G;
          if (nd > 0 && (int)blockIdx.x >= rem) { __syncthreads(); p0_convert(F, ((int)blockIdx.x - rem) * NWAVES + F.wave, (F.G - rem) * NWAVES, P0_N8 - nd, P0_N8); } }
    } SEAM(2);
#ifdef MK_SEPARATE_QKNORM
    if (IN(3)) { p3_qknorm(F); } SEAM(3);
#endif
    if (IN(4)) { p4_attention(F, (char*)lds); STAMP(17); } SEAM(4);
#ifdef MK_SEPARATE_MIX
    if (IN(5)) { p5_mix(F); } SEAM(5);
#endif
    if (IN(6)) {
        pg8::Gemm g{(const bf16*)(F.ws + WS_MIX), (const bf16*)(F.ws + WS_WO), TT, DM, DM, 0};
        pg8::StaticOrder S; S.init(TT, DM, F.G, (int)blockIdx.x);
        pg8::EpiOut E{F.in[I_X], (bf16*)(F.ws + WS_X1), (const float*)(F.ws + WS_TAB) + TB_MOD};
        pg8::gemm_phase<pg8::EpiOut, pg8::StaticOrder, true, true, 1>(F.lds, g, S, E); STAMP(18);
    } SEAM(6);
    if (IN(7)) { p7_router(F); STAMP(20); } SEAM(7);
    if (IN(8)) { p8_scatter(F); STAMP(21); } SEAM(8);
    if (IN(9)) {
        LAS int* bexp = (LAS int*)(F.lds + MISC_OFF + 1024);
        const int nblk = moe_block_table(F, bexp);
        pg8::Gemm g{(const bf16*)(F.ws + WS_XG), (const bf16*)(F.ws + WS_WGU), MPAD, 2048, DM, (size_t)2048 * 1024};
        g.atab = (const unsigned*)(F.ws + WS_RT + RT_TOK); g.tkl = (LAS unsigned*)(F.lds + MISC_OFF + 5120);
        pg8::MoeOrder S; S.init(nblk, 8, F.G, (int)blockIdx.x, bexp);
        pg8::EpiSwiGLU E{F.ws + WS_ACT, F.in[I_BGU], (LAS float*)(F.lds + MISC_OFF + 13312)};
        pg8::gemm_phase<pg8::EpiSwiGLU, pg8::MoeOrder, true, true, 1, true>(F.lds, g, S, E); STAMP(14);
    } SEAM(9);
    if (IN(10)) {
        LAS int* bexp = (LAS int*)(F.lds + MISC_OFF + 1024);
        const int nblk = moe_block_table(F, bexp);
        pg8::Gemm g{(const bf16*)(F.ws + WS_ACT), (const bf16*)(F.ws + WS_WDN), MPAD, 1024, DM, (size_t)1024 * 1024};
        pg8::MoeOrder S; S.init(nblk, 4, F.G, (int)blockIdx.x, bexp);
        pg8::EpiDown E{F.ws + WS_Y, F.in[I_BD], (LAS float*)(F.lds + MISC_OFF + 13312)};
        pg8::gemm_phase<pg8::EpiDown, pg8::MoeOrder, true, true, 1>(F.lds, g, S, E); STAMP(15);
    } SEAM(10);
    if (IN(11)) { p11_combine(F); }
#ifdef MK_DBG_TAIL
    xcd_barrier(bar); STAMP(13);
    if (blockIdx.x == 0 && FTID == 0) { __builtin_amdgcn_s_waitcnt(0); const unsigned* ts_ = (const unsigned*)((const float*)(F.ws + WS_TAB) + TB_RC + 128); F.out[0] += 8.0f + (float)(ts_[13] - ts_[11]) * (0.01f / 2.0f); }
#endif
#undef IN
#undef SEAM
}

extern "C" void kernel_launch(void* const* d_in, const int* in_sizes, int n_in, void* d_out, int out_size, void* d_ws, size_t ws_size, hipStream_t stream) {
    static int grid = 0;
    if (grid == 0) {
        if (n_in != N_IN || in_sizes[0] != TT * DM || out_size != TT * DM || ws_size < WS_END) { fprintf(stderr, "kernel_launch: unexpected shapes (n_in %d, in0 %d, out %d, ws %zu)\n", n_in, n_in > 0 ? in_sizes[0] : -1, out_size, ws_size); grid = -1; return; }
        int dev = 0, cus = 0, per_cu = 0;
        if (hipGetDevice(&dev) != hipSuccess || hipDeviceGetAttribute(&cus, hipDeviceAttributeMultiprocessorCount, dev) != hipSuccess) { grid = -1; return; }
        if (hipFuncSetAttribute((const void*)mk_fwd, hipFuncAttributeMaxDynamicSharedMemorySize, LDS_BYTES) != hipSuccess) { fprintf(stderr, "kernel_launch: hipFuncSetAttribute failed\n"); grid = -1; return; }
        if (hipOccupancyMaxActiveBlocksPerMultiprocessor(&per_cu, (const void*)mk_fwd, NWAVES * 64, LDS_BYTES) != hipSuccess || per_cu < 1) { fprintf(stderr, "kernel_launch: occupancy query reports %d\n", per_cu); (void)hipGetLastError(); per_cu = 1; }
        grid = cus;
    }
    if (grid < 0) return;
    (void)hipMemsetAsync((char*)d_ws + WS_CTL, 0, CTL_ZERO_BYTES, stream);
    Args a{};
    for (int i = 0; i < N_IN; ++i) a.in[i] = (const float*)d_in[i];
    a.out = (float*)d_out; a.ws = (unsigned char*)d_ws;
    int lo_[3] = {0, 0, 0}, hi_[3] = {N_PHASES, 0, 0}, nl = 1;
    if (MK_PROBE_PHASE >= 0) { nl = 0; lo_[nl] = 0; hi_[nl] = MK_PROBE_PHASE + 1; ++nl; lo_[nl] = MK_PROBE_PHASE; hi_[nl] = MK_PROBE_PHASE + 1; ++nl; if (MK_PROBE_PHASE + 1 < N_PHASES) { lo_[nl] = MK_PROBE_PHASE + 1; hi_[nl] = N_PHASES; ++nl; } }
#ifdef MK_TWICE
    nl = 2; lo_[1] = 0; hi_[1] = N_PHASES;
#endif
    for (int li = 0; li < nl; ++li) {
#ifdef MK_TWICE
        if (li == 1) (void)hipMemsetAsync((char*)d_ws + WS_CTL, 0, CTL_ZERO_BYTES, stream);
#endif
        a.ph_lo = lo_[li]; a.ph_hi = hi_[li]; a.li = (MK_PROBE_PHASE >= 0) ? li : 0;
        void* params[] = {&a};
        const hipError_t e = hipLaunchCooperativeKernel((const void*)mk_fwd, dim3(grid), dim3(NWAVES * 64), params, LDS_BYTES, stream);
        if (e != hipSuccess) fprintf(stderr, "kernel_launch: cooperative launch failed: %s (grid %d)\n", hipGetErrorString(e), grid);
    }
}
```

```cpp
#include <hip/hip_runtime.h>
#include <hip/hip_cooperative_groups.h>
#include <cstdio>
#include <cstdint>
namespace cg = cooperative_groups;
namespace pg8 {
#define PG8_LAS __attribute__((address_space(3)))
typedef unsigned short bf16_t;
typedef short bf16x8 __attribute__((ext_vector_type(8)));
typedef float f32x4 __attribute__((ext_vector_type(4)));
typedef unsigned u32x4 __attribute__((ext_vector_type(4)));
constexpr int BM = 256, BK = 64, HALF = 128, HTB = HALF * BK * 2  , STAGE_BYTES = 8 * HTB, NXCD = 8, WGM = 8;

__host__ __device__ __forceinline__ int lds_byte(int r, int c) { const int st = (r >> 4) * 2 + (c >> 5), rr = r & 15, cc = c & 31, ob = rr * 64 + cc * 2; return st * 1024 + (ob ^ (((ob >> 9) & 1) << 5)); }
__host__ __device__ __forceinline__ void stage_rc(int b, int& R, int& C) { const int st = b / 1024, sb = b % 1024, swz = sb ^ (((sb >> 9) & 1) << 5); R = (st >> 1) * 16 + swz / 64; C = (st & 1) * 32 + (swz % 64) / 2; }
__host__ __device__ __forceinline__ int perm32(int rho) { const int n = rho >> 4, i = rho & 15; return 8 * (i >> 2) + 4 * n + (i & 3); }

struct Unit { int pm, pn, e; };
struct Gemm { const bf16_t* A; const bf16_t* Bt; int M, N, K; size_t estride; const unsigned* atab = nullptr; PG8_LAS unsigned* tkl = nullptr; };

struct StaticOrder {
    int nM, nN, nwg, G, c;
    __host__ __device__ void init(int M, int N, int G_, int c_) { nM = M / BM; nN = N / BM; nwg = nM * nN; G = G_; c = c_; }
    __host__ __device__ bool next(int i, Unit& u) const {
        const long L = (long)i * G + c; if (L >= nwg) return false;
        int wgid = (int)L; { const int q = nwg / NXCD, r = nwg % NXCD, xcd = wgid % NXCD, off = wgid / NXCD; wgid = (xcd < r ? xcd * (q + 1) : r * (q + 1) + (xcd - r) * q) + off; }
        const int nig = WGM * nN, gid = wgid / nig, fm = gid * WGM, gsz = (nM - fm) < WGM ? (nM - fm) : WGM;
        u.pm = fm + ((wgid % nig) % gsz); u.pn = (wgid % nig) / gsz; u.e = 0; return true;
    }
    __device__ __forceinline__ void a_ready(const Unit&) const {}
    __device__ __forceinline__ void done(const Unit&) const {}
};

__device__ __forceinline__ unsigned cvt_pk_bf16(float lo, float hi) { unsigned r; asm volatile("v_cvt_pk_bf16_f32 %0, %1, %2" : "=v"(r) : "v"(lo), "v"(hi)); return r; }
typedef float f32x2 __attribute__((ext_vector_type(2)));
__device__ __forceinline__ f32x2 gelu_pk(f32x2 v) {
    const f32x2 av = __builtin_elementwise_abs(v), d = av * 0.2316418882f + 1.0f;
    f32x2 t; t.x = __builtin_amdgcn_rcpf(d.x); t.y = __builtin_amdgcn_rcpf(d.y);
    f32x2 q = t * 0.5307027145f + (-0.7265760135f); q = q * t + 0.7107068705f; q = q * t + (-0.142248368f); q = q * t + 0.127414796f; q = q * t;
    const f32x2 s = (v * v) * (-0.72134752044f);
    f32x2 e; e.x = __builtin_amdgcn_exp2f(s.x); e.y = __builtin_amdgcn_exp2f(s.y);
    const f32x2 m = v * (q * e), r = v - m;
    f32x2 o; o.x = v.x < 0.f ? m.x : r.x; o.y = v.y < 0.f ? m.y : r.y; return o;
}

template <int ACT  > struct EpiBf16 {
    static constexpr bool PERM = true, AFTER_DRAIN = false; static_assert(ACT == 0 || ACT == 1, "EpiBf16: ACT is 0 (none) or 1 (gelu_pk)");
    __device__ __forceinline__ void prefetch(const Unit&, int, int, int) const {}
    bf16_t* O; int ldc; const float* bias; int split_cols; size_t split_stride; float scale0;
    __device__ __forceinline__ void operator()(const f32x4 (&acc)[2][2][4][2], const Unit& u, int wr, int wc, int fr, int fq, int = 0) const {
        const int row0 = u.pm * BM + wr * 64 + fr; int colt = u.pn * BM; bf16_t* base = O;
        float sc = 1.f; if (split_cols) { const int t = colt / split_cols; base += (size_t)t * split_stride; colt -= t * split_cols; if (t == 0) sc = scale0; }
        const int col0 = colt + wc * 32 + 8 * fq, bcol0 = u.pn * BM + wc * 32 + 8 * fq;
        f32x4 bv[2][2];
#pragma unroll
        for (int bj = 0; bj < 2; ++bj)
#pragma unroll
            for (int n = 0; n < 2; ++n) bv[bj][n] = bias ? *(const f32x4*)(bias + bcol0 + bj * HALF + 4 * n) : (f32x4){0.f, 0.f, 0.f, 0.f};
#pragma unroll
        for (int ai = 0; ai < 2; ++ai)
#pragma unroll
            for (int m = 0; m < 4; ++m) { bf16_t* rowp = base + (size_t)(row0 + ai * HALF + m * 16) * ldc + col0;
#pragma unroll
                for (int bj = 0; bj < 2; ++bj) { f32x4 v0 = acc[ai][bj][m][0] + bv[bj][0], v1 = acc[ai][bj][m][1] + bv[bj][1];
                    if (ACT == 1) { f32x2 a = gelu_pk((f32x2){v0[0], v0[1]}), b = gelu_pk((f32x2){v0[2], v0[3]}), c = gelu_pk((f32x2){v1[0], v1[1]}), d = gelu_pk((f32x2){v1[2], v1[3]});
                        v0 = (f32x4){a.x, a.y, b.x, b.y}; v1 = (f32x4){c.x, c.y, d.x, d.y}; }
                    v0 = v0 * sc; v1 = v1 * sc; u32x4 w; w.x = cvt_pk_bf16(v0[0], v0[1]); w.y = cvt_pk_bf16(v0[2], v0[3]); w.z = cvt_pk_bf16(v1[0], v1[1]); w.w = cvt_pk_bf16(v1[2], v1[3]);
                    *(u32x4*)(rowp + bj * HALF) = w; } }
    }
};

typedef int i32x4 __attribute__((ext_vector_type(4)));
typedef int i32x8 __attribute__((ext_vector_type(8)));
__device__ __forceinline__ i32x8 cat8(bf16x8 lo, bf16x8 hi) { const i32x4 a = __builtin_bit_cast(i32x4, lo), b = __builtin_bit_cast(i32x4, hi); return __builtin_shufflevector(a, b, 0, 1, 2, 3, 4, 5, 6, 7); }
template <class Epi, class Sched, bool ALIGN_EPI = false, bool SP2 = false, int ESZ = 2, bool AGATHER = false>
__device__ __forceinline__ void gemm_phase(PG8_LAS unsigned char* lds, const Gemm g, const Sched& S, const Epi& E) {
    const int tid = threadIdx.x, wid = __builtin_amdgcn_readfirstlane(tid >> 6), lane = tid & 63, wr = wid >> 2, wc = wid & 3, fr = lane & 15, fq = lane >> 4;
    const int K = g.K, nt = K * ESZ / (BK * 2);
    unsigned voffA[2], voffB[2];
#pragma unroll
    for (int i = 0; i < 2; ++i) { int R, C; stage_rc(tid * 16 + i * 8192, R, C); const int Rb = Epi::PERM ? ((R & ~31) + perm32(R & 31)) : R;
        voffA[i] = (unsigned)(R * K * ESZ + C * 2); voffB[i] = (unsigned)(Rb * K * ESZ + C * 2); }
    static_assert(!AGATHER || SP2, "AGATHER is written for the SP2 schedule");
    int gR0 = 0, gC2 = 0; { int R, C; stage_rc(tid * 16, R, C); gR0 = R; gC2 = C * 2; }
    unsigned offA[2][2] = {{0u, 0u}, {0u, 0u}};
#define PG8_TKLOAD(par, h) do { int r0_ = gR0; asm volatile("" : "+v"(r0_));   \
        const PG8_LAS unsigned* tp_ = g.tkl + (par) * 256 + (h) * 128 + r0_; offA[h][0] = tp_[0] + (unsigned)gC2; offA[h][1] = tp_[64] + (unsigned)gC2; } while (0)
    const size_t kstep = (size_t)(BK * 2);
    const size_t hstep = (size_t)HALF * K * ESZ;
    const size_t tstep = 2 * hstep;
    const unsigned ldsw = (unsigned)wid * 1024u;
    const unsigned ldsb = (unsigned)__builtin_amdgcn_readfirstlane((int)((unsigned)(size_t)lds + ldsw));
    const int aoff = lds_byte(wr * 64 + fr, fq * 8), boff = lds_byte(wc * 32 + fr, fq * 8);
#define PG8_SA(b, h) (((b) * 2 + (h)) * HTB)
#define PG8_SB(b, h) ((4 + (b) * 2 + (h)) * HTB)
#define PG8_STAGE(bufoff, gbase, voff) do { _Pragma("unroll") for (int _i = 0; _i < 2; ++_i) \
        { unsigned keep_; asm volatile("s_mov_b32 %0, m0\n\ts_mov_b32 m0, %3\n\ts_nop 0\n\tglobal_load_lds_dwordx4 %1, %2\n\ts_mov_b32 m0, %0" : "=&s"(keep_) : "v"((voff)[_i]), "s"((const char*)(gbase)), "s"((unsigned)ldsb + (unsigned)((bufoff) + _i * 8192)) : "memory"); } } while (0)
#define PG8_STAGEA(bufoff, gbase, H) do { if constexpr (AGATHER) PG8_STAGE(bufoff, gbase, offA[H]); else PG8_STAGE(bufoff, (gbase) + (H) * hstep, voffA); } while (0)
#define PG8_LDA(dst, b, h) do { _Pragma("unroll") for (int m = 0; m < 4; ++m) _Pragma("unroll") for (int k = 0; k < 2; ++k) dst[m][k] = *(const PG8_LAS bf16x8*)(lds + PG8_SA(b, h) + aoff + m * 2048 + k * 1024); } while (0)
#define PG8_LDB(dst, b, h) do { _Pragma("unroll") for (int n = 0; n < 2; ++n) _Pragma("unroll") for (int k = 0; k < 2; ++k) dst[n][k] = *(const PG8_LAS bf16x8*)(lds + PG8_SB(b, h) + boff + n * 2048 + k * 1024); } while (0)
#define PG8_MMA(ai, bj, At, Bt) do { __builtin_amdgcn_s_setprio(1); _Pragma("unroll") for (int m = 0; m < 4; ++m) _Pragma("unroll") for (int n = 0; n < 2; ++n) { \
        if constexpr (ESZ == 2) { _Pragma("unroll") for (int k = 0; k < 2; ++k) acc[ai][bj][m][n] = __builtin_amdgcn_mfma_f32_16x16x32_bf16(Bt[n][k], At[m][k], acc[ai][bj][m][n], 0, 0, 0); } \
        else { acc[ai][bj][m][n] = __builtin_amdgcn_mfma_scale_f32_16x16x128_f8f6f4(cat8(Bt[n][0], Bt[n][1]), cat8(At[m][0], At[m][1]), acc[ai][bj][m][n], 0, 0, 0, 0x7f7f7f7f, 0, 0x7f7f7f7f); } } \
        if constexpr (ESZ == 1) {   \
            _Pragma("unroll") for (int m = 0; m < 4; ++m) asm volatile("" : "+v"(acc[ai][bj][m][0]), "+v"(acc[ai][bj][m][1])); } \
        __builtin_amdgcn_s_setprio(0); } while (0)
#define PG8_WAIT_V(n) asm volatile("s_waitcnt vmcnt(" #n ")" ::: "memory")
#define PG8_WAIT_L(n) asm volatile("s_waitcnt lgkmcnt(" #n ")" ::: "memory")
#define PG8_BAR __builtin_amdgcn_s_barrier()
#define PG8_SCHED __builtin_amdgcn_sched_barrier(0)
    Unit cur, nxt; int ui = 0;
    if (!S.next(0, cur)) return;
    f32x4 acc[2][2][4][2];
#pragma unroll
    for (int a = 0; a < 2; ++a)
#pragma unroll
        for (int b = 0; b < 2; ++b)
#pragma unroll
            for (int m = 0; m < 4; ++m)
#pragma unroll
                for (int n = 0; n < 2; ++n) acc[a][b][m][n] = (f32x4){0.f, 0.f, 0.f, 0.f};
    bf16x8 At[4][2], B0[2][2], B1[2][2];
    const char* cA = (const char*)g.A + (AGATHER ? (size_t)0 : (size_t)cur.pm * tstep); const char* cB = (const char*)g.Bt + (size_t)cur.e * g.estride + (size_t)cur.pn * tstep;
    S.a_ready(cur);
    E.prefetch(cur, ui, wid, lane);
    if constexpr (AGATHER) {
        if (wid == 1) __builtin_amdgcn_global_load_lds(g.atab + (size_t)cur.pm * 256 + lane * 4, (PG8_LAS unsigned*)g.tkl, 16, 0, 0);
        asm volatile("s_waitcnt vmcnt(0)" ::: "memory"); __builtin_amdgcn_s_barrier(); asm volatile("" ::: "memory");
        PG8_TKLOAD(0, 0); PG8_TKLOAD(0, 1);
    }
    if constexpr (SP2) {
        PG8_STAGE(PG8_SB(0, 0), cB, voffB); PG8_STAGE(PG8_SB(0, 1), cB + hstep, voffB); PG8_STAGEA(PG8_SA(0, 0), cA, 0); PG8_STAGEA(PG8_SA(0, 1), cA, 1);
        if (wr == 1) PG8_BAR;
        PG8_WAIT_V(2); PG8_BAR;
        PG8_STAGE(PG8_SB(1, 0), cB + kstep, voffB); PG8_STAGEA(PG8_SA(1, 0), cA + kstep, 0); PG8_STAGE(PG8_SB(1, 1), cB + hstep + kstep, voffB);
        PG8_WAIT_V(6); PG8_BAR;
    } else {
        PG8_STAGE(PG8_SB(0, 0), cB, voffB); PG8_STAGEA(PG8_SA(0, 0), cA, 0); PG8_STAGE(PG8_SB(0, 1), cB + hstep, voffB); PG8_STAGEA(PG8_SA(0, 1), cA, 1);
        if (wr == 1) PG8_BAR;
        PG8_WAIT_V(4); PG8_BAR;
        PG8_STAGE(PG8_SB(1, 0), cB + kstep, voffB); PG8_STAGEA(PG8_SA(1, 0), cA + kstep, 0); PG8_STAGE(PG8_SB(1, 1), cB + hstep + kstep, voffB);
        PG8_WAIT_V(6); PG8_BAR;
    }
    for (;;) {
        const bool has_next = S.next(ui + 1, nxt);
        if constexpr (AGATHER) { if (has_next && wid == 1) { int l_ = lane; asm volatile("" : "+v"(l_)); __builtin_amdgcn_global_load_lds(g.atab + (size_t)nxt.pm * 256 + l_ * 4, (PG8_LAS unsigned*)(g.tkl + ((ui + 1) & 1) * 256), 16, 0, 0); } }
        const char* nA = (has_next && !AGATHER) ? (const char*)g.A + (size_t)nxt.pm * tstep : cA; const char* nB = has_next ? (const char*)g.Bt + (size_t)nxt.e * g.estride + (size_t)nxt.pn * tstep : cB;
        for (int t = 0; t < nt; t += 2) {
            const bool last = (t == nt - 2);
            const char* a1 = cA + (size_t)(t + 1) * kstep;
            const char* a2 = last ? nA : cA + (size_t)(t + 2) * kstep; const char* b2 = last ? nB : cB + (size_t)(t + 2) * kstep;
            const char* a3 = a2 + kstep; const char* b3 = b2 + kstep;
            if (last && has_next) S.a_ready(nxt);
            if constexpr (AGATHER) { if (last && has_next) PG8_TKLOAD((ui + 1) & 1, 0); }
            if constexpr (SP2) {
            PG8_LDB(B0, 0, 0); PG8_LDB(B1, 0, 1); PG8_SCHED; PG8_LDA(At, 0, 0); PG8_STAGEA(PG8_SA(1, 1), a1, 1);
            if constexpr (AGATHER) { if (last && has_next) PG8_TKLOAD((ui + 1) & 1, 1); }
            PG8_WAIT_V(8); PG8_WAIT_L(0); PG8_BAR; PG8_MMA(0, 0, At, B0); PG8_MMA(0, 1, At, B1); PG8_BAR; PG8_SCHED;
            PG8_LDA(At, 0, 1); PG8_STAGE(PG8_SB(0, 0), b2, voffB); PG8_STAGE(PG8_SB(0, 1), b2 + hstep, voffB); PG8_STAGEA(PG8_SA(0, 0), a2, 0);
            PG8_WAIT_V(8); PG8_WAIT_L(0); PG8_BAR; PG8_MMA(1, 0, At, B0); PG8_MMA(1, 1, At, B1); PG8_BAR; PG8_SCHED;
            PG8_LDB(B0, 1, 0); PG8_LDB(B1, 1, 1); PG8_SCHED; PG8_LDA(At, 1, 0); PG8_STAGEA(PG8_SA(0, 1), a2, 1);
            PG8_WAIT_V(8); PG8_WAIT_L(0); PG8_BAR; PG8_MMA(0, 0, At, B0); PG8_MMA(0, 1, At, B1); PG8_BAR; PG8_SCHED;
            PG8_LDA(At, 1, 1); PG8_STAGE(PG8_SB(1, 0), b3, voffB); PG8_STAGE(PG8_SB(1, 1), b3 + hstep, voffB); PG8_STAGEA(PG8_SA(1, 0), a3, 0);
            PG8_WAIT_V(8); PG8_WAIT_L(0); PG8_BAR; PG8_MMA(1, 0, At, B0); PG8_MMA(1, 1, At, B1); PG8_BAR; PG8_SCHED;
            } else {
            PG8_LDB(B0, 0, 0); PG8_SCHED; PG8_LDA(At, 0, 0); PG8_STAGEA(PG8_SA(1, 1), a1, 1);
            PG8_WAIT_L(8); PG8_BAR; PG8_WAIT_L(0); PG8_MMA(0, 0, At, B0); PG8_BAR; PG8_SCHED;
            PG8_LDB(B1, 0, 1); PG8_STAGE(PG8_SB(0, 0), b2, voffB);
            PG8_BAR; PG8_WAIT_L(0); PG8_MMA(0, 1, At, B1); PG8_BAR;
            PG8_LDA(At, 0, 1); PG8_STAGEA(PG8_SA(0, 0), a2, 0);
            PG8_BAR; PG8_WAIT_L(0); PG8_MMA(1, 0, At, B0); PG8_BAR; PG8_SCHED;
            PG8_STAGE(PG8_SB(0, 1), b2 + hstep, voffB);
            PG8_WAIT_V(6); PG8_BAR; PG8_MMA(1, 1, At, B1); PG8_BAR;
            PG8_LDB(B0, 1, 0); PG8_SCHED; PG8_LDA(At, 1, 0); PG8_STAGEA(PG8_SA(0, 1), a2, 1);
            PG8_WAIT_L(8); PG8_BAR; PG8_WAIT_L(0); PG8_MMA(0, 0, At, B0); PG8_BAR; PG8_SCHED;
            PG8_LDB(B1, 1, 1); PG8_STAGE(PG8_SB(1, 0), b3, voffB);
            PG8_BAR; PG8_WAIT_L(0); PG8_MMA(0, 1, At, B1); PG8_BAR;
            PG8_LDA(At, 1, 1); PG8_STAGEA(PG8_SA(1, 0), a3, 0);
            PG8_BAR; PG8_WAIT_L(0); PG8_MMA(1, 0, At, B0); PG8_BAR; PG8_SCHED;
            PG8_STAGE(PG8_SB(1, 1), b3 + hstep, voffB);
            PG8_WAIT_V(6); PG8_BAR; PG8_MMA(1, 1, At, B1); PG8_BAR;
            }
        }
        if constexpr (ALIGN_EPI) { if (wr == 0) PG8_BAR; }
        if constexpr (!Epi::AFTER_DRAIN) { E(acc, cur, wr, wc, fr, fq, ui); S.done(cur); }
        if (!has_next) break;
#pragma unroll
        for (int a = 0; a < 2; ++a)
#pragma unroll
            for (int b = 0; b < 2; ++b)
#pragma unroll
                for (int m = 0; m < 4; ++m)
#pragma unroll
                    for (int n = 0; n < 2; ++n) acc[a][b][m][n] = (f32x4){0.f, 0.f, 0.f, 0.f};
        cur = nxt; cA = nA; cB = nB; ++ui;
        E.prefetch(cur, ui, wid, lane);
        if constexpr (ALIGN_EPI) { if (wr == 1) PG8_BAR; }
    }
    PG8_WAIT_V(0);
    if constexpr (!ALIGN_EPI) { if (wr == 0) PG8_BAR; }
    PG8_BAR;
    if constexpr (Epi::AFTER_DRAIN) { E.fused(acc, cur, wr, wc, fr, fq, lds, wid, lane); S.done(cur); }
#undef PG8_STAGEA
#undef PG8_TKLOAD
#undef PG8_SA
#undef PG8_SB
#undef PG8_STAGE
#undef PG8_LDA
#undef PG8_LDB
#undef PG8_MMA
#undef PG8_WAIT_V
#undef PG8_WAIT_L
#undef PG8_BAR
#undef PG8_SCHED
}
}

namespace pg8 {
struct MoeOrder {
    int nM, nN, nwg, G, c; const PG8_LAS int* bexp;
    __device__ __forceinline__ void init(int nM_, int nN_, int G_, int c_, const PG8_LAS int* bexp_) { nM = nM_; nN = nN_; nwg = nM_ * nN_; G = G_; c = c_; bexp = bexp_; }
    __device__ __forceinline__ bool next(int i, Unit& u) const {
        const long L = (long)i * G + c; if (L >= nwg) return false;
        int wgid = (int)L; { const int q = nwg / NXCD, r = nwg % NXCD, xcd = wgid % NXCD, off = wgid / NXCD; wgid = (xcd < r ? xcd * (q + 1) : r * (q + 1) + (xcd - r) * q) + off; }
        const int nig = WGM * nN, gid = wgid / nig, fm = gid * WGM, gsz = (nM - fm) < WGM ? (nM - fm) : WGM;
        u.pm = fm + ((wgid % nig) % gsz); u.pn = (wgid % nig) / gsz; u.e = __builtin_amdgcn_readfirstlane(bexp[u.pm]); return true;
    }
    __device__ __forceinline__ void a_ready(const Unit&) const {}
    __device__ __forceinline__ void done(const Unit&) const {}
};
struct EpiOut {
    static constexpr bool PERM = true, AFTER_DRAIN = false;
    const float* x; bf16_t* x1; const float* mod;
    __device__ __forceinline__ void prefetch(const Unit&, int, int, int) const {}
    __device__ __forceinline__ void operator()(const f32x4 (&acc)[2][2][4][2], const Unit& u, int wr, int wc, int fr, int fq, int = 0) const {
        const int row0 = u.pm * BM + wr * 64 + fr, col0 = u.pn * BM + wc * 32 + 8 * fq;
        const float* g = mod + (size_t)(u.pm >> 5) * 6144 + 2 * 1024;
        f32x4 gv[2][2];
#pragma unroll
        for (int bj = 0; bj < 2; ++bj)
#pragma unroll
            for (int n = 0; n < 2; ++n) gv[bj][n] = *(const f32x4*)(g + col0 + bj * HALF + 4 * n) * (1.0f / 32.0f);
#pragma unroll
        for (int ai = 0; ai < 2; ++ai) { f32x4 xa[4][2], xb[4][2];
#pragma unroll
            for (int m = 0; m < 4; ++m) { const size_t off = (size_t)(row0 + ai * HALF + m * 16) * 1024 + col0;
#pragma unroll
                for (int bj = 0; bj < 2; ++bj) { xa[m][bj] = *(const f32x4*)(x + off + bj * HALF); xb[m][bj] = *(const f32x4*)(x + off + bj * HALF + 4); } }
#pragma unroll
            for (int m = 0; m < 4; ++m) { const size_t off = (size_t)(row0 + ai * HALF + m * 16) * 1024 + col0;
#pragma unroll
                for (int bj = 0; bj < 2; ++bj) {
                    const f32x4 v0 = xa[m][bj] + gv[bj][0] * acc[ai][bj][m][0], v1 = xb[m][bj] + gv[bj][1] * acc[ai][bj][m][1];
                    u32x4 w; w.x = cvt_pk_bf16(v0[0], v0[1]); w.y = cvt_pk_bf16(v0[2], v0[3]); w.z = cvt_pk_bf16(v1[0], v1[1]); w.w = cvt_pk_bf16(v1[2], v1[3]);
                    *(u32x4*)(x1 + off + bj * HALF) = w; } } }
    }
};
__device__ __forceinline__ float swiglu1(float g, float l) {
    const float glu = fminf(g, 7.0f), lin = fminf(fmaxf(l, -7.0f), 7.0f);
    const float sg = __builtin_amdgcn_rcpf(1.0f + __builtin_amdgcn_exp2f(glu * (-1.702f * 1.4426950408889634f)));
    return glu * sg * (lin + 1.0f);
}
typedef float f32x2s __attribute__((ext_vector_type(2)));
__device__ __forceinline__ f32x2s swiglu2(f32x2s g, f32x2s l) {
    f32x2s glu, lin; glu.x = fminf(g.x, 7.0f); glu.y = fminf(g.y, 7.0f); lin.x = __builtin_amdgcn_fmed3f(l.x, -7.0f, 7.0f); lin.y = __builtin_amdgcn_fmed3f(l.y, -7.0f, 7.0f);
    const f32x2s a = glu * (-1.702f * 1.4426950408889634f);
    f32x2s ex; ex.x = __builtin_amdgcn_exp2f(a.x); ex.y = __builtin_amdgcn_exp2f(a.y);
    const f32x2s d = ex + 1.0f;
    f32x2s sg; sg.x = __builtin_amdgcn_rcpf(d.x); sg.y = __builtin_amdgcn_rcpf(d.y);
    const f32x2s t = glu * sg;
    return t * lin + t;
}
__device__ __forceinline__ float sat8(float v) { return __builtin_amdgcn_fmed3f(v, -448.0f, 448.0f); }
__device__ __forceinline__ unsigned pk4_fp8(float a, float b, float c, float d) { int w = 0; w = __builtin_amdgcn_cvt_pk_fp8_f32(a, b, w, false); w = __builtin_amdgcn_cvt_pk_fp8_f32(c, d, w, true); return (unsigned)w; }
constexpr float W8_SCALE = 32.0f, W8_INV = 1.0f / 32.0f;
struct EpiSwiGLU {
    static constexpr bool PERM = true, AFTER_DRAIN = false;
    unsigned char* act; const float* bgu;
    PG8_LAS float* bls;
    __device__ __forceinline__ void prefetch(const Unit& u, int ui, int wid, int lane) const {
        if (wid == 0) { asm volatile("" : "+v"(lane)); const float* src = bgu + (size_t)u.e * 2048 + (lane < 32 ? 0 : 1024 - 128) + u.pn * 128 + lane * 4;
            __builtin_amdgcn_global_load_lds((const unsigned*)src, (PG8_LAS unsigned*)(bls + (ui & 1) * 256), 16, 0, 0); }
    }
    __device__ __forceinline__ void operator()(const f32x4 (&acc)[2][2][4][2], const Unit& u, int wr, int wc, int fr, int fq, int ui) const {
        const int row0 = u.pm * BM + wr * 64 + fr, cg = u.pn * 128 + wc * 32 + 8 * fq;
        const PG8_LAS float* bb = bls + (ui & 1) * 256 + wc * 32 + 8 * fq;
        f32x4 bg[2], bl[2];
#pragma unroll
        for (int n = 0; n < 2; ++n) { bg[n] = *(const PG8_LAS f32x4*)(bb + 4 * n); bl[n] = *(const PG8_LAS f32x4*)(bb + 128 + 4 * n); }
#pragma unroll
        for (int ai = 0; ai < 2; ++ai)
#pragma unroll
            for (int m = 0; m < 4; ++m) { unsigned char* rowp = act + (size_t)(row0 + ai * HALF + m * 16) * 1024 + cg;
                const f32x4 g0 = acc[ai][0][m][0] * W8_INV + bg[0], g1 = acc[ai][0][m][1] * W8_INV + bg[1], l0 = acc[ai][1][m][0] * W8_INV + bl[0], l1 = acc[ai][1][m][1] * W8_INV + bl[1];
                typedef unsigned u32x2 __attribute__((ext_vector_type(2)));
                const f32x2s s0 = swiglu2((f32x2s){g0[0], g0[1]}, (f32x2s){l0[0], l0[1]}), s1 = swiglu2((f32x2s){g0[2], g0[3]}, (f32x2s){l0[2], l0[3]});
                const f32x2s s2 = swiglu2((f32x2s){g1[0], g1[1]}, (f32x2s){l1[0], l1[1]}), s3 = swiglu2((f32x2s){g1[2], g1[3]}, (f32x2s){l1[2], l1[3]});
                u32x2 w; w.x = pk4_fp8(s0.x, s0.y, s1.x, s1.y); w.y = pk4_fp8(s2.x, s2.y, s3.x, s3.y);
                *(u32x2*)rowp = w; }
    }
};
struct EpiDown {
    static constexpr bool PERM = true, AFTER_DRAIN = false;
    unsigned char* y; const float* bd;
    PG8_LAS float* bls;
    __device__ __forceinline__ void prefetch(const Unit& u, int ui, int wid, int lane) const {
        if (wid == 0) { const float* src = bd + (size_t)u.e * 1024 + u.pn * BM + lane * 4;
            __builtin_amdgcn_global_load_lds((const unsigned*)src, (PG8_LAS unsigned*)(bls + (ui & 1) * 256), 16, 0, 0); }
    }
    __device__ __forceinline__ void operator()(const f32x4 (&acc)[2][2][4][2], const Unit& u, int wr, int wc, int fr, int fq, int ui) const {
        const int row0 = u.pm * BM + wr * 64 + fr, col0 = u.pn * BM + wc * 32 + 8 * fq;
        const PG8_LAS float* bb = bls + (ui & 1) * 256 + wc * 32 + 8 * fq;
        f32x4 bv[2][2];
#pragma unroll
        for (int bj = 0; bj < 2; ++bj)
#pragma unroll
            for (int n = 0; n < 2; ++n) bv[bj][n] = *(const PG8_LAS f32x4*)(bb + bj * HALF + 4 * n);
#pragma unroll
        for (int ai = 0; ai < 2; ++ai)
#pragma unroll
            for (int m = 0; m < 4; ++m) { unsigned char* rowp = y + (size_t)(row0 + ai * HALF + m * 16) * 1024 + col0;
#pragma unroll
                for (int bj = 0; bj < 2; ++bj) { const f32x4 v0 = acc[ai][bj][m][0] * W8_INV + bv[bj][0], v1 = acc[ai][bj][m][1] * W8_INV + bv[bj][1];
                    typedef unsigned u32x2 __attribute__((ext_vector_type(2)));
                    u32x2 w; w.x = pk4_fp8(sat8(v0[0]), sat8(v0[1]), sat8(v0[2]), sat8(v0[3])); w.y = pk4_fp8(sat8(v1[0]), sat8(v1[1]), sat8(v1[2]), sat8(v1[3]));
                    *(u32x2*)(rowp + bj * HALF) = w; } }
    }
};

template <int NWOFF, int RCOS, int RSIN, int CCOS, int CSIN> struct EpiQKV {
    static constexpr bool PERM = true, AFTER_DRAIN = false;
    bf16_t* P; const float* tab;
    PG8_LAS float* xch;
    __device__ __forceinline__ void prefetch(const Unit&, int, int, int) const {}
    float qscale;
    __device__ __forceinline__ void operator()(const f32x4 (&acc)[2][2][4][2], const Unit& u, int wr, int wc, int fr, int fq, int = 0) const {
        const int type = u.pn >> 1, row0 = u.pm * BM + wr * 64 + fr, col0 = u.pn * BM + wc * 32 + 8 * fq;
        if (type == 2 || type == 5) {
#pragma unroll
            for (int ai = 0; ai < 2; ++ai)
#pragma unroll
                for (int m = 0; m < 4; ++m) { bf16_t* rowp = P + (size_t)(row0 + ai * HALF + m * 16) * 3072 + col0;
#pragma unroll
                    for (int bj = 0; bj < 2; ++bj) { const f32x4 v0 = acc[ai][bj][m][0] * W8_INV, v1 = acc[ai][bj][m][1] * W8_INV;
                        u32x4 w; w.x = cvt_pk_bf16(v0[0], v0[1]); w.y = cvt_pk_bf16(v0[2], v0[3]); w.z = cvt_pk_bf16(v1[0], v1[1]); w.w = cvt_pk_bf16(v1[2], v1[3]);
                        *(u32x4*)(rowp + bj * HALF) = w; } }
            return;
        }
        const int wid = wr * 4 + wc;
        float ss[16];
#pragma unroll
        for (int ai = 0; ai < 2; ++ai)
#pragma unroll
            for (int m = 0; m < 4; ++m)
#pragma unroll
                for (int bj = 0; bj < 2; ++bj) { const f32x4 a = acc[ai][bj][m][0], b = acc[ai][bj][m][1];
                    float s = (a[0] * a[0] + a[1] * a[1]) + (a[2] * a[2] + a[3] * a[3]) + (b[0] * b[0] + b[1] * b[1]) + (b[2] * b[2] + b[3] * b[3]);
                    s += __shfl_xor(s, 16); s += __shfl_xor(s, 32); ss[(ai * 4 + m) * 2 + bj] = s; }
        int xo_ = wid * 256 + fr; asm volatile("" : "+v"(xo_));
        PG8_LAS float* xw_ = xch + xo_; const PG8_LAS float* xr_ = xch + (xo_ ^ 256);
        if (fq == 0) {
#pragma unroll
            for (int i = 0; i < 16; ++i) xw_[i * 16] = ss[i]; }
        asm volatile("s_waitcnt lgkmcnt(0)" ::: "memory"); __builtin_amdgcn_s_barrier(); asm volatile("" ::: "memory");
#pragma unroll
        for (int i = 0; i < 16; ++i) ss[i] += xr_[i * 16];
        const int d0 = 32 * (wc & 1) + 8 * fq;
        const float* nwp = tab + NWOFF + (type - (type > 2 ? 1 : 0)) * 64 + d0;
        const f32x4 w0 = *(const f32x4*)nwp, w1 = *(const f32x4*)(nwp + 4);
        const float qs = (type == 0 || type == 3) ? qscale : 1.0f;
        const bool rope = (type < 2) && (u.pm < 128);
        const int half = wc & 1, f0 = 8 * (fq & 1); const bool isx2 = fq >= 2;
#pragma unroll
        for (int ai = 0; ai < 2; ++ai)
#pragma unroll
            for (int m = 0; m < 4; ++m) { const int row = row0 + ai * HALF + m * 16; bf16_t* rowp = P + (size_t)row * 3072 + col0;
                f32x4 cs0 = {1.f, 1.f, 1.f, 1.f}, cs1 = cs0, sn0 = {0.f, 0.f, 0.f, 0.f}, sn1 = sn0;
                if (rope) { const int s = row & 8191, pp = half ? (s & 63) : (s >> 6); const float* ct = tab + RCOS + half * (CCOS - RCOS) + pp * 16 + f0; const float* st = tab + RSIN + half * (CSIN - RSIN) + pp * 16 + f0;
                    cs0 = *(const f32x4*)ct; cs1 = *(const f32x4*)(ct + 4); sn0 = *(const f32x4*)st; sn1 = *(const f32x4*)(st + 4); if (!isx2) { sn0 = -sn0; sn1 = -sn1; } }
#pragma unroll
                for (int bj = 0; bj < 2; ++bj) {
                    const float rstd = (W8_INV * qs) * __builtin_amdgcn_rsqf(ss[(ai * 4 + m) * 2 + bj] * (W8_INV * W8_INV / 64.0f) + 1e-6f);
                    f32x4 y0 = acc[ai][bj][m][0] * rstd * w0, y1 = acc[ai][bj][m][1] * rstd * w1;
                    if (rope) { f32x4 p0, p1;
#pragma unroll
                        for (int i = 0; i < 4; ++i) { p0[i] = __shfl_xor(y0[i], 32); p1[i] = __shfl_xor(y1[i], 32); }
                        y0 = y0 * cs0 + p0 * sn0; y1 = y1 * cs1 + p1 * sn1; }
                    u32x4 w; w.x = cvt_pk_bf16(y0[0], y0[1]); w.y = cvt_pk_bf16(y0[2], y0[3]); w.z = cvt_pk_bf16(y1[0], y1[1]); w.w = cvt_pk_bf16(y1[2], y1[3]);
                    *(u32x4*)(rowp + bj * HALF) = w; }
                asm volatile("" ::: "memory"); }
    }
};
}

namespace att {
typedef unsigned short bf16_t;
using bf16x8 = __attribute__((ext_vector_type(8))) short;
using s16x4  = __attribute__((ext_vector_type(4))) short;
using f32x16 = __attribute__((ext_vector_type(16))) float;
using u32x4  = __attribute__((ext_vector_type(4))) unsigned;
constexpr int NW = 8, QBLK = 32, KVBLK = 64, LD = 3072;
constexpr float SCALE = 0.125f, C2 = 0.125f * 1.4426950408889634f;
#define KSWZ64(row, colB) ((row) * 128 + ((colB) ^ ((((row) >> 1) & 7) << 4)))
#define ASBAR() __builtin_amdgcn_sched_barrier(0)
__device__ __forceinline__ unsigned pk4f8(float a, float b, float c, float d) { int w = 0; w = __builtin_amdgcn_cvt_pk_fp8_f32(a, b, w, false); w = __builtin_amdgcn_cvt_pk_fp8_f32(c, d, w, true); return (unsigned)w; }
__device__ __forceinline__ int crow(int r, int hi) { return (r & 3) + 8 * (r >> 2) + 4 * hi; }
__device__ __forceinline__ unsigned cvtpk(float lo, float hi) { unsigned r; asm volatile("v_cvt_pk_bf16_f32 %0, %1, %2" : "=v"(r) : "v"(lo), "v"(hi)); return r; }
__device__ __forceinline__ bf16x8 ld8(const bf16_t* p) { return *reinterpret_cast<const bf16x8*>(p); }
__device__ __forceinline__ void glds16(const void* gsrc, unsigned lds_dst) { unsigned keep;
  asm volatile("s_mov_b32 %0, m0\n\ts_mov_b32 m0, %2\n\ts_nop 0\n\tglobal_load_lds_dwordx4 %1, off\n\ts_mov_b32 m0, %0" : "=&s"(keep) : "v"(gsrc), "s"(lds_dst) : "memory"); }
__device__ __forceinline__ void glds16s(const void* sbase, unsigned voff, unsigned lds_dst) { unsigned keep;
  asm volatile("s_mov_b32 %0, m0\n\ts_mov_b32 m0, %3\n\ts_nop 0\n\tglobal_load_lds_dwordx4 %1, %2\n\ts_mov_b32 m0, %0" : "=&s"(keep) : "v"(voff), "s"(sbase), "s"(lds_dst) : "memory"); }

template <int NVB> __device__ __forceinline__ void dma_kv(const void* kbase, const void* vbase, unsigned koff, unsigned voff, unsigned kd, unsigned vd) { unsigned keep;
  if constexpr (NVB == 4)
    asm volatile("s_mov_b32 %0, m0\n\ts_mov_b32 m0, %5\n\ts_nop 0\n\tglobal_load_lds_dwordx4 %1, %3\n\ts_mov_b32 m0, %6\n\ts_nop 0\n\tglobal_load_lds_dwordx4 %2, %4\n\ts_mov_b32 m0, %7\n\ts_nop 0\n\tglobal_load_lds_dwordx4 %2, %4 offset:128\n\ts_mov_b32 m0, %0"
                 : "=&s"(keep) : "v"(koff), "v"(voff), "s"(kbase), "s"(vbase), "s"(kd), "s"(vd), "s"(vd + 896u) : "memory");
  else
    asm volatile("s_mov_b32 %0, m0\n\ts_mov_b32 m0, %5\n\ts_nop 0\n\tglobal_load_lds_dwordx4 %1, %3\n\ts_mov_b32 m0, %6\n\ts_nop 0\n\tglobal_load_lds_dwordx4 %2, %4\n\ts_mov_b32 m0, %0"
                 : "=&s"(keep) : "v"(koff), "v"(voff), "s"(kbase), "s"(vbase), "s"(kd), "s"(vd) : "memory");
}
__device__ __forceinline__ void exp16(f32x16& p, float mref) {
#pragma unroll
  for (int r = 0; r < 16; ++r) p[r] = __builtin_amdgcn_exp2f(p[r]);
}
__device__ __forceinline__ void finishSM(f32x16& p0, f32x16& p1, float mref, float& l_reg, bf16x8& pa0, bf16x8& pa1, bf16x8& pa2, bf16x8& pa3) {
  exp16(p1, mref);
  float ps = 0;
#pragma unroll
  for (int r = 0; r < 16; ++r) ps += p0[r];
#pragma unroll
  for (int r = 0; r < 16; ++r) ps += p1[r];
  l_reg += ps;
#define PK4(P, BASE, OUT) do { u32x4 w = {cvtpk(P[BASE + 0], P[BASE + 1]), cvtpk(P[BASE + 2], P[BASE + 3]), cvtpk(P[BASE + 4], P[BASE + 5]), cvtpk(P[BASE + 6], P[BASE + 7])}; OUT = *reinterpret_cast<bf16x8*>(&w); } while (0)
  PK4(p0, 0, pa0); PK4(p0, 8, pa1); PK4(p1, 0, pa2); PK4(p1, 8, pa3);
#undef PK4
}
template <bool NEGM> __device__ __forceinline__ void qkt(f32x16& p0, f32x16& p1, const char* Ks, const bf16x8* qr, const f32x16& negm, int r32, int hi) {
#pragma unroll
  for (int d0 = 0; d0 < 4; ++d0) { const int cb = (d0 * 16 + hi * 8) * 2;
    const bf16x8 b0 = *reinterpret_cast<const bf16x8*>(Ks + KSWZ64(r32, cb));
    const bf16x8 b1 = *reinterpret_cast<const bf16x8*>(Ks + KSWZ64(32 + r32, cb));
    if (d0 == 0) { if constexpr (NEGM) { p0 = __builtin_amdgcn_mfma_f32_32x32x16_bf16(b0, qr[0], negm, 0, 0, 0); p1 = __builtin_amdgcn_mfma_f32_32x32x16_bf16(b1, qr[0], negm, 0, 0, 0); }
      else { p0 = __builtin_amdgcn_mfma_f32_32x32x16_bf16(b0, qr[0], f32x16{}, 0, 0, 0); p1 = __builtin_amdgcn_mfma_f32_32x32x16_bf16(b1, qr[0], f32x16{}, 0, 0, 0); } }
    else { p0 = __builtin_amdgcn_mfma_f32_32x32x16_bf16(b0, qr[d0], p0, 0, 0, 0); p1 = __builtin_amdgcn_mfma_f32_32x32x16_bf16(b1, qr[d0], p1, 0, 0, 0); } }
}
template <int NVB> __device__ __forceinline__ int v_st(int k, int c) { const int kk = k; return ((kk >> 3) * NVB + (c >> 5)) * 512 + ((kk & 7) * 32 + (c & 31)) * 2; }
__device__ __forceinline__ int v_rd_base(int lane) { return ((lane & 3) << 3) | (((lane >> 2) & 3) << 6) | (((lane >> 4) & 1) << 5) | (((lane >> 5) & 1) << 8); }
template <int NVB> constexpr int v_rd_off(int d0, int ks, int half) { return d0 * 512 + ks * (NVB * 1024) + half * (NVB * 512); }
template <int OFF> __device__ __forceinline__ s16x4 tr_read(int vb) {
  s16x4 r; asm volatile("ds_read_b64_tr_b16 %0, %1 offset:%2" : "=&v"(r) : "v"(vb), "i"(OFF) : "memory"); return r;
}
template <int NVB, int D0> __device__ __forceinline__ void v_rd(s16x4* f, int vb) {
  f[0] = tr_read<v_rd_off<NVB>(D0, 0, 0)>(vb); f[1] = tr_read<v_rd_off<NVB>(D0, 0, 1)>(vb); f[2] = tr_read<v_rd_off<NVB>(D0, 1, 0)>(vb); f[3] = tr_read<v_rd_off<NVB>(D0, 1, 1)>(vb);
  f[4] = tr_read<v_rd_off<NVB>(D0, 2, 0)>(vb); f[5] = tr_read<v_rd_off<NVB>(D0, 2, 1)>(vb); f[6] = tr_read<v_rd_off<NVB>(D0, 3, 0)>(vb); f[7] = tr_read<v_rd_off<NVB>(D0, 3, 1)>(vb);
}
__device__ __forceinline__ void pv_mm(f32x16& od, const s16x4* f, bf16x8 pa0, bf16x8 pa1, bf16x8 pa2, bf16x8 pa3) {
#define PK(L, H) (bf16x8){L[0], L[1], L[2], L[3], H[0], H[1], H[2], H[3]}
  od = __builtin_amdgcn_mfma_f32_32x32x16_bf16(pa0, PK(f[0], f[1]), od, 0, 0, 0);
  od = __builtin_amdgcn_mfma_f32_32x32x16_bf16(pa1, PK(f[2], f[3]), od, 0, 0, 0);
  od = __builtin_amdgcn_mfma_f32_32x32x16_bf16(pa2, PK(f[4], f[5]), od, 0, 0, 0);
  od = __builtin_amdgcn_mfma_f32_32x32x16_bf16(pa3, PK(f[6], f[7]), od, 0, 0, 0);
#undef PK
}
template <int LO, int N> __device__ __forceinline__ void exp_part(f32x16& p, float mref) {
#pragma unroll
  for (int r = LO; r < LO + N; ++r) p[r] = __builtin_amdgcn_exp2f(p[r]);
}
#define LGKM0() do { asm volatile("s_waitcnt lgkmcnt(0)" ::: "memory"); ASBAR(); } while (0)
template <int NVB> __device__ __forceinline__ void pv_all(f32x16* o, int vb, s16x4* fa, s16x4* fb, bf16x8 pa0, bf16x8 pa1, bf16x8 pa2, bf16x8 pa3, f32x16& c, float mref) {
  if constexpr (NVB == 4) {
    LGKM0(); v_rd<NVB, 1>(fb, vb); pv_mm(o[0], fa, pa0, pa1, pa2, pa3); exp_part<0, 4>(c, mref);
    LGKM0(); v_rd<NVB, 2>(fa, vb); pv_mm(o[1], fb, pa0, pa1, pa2, pa3); exp_part<4, 4>(c, mref);
    LGKM0(); v_rd<NVB, 3>(fb, vb); pv_mm(o[2], fa, pa0, pa1, pa2, pa3); exp_part<8, 4>(c, mref);
    LGKM0();                       pv_mm(o[3], fb, pa0, pa1, pa2, pa3); exp_part<12, 4>(c, mref);
  } else {
    LGKM0(); v_rd<NVB, 1>(fb, vb); pv_mm(o[0], fa, pa0, pa1, pa2, pa3); exp_part<0, 8>(c, mref);
    LGKM0();                       pv_mm(o[1], fb, pa0, pa1, pa2, pa3); exp_part<8, 8>(c, mref);
  }
}
template <bool SHIFT> struct DiffPol {
  static constexpr bool NEGM = false;
  const bf16_t* Kg; const bf16_t* Vg; long lat0, ctx0; float mref;
  __device__ __forceinline__ int krow(int t) const { return t < 128 ? (int)lat0 + 64 * t : (int)ctx0 + 64 * (t - 128); }
  static constexpr bool INCR = true;
  __device__ __forceinline__ long delta(int t) const { return t == 127 ? ((long)ctx0 - (long)lat0 - 64L * 127) * LD : 64L * LD; }
  __device__ __forceinline__ void mod(f32x16& p0, f32x16& p1, int, int, int, int) const {
    if constexpr (SHIFT) {
#pragma unroll
      for (int i = 0; i < 16; ++i) { p0[i] -= mref; p1[i] -= mref; } }
  }
};
template <int PAR> struct NaPol {
  static constexpr bool NEGM = false;
  const bf16_t* Kg; const bf16_t* Vg; long lat0, ctx0; int rbase, r; const float* tab; float mref;
  static constexpr bool INCR = false;
  __device__ __forceinline__ long delta(int) const { return 0; }
  __device__ __forceinline__ int krow(int t) const { if (t < 11) { int kr = rbase + t; kr = kr > 127 ? 127 : kr; return (int)lat0 + 64 * kr; } return (int)ctx0 + 64 * (t - 11); }
  __device__ __forceinline__ void mod(f32x16& p0, f32x16& p1, int t, int wid, int r32, int hi) const {
    if (t >= 11) {
#pragma unroll
      for (int i = 0; i < 16; ++i) { p0[i] -= mref; p1[i] -= mref; }
      return; }
    const float NEG = -INFINITY;
    const int kr = rbase + t, rq = r + (wid >> 1), c = 32 * (wid & 1) + r32;
    int r0q = rq - 4; r0q = r0q < 0 ? 0 : (r0q > 120 ? 120 : r0q);
    if (!((kr >= r0q) && (kr < r0q + 8))) {
#pragma unroll
      for (int i = 0; i < 16; ++i) { p0[i] = NEG; p1[i] = NEG; }
      return; }
    int c0 = c - 8; c0 = c0 < 0 ? 0 : (c0 > 48 ? 48 : c0);
    int d = 4 * hi - c0, off = (kr - rq + 7) * 31 + 15 - c + 4 * hi;
    asm volatile("" : "+v"(d), "+v"(off));
#pragma unroll
    for (int i = 0; i < 16; ++i) { const int ci = (i & 3) + 8 * (i >> 2);
      if (PAR == 1 && i < 12) p0[i] = NEG; else { const bool v0 = (unsigned)(ci + d) < 16u; p0[i] += tab[v0 ? off + ci : 15 * 31]; }
      if (PAR == 0 && i >= 4) p1[i] = NEG; else { const bool v1 = (unsigned)(ci + 32 + d) < 16u; p1[i] += tab[v1 ? off + ci + 32 : 15 * 31]; } }
  }
};
template <int NVB> constexpr int lds_bytes() { return 3 * (64 * NVB * 64) + 3 * (64 * 128) + NW * 64 * 4; }
constexpr int STAGE_OFF = 77824;
struct NextU { const bf16_t* k0; const bf16_t* k1; int vk; const bf16_t* q; };
template <int NVB, class Pol, int MODE, int VKB>
__device__ __forceinline__ void attn_unit(const bf16_t* __restrict__ Qb, const Pol& pol, bf16_t* __restrict__ Ob, int ldo, int NT, float mref, char* lds, float lam, const float* wn, bool pre, const NextU nx) {
  constexpr int SHM_V = 64 * NVB * 64, SHM_K = 64 * 128;
  const int tid = threadIdx.x, lane = tid & 63, r32 = lane & 31, hi = lane >> 5; const int wid = __builtin_amdgcn_readfirstlane(tid >> 6);
  char* V_lds = lds; char* K_lds = lds + 3 * SHM_V;
  float* li_l = (float*)(lds + 3 * SHM_V + 3 * SHM_K) + wid * 64;
  const unsigned lds0 = (unsigned)(uintptr_t)lds;
  const int krow_ = 8 * wid + (lane >> 3), kch = (lane & 7) ^ ((krow_ >> 1) & 7);
  const unsigned koff = (unsigned)(krow_ * LD + kch * 8) * 2u;
  const unsigned voff = (unsigned)((8 * wid + ((lane >> 2) & 7)) * LD + (lane >> 5) * 32 + (lane & 3) * 8) * 2u;
  const unsigned kdst = lds0 + 3 * SHM_V + wid * 1024, vdst = lds0 + wid * (NVB == 4 ? 2048 : 1024);
  const bf16_t* kq = pol.Kg + (unsigned)(int)pol.krow(0) * (unsigned)LD;
#define DMA_TILE(t, b) do { const bf16_t* kp_; if constexpr (Pol::INCR) { kp_ = kq; kq += pol.delta(t); } else kp_ = pol.Kg + (unsigned)(int)pol.krow(t) * (unsigned)LD;        \
    dma_kv<NVB>(kp_, kp_ + VKB / 2, koff, voff, (unsigned)__builtin_amdgcn_readfirstlane(kdst + (b) * SHM_K), (unsigned)__builtin_amdgcn_readfirstlane(vdst + (b) * SHM_V)); } while (0)
#define WAIT_BAR() do { asm volatile("s_waitcnt vmcnt(0)" ::: "memory"); __syncthreads(); } while (0)
  if (!pre) { DMA_TILE(0, 0); DMA_TILE(1, 1); } else if constexpr (Pol::INCR) kq += pol.delta(0) + pol.delta(1);
  float l_reg = 0; f32x16 o[NVB]; bf16x8 qr[4]; f32x16 negm;
#pragma unroll
  for (int r = 0; r < 16; ++r) negm[r] = -mref;
  if constexpr (Pol::NEGM) asm volatile("" : "+v"(negm));
#pragma unroll
  for (int d = 0; d < NVB; ++d) o[d] = f32x16{};
  const bf16_t* Qw = Qb + (long)(wid * QBLK + r32) * LD + hi * 8;
#pragma unroll
  for (int d0 = 0; d0 < 4; ++d0) qr[d0] = ld8(Qw + d0 * 16);
#define NEXT_PREFETCH() do { if (nx.k0 != nullptr) { \
    dma_kv<NVB>(nx.k0, nx.k0 + nx.vk, koff, voff, (unsigned)__builtin_amdgcn_readfirstlane(kdst), (unsigned)__builtin_amdgcn_readfirstlane(vdst)); \
    dma_kv<NVB>(nx.k1, nx.k1 + nx.vk, koff, voff, (unsigned)__builtin_amdgcn_readfirstlane(kdst + SHM_K), (unsigned)__builtin_amdgcn_readfirstlane(vdst + SHM_V)); } } while (0)
  const int vb0 = (int)(uintptr_t)V_lds + v_rd_base(lane);
  f32x16 pA0, pA1, pB0, pB1; bf16x8 pa0, pa1, pa2, pa3; s16x4 fa[8], fb[8];
  int bp = 0, bc = 1, bn = 2;
  WAIT_BAR();
  qkt<Pol::NEGM>(pA0, pA1, K_lds, qr, negm, r32, hi); pol.mod(pA0, pA1, 0, wid, r32, hi); exp16(pA0, mref);
#define STEP(C0, C1, P0, P1, j) do { \
    if ((j) + 1 < NT) DMA_TILE((j) + 1, bn); \
    ASBAR(); __builtin_amdgcn_s_setprio(1); v_rd<NVB, 0>(fa, vb0 + bp * SHM_V); qkt<Pol::NEGM>(C0, C1, K_lds + bc * SHM_K, qr, negm, r32, hi); \
    finishSM(P0, P1, mref, l_reg, pa0, pa1, pa2, pa3); ASBAR(); \
    pol.mod(C0, C1, (j), wid, r32, hi); __builtin_amdgcn_s_setprio(0); ASBAR(); \
    pv_all<NVB>(o, vb0 + bp * SHM_V, fa, fb, pa0, pa1, pa2, pa3, C0, mref); \
    WAIT_BAR(); \
    bp = bc; bc = bn; bn = (bn == 2) ? 0 : bn + 1; } while (0)
  int j = 1;
#pragma nounroll
  for (; j + 1 < NT; j += 2) { STEP(pB0, pB1, pA0, pA1, j); STEP(pA0, pA1, pB0, pB1, j + 1); }
  if (NT & 1) {
    NEXT_PREFETCH();
    finishSM(pA0, pA1, mref, l_reg, pa0, pa1, pa2, pa3); ASBAR();
    v_rd<NVB, 0>(fa, vb0 + bp * SHM_V); pv_all<NVB>(o, vb0 + bp * SHM_V, fa, fb, pa0, pa1, pa2, pa3, pB0, 0.f);
  } else {
    STEP(pB0, pB1, pA0, pA1, NT - 1);
    NEXT_PREFETCH();
    finishSM(pB0, pB1, mref, l_reg, pa0, pa1, pa2, pa3); ASBAR();
    v_rd<NVB, 0>(fa, vb0 + bp * SHM_V); pv_all<NVB>(o, vb0 + bp * SHM_V, fa, fb, pa0, pa1, pa2, pa3, pA0, 0.f);
  }
  { auto rr = __builtin_amdgcn_permlane32_swap(__float_as_uint(l_reg), __float_as_uint(l_reg), false, false); l_reg = __uint_as_float(rr[0]) + __uint_as_float(rr[1]); }
  if (hi == 0) li_l[r32] = l_reg; asm volatile("s_waitcnt lgkmcnt(0)" ::: "memory");
  bf16_t* stg = (bf16_t*)(lds + STAGE_OFF) + wid * (32 * 32 * NVB);
  bf16_t* Ow = Ob + (long)(wid * QBLK) * ldo;
  if constexpr (MODE == 0) {
#pragma unroll
    for (int r = 0; r < 16; ++r) { const int orow = crow(r, hi); const float rl = __builtin_amdgcn_rcpf(li_l[orow]);
#pragma unroll
      for (int d0 = 0; d0 < NVB; ++d0) { const float v = o[d0][r] * rl; const unsigned pk = cvtpk(v, v); stg[orow * (32 * NVB) + d0 * 32 + r32] = (bf16_t)(pk & 0xffffu); } }
  } else {
    float ss[16];
#pragma unroll
    for (int r = 0; r < 16; ++r) { const int orow = crow(r, hi); float a = 0.f; const float rl = __builtin_amdgcn_rcpf(li_l[orow]);
#pragma unroll
      for (int d0 = 0; d0 < NVB; ++d0) { float v = o[d0][r] * rl;
        if constexpr (MODE == 1) { const float o1 = __uint_as_float(((unsigned)stg[orow * (32 * NVB) + d0 * 32 + r32]) << 16); v = o1 - lam * v; }
        o[d0][r] = v; a += v * v; }
      ss[r] = a; }
#pragma unroll
    for (int sft = 1; sft < 32; sft <<= 1) {
#pragma unroll
      for (int r = 0; r < 16; ++r) ss[r] += __shfl_xor(ss[r], sft); }
    float wv[NVB];
#pragma unroll
    for (int d0 = 0; d0 < NVB; ++d0) wv[d0] = wn[d0 * 32 + r32];
#pragma unroll
    for (int r = 0; r < 16; ++r) { const int orow = crow(r, hi);
      const float rs = (MODE == 1 ? 0.8f : 1.0f) / sqrtf(ss[r] * (1.0f / (32 * NVB)) + 1e-6f);
#pragma unroll
      for (int d0 = 0; d0 < NVB; ++d0) { const float v = o[d0][r] * rs * wv[d0]; const unsigned pk = cvtpk(v, v); stg[orow * (32 * NVB) + d0 * 32 + r32] = (bf16_t)(pk & 0xffffu); } }
    asm volatile("s_waitcnt lgkmcnt(0)" ::: "memory");
    constexpr int CH = 2 * NVB;
#pragma unroll
    for (int i = 0; i < (32 * CH) / 64; ++i) { const int idx = i * 64 + lane, row = idx / CH, ch = idx % CH;
      const u32x4 a = *(const u32x4*)(stg + row * (32 * NVB) + ch * 16), b = *(const u32x4*)(stg + row * (32 * NVB) + ch * 16 + 8);
#define F8P(w0, w1) pk4f8(__uint_as_float((w0) << 16), __uint_as_float((w0) & 0xffff0000u), __uint_as_float((w1) << 16), __uint_as_float((w1) & 0xffff0000u))
      u32x4 v; v.x = F8P(a.x, a.y); v.y = F8P(a.z, a.w); v.z = F8P(b.x, b.y); v.w = F8P(b.z, b.w);
#undef F8P
      *(u32x4*)((unsigned char*)Ob + (long)(wid * QBLK + row) * ldo + ch * 16) = v; }
  }
  __syncthreads();
#undef DMA_TILE
#undef WAIT_BAR
#undef STEP
#undef NEXT_PREFETCH
}
}

#ifndef MK_PROBE_PHASE
#define MK_PROBE_PHASE -1
#endif
#ifndef MK_N_LAUNCHES
#define MK_N_LAUNCHES 1
#endif
constexpr int N_PHASES = 12;
constexpr int NWAVES = 8;
constexpr int DM = 1024, NB = 4, SEQ = 8192, TT = NB * SEQ, CTX = 256, TC = NB * CTX, MQ = TT + TC, NQKV = 3072;
constexpr int NE = 32, TOPK = 4, MPAD = TT * TOPK + NE * 256, MAXBLK = MPAD / 256;
constexpr float NORM_EPS = 1e-6f;
enum { I_X = 0, I_C, I_CTX, I_CCTX, I_WADA, I_BADA, I_GATTN, I_WIN, I_QND, I_KND, I_LQ1, I_LK1, I_LQ2, I_LK2, I_SUBLN, I_QNN, I_KNN, I_RPB, I_ONN, I_WOUT, I_GFFN, I_WR, I_BR, I_WGU, I_BGU, I_WD, I_BD, N_IN };

constexpr size_t MiB = 1u << 20;
constexpr size_t WS_CTL = 0, CTL_ZERO_BYTES = 64 * 1024;
constexpr size_t WS_TAB = 1 * MiB;
constexpr size_t WS_WR3 = 128 * 1024;
constexpr size_t WS_WQKV = 2 * MiB, WS_WO = 8 * MiB, WS_WGU = 10 * MiB, WS_WDN = 138 * MiB;
constexpr size_t WS_XN = 202 * MiB;
constexpr size_t WS_P = 268 * MiB;
constexpr size_t WS_OD = 499 * MiB, WS_ON = 563 * MiB, WS_MIX = 595 * MiB;
constexpr size_t WS_X1 = 499 * MiB;
constexpr size_t WS_XG = 202 * MiB;
constexpr size_t WS_ACT = 659 * MiB;
constexpr size_t WS_Y = 202 * MiB;
constexpr size_t WS_RT = 931 * MiB;
constexpr size_t WS_END = 936 * MiB;
static_assert(WS_XN + (size_t)MQ * 2048 <= WS_P && WS_P + (size_t)MQ * 6144 <= WS_OD && WS_XG + (size_t)MPAD * 2048 <= WS_OD && WS_ACT + (size_t)MPAD * 2048 <= WS_RT, "d_ws map");
constexpr int TB_MOD = 0;
constexpr int TB_RCOS = 30720, TB_RSIN = TB_RCOS + 128 * 16, TB_CCOS = TB_RSIN + 128 * 16, TB_CSIN = TB_CCOS + 64 * 16;
constexpr int TB_LAM = TB_CSIN + 64 * 16;
constexpr int TB_NW = TB_LAM + 64;
constexpr int TB_WR = TB_NW + 256;
constexpr int TB_RC = TB_WR + 4 * 1024 * 32;
static_assert((size_t)(TB_RC + 128 + 64) * 4 <= MiB, "TAB region");
constexpr int CW_CNT = 0;
constexpr int CW_RC = 64;
constexpr int CW_BAR = 4096;
constexpr size_t RT_E = 0, RT_G = 512 * 1024, RT_POS = 1024 * 1024, RT_SLOT = 1536 * 1024;
constexpr size_t RT_TOK = 2048 * 1024;

constexpr int RING_BYTES = 131072;
constexpr int MISC_OFF = RING_BYTES;
constexpr int LDS_BYTES = 147456;

#define GAS __attribute__((address_space(1)))
#define LAS __attribute__((address_space(3)))
typedef unsigned short bf16;
typedef unsigned v4u __attribute__((ext_vector_type(4)));
typedef unsigned v2u __attribute__((ext_vector_type(2)));
typedef float f32x4 __attribute__((ext_vector_type(4)));
typedef float f32x16 __attribute__((ext_vector_type(16)));
#define LDS_WAIT() asm volatile("s_waitcnt lgkmcnt(0)" ::: "memory")
__device__ __forceinline__ unsigned f2bf(float f) { unsigned u = __builtin_bit_cast(unsigned, f); return (u + 0x7fffu + ((u >> 16) & 1u)) >> 16; }
__device__ __forceinline__ unsigned pk2(float lo, float hi) { return f2bf(lo) | (f2bf(hi) << 16); }
__device__ __forceinline__ float bflo(unsigned w) { return __uint_as_float(w << 16); }
__device__ __forceinline__ float bfhi(unsigned w) { return __uint_as_float(w & 0xffff0000u); }
__device__ __forceinline__ float wave_sum(float v) {
#pragma unroll
    for (int o = 1; o < 64; o <<= 1) v += __shfl_xor(v, o);
    return v;
}

#define FTID ((int)threadIdx.x)
#define FLANE ((int)(threadIdx.x & 63u))
struct Frame {
    LAS unsigned char* lds;
    int wave, vcu, G;
    const float* in[N_IN]; float* out; unsigned char* ws;
};

__device__ __forceinline__ void p0_transpose_item(const float* W, int K, int N, bf16* WT, int k0, int n0, int drow0, LAS float* scr, int lane) {
    float st_[32];
#pragma unroll
    for (int i = 0; i < 32; ++i) st_[i] = __builtin_nontemporal_load(&W[(size_t)(k0 + 2 * i + (lane >> 5)) * N + n0 + (lane & 31)]);
#pragma unroll
    for (int i = 0; i < 32; ++i) scr[(2 * i + (lane >> 5)) * 33 + (lane & 31)] = st_[i];
    LDS_WAIT(); asm volatile("" ::: "memory");
    const int c = lane & 7;
#pragma unroll
    for (int j = 0; j < 4; ++j) { const int n = (lane >> 3) + 8 * j; const LAS float* s = scr + (8 * c) * 33 + n;
        v4u o; o.x = pk2(s[0 * 33], s[1 * 33]); o.y = pk2(s[2 * 33], s[3 * 33]); o.z = pk2(s[4 * 33], s[5 * 33]); o.w = pk2(s[6 * 33], s[7 * 33]);
        *(v4u*)(WT + (size_t)(drow0 + n) * K + k0 + 8 * c) = o; }
    LDS_WAIT(); asm volatile("" ::: "memory");
}

__device__ __forceinline__ void p0_transpose_item8(const float* W, int K, int N, unsigned char* WT, int k0, int n0, int drow0, LAS float* scr, int lane) {
    float st_[32];
#pragma unroll
    for (int i = 0; i < 32; ++i) st_[i] = __builtin_nontemporal_load(&W[(size_t)(k0 + 2 * i + (lane >> 5)) * N + n0 + (lane & 31)]);
#pragma unroll
    for (int i = 0; i < 32; ++i) scr[(2 * i + (lane >> 5)) * 33 + (lane & 31)] = st_[i];
    LDS_WAIT(); asm volatile("" ::: "memory");
    const int n = lane & 31, hf = lane >> 5; const LAS float* s = scr + (32 * hf) * 33 + n;
    v4u o0, o1;
#define P4(j) pg8::pk4_fp8(s[(j) * 33] * pg8::W8_SCALE, s[((j) + 1) * 33] * pg8::W8_SCALE, s[((j) + 2) * 33] * pg8::W8_SCALE, s[((j) + 3) * 33] * pg8::W8_SCALE)
    o0.x = P4(0); o0.y = P4(4); o0.z = P4(8); o0.w = P4(12); o1.x = P4(16); o1.y = P4(20); o1.z = P4(24); o1.w = P4(28);
#undef P4
    unsigned char* dst = WT + (size_t)(drow0 + n) * K + k0 + 32 * hf;
    *(v4u*)dst = o0; *(v4u*)(dst + 16) = o1;
    LDS_WAIT(); asm volatile("" ::: "memory");
}

constexpr int P0_I_IN = 16 * 96, P0_I_GU = 16 * 64, P0_I_DN = 16 * 32, P0_I_OUT = 16 * 32;
constexpr int P0_N8 = P0_I_IN + NE * (P0_I_GU + P0_I_DN);
constexpr int P0_QUOTA = 3;
__device__ __forceinline__ int p0_deferred(int G) { const int rem = (MQ / 256 * (NQKV / 256)) % G; return rem == 0 ? 0 : (G - rem) * NWAVES * P0_QUOTA; }
__device__ __forceinline__ void p0_convert(Frame& F, int first, int stride, int begin, int end) {
    constexpr int I_IN = P0_I_IN, I_GU = P0_I_GU, I_DN = P0_I_DN;
    LAS float* scr = (LAS float*)(F.lds + 32768 + F.wave * 8704);
#define P0_DECODE(it_, W_, N_, k0_, n0_, dr_, D_) do { int r_ = (it_); \
        if (r_ < I_IN) { W_ = F.in[I_WIN]; N_ = 3072; k0_ = 64 * (r_ / 96); n0_ = 32 * (r_ % 96); dr_ = n0_; D_ = F.ws + WS_WQKV; } \
        else if ((r_ -= I_IN) < NE * I_GU) { const int e_ = r_ / I_GU, q_ = r_ % I_GU; W_ = F.in[I_WGU] + (size_t)e_ * 1024 * 2048; N_ = 2048; k0_ = 64 * (q_ / 64); n0_ = 32 * (q_ % 64); \
            dr_ = (n0_ < 1024) ? ((n0_ >> 7) * 256 + (n0_ & 127)) : (((n0_ - 1024) >> 7) * 256 + 128 + ((n0_ - 1024) & 127)); D_ = F.ws + WS_WGU + (size_t)e_ * 2048 * 1024; } \
        else { r_ -= NE * I_GU; const int e_ = r_ / I_DN, q_ = r_ % I_DN; W_ = F.in[I_WD] + (size_t)e_ * 1024 * 1024; N_ = 1024; k0_ = 64 * (q_ / 32); n0_ = 32 * (q_ % 32); dr_ = n0_; D_ = F.ws + WS_WDN + (size_t)e_ * 1024 * 1024; } } while (0)
#define P0_LOAD(R_, W_, N_, k0_, n0_) do { _Pragma("unroll") for (int i = 0; i < 32; ++i) R_[i] = __builtin_nontemporal_load(&W_[(size_t)(k0_ + 2 * i + (FLANE >> 5)) * N_ + n0_ + (FLANE & 31)]); } while (0)
#define P0_STORE8(R_, D_, dr_, k0_) do { _Pragma("unroll") for (int i = 0; i < 32; ++i) scr[(2 * i + (FLANE >> 5)) * 33 + (FLANE & 31)] = R_[i]; \
        LDS_WAIT(); asm volatile("" ::: "memory"); \
        { const int n_ = FLANE & 31, hf_ = FLANE >> 5; const LAS float* s = scr + (32 * hf_) * 33 + n_; v4u o0, o1; \
          o0.x = P4(0); o0.y = P4(4); o0.z = P4(8); o0.w = P4(12); o1.x = P4(16); o1.y = P4(20); o1.z = P4(24); o1.w = P4(28); \
          unsigned char* dst_ = D_ + (size_t)(dr_ + n_) * 1024 + k0_ + 32 * hf_; *(v4u*)dst_ = o0; *(v4u*)(dst_ + 16) = o1; } \
        LDS_WAIT(); asm volatile("" ::: "memory"); } while (0)
#define P4(j) pg8::pk4_fp8(s[(j) * 33] * pg8::W8_SCALE, s[((j) + 1) * 33] * pg8::W8_SCALE, s[((j) + 2) * 33] * pg8::W8_SCALE, s[((j) + 3) * 33] * pg8::W8_SCALE)
    {
        float ra[32], rb[32]; const float *Wa, *Wb; unsigned char *Da, *Db; int Na, ka, na, da, Nb, kb2, nb2, db;
        int it = begin + first;
        if (it < end) { P0_DECODE(it, Wa, Na, ka, na, da, Da); P0_LOAD(ra, Wa, Na, ka, na); }
        while (it < end) {
            const int it2 = it + stride;
            if (it2 < end) { P0_DECODE(it2, Wb, Nb, kb2, nb2, db, Db); P0_LOAD(rb, Wb, Nb, kb2, nb2); }
            P0_STORE8(ra, Da, da, ka);
            if (it2 >= end) break;
            const int it3 = it2 + stride;
            if (it3 < end) { P0_DECODE(it3, Wa, Na, ka, na, da, Da); P0_LOAD(ra, Wa, Na, ka, na); }
            P0_STORE8(rb, Db, db, kb2);
            it = it3;
        }
    }
#undef P4
#undef P0_DECODE
#undef P0_LOAD
#undef P0_STORE8
}

__device__ __forceinline__ void p0_prologue(Frame& F) {
    float* tab = (float*)(F.ws + WS_TAB);
    for (int task = blockIdx.x; task < 96; task += F.G) {
        LAS float* ssilu = (LAS float*)F.lds;
        LAS float* part = ssilu + 5 * 1024;
#pragma unroll
        for (int j = 0; j < 10; ++j) { const int i = FTID + 512 * j, r = i >> 10, k = i & 1023; const float v = (r < 4) ? F.in[I_C][r * 1024 + k] : F.in[I_CCTX][k]; ssilu[i] = v / (1.0f + __expf(-v)); }
        __syncthreads();
        const int kk = FLANE >> 4, c4 = FLANE & 15, kb = F.wave * 128;
        const f32x4* w = (const f32x4*)(F.in[I_WADA] + task * 64);
        f32x4 a0 = {0.f, 0.f, 0.f, 0.f}, a1 = a0, a2 = a0, a3 = a0, a4 = a0;
#pragma unroll 1
        for (int h = 0; h < 2; ++h) {
            f32x4 wv[16]; int ro = (kb + 64 * h + kk) * 1536 + c4; asm volatile("" : "+v"(ro));
#pragma unroll
            for (int i = 0; i < 16; ++i) wv[i] = __builtin_nontemporal_load(w + (ro + i * 4 * 1536));
#pragma unroll
            for (int i = 0; i < 16; ++i) { const int k = kb + 64 * h + 4 * i + kk; a0 += wv[i] * ssilu[k]; a1 += wv[i] * ssilu[1024 + k]; a2 += wv[i] * ssilu[2048 + k]; a3 += wv[i] * ssilu[3072 + k]; a4 += wv[i] * ssilu[4096 + k];
                if ((i & 3) == 3) asm volatile("" ::: "memory"); }
        }
#define P0_RED(a_, r_) do { _Pragma("unroll") for (int q = 0; q < 4; ++q) { float t_ = a_[q]; t_ += __shfl_xor(t_, 16); t_ += __shfl_xor(t_, 32); if (kk == 0) part[(F.wave * 5 + r_) * 64 + 4 * c4 + q] = t_; } } while (0)
        P0_RED(a0, 0); P0_RED(a1, 1); P0_RED(a2, 2); P0_RED(a3, 3); P0_RED(a4, 4);
#undef P0_RED
        __syncthreads();
        if (FTID < 320) { const int r = FTID >> 6, cl = FTID & 63; float s = 0; for (int wv = 0; wv < 8; ++wv) s += part[(wv * 5 + r) * 64 + cl]; const int j = task * 64 + cl; tab[TB_MOD + r * 6144 + j] = s + F.in[I_BADA][j]; }
        __syncthreads();
    }
    if ((int)blockIdx.x == F.G - 1) {
        for (int i = FTID; i < 192 * 16; i += 512) { const int p = i >> 4, f = i & 15; const float inv = 1.0f / powf(10000.0f, (float)f / 16.0f); const int pos = p < 128 ? p : p - 128; const float ang = (float)pos * inv;
            const float cv = cosf(ang), sv = sinf(ang);
            if (p < 128) { tab[TB_RCOS + pos * 16 + f] = cv; tab[TB_RSIN + pos * 16 + f] = sv; } else { tab[TB_CCOS + pos * 16 + f] = cv; tab[TB_CSIN + pos * 16 + f] = sv; } }
        LAS float* rmx = (LAS float*)(F.lds + 31744);
        { float rm = -1e30f;
#pragma unroll
          for (int j = 0; j < 8; ++j) { const int i = FTID + 512 * j; if (i < 8 * 465) rm = fmaxf(rm, F.in[I_RPB][i]); }
#pragma unroll
          for (int o = 1; o < 64; o <<= 1) rm = fmaxf(rm, __shfl_xor(rm, o));
          if (FLANE == 0) rmx[F.wave] = rm; }
        __syncthreads();
        if (F.wave == 0) tab[TB_NW + FLANE] = F.in[I_QND][FLANE];
        if (F.wave == 1) tab[TB_NW + 64 + FLANE] = F.in[I_KND][FLANE];
        if (F.wave == 2) tab[TB_NW + 128 + FLANE] = F.in[I_QNN][FLANE];
        if (F.wave == 3) tab[TB_NW + 192 + FLANE] = F.in[I_KNN][FLANE];
        if (F.wave == 0) { const float s1 = wave_sum(F.in[I_LQ1][FLANE] * F.in[I_LK1][FLANE]), s2 = wave_sum(F.in[I_LQ2][FLANE] * F.in[I_LK2][FLANE]);
            if (FLANE == 0) tab[TB_LAM] = expf(s1) - expf(s2) + 0.2f;
            float a = fabsf(F.in[I_QND][FLANE]), bq = fabsf(F.in[I_KND][FLANE]), c = fabsf(F.in[I_QNN][FLANE]), d = fabsf(F.in[I_KNN][FLANE]); float rm = rmx[FLANE & 7];
#pragma unroll
            for (int o = 1; o < 64; o <<= 1) { a = fmaxf(a, __shfl_xor(a, o)); bq = fmaxf(bq, __shfl_xor(bq, o)); c = fmaxf(c, __shfl_xor(c, o)); d = fmaxf(d, __shfl_xor(d, o)); rm = fmaxf(rm, __shfl_xor(rm, o)); }
            if (FLANE == 0) { tab[TB_LAM + 1] = att::C2 * 64.0f * a * bq * 1.02f + 0.05f; tab[TB_LAM + 2] = att::C2 * 64.0f * c * d * 1.02f + 0.05f + fmaxf(rm, 0.f) * 1.4426950408889634f; } }
    }
    LAS float* scr = (LAS float*)(F.lds + 32768 + F.wave * 8704);
    const int gw = F.vcu * NWAVES + F.wave, NGW = F.G * NWAVES;
    constexpr int I_OUT = P0_I_OUT; const int N8 = P0_N8 - p0_deferred(F.G);
    p0_convert(F, gw, NGW, 0, N8);
    for (int it = (gw - N8 % NGW + NGW) % NGW; it < I_OUT; it += NGW) { const int kb = it / 32, nb = it % 32; p0_transpose_item8(F.in[I_WOUT], 1024, 1024, F.ws + WS_WO, 64 * kb, 32 * nb, 32 * nb, scr, FLANE); }
}

__device__ __forceinline__ void p1_norm(Frame& F) {
    const float* tab = (const float*)(F.ws + WS_TAB); unsigned char* XN = F.ws + WS_XN;
    const int gw = F.vcu * NWAVES + F.wave, NGW = F.G * NWAVES;
    LAS float* mA = (LAS float*)F.lds; LAS float* mC = mA + 5 * 1024;
#pragma unroll
    for (int q = 0; q < 10; ++q) { const int i = FTID + 512 * q, b = i >> 10, k = i & 1023; mA[i] = F.in[I_GATTN][k] * (1.0f + tab[TB_MOD + b * 6144 + 1024 + k]); mC[i] = tab[TB_MOD + b * 6144 + k]; }
    __syncthreads();
    constexpr int RB = 4;
    for (int m0 = gw; m0 < MQ; m0 += RB * NGW) {
        f32x4 v[RB][4]; float s[RB];
#pragma unroll
        for (int r = 0; r < RB; ++r) { const int m = m0 + r * NGW; s[r] = 0.f;
            if (m < MQ) { const float* xrow = m < TT ? F.in[I_X] + (size_t)m * DM : F.in[I_CTX] + (size_t)(m - TT) * DM; const f32x4* xr = (const f32x4*)xrow + FLANE;
#pragma unroll
                for (int j = 0; j < 4; ++j) v[r][j] = __builtin_nontemporal_load(xr + 64 * j); }
            else {
#pragma unroll
                for (int j = 0; j < 4; ++j) v[r][j] = (f32x4){0.f, 0.f, 0.f, 0.f}; } }
#pragma unroll
        for (int r = 0; r < RB; ++r) {
#pragma unroll
            for (int j = 0; j < 4; ++j) s[r] += (v[r][j].x * v[r][j].x + v[r][j].y * v[r][j].y) + (v[r][j].z * v[r][j].z + v[r][j].w * v[r][j].w); }
#pragma unroll
        for (int o = 1; o < 64; o <<= 1) {
#pragma unroll
            for (int r = 0; r < RB; ++r) s[r] += __shfl_xor(s[r], o); }
#pragma unroll
        for (int r = 0; r < RB; ++r) { const int m = m0 + r * NGW; if (m >= MQ) break;
            const int b = m < TT ? (m >> 13) : 4; const float rstd = 1.0f / sqrtf(s[r] * (1.f / DM) + NORM_EPS);
            const LAS f32x4* sa = (const LAS f32x4*)(mA + b * 1024) + FLANE; const LAS f32x4* sh = (const LAS f32x4*)(mC + b * 1024) + FLANE;
            unsigned* o4 = (unsigned*)(XN + (size_t)m * DM) + FLANE;
#pragma unroll
            for (int j = 0; j < 4; ++j) { const f32x4 a = sa[64 * j], c = sh[64 * j];
                const f32x4 h = (v[r][j] * rstd) * a + c;
                o4[64 * j] = pg8::pk4_fp8(pg8::sat8(h.x), pg8::sat8(h.y), pg8::sat8(h.z), pg8::sat8(h.w)); } }
    }
    float* tw = (float*)(F.ws + WS_TAB);
    bf16* w3 = (bf16*)(F.ws + WS_WR3);
    for (int i = (int)blockIdx.x * 512 + FTID; i < 4 * 1024 * 32; i += F.G * 512) { const int b = i >> 15, k = (i >> 5) & 1023, e = i & 31;
        const float w = F.in[I_GFFN][k] * (1.0f + tab[TB_MOD + b * 6144 + 4 * 1024 + k]) * F.in[I_WR][i & 32767];
        const unsigned h0 = pk2(w, w) & 0xffffu; const float r1 = w - __uint_as_float(h0 << 16);
        const unsigned h1 = pk2(r1, r1) & 0xffffu; const float r2 = r1 - __uint_as_float(h1 << 16);
        const unsigned h2 = pk2(r2, r2) & 0xffffu;
        const size_t o = ((size_t)((b * 2 + (k >> 9)) * 3) * 32 + ((k & 511) >> 4)) * 512 + (e + 32 * ((k >> 3) & 1)) * 8 + (k & 7);
        w3[o] = (bf16)h0; w3[o + 32 * 512] = (bf16)h1; w3[o + 2 * 32 * 512] = (bf16)h2; }
    if (F.wave == 0) for (int t = F.vcu; t < 128; t += F.G) { const int b = t >> 5, e = t & 31; float s = 0.f;
#pragma unroll
        for (int q = 0; q < 16; ++q) { const int k = FLANE + 64 * q; s += tab[TB_MOD + b * 6144 + 3 * 1024 + k] * F.in[I_WR][k * 32 + e]; }
        s = wave_sum(s); if (FLANE == 0) tw[TB_RC + t] = s + F.in[I_BR][e]; }
}

__device__ __forceinline__ void p3_qknorm(Frame& F) {
    const float* tab = (const float*)(F.ws + WS_TAB); bf16* P = (bf16*)(F.ws + WS_P);
    const int gw = F.vcu * NWAVES + F.wave, NGW = F.G * NWAVES;
    const int j = FLANE & 7;
    for (int task = gw; task < MQ * 4; task += NGW) {
        const int row = task >> 2, g = task & 3;
        const int colb = (g == 0) ? 0 : (g == 1) ? 512 : (g == 2) ? 1536 : 2048;
        const float* nw = ((g == 0) ? F.in[I_QND] : (g == 1) ? F.in[I_KND] : (g == 2) ? F.in[I_QNN] : F.in[I_KNN]) + 8 * j;
        bf16* p = P + (size_t)row * NQKV + colb + FLANE * 8;
        const v4u w = *(const v4u*)p;
        float v[8] = {bflo(w.x), bfhi(w.x), bflo(w.y), bfhi(w.y), bflo(w.z), bfhi(w.z), bflo(w.w), bfhi(w.w)};
        float ss = 0.f;
#pragma unroll
        for (int i = 0; i < 8; ++i) ss += v[i] * v[i];
        ss += __shfl_xor(ss, 1); ss += __shfl_xor(ss, 2); ss += __shfl_xor(ss, 4);
        const float rstd = 1.0f / sqrtf(ss * (1.f / 64.f) + NORM_EPS);
        const f32x4 n0 = *(const f32x4*)nw, n1 = *(const f32x4*)(nw + 4);
        v[0] *= rstd * n0.x; v[1] *= rstd * n0.y; v[2] *= rstd * n0.z; v[3] *= rstd * n0.w; v[4] *= rstd * n1.x; v[5] *= rstd * n1.y; v[6] *= rstd * n1.z; v[7] *= rstd * n1.w;
        if (g < 2 && row < TT) {
            const int s = row & (SEQ - 1), prow = s >> 6, pcol = s & 63, half = j >> 2, isx2 = (j >> 1) & 1;
            const float* ct = tab + (half ? TB_CCOS + pcol * 16 : TB_RCOS + prow * 16) + 8 * (j & 1);
            const float* st = tab + (half ? TB_CSIN + pcol * 16 : TB_RSIN + prow * 16) + 8 * (j & 1);
            const f32x4 c0 = *(const f32x4*)ct, c1 = *(const f32x4*)(ct + 4), s0 = *(const f32x4*)st, s1 = *(const f32x4*)(st + 4);
            const float cc[8] = {c0.x, c0.y, c0.z, c0.w, c1.x, c1.y, c1.z, c1.w}, sn[8] = {s0.x, s0.y, s0.z, s0.w, s1.x, s1.y, s1.z, s1.w};
#pragma unroll
            for (int i = 0; i < 8; ++i) { const float pr = __shfl_xor(v[i], 2); v[i] = isx2 ? (v[i] * cc[i] + pr * sn[i]) : (v[i] * cc[i] - pr * sn[i]); }
        }
        if (g == 0 || g == 2) {
#pragma unroll
            for (int i = 0; i < 8; ++i) v[i] *= att::C2;
        }
        v4u o; o.x = pk2(v[0], v[1]); o.y = pk2(v[2], v[3]); o.z = pk2(v[4], v[5]); o.w = pk2(v[6], v[7]);
        *(v4u*)p = o;
    }
}

__device__ __forceinline__ void p4_attention(Frame& F, char* lds) {
    const bf16* P = (const bf16*)(F.ws + WS_P); bf16* OD = (bf16*)(F.ws + WS_OD); bf16* MX = (bf16*)(F.ws + WS_MIX);
    const float* tab = (const float*)(F.ws + WS_TAB); const float mref_d = tab[TB_LAM + 1], mref_n = tab[TB_LAM + 2], lam = tab[TB_LAM];
    float* wnl = (float*)(lds + 143360);
    for (int i = FTID; i < 640; i += 512) wnl[i] = (i < 128) ? F.in[I_SUBLN][i] : F.in[I_ONN][i - 128];
    __syncthreads();
    const att::NextU none{nullptr, nullptr, 0, nullptr};
#ifndef MK_NO_DIFF
#define DIFF_UNITS(SH) { bool pre = false; for (int su = F.vcu; su < 512; su += F.G) { \
        const int bh = su >> 5, qb = su & 31, b = bh >> 2, h = bh & 3; const size_t row0 = (size_t)b * SEQ + qb * 256; \
        att::DiffPol<SH> pol; pol.Vg = P + 1024 + h * 128; pol.lat0 = (long)b * SEQ; pol.ctx0 = (long)TT + b * CTX; pol.mref = mref_d; \
        pol.Kg = P + 512 + h * 128; \
        const bf16* k2 = P + 512 + h * 128 + 64 + (size_t)b * SEQ * NQKV;        \
        const att::NextU n1{k2, k2 + (size_t)64 * NQKV, 448, P + row0 * NQKV + h * 128 + 64}; \
        att::attn_unit<4, att::DiffPol<SH>, 0, 1024>(P + row0 * NQKV + h * 128, pol, MX, 1024, 132, mref_d, lds, 0.f, nullptr, pre, n1); \
        pol.Kg = P + 512 + h * 128 + 64; \
        const int sn = su + F.G, bhn = sn >> 5, qbn = sn & 31, bn_ = bhn >> 2, hn_ = bhn & 3; \
        const bf16* k1n = P + 512 + hn_ * 128 + (size_t)bn_ * SEQ * NQKV; \
        const att::NextU n2 = sn < 512 ? att::NextU{k1n, k1n + (size_t)64 * NQKV, 512, P + ((size_t)bn_ * SEQ + qbn * 256) * NQKV + hn_ * 128} : none; \
        att::attn_unit<4, att::DiffPol<SH>, 1, 896>(P + row0 * NQKV + h * 128 + 64, pol, (bf16*)((unsigned char*)MX + row0 * 1024 + h * 128), 1024, 132, mref_d, lds, lam, wnl, true, n2); \
        pre = sn < 512; } }
    if (mref_d <= 100.0f) { DIFF_UNITS(false) } else { DIFF_UNITS(true) }
#undef DIFF_UNITS
#endif
#ifdef MK_DBG_PHASE
    if (blockIdx.x == 0 && FTID == 0) ((unsigned*)((float*)(F.ws + WS_TAB) + TB_RC + 128))[23] = (unsigned)__builtin_amdgcn_s_memrealtime();
#endif
#ifndef MK_NO_NA
    float* tabl = (float*)(lds + att::lds_bytes<4>());
    bool pre = false;
    for (int unit = F.vcu; unit < 1024; unit += F.G) {
        const int bh = unit >> 5, rb = unit & 31, b = bh >> 3, hn = bh & 7, r = rb * 4;
        int i0 = FTID; asm volatile("" : "+v"(i0));
        for (int i = i0; i < 15 * 31 + 1; i += 512) tabl[i] = i < 15 * 31 ? F.in[I_RPB][hn * 465 + i] * 1.4426950408889634f - mref_n : -INFINITY;
        const int un = unit + F.G, bhn = un >> 5, rn = (un & 31) * 4, bn_ = bhn >> 3, hnn = bhn & 7, rbn = (rn - 4) < 0 ? 0 : ((rn - 4) > 120 ? 120 : (rn - 4));
        const bf16* kn = P + 2048 + hnn * 64 + ((size_t)bn_ * SEQ + 64 * rbn) * NQKV;
        const att::NextU nxn = un < 1024 ? att::NextU{kn, kn + (size_t)64 * NQKV, 512, P + ((size_t)bn_ * SEQ + rn * 64) * NQKV + 1536 + hnn * 64} : none;
#define NA_UNIT(PAR) do { att::NaPol<PAR> pol; pol.Kg = P + 2048 + hn * 64; pol.Vg = P + 2560 + hn * 64; pol.lat0 = (long)b * SEQ; pol.ctx0 = (long)TT + b * CTX; \
        pol.mref = mref_n; pol.r = r; pol.rbase = (r - 4) < 0 ? 0 : ((r - 4) > 120 ? 120 : (r - 4)); pol.tab = tabl; \
        att::attn_unit<2, att::NaPol<PAR>, 2, 1024>(P + ((size_t)b * SEQ + r * 64) * NQKV + 1536 + hn * 64, pol, (bf16*)((unsigned char*)MX + ((size_t)b * SEQ + r * 64) * 1024 + 512 + hn * 64), 1024, 15, mref_n, lds, 0.f, wnl + 128 + hn * 64, pre, nxn); } while (0)
        if (F.wave & 1) NA_UNIT(1); else NA_UNIT(0);
#undef NA_UNIT
        pre = un < 1024;
    }
#endif
}

__device__ __forceinline__ void p5_mix(Frame& F) {
    const float* tab = (const float*)(F.ws + WS_TAB); const bf16* OD = (const bf16*)(F.ws + WS_OD); const bf16* ON = (const bf16*)(F.ws + WS_ON); bf16* MX = (bf16*)(F.ws + WS_MIX);
    const int gw = F.vcu * NWAVES + F.wave, NGW = F.G * NWAVES;
    const float lam = tab[TB_LAM];
    const int h = FLANE >> 4, e0 = (FLANE & 15) * 8;
    const f32x4 sl0 = *(const f32x4*)(F.in[I_SUBLN] + e0), sl1 = *(const f32x4*)(F.in[I_SUBLN] + e0 + 4);
    const f32x4 on0 = *(const f32x4*)(F.in[I_ONN] + FLANE * 8), on1 = *(const f32x4*)(F.in[I_ONN] + FLANE * 8 + 4);
    for (int t = gw; t < TT; t += NGW) {
        const v4u a = *(const v4u*)(OD + (size_t)t * 1024 + h * 256 + e0), c = *(const v4u*)(OD + (size_t)t * 1024 + h * 256 + 128 + e0);
        const v4u n = *(const v4u*)(ON + (size_t)t * 512 + FLANE * 8);
        float d[8] = {bflo(a.x) - lam * bflo(c.x), bfhi(a.x) - lam * bfhi(c.x), bflo(a.y) - lam * bflo(c.y), bfhi(a.y) - lam * bfhi(c.y),
                      bflo(a.z) - lam * bflo(c.z), bfhi(a.z) - lam * bfhi(c.z), bflo(a.w) - lam * bflo(c.w), bfhi(a.w) - lam * bfhi(c.w)};
        float ss = 0.f;
#pragma unroll
        for (int i = 0; i < 8; ++i) ss += d[i] * d[i];
        ss += __shfl_xor(ss, 1); ss += __shfl_xor(ss, 2); ss += __shfl_xor(ss, 4); ss += __shfl_xor(ss, 8);
        const float rs = 0.8f / sqrtf(ss * (1.f / 128.f) + NORM_EPS);
        v4u o; o.x = pk2(d[0] * rs * sl0.x, d[1] * rs * sl0.y); o.y = pk2(d[2] * rs * sl0.z, d[3] * rs * sl0.w); o.z = pk2(d[4] * rs * sl1.x, d[5] * rs * sl1.y); o.w = pk2(d[6] * rs * sl1.z, d[7] * rs * sl1.w);
        *(v4u*)(MX + (size_t)t * 1024 + h * 128 + e0) = o;
        float q[8] = {bflo(n.x), bfhi(n.x), bflo(n.y), bfhi(n.y), bflo(n.z), bfhi(n.z), bflo(n.w), bfhi(n.w)};
        float s2 = 0.f;
#pragma unroll
        for (int i = 0; i < 8; ++i) s2 += q[i] * q[i];
        s2 += __shfl_xor(s2, 1); s2 += __shfl_xor(s2, 2); s2 += __shfl_xor(s2, 4);
        const float r2 = 1.0f / sqrtf(s2 * (1.f / 64.f) + NORM_EPS);
        v4u o2; o2.x = pk2(q[0] * r2 * on0.x, q[1] * r2 * on0.y); o2.y = pk2(q[2] * r2 * on0.z, q[3] * r2 * on0.w); o2.z = pk2(q[4] * r2 * on1.x, q[5] * r2 * on1.y); o2.w = pk2(q[6] * r2 * on1.z, q[7] * r2 * on1.w);
        *(v4u*)(MX + (size_t)t * 1024 + 512 + FLANE * 8) = o2;
    }
}

__device__ __forceinline__ void p7_router(Frame& F) {
    const float* tab = (const float*)(F.ws + WS_TAB); unsigned* cnt = (unsigned*)(F.ws + WS_CTL) + CW_CNT;
    int* rt_e = (int*)(F.ws + WS_RT + RT_E); float* rt_g = (float*)(F.ws + WS_RT + RT_G); int* rt_pos = (int*)(F.ws + WS_RT + RT_POS);
    LAS unsigned* cntl = (LAS unsigned*)(F.lds + MISC_OFF); LAS unsigned* basel = cntl + 32; LAS float* rstdl = (LAS float*)(F.lds + MISC_OFF + 512);
    const int j = FLANE & 31, kh = FLANE >> 5;
    for (int tile = F.vcu; tile < TT / 128; tile += F.G) {
        if (FTID < 32) cntl[FTID] = 0u;
        __syncthreads();
        int te[4] = {0, 0, 0, 0}; float tg[4] = {0, 0, 0, 0}; unsigned lp[4] = {0, 0, 0, 0}; const int t = tile * 128 + 32 * F.wave + j;
        f32x16 acc = f32x16{}, accs = f32x16{}; float ss = 0.f;
        const int bt = (tile * 128) >> 13;
#pragma unroll 1
        for (int half = 0; half < 2; ++half) {
            if (half) __syncthreads();
            { const f32x4* g4 = (const f32x4*)(F.ws + WS_WR3 + (size_t)(bt * 2 + half) * 98304) + FTID; LAS f32x4* l4 = (LAS f32x4*)F.lds + FTID;
#pragma unroll
                for (int i = 0; i < 12; ++i) l4[512 * i] = g4[512 * i]; }
            __syncthreads();
            if (F.wave < 4) {
                const bf16* xr = (const bf16*)(F.ws + WS_X1) + (size_t)t * DM + half * 512 + 8 * kh;
                const LAS unsigned char* wp = F.lds + FLANE * 16;
#pragma unroll 16
                for (int s = 0; s < 32; ++s) {
                    const att::bf16x8 xv = *(const att::bf16x8*)(xr + 16 * s);
                    const att::bf16x8 a0 = *(const LAS att::bf16x8*)(wp + s * 1024), a1 = *(const LAS att::bf16x8*)(wp + (32 + s) * 1024), a2 = *(const LAS att::bf16x8*)(wp + (64 + s) * 1024);
                    acc = __builtin_amdgcn_mfma_f32_32x32x16_bf16(a0, xv, acc, 0, 0, 0);
                    acc = __builtin_amdgcn_mfma_f32_32x32x16_bf16(a1, xv, acc, 0, 0, 0);
                    acc = __builtin_amdgcn_mfma_f32_32x32x16_bf16(a2, xv, acc, 0, 0, 0);
                    accs = __builtin_amdgcn_mfma_f32_32x32x16_bf16(xv, xv, accs, 0, 0, 0);
                }
            }
        }
        if (F.wave < 4) {
#pragma unroll
            for (int r = 0; r < 16; ++r) ss += (att::crow(r, kh) == j) ? accs[r] : 0.f;
        }
        __syncthreads();
        if (F.wave < 4) {
            const int b = t >> 13;
            ss += __shfl_xor(ss, 32);
            const float rstd = 1.0f / sqrtf(ss * (1.f / DM) + NORM_EPS);
            if (kh == 0) rstdl[32 * F.wave + j] = rstd;
            float v[16];
#pragma unroll
            for (int r = 0; r < 16; ++r) v[r] = acc[r] * rstd + tab[TB_RC + b * 32 + att::crow(r, kh)];
            float cv[8]; int ce[8];
#pragma unroll
            for (int k = 0; k < 4; ++k) { float best = -INFINITY; int bi = 0;
#pragma unroll
                for (int r = 0; r < 16; ++r) if (v[r] > best) { best = v[r]; bi = r; }
#pragma unroll
                for (int r = 0; r < 16; ++r) if (r == bi) v[r] = -INFINITY;
                cv[k] = best; ce[k] = att::crow(bi, kh); }
#pragma unroll
            for (int k = 0; k < 4; ++k) { cv[4 + k] = __shfl_xor(cv[k], 32); ce[4 + k] = __shfl_xor(ce[k], 32); }
            float tv[4];
#pragma unroll
            for (int k = 0; k < 4; ++k) { float best = -INFINITY; int be = 1 << 30, bi = 0;
#pragma unroll
                for (int q = 0; q < 8; ++q) if (cv[q] > best || (cv[q] == best && ce[q] < be)) { best = cv[q]; be = ce[q]; bi = q; }
#pragma unroll
                for (int q = 0; q < 8; ++q) if (q == bi) cv[q] = -INFINITY;
                tv[k] = best; te[k] = be; }
            const float e1 = __expf(tv[1] - tv[0]), e2 = __expf(tv[2] - tv[0]), e3 = __expf(tv[3] - tv[0]); const float inv = 1.0f / (1.0f + e1 + e2 + e3);
            tg[0] = inv; tg[1] = e1 * inv; tg[2] = e2 * inv; tg[3] = e3 * inv;
            if (kh == 0) {
#pragma unroll
                for (int k = 0; k < 4; ++k) lp[k] = __hip_atomic_fetch_add(cntl + te[k], 1u, __ATOMIC_RELAXED, __HIP_MEMORY_SCOPE_WORKGROUP);
            }
        }
        __syncthreads();
        if (FTID < 32) { const unsigned c = cntl[FTID]; basel[FTID] = c ? atomicAdd(cnt + FTID, c) : 0u; }
        __syncthreads();
        if (F.wave < 4 && kh == 0) {
#pragma unroll
            for (int k = 0; k < 4; ++k) { rt_e[t * 4 + k] = te[k]; rt_g[t * 4 + k] = tg[k]; rt_pos[t * 4 + k] = (int)(basel[te[k]] + lp[k]); }
        }
        { const int c0 = 16 * FLANE; f32x4 mA4[4], mC4[4];
#pragma unroll
          for (int q = 0; q < 4; ++q) { const f32x4 g = *(const f32x4*)(F.in[I_GFFN] + c0 + 4 * q), sc = *(const f32x4*)(tab + TB_MOD + bt * 6144 + 4 * 1024 + c0 + 4 * q);
              mA4[q] = g * (sc + 1.0f); mC4[q] = *(const f32x4*)(tab + TB_MOD + bt * 6144 + 3 * 1024 + c0 + 4 * q); }
          unsigned char* H2 = F.ws + WS_XG;
#pragma unroll 8
          for (int r = 0; r < 16; ++r) { const int tl = 16 * F.wave + r; const int tt = tile * 128 + tl; const float rs = rstdl[tl];
              const v4u* xr = (const v4u*)((const bf16*)(F.ws + WS_X1) + (size_t)tt * DM) + 2 * FLANE; const v4u x0 = xr[0], x1v = xr[1];
              const unsigned xw[8] = {x0.x, x0.y, x0.z, x0.w, x1v.x, x1v.y, x1v.z, x1v.w}; v4u o; unsigned ow[4];
#pragma unroll
              for (int q = 0; q < 4; ++q) { const f32x4 xv = {bflo(xw[2 * q]), bfhi(xw[2 * q]), bflo(xw[2 * q + 1]), bfhi(xw[2 * q + 1])}; const f32x4 h = (xv * rs) * mA4[q] + mC4[q];
                  ow[q] = pg8::pk4_fp8(pg8::sat8(h.x), pg8::sat8(h.y), pg8::sat8(h.z), pg8::sat8(h.w)); }
              o.x = ow[0]; o.y = ow[1]; o.z = ow[2]; o.w = ow[3];
              *(v4u*)(H2 + (size_t)tt * DM + c0) = o; } }
        __syncthreads();
    }
}

__device__ __forceinline__ int pad_starts(const unsigned* cnt, int lane) {
    const int c = lane < 32 ? (int)__hip_atomic_load(cnt + lane, __ATOMIC_RELAXED, __HIP_MEMORY_SCOPE_AGENT) : 0;
    int p = (c + 255) & ~255, incl = p;
#pragma unroll
    for (int o = 1; o < 64; o <<= 1) { const int n = __shfl_up(incl, o); if (lane >= o) incl += n; }
    return incl - p;
}

__device__ __forceinline__ void p8_scatter(Frame& F) {
    const unsigned* cnt = (const unsigned*)(F.ws + WS_CTL) + CW_CNT;
    const int* rt_e = (const int*)(F.ws + WS_RT + RT_E); const int* rt_pos = (const int*)(F.ws + WS_RT + RT_POS); int* rt_slot = (int*)(F.ws + WS_RT + RT_SLOT);
    unsigned* rt_tok = (unsigned*)(F.ws + WS_RT + RT_TOK);
    const int gw = F.vcu * NWAVES + F.wave, NGW = F.G * NWAVES;
    const int pst = pad_starts(cnt, FLANE);
    LAS int* pstl = (LAS int*)(F.lds + MISC_OFF);
    if (F.wave == 0 && FLANE < 33) pstl[FLANE] = pst;
    __syncthreads();
    for (int i = (int)blockIdx.x * 512 + FTID; i < TT * TOPK; i += F.G * 512) { const int slot = pstl[rt_e[i]] + rt_pos[i]; rt_slot[i] = slot; rt_tok[slot] = (unsigned)(i >> 2) * (unsigned)DM; }
    for (int e = gw; e < NE; e += NGW) { const int c = (int)__hip_atomic_load(cnt + e, __ATOMIC_RELAXED, __HIP_MEMORY_SCOPE_AGENT), s0 = __shfl(pst, e) + c, s1 = __shfl(pst, e + 1);
        for (int i = s0 + FLANE; i < s1; i += 64) rt_tok[i] = 0u; }
}

__device__ __forceinline__ int moe_block_table(Frame& F, LAS int* bexp) {
    const unsigned* cnt = (const unsigned*)(F.ws + WS_CTL) + CW_CNT;
    const int pst = pad_starts(cnt, FLANE);
    const int total = __shfl(pst, 32) >> 8;
    if (F.wave == 0) {
        const int nxt = __shfl_down(pst, 1);
        if (FLANE < 32) for (int bl = pst >> 8; bl < (nxt >> 8); ++bl) bexp[bl] = FLANE;
    }
    __syncthreads();
    return __builtin_amdgcn_readfirstlane(total);
}

__device__ __forceinline__ void p11_combine(Frame& F) {
    const float* tab = (const float*)(F.ws + WS_TAB); const unsigned char* Y = F.ws + WS_Y;
    const float* rt_g = (const float*)(F.ws + WS_RT + RT_G); const int* rt_slot = (const int*)(F.ws + WS_RT + RT_SLOT);
    const int gw = F.vcu * NWAVES + F.wave, NGW = F.G * NWAVES;
    constexpr int RB = 2;
    for (int t0 = gw; t0 < TT; t0 += RB * NGW) {
        int my_slot[RB]; float my_g[RB];
#pragma unroll
        for (int r = 0; r < RB; ++r) { const int t = t0 + r * NGW; const int tt = t < TT ? t : 0; my_slot[r] = rt_slot[tt * 4 + (FLANE & 3)]; my_g[r] = rt_g[tt * 4 + (FLANE & 3)]; }
        unsigned yw[RB][4][4]; v2u xw[RB][4];
#pragma unroll
        for (int r = 0; r < RB; ++r) { const int t = t0 + r * NGW; const int tt = t < TT ? t : 0;
            const v2u* xr = (const v2u*)((const bf16*)(F.ws + WS_X1) + (size_t)tt * DM) + FLANE;
#pragma unroll
            for (int jj = 0; jj < 4; ++jj) xw[r][jj] = xr[64 * jj];
#pragma unroll
            for (int k = 0; k < 4; ++k) { const int slot = __shfl(my_slot[r], k); const unsigned* yr = (const unsigned*)(Y + (size_t)slot * DM) + FLANE;
#pragma unroll
                for (int jj = 0; jj < 4; ++jj) yw[r][k][jj] = __builtin_nontemporal_load(yr + 64 * jj); } }
#pragma unroll
        for (int r = 0; r < RB; ++r) { const int t = t0 + r * NGW; if (t >= TT) break;
            const int b = t >> 13; f32x4* xo = (f32x4*)(F.out + (size_t)t * DM) + FLANE;
            const f32x4* g2 = (const f32x4*)(tab + TB_MOD + b * 6144 + 5 * 1024) + FLANE;
#pragma unroll
            for (int jj = 0; jj < 4; ++jj) { f32x4 acc = (f32x4){0.f, 0.f, 0.f, 0.f};
#pragma unroll
                for (int k = 0; k < 4; ++k) { const float g = __shfl(my_g[r], k); const int w = (int)yw[r][k][jj];
                    acc += (f32x4){__builtin_amdgcn_cvt_f32_fp8(w, 0), __builtin_amdgcn_cvt_f32_fp8(w, 1), __builtin_amdgcn_cvt_f32_fp8(w, 2), __builtin_amdgcn_cvt_f32_fp8(w, 3)} * g; }
                const v2u x2 = xw[r][jj];
                __builtin_nontemporal_store((f32x4){bflo(x2.x), bfhi(x2.x), bflo(x2.y), bfhi(x2.y)} + g2[64 * jj] * acc, xo + 64 * jj); }
#ifdef MK_DBG_PHASE
            __builtin_amdgcn_s_waitcnt(0); if (t == 0 && FLANE == 0) { const unsigned* ts_ = (const unsigned*)(tab + TB_RC + 128); F.out[0] += 8.0f + (float)(ts_[MK_DBG_B] - ts_[MK_DBG_A]) * (0.01f / (MK_DBG_DIV)); }
#endif
        }
    }
}

#define XB_TMO      128
#define XB_XCNT(j)  (256  + 64 * (j))
#define XB_XSUB(j)  (1280 + 64 * (j))
#define XB_XGEN(j)  (2304 + 64 * (j))
#define XB_TOP      3328
#define XB_TOPGEN   3392
#define XCD_BAR_WORDS 3456
#define XB_SPIN_CAP (1u << 18)

__device__ __forceinline__ unsigned xb_ld(unsigned* p)              { return __hip_atomic_load(p, __ATOMIC_RELAXED, __HIP_MEMORY_SCOPE_AGENT); }
__device__ __forceinline__ unsigned xb_add(unsigned* p, unsigned v) { return __hip_atomic_fetch_add(p, v, __ATOMIC_RELAXED, __HIP_MEMORY_SCOPE_AGENT); }
__device__ __forceinline__ unsigned xb_xcc_id() { return (unsigned)__builtin_amdgcn_s_getreg((3 << 11) | 20) & 0xFu; }
#define XB_SPIN(cond, bar) do { unsigned _sp = 0; while (cond) { __builtin_amdgcn_s_sleep(1); \
    if ((++_sp & 255u) == 0u) { if (xb_ld(&(bar)[XB_TMO])) break; if (_sp > XB_SPIN_CAP) { atomicAdd(&(bar)[XB_TMO], 1u); break; } } } } while (0)

struct XcdBarrier {
    unsigned* bar; unsigned x;
    volatile LAS unsigned* st;
};

__device__ __forceinline__ XcdBarrier xcd_barrier_post(unsigned* bar, volatile LAS unsigned* st) {
    XcdBarrier b; b.bar = bar; b.x = xb_xcc_id(); b.st = st;
    if (threadIdx.x == 0) (void)xb_add(&bar[XB_XCNT(b.x)], 1u);
    return b;
}
__device__ __forceinline__ void xcd_barrier_complete(unsigned* bar, unsigned x, unsigned& nloc, unsigned& nx) {
    const unsigned G = gridDim.x * gridDim.y * gridDim.z;
    unsigned sum, cnt, mine, sp = 0u;
    for (;;) {
        sum = 0u; cnt = 0u; mine = 0u;
#pragma unroll
        for (unsigned j = 0; j < 16; ++j) { const unsigned c = xb_ld(&bar[XB_XCNT(j)]); sum += c; cnt += (c > 0u) ? 1u : 0u; mine = (j == x) ? c : mine; }
        if (sum == G) break;
        __builtin_amdgcn_s_sleep(1);
        if ((++sp & 255u) == 0u) { if (xb_ld(&bar[XB_TMO])) break; if (sp > XB_SPIN_CAP) { atomicAdd(&bar[XB_TMO], 1u); break; } }
    }
    nloc = mine > 0u ? mine : 1u; nx = cnt > 0u ? cnt : 1u;
}

__device__ __forceinline__ void xcd_barrier(const XcdBarrier& b) {
    asm volatile("s_waitcnt vmcnt(0)" ::: "memory");
    __syncthreads();
    if (threadIdx.x == 0) {
        unsigned* bar = b.bar;
        __builtin_amdgcn_s_waitcnt(0);
        unsigned nloc = b.st[0], nx = b.st[1];
        if (nloc == 0u) { xcd_barrier_complete(bar, b.x, nloc, nx); b.st[0] = nloc; b.st[1] = nx; }
        const unsigned old = xb_add(&bar[XB_XSUB(b.x)], 1u);
        const unsigned gen = old / nloc;
        if (old + 1u == (gen + 1u) * nloc) {
            __builtin_amdgcn_fence(__ATOMIC_RELEASE, "agent");
            asm volatile("s_waitcnt vmcnt(0)" ::: "memory");
            const unsigned og = xb_add(&bar[XB_TOP], 1u);
            const unsigned tg = og / nx;
            if (og + 1u == (tg + 1u) * nx) xb_add(&bar[XB_TOPGEN], 1u);
            else XB_SPIN(xb_ld(&bar[XB_TOPGEN]) == tg, bar);
            __builtin_amdgcn_fence(__ATOMIC_ACQUIRE, "agent");
            xb_add(&bar[XB_XGEN(b.x)], 1u);
            asm volatile("s_waitcnt vmcnt(0)" ::: "memory");
        } else {
            XB_SPIN(xb_ld(&bar[XB_XGEN(b.x)]) == gen, bar);
            __builtin_amdgcn_fence(__ATOMIC_ACQUIRE, "agent");
            asm volatile("s_waitcnt vmcnt(0)" ::: "memory");
        }
    }
    __syncthreads();
}

struct Args { const float* in[N_IN]; float* out; unsigned char* ws; int ph_lo, ph_hi, li, pad; };
__global__ void __launch_bounds__(NWAVES * 64, 2) mk_fwd(Args args) {
    extern __shared__ __attribute__((aligned(16))) unsigned char lds[];
    Frame F;
    F.lds = (LAS unsigned char*)lds;
    F.wave = __builtin_amdgcn_readfirstlane((int)threadIdx.x >> 6);
    F.G = gridDim.x; { const int bx = blockIdx.x; F.vcu = (F.G % 8 == 0) ? (bx % 8) * (F.G / 8) + bx / 8 : bx; }
#pragma unroll
    for (int i = 0; i < N_IN; ++i) F.in[i] = args.in[i];
    F.out = args.out; F.ws = args.ws;
    const int lo = args.ph_lo, hi = args.ph_hi;
    volatile LAS unsigned* bst = (volatile LAS unsigned*)(F.lds + LDS_BYTES - 16);
    if (FTID < 2) bst[FTID] = 0u;
    __syncthreads();
    XcdBarrier bar; bar.bar = (unsigned*)(F.ws + WS_CTL) + CW_BAR + args.li * XCD_BAR_WORDS; bar.x = 0; bar.st = nullptr;
    if (hi - lo > 1) bar = xcd_barrier_post((unsigned*)(F.ws + WS_CTL) + CW_BAR + args.li * XCD_BAR_WORDS, bst);
#ifndef MK_PHASE_MASK
#define MK_PHASE_MASK 0xFFF
#endif
#define IN(k) (((MK_PHASE_MASK >> (k)) & 1) && lo <= (k) && (k) < hi)
    if (args.pad != 0) cg::this_grid().sync();
#ifdef MK_DBG_PHASE
    unsigned* tsb = (unsigned*)((float*)(F.ws + WS_TAB) + TB_RC + 128);
#define STAMP(k) do { if (blockIdx.x == 0 && FTID == 0) tsb[(k)] = (unsigned)__builtin_amdgcn_s_memrealtime(); } while (0)
    STAMP(0);
#else
#define STAMP(k) do {} while (0)
#endif
#define SEAM(k) do { if (IN(k) && IN((k) + 1)) { xcd_barrier(bar); } STAMP((k) + 1); } while (0)
    if (IN(0)) { p0_prologue(F); STAMP(12); } SEAM(0);
    if (IN(1)) { p1_norm(F); STAMP(19); } SEAM(1);
    if (IN(2)) {
        pg8::Gemm g{(const bf16*)(F.ws + WS_XN), (const bf16*)(F.ws + WS_WQKV), MQ, NQKV, DM, 0};
        pg8::StaticOrder S; S.init(MQ, NQKV, F.G, (int)blockIdx.x);
        typedef pg8::EpiQKV<TB_NW, TB_RCOS, TB_RSIN, TB_CCOS, TB_CSIN> EpiQ;
        EpiQ E{(bf16*)(F.ws + WS_P), (const float*)(F.ws + WS_TAB), (LAS float*)(F.lds + MISC_OFF + 5120), att::C2};
        pg8::gemm_phase<EpiQ, pg8::StaticOrder, true, true, 1>(F.lds, g, S, E); STAMP(16);
        { const int nd = p0_deferred(F.G), rem = (MQ / 256 * (NQKV / 256)) % F.G;
          if (nd > 0 && (int)blockIdx.x >= rem) { __syncthreads(); p0_convert(F, ((int)blockIdx.x - rem) * NWAVES + F.wave, (F.G - rem) * NWAVES, P0_N8 - nd, P0_N8); } }
    } SEAM(2);
#ifdef MK_SEPARATE_QKNORM
    if (IN(3)) { p3_qknorm(F); } SEAM(3);
#endif
    if (IN(4)) { p4_attention(F, (char*)lds); STAMP(17); } SEAM(4);
#ifdef MK_SEPARATE_MIX
    if (IN(5)) { p5_mix(F); } SEAM(5);
#endif
    if (IN(6)) {
        pg8::Gemm g{(const bf16*)(F.ws + WS_MIX), (const bf16*)(F.ws + WS_WO), TT, DM, DM, 0};
        pg8::StaticOrder S; S.init(TT, DM, F.G, (int)blockIdx.x);
        pg8::EpiOut E{F.in[I_X], (bf16*)(F.ws + WS_X1), (const float*)(F.ws + WS_TAB) + TB_MOD};
        pg8::gemm_phase<pg8::EpiOut, pg8::StaticOrder, true, true, 1>(F.lds, g, S, E); STAMP(18);
    } SEAM(6);
    if (IN(7)) { p7_router(F); STAMP(20); } SEAM(7);
    if (IN(8)) { p8_scatter(F); STAMP(21); } SEAM(8);
    if (IN(9)) {
        LAS int* bexp = (LAS int*)(F.lds + MISC_OFF + 1024);
        const int nblk = moe_block_table(F, bexp);
        pg8::Gemm g{(const bf16*)(F.ws + WS_XG), (const bf16*)(F.ws + WS_WGU), MPAD, 2048, DM, (size_t)2048 * 1024};
        g.atab = (const unsigned*)(F.ws + WS_RT + RT_TOK); g.tkl = (LAS unsigned*)(F.lds + MISC_OFF + 5120);
        pg8::MoeOrder S; S.init(nblk, 8, F.G, (int)blockIdx.x, bexp);
        pg8::EpiSwiGLU E{F.ws + WS_ACT, F.in[I_BGU], (LAS float*)(F.lds + MISC_OFF + 13312)};
        pg8::gemm_phase<pg8::EpiSwiGLU, pg8::MoeOrder, true, true, 1, true>(F.lds, g, S, E); STAMP(14);
    } SEAM(9);
    if (IN(10)) {
        LAS int* bexp = (LAS int*)(F.lds + MISC_OFF + 1024);
        const int nblk = moe_block_table(F, bexp);
        pg8::Gemm g{(const bf16*)(F.ws + WS_ACT), (const bf16*)(F.ws + WS_WDN), MPAD, 1024, DM, (size_t)1024 * 1024};
        pg8::MoeOrder S; S.init(nblk, 4, F.G, (int)blockIdx.x, bexp);
        pg8::EpiDown E{F.ws + WS_Y, F.in[I_BD], (LAS float*)(F.lds + MISC_OFF + 13312)};
        pg8::gemm_phase<pg8::EpiDown, pg8::MoeOrder, true, true, 1>(F.lds, g, S, E); STAMP(15);
    } SEAM(10);
    if (IN(11)) { p11_combine(F); }
#ifdef MK_DBG_TAIL
    xcd_barrier(bar); STAMP(13);
    if (blockIdx.x == 0 && FTID == 0) { __builtin_amdgcn_s_waitcnt(0); const unsigned* ts_ = (const unsigned*)((const float*)(F.ws + WS_TAB) + TB_RC + 128); F.out[0] += 8.0f + (float)(ts_[13] - ts_[11]) * (0.01f / 2.0f); }
#endif
#undef IN
#undef SEAM
}

extern "C" void kernel_launch(void* const* d_in, const int* in_sizes, int n_in, void* d_out, int out_size, void* d_ws, size_t ws_size, hipStream_t stream) {
    static int grid = 0;
    if (grid == 0) {
        if (n_in != N_IN || in_sizes[0] != TT * DM || out_size != TT * DM || ws_size < WS_END) { fprintf(stderr, "kernel_launch: unexpected shapes (n_in %d, in0 %d, out %d, ws %zu)\n", n_in, n_in > 0 ? in_sizes[0] : -1, out_size, ws_size); grid = -1; return; }
        int dev = 0, cus = 0, per_cu = 0;
        if (hipGetDevice(&dev) != hipSuccess || hipDeviceGetAttribute(&cus, hipDeviceAttributeMultiprocessorCount, dev) != hipSuccess) { grid = -1; return; }
        if (hipFuncSetAttribute((const void*)mk_fwd, hipFuncAttributeMaxDynamicSharedMemorySize, LDS_BYTES) != hipSuccess) { fprintf(stderr, "kernel_launch: hipFuncSetAttribute failed\n"); grid = -1; return; }
        if (hipOccupancyMaxActiveBlocksPerMultiprocessor(&per_cu, (const void*)mk_fwd, NWAVES * 64, LDS_BYTES) != hipSuccess || per_cu < 1) { fprintf(stderr, "kernel_launch: occupancy query reports %d\n", per_cu); (void)hipGetLastError(); per_cu = 1; }
        grid = cus;
    }
    if (grid < 0) return;
    (void)hipMemsetAsync((char*)d_ws + WS_CTL, 0, CTL_ZERO_BYTES, stream);
    Args a{};
    for (int i = 0; i < N_IN; ++i) a.in[i] = (const float*)d_in[i];
    a.out = (float*)d_out; a.ws = (unsigned char*)d_ws;
    int lo_[3] = {0, 0, 0}, hi_[3] = {N_PHASES, 0, 0}, nl = 1;
    if (MK_PROBE_PHASE >= 0) { nl = 0; lo_[nl] = 0; hi_[nl] = MK_PROBE_PHASE + 1; ++nl; lo_[nl] = MK_PROBE_PHASE; hi_[nl] = MK_PROBE_PHASE + 1; ++nl; if (MK_PROBE_PHASE + 1 < N_PHASES) { lo_[nl] = MK_PROBE_PHASE + 1; hi_[nl] = N_PHASES; ++nl; } }
#ifdef MK_TWICE
    nl = 2; lo_[1] = 0; hi_[1] = N_PHASES;
#endif
    for (int li = 0; li < nl; ++li) {
#ifdef MK_TWICE
        if (li == 1) (void)hipMemsetAsync((char*)d_ws + WS_CTL, 0, CTL_ZERO_BYTES, stream);
#endif
        a.ph_lo = lo_[li]; a.ph_hi = hi_[li]; a.li = (MK_PROBE_PHASE >= 0) ? li : 0;
        void* params[] = {&a};
        const hipError_t e = hipLaunchCooperativeKernel((const void*)mk_fwd, dim3(grid), dim3(NWAVES * 64), params, LDS_BYTES, stream);
        if (e != hipSuccess) fprintf(stderr, "kernel_launch: cooperative launch failed: %s (grid %d)\n", hipGetErrorString(e), grid);
    }
}
```
